# Optimizing an MI355X kernel written in HIP

```python
import math
import jax
import jax.numpy as jnp
from jax import lax
import numpy as np

D_MODEL = 1024
BATCH = 32
SEQ = 256
DEPTH = 2
DEC_BATCH = 2
DEC_SEQ = 4096
PAST_LEN = 256

GRID_W = 64
ROPE_BASE = 10000.0
EPS = 1e-6
NEG_INF = -1e30
Q_BLOCK = 128
N_BRANCH = 4
BRANCH_W = 256

A_HEADS = 4
A_KV_HEADS = 2
A_GROUP = A_HEADS // A_KV_HEADS
A_HD = 64
A_WINDOW = 128
A_SCALE = A_HD ** -0.5
B_HEADS = 4
B_Q_RANK = 192
B_KV_RANK = 128
B_NOPE = 64
B_ROPE = 32
B_VD = 64
B_SCALE = (B_NOPE + B_ROPE) ** -0.5
C_GROUPS = 4
C_GW = 64
C_WINDOWS = (2, 4, 8, 16)
D_HEADS = 4
D_DK = 64
D_DV = 64
D_CONV = 5
D_CHUNK = 64
FF_RAW = -(-8 * D_MODEL // 3)
D_FF = -(-FF_RAW // 256) * 256

IN_SIZES = (A_HEADS * A_HD, A_KV_HEADS * A_HD, A_KV_HEADS * A_HD,
            B_Q_RANK, B_KV_RANK, B_ROPE,
            C_GROUPS * C_GW,
            D_HEADS * (2 * D_DK + D_DV), D_HEADS * D_DV, 2 * D_HEADS, 2 * D_HEADS,
            N_BRANCH * D_MODEL)
P_IN = sum(IN_SIZES)

kernel_name = 'hybrid_prefix_diffusion_step'


def _split_points(sizes):
    pts, acc = [], 0
    for s in sizes[:-1]:
        acc += s
        pts.append(acc)
    return pts


def rmsnorm(x, g):
    xf = x.astype(jnp.float32)
    y = xf * lax.rsqrt(jnp.mean(xf * xf, axis=-1, keepdims=True) + EPS)
    return (y * g.astype(jnp.float32)).astype(x.dtype)


def l2norm(x):
    return x * lax.rsqrt(jnp.sum(x * x, axis=-1, keepdims=True) + EPS)


def axial_rope_tables(n_tokens, dim):
    n_rows = n_tokens // GRID_W
    row = jnp.repeat(jnp.arange(n_rows), GRID_W).astype(jnp.float32)
    col = jnp.tile(jnp.arange(GRID_W), n_rows).astype(jnp.float32)
    nfreq = dim // 4
    inv = ROPE_BASE ** (-jnp.arange(nfreq, dtype=jnp.float32) / nfreq)
    ang_r = row[:, None] * inv
    ang_c = col[:, None] * inv
    ang = jnp.concatenate([ang_r, ang_r, ang_c, ang_c], axis=-1)
    return jnp.cos(ang), jnp.sin(ang)


def apply_rope(x, cos, sin):
    xf = x.astype(jnp.float32)
    x1, x2, x3, x4 = jnp.split(xf, 4, axis=-1)
    rot = jnp.concatenate([-x2, x1, -x4, x3], axis=-1)
    return (xf * cos[:, None, :] + rot * sin[:, None, :]).astype(x.dtype)


def joint_softmax(scores, sink=None):
    sizes = [s.shape[-1] for s in scores]
    s = jnp.concatenate(scores, axis=-1)
    if sink is not None:
        s = jnp.concatenate([s, jnp.broadcast_to(sink.astype(jnp.float32), s.shape[:-1] + (1,))], axis=-1)
    p = jax.nn.softmax(s, axis=-1)
    return jnp.split(p[..., :sum(sizes)], _split_points(sizes), axis=-1)


def dense_attention(q, k, v, scale, sink=None, q_ctx=None, k_ctx=None, v_ctx=None):
    B, T, KVH, G, d = q.shape
    nb = T // Q_BLOCK
    with_ctx = q_ctx is not None

    def blocks(a):
        return jnp.moveaxis(a.reshape((B, nb, Q_BLOCK) + a.shape[2:]), 1, 0)

    xs = (blocks(q),) + ((blocks(q_ctx),) if with_ctx else ())

    def one_block(qs):
        scores = [jnp.einsum('bqhgd,bshd->bhgqs', qs[0], k, preferred_element_type=jnp.float32) * scale]
        vals = [v]
        if with_ctx:
            scores.append(jnp.einsum('bqhgd,bshd->bhgqs', qs[1], k_ctx, preferred_element_type=jnp.float32) * scale)
            vals.append(v_ctx)
        probs = joint_softmax(scores, sink)
        out = jnp.einsum('bhgqs,bshe->bqhge', probs[0].astype(vals[0].dtype), vals[0])
        for p, vv in zip(probs[1:], vals[1:]):
            out = out + jnp.einsum('bhgqs,bshe->bqhge', p.astype(vv.dtype), vv)
        return out

    out = lax.map(one_block, xs)
    return jnp.moveaxis(out, 0, 1).reshape(B, T, -1)


def window_attention(q, k, v, q_ctx, k_ctx, v_ctx, sink):
    B, T, KVH, G, d = q.shape
    nb = T // Q_BLOCK
    pad = [(0, 0), (Q_BLOCK, Q_BLOCK), (0, 0), (0, 0)]

    def band(a):
        ap = jnp.pad(a, pad).reshape(B, nb + 2, Q_BLOCK, KVH, a.shape[-1])
        return jnp.concatenate([ap[:, :-2], ap[:, 1:-1], ap[:, 2:]], axis=2)

    kb, vb = band(k), band(v)
    qb = q.reshape(B, nb, Q_BLOCK, KVH, G, d)
    qcb = q_ctx.reshape(B, nb, Q_BLOCK, KVH, G, d)
    q_pos = jnp.arange(T).reshape(nb, Q_BLOCK)
    k_pos = (jnp.arange(nb)[:, None] - 1) * Q_BLOCK + jnp.arange(3 * Q_BLOCK)[None, :]
    valid = ((jnp.abs(q_pos[:, :, None] - k_pos[:, None, :]) <= A_WINDOW)
             & (k_pos >= 0)[:, None, :] & (k_pos < T)[:, None, :])
    s_loc = jnp.einsum('bnqhgd,bnshd->bnhgqs', qb, kb, preferred_element_type=jnp.float32) * A_SCALE
    s_loc = jnp.where(valid[None, :, None, None], s_loc, NEG_INF)
    s_ctx = jnp.einsum('bnqhgd,bchd->bnhgqc', qcb, k_ctx, preferred_element_type=jnp.float32) * A_SCALE
    p_loc, p_ctx = joint_softmax([s_loc, s_ctx], sink)
    out = (jnp.einsum('bnhgqs,bnshe->bnqhge', p_loc.astype(vb.dtype), vb)
           + jnp.einsum('bnhgqc,bche->bnqhge', p_ctx.astype(v_ctx.dtype), v_ctx))
    return out.reshape(B, T, -1)


def mla_keys_values(ckv, k_pe, w_ukv):
    B, S, _ = ckv.shape
    kv = jnp.matmul(ckv, w_ukv).reshape(B, S, B_HEADS, B_NOPE + B_VD)
    k_pe_h = jnp.broadcast_to(k_pe[:, :, None, :], (B, S, B_HEADS, B_ROPE)).astype(kv.dtype)
    return jnp.concatenate([kv[..., :B_NOPE], k_pe_h], axis=-1), kv[..., B_NOPE:]


def pool_mixer(x, w_pool, scale):
    B, T, _ = x.shape
    xf = x.astype(jnp.float32).reshape(B, T, C_GROUPS, C_GW)
    cs = jnp.concatenate([jnp.zeros((B, 1, C_GROUPS, C_GW), jnp.float32), jnp.cumsum(xf, axis=1)], axis=1)
    t = jnp.arange(T)
    outs = []
    for gi, w in enumerate(C_WINDOWS):
        lo = jnp.clip(t - w // 2, 0, T)
        hi = jnp.clip(t + w - w // 2, 0, T)
        win_sum = jnp.take(cs[:, :, gi], hi, axis=1) - jnp.take(cs[:, :, gi], lo, axis=1)
        outs.append(win_sum / (hi - lo).astype(jnp.float32)[None, :, None] - xf[:, :, gi])
    y = jnp.stack(outs, axis=2)
    y = jnp.einsum('btgc,gcd->btgd', y, w_pool.astype(jnp.float32))
    return (y.reshape(B, T, -1) * scale.astype(jnp.float32)).astype(x.dtype)


def short_conv(x, w):
    C = x.shape[-1]
    pad = D_CONV // 2
    return lax.conv_general_dilated(x, w[:, None, :].astype(x.dtype), window_strides=(1,),
                                    padding=[(pad, pad)], dimension_numbers=('NWC', 'WIO', 'NWC'),
                                    feature_group_count=C)


def gated_delta_chunked(q, k, v, g, beta, s0):
    B, H, T, DK = q.shape
    DV = v.shape[-1]
    C = D_CHUNK
    N = T // C

    def chunks(a):
        return a.reshape((B, H, N, C) + a.shape[3:])

    q, k, v, g, beta = chunks(q), chunks(k), chunks(v), chunks(g), chunks(beta)
    g = jnp.cumsum(g, axis=-1)
    incl = jnp.tril(jnp.ones((C, C), bool))
    strict = jnp.tril(jnp.ones((C, C), bool), -1)
    decay = jnp.exp(jnp.where(incl, g[..., :, None] - g[..., None, :], -jnp.inf))
    k_beta = k * beta[..., None]
    lmat = jnp.where(strict, jnp.einsum('bhncd,bhnsd->bhncs', k_beta, k) * decay, 0.0)
    eye = jnp.eye(C, dtype=jnp.float32)
    rhs = jnp.concatenate([v * beta[..., None], k_beta * jnp.exp(g)[..., None]], axis=-1)
    sol = lax.linalg.triangular_solve(lmat + eye, rhs, left_side=True, lower=True, unit_diagonal=True)
    u, w = sol[..., :DV], sol[..., DV:]
    a_intra = jnp.einsum('bhncd,bhnsd->bhncs', q, k) * decay

    def step(S, inp):
        q_i, k_i, u_i, w_i, g_i, a_i = inp
        v_new = u_i - jnp.einsum('bhcd,bhde->bhce', w_i, S)
        o_i = (jnp.einsum('bhcd,bhde->bhce', q_i * jnp.exp(g_i)[..., None], S)
               + jnp.einsum('bhcs,bhse->bhce', a_i, v_new))
        g_last = g_i[..., -1:]
        S = (S * jnp.exp(g_last)[..., None]
             + jnp.einsum('bhcd,bhce->bhde', k_i * jnp.exp(g_last - g_i)[..., None], v_new))
        return S, o_i

    xs = tuple(jnp.moveaxis(a, 2, 0) for a in (q, k, u, w, g, a_intra))
    s_final, o = lax.scan(step, s0.astype(jnp.float32), xs)
    return jnp.moveaxis(o, 0, 2).reshape(B, H, T, DV), s_final


def gdn_mixer(qkv, z, beta_raw, alpha_raw, conv_w, a_log, dt_bias, g_norm, s0_f, s0_b):
    B, T, _ = qkv.shape
    u = jax.nn.silu(short_conv(qkv, conv_w)).astype(jnp.float32)
    q, k, v = jnp.split(u, [D_HEADS * D_DK, 2 * D_HEADS * D_DK], axis=-1)

    def heads(a):
        return a.reshape(B, T, D_HEADS, -1).transpose(0, 2, 1, 3)

    q = l2norm(heads(q)) * (D_DK ** -0.5)
    k = l2norm(heads(k))
    v = heads(v)
    beta = jax.nn.sigmoid(beta_raw.astype(jnp.float32)).reshape(B, T, 2, D_HEADS).transpose(2, 0, 3, 1)
    alpha = alpha_raw.astype(jnp.float32).reshape(B, T, 2, D_HEADS).transpose(2, 0, 3, 1)
    g = -jnp.exp(a_log.astype(jnp.float32))[:, None, :, None] * jax.nn.softplus(
        alpha + dt_bias.astype(jnp.float32)[:, None, :, None])
    o_f, s_f = gated_delta_chunked(q, k, v, g[0], beta[0], s0_f)

    def rev(a):
        return jnp.flip(a, axis=2)

    o_b, s_b = gated_delta_chunked(rev(q), rev(k), rev(v), rev(g[1]), rev(beta[1]), s0_b)
    o = (o_f + rev(o_b)).transpose(0, 2, 1, 3)
    o = rmsnorm(o, g_norm) * jax.nn.silu(z.astype(jnp.float32).reshape(B, T, D_HEADS, D_DV))
    return o.reshape(B, T, -1).astype(qkv.dtype), s_f, s_b


def trunk_layer(x, cond, lp, ctx):
    B, T, _ = x.shape
    latent = ctx is not None
    mod = jnp.matmul(jax.nn.silu(cond), lp['w_mod']) + lp['b_mod']
    sh1, sc1, ga1, sh2, sc2, ga2 = jnp.split(mod[:, None, :], 6, axis=-1)

    h = rmsnorm(x, lp['g_pre1']) * (1 + sc1) + sh1
    proj = jnp.matmul(h, lp['w_in'])
    (a_q, a_k, a_v, b_cq, b_ckv, b_kr, c_in, d_qkv, d_z, d_beta, d_alpha,
     gate_raw) = jnp.split(proj, _split_points(IN_SIZES), axis=-1)

    qa = a_q.reshape(B, T, A_HEADS, A_HD)
    ka = a_k.reshape(B, T, A_KV_HEADS, A_HD)
    va = a_v.reshape(B, T, A_KV_HEADS, A_HD)

    def grp(t):
        return t.reshape(B, T, A_KV_HEADS, A_GROUP, A_HD)

    sink = lp['a_sink'].reshape(A_KV_HEADS, A_GROUP, 1, 1)

    cq = rmsnorm(b_cq, lp['b_g_cq'])
    qb = jnp.matmul(cq, lp['b_w_uq']).reshape(B, T, B_HEADS, B_NOPE + B_ROPE)
    ckv = rmsnorm(b_ckv, lp['b_g_ckv'])

    if latent:
        ctx_a_k, ctx_a_v, ctx_ckv, ctx_kr, s0_f, s0_b = ctx
        cos_a, sin_a = axial_rope_tables(T, A_HD)
        cos_b, sin_b = axial_rope_tables(T, B_ROPE)
        out_a = window_attention(grp(apply_rope(qa, cos_a, sin_a)), apply_rope(ka, cos_a, sin_a), va,
                                 grp(qa), ctx_a_k, ctx_a_v, sink)
        q_nope, q_pe = qb[..., :B_NOPE], qb[..., B_NOPE:]
        kr_rot = apply_rope(b_kr[:, :, None, :], cos_b, sin_b)[:, :, 0]
        k_lat, v_lat = mla_keys_values(ckv, kr_rot, lp['b_w_ukv'])
        k_ctx, v_ctx = mla_keys_values(ctx_ckv, ctx_kr, lp['b_w_ukv'])
        q_lat = jnp.concatenate([q_nope, apply_rope(q_pe, cos_b, sin_b)], axis=-1)[:, :, :, None]
        out_b = dense_attention(q_lat, k_lat, v_lat, B_SCALE,
                                q_ctx=qb[:, :, :, None], k_ctx=k_ctx, v_ctx=v_ctx)
    else:
        s0_f = jnp.zeros((B, D_HEADS, D_DK, D_DV), jnp.float32)
        s0_b = s0_f
        out_a = dense_attention(grp(qa), ka, va, A_SCALE, sink=sink)
        k_c, v_c = mla_keys_values(ckv, b_kr, lp['b_w_ukv'])
        out_b = dense_attention(qb[:, :, :, None], k_c, v_c, B_SCALE)

    out_c = pool_mixer(c_in, lp['c_w_pool'], lp['c_scale'])
    out_d, s_f, s_b = gdn_mixer(d_qkv, d_z, d_beta, d_alpha, lp['d_conv'], lp['d_a_log'],
                                lp['d_dt_bias'], lp['d_g_norm'], s0_f, s0_b)

    branches = jnp.stack([out_a.astype(x.dtype), out_b.astype(x.dtype), out_c, out_d], axis=2)
    br = jnp.einsum('btmc,mcd->btmd', branches, lp['w_br'])
    gates = jax.nn.sigmoid(gate_raw.reshape(B, T, N_BRANCH, D_MODEL))
    mix = jnp.matmul(jnp.sum(gates * br, axis=2), lp['w_o'])
    x = x + ga1 * rmsnorm(mix, lp['g_post1'])

    h2 = rmsnorm(x, lp['g_pre2']) * (1 + sc2) + sh2
    gt, up = jnp.split(jnp.matmul(h2, lp['w_up']), 2, axis=-1)
    f = jnp.matmul(jax.nn.silu(gt) * up, lp['w_down'])
    x = x + ga2 * rmsnorm(f, lp['g_post2'])

    new_ctx = None if latent else (ka, va, ckv, b_kr, s_f, s_b)
    return x, new_ctx


def setup_inputs(seed: int = 0) -> dict:
    key = jax.random.key(seed)
    ks = jax.random.split(key, 32)
    D = D_MODEL

    def nrm(i, shape, scale):
        return jax.random.normal(ks[i], shape, jnp.float32) * scale

    a_log = jnp.log(jax.random.uniform(ks[25], (DEPTH, 2, D_HEADS), jnp.float32, 1.0, 16.0))
    dt = jnp.exp(jax.random.uniform(ks[26], (DEPTH, 2, D_HEADS), jnp.float32,
                                    math.log(1e-3), math.log(1e-1)))
    dt_bias = dt + jnp.log(-jnp.expm1(-dt))
    return {
        'x_prompt': nrm(0, (BATCH, SEQ, D), 1.0),
        'x_sample': nrm(1, (DEC_BATCH, DEC_SEQ, D), 1.0),
        'cache_a_k': nrm(2, (DEC_BATCH, DEPTH, PAST_LEN, A_KV_HEADS, A_HD), 1.0),
        'cache_a_v': nrm(3, (DEC_BATCH, DEPTH, PAST_LEN, A_KV_HEADS, A_HD), 1.0),
        'cache_b_ckv': nrm(4, (DEC_BATCH, DEPTH, PAST_LEN, B_KV_RANK), 1.0),
        'cache_b_krope': nrm(5, (DEC_BATCH, DEPTH, PAST_LEN, B_ROPE), 1.0),
        'state_d_fwd': nrm(6, (DEC_BATCH, DEPTH, D_HEADS, D_DK, D_DV), 0.1),
        'state_d_bwd': nrm(7, (DEC_BATCH, DEPTH, D_HEADS, D_DK, D_DV), 0.1),
        'c': nrm(8, (DEC_BATCH, D), 1.0),
        'c_ctx': nrm(9, (D,), 1.0),
        'w_mod': nrm(10, (DEPTH, D, 6 * D), 0.5 * D ** -0.5),
        'b_mod': nrm(11, (DEPTH, 6 * D), 0.01),
        'g_pre1': 1.0 + nrm(12, (DEPTH, D), 0.1),
        'g_post1': 1.0 + nrm(13, (DEPTH, D), 0.1),
        'g_pre2': 1.0 + nrm(14, (DEPTH, D), 0.1),
        'g_post2': 1.0 + nrm(15, (DEPTH, D), 0.1),
        'w_in': nrm(16, (DEPTH, D, P_IN), D ** -0.5),
        'a_sink': nrm(17, (DEPTH, A_HEADS), 0.5),
        'b_g_cq': 1.0 + nrm(18, (DEPTH, B_Q_RANK), 0.1),
        'b_g_ckv': 1.0 + nrm(19, (DEPTH, B_KV_RANK), 0.1),
        'b_w_uq': nrm(20, (DEPTH, B_Q_RANK, B_HEADS * (B_NOPE + B_ROPE)), B_Q_RANK ** -0.5),
        'b_w_ukv': nrm(21, (DEPTH, B_KV_RANK, B_HEADS * (B_NOPE + B_VD)), B_KV_RANK ** -0.5),
        'c_w_pool': nrm(22, (DEPTH, C_GROUPS, C_GW, C_GW), C_GW ** -0.5),
        'c_scale': 1.0 + nrm(23, (DEPTH, C_GROUPS * C_GW), 0.1),
        'd_conv': nrm(24, (DEPTH, D_CONV, D_HEADS * (2 * D_DK + D_DV)), D_CONV ** -0.5),
        'd_a_log': a_log,
        'd_dt_bias': dt_bias,
        'd_g_norm': 1.0 + nrm(27, (DEPTH, D_DV), 0.1),
        'w_br': nrm(28, (DEPTH, N_BRANCH, BRANCH_W, D), BRANCH_W ** -0.5),
        'w_o': nrm(29, (DEPTH, D, D), D ** -0.5),
        'w_up': nrm(30, (DEPTH, D, 2 * D_FF), D ** -0.5),
        'w_down': nrm(31, (DEPTH, D_FF, D), D_FF ** -0.5),
    }


def reference(x_prompt, x_sample, cache_a_k, cache_a_v, cache_b_ckv, cache_b_krope,
              state_d_fwd, state_d_bwd, c, c_ctx, w_mod, b_mod, g_pre1, g_post1, g_pre2, g_post2,
              w_in, a_sink, b_g_cq, b_g_ckv, b_w_uq, b_w_ukv, c_w_pool, c_scale, d_conv,
              d_a_log, d_dt_bias, d_g_norm, w_br, w_o, w_up, w_down):
    y_prompt = x_prompt
    y_sample = x_sample
    cond_ctx = c_ctx[None, :]
    ak_l, av_l, ckv_l, kr_l, sf_l, sb_l = [], [], [], [], [], []
    for l in range(DEPTH):
        lp = {
            'w_mod': w_mod[l], 'b_mod': b_mod[l], 'g_pre1': g_pre1[l], 'g_post1': g_post1[l],
            'g_pre2': g_pre2[l], 'g_post2': g_post2[l], 'w_in': w_in[l], 'a_sink': a_sink[l],
            'b_g_cq': b_g_cq[l], 'b_g_ckv': b_g_ckv[l], 'b_w_uq': b_w_uq[l], 'b_w_ukv': b_w_ukv[l],
            'c_w_pool': c_w_pool[l], 'c_scale': c_scale[l], 'd_conv': d_conv[l],
            'd_a_log': d_a_log[l], 'd_dt_bias': d_dt_bias[l], 'd_g_norm': d_g_norm[l],
            'w_br': w_br[l], 'w_o': w_o[l], 'w_up': w_up[l], 'w_down': w_down[l],
        }
        y_prompt, (ak, av, ckv, kr, sf, sb) = trunk_layer(y_prompt, cond_ctx, lp, None)
        ak_l.append(ak)
        av_l.append(av)
        ckv_l.append(ckv)
        kr_l.append(kr)
        sf_l.append(sf)
        sb_l.append(sb)
        ctx = (cache_a_k[:, l], cache_a_v[:, l], cache_b_ckv[:, l], cache_b_krope[:, l],
               state_d_fwd[:, l], state_d_bwd[:, l])
        y_sample, _ = trunk_layer(y_sample, c, lp, ctx)
    new_cache_a_k = jnp.stack(ak_l, axis=1)
    new_cache_a_v = jnp.stack(av_l, axis=1)
    new_cache_b_ckv = jnp.stack(ckv_l, axis=1)
    new_cache_b_krope = jnp.stack(kr_l, axis=1)
    new_state_d_fwd = jnp.stack(sf_l, axis=1)
    new_state_d_bwd = jnp.stack(sb_l, axis=1)
    return (y_prompt, y_sample, new_cache_a_k, new_cache_a_v, new_cache_b_ckv, new_cache_b_krope, new_state_d_fwd, new_state_d_bwd)
```

```cpp
#include <hip/hip_runtime.h>
#include <stdint.h>
#include <stdio.h>

typedef unsigned short bf16;
typedef short bf16x8 __attribute__((ext_vector_type(8)));
typedef float f32x16 __attribute__((ext_vector_type(16)));

#define DM 1024
#define NTOK 16384
#define NPROMPT 8192
#define PLD 2176
#define C_AQ 0
#define C_AK 256
#define C_AV 384
#define C_BCQ 512
#define C_BCKV 704
#define C_BKR 832
#define C_CIN 864
#define C_DQKV 1120
#define C_DZ 1888
#define C_DBETA 2144
#define C_DALPHA 2152
#define C_GATE 2160
#define PIN 6256
#define DFF 2816
#define EPS 1e-6f
#define NKVROWS 16896

#define O_Y 0
#define O_CAK 16777216
#define O_CAV 18874368
#define O_CKV 20971520
#define O_KR 23068672
#define O_SF 23592960
#define O_SB 24641536

#define MB(x) ((size_t)(x) * 1024 * 1024)
#define WS_MOD 0
#define WS_TAB (WS_MOD + 147456)
#define WS_KAC (WS_TAB + 12288)
#define WS_VAC (WS_KAC + 512 * 128 * 2)
#define WS_W (MB(1))
#define W_A 0
#define W_G (W_A + 2176 * 1024 * 2)
#define W_BR (W_G + 4096 * 1024 * 2)
#define W_O4 (W_BR + 4 * 1024 * 256 * 2)
#define W_UP (W_O4 + 1024 * 4096 * 2)
#define W_DN (W_UP + 5632 * 1024 * 2)
#define W_UQ (W_DN + 1024 * 2816 * 2)
#define W_UKV (W_UQ + 384 * 192 * 2)
#define W_END (W_UKV + 512 * 128 * 2)
#define WS_H (MB(42))
#define WS_BR (MB(74))
#define WS_BIG (MB(106))
#define B_PROJ 0
#define B_CQ (B_PROJ + (size_t)16384 * 2176 * 2)
#define B_CKV (B_CQ + (size_t)16384 * 192 * 2)
#define B_QB (B_CKV + (size_t)16896 * 128 * 2)
#define B_KV (B_QB + (size_t)16384 * 384 * 2)
#define B_QA1S (B_KV + (size_t)16896 * 512 * 2)
#define B_KA1S (B_QA1S + (size_t)8192 * 256 * 2)
#define B_KB (B_KA1S + (size_t)8192 * 128 * 2)
#define B_OFW (B_KB + (size_t)16896 * 384 * 2)
#define B_END_A (B_OFW + (size_t)16384 * 256 * 4)
#define B_PROD 0
#define B_HID 0
#define WS_NEED (WS_BIG + B_END_A)

struct P {
    const float *x_prompt, *x_sample, *cache_a_k, *cache_a_v, *cache_b_ckv, *cache_b_krope, *state_f, *state_b, *c, *c_ctx;
    const float *w_mod, *b_mod, *g_pre1, *g_post1, *g_pre2, *g_post2, *w_in, *a_sink, *b_g_cq, *b_g_ckv, *b_w_uq, *b_w_ukv;
    const float *c_w_pool, *c_scale, *d_conv, *d_a_log, *d_dt_bias, *d_g_norm, *w_br, *w_o, *w_up, *w_down;
    float* out;
    unsigned char* ws;
};

__device__ __forceinline__ bf16 f2bf(float f) {
    unsigned u = __float_as_uint(f);
    u += 0x7fffu + ((u >> 16) & 1u);
    return (bf16)(u >> 16);
}
__device__ __forceinline__ float bf2f(bf16 h) { return __uint_as_float(((unsigned)h) << 16); }
__device__ __forceinline__ float wave_sum(float v) {
#pragma unroll
    for (int o = 32; o > 0; o >>= 1) v += __shfl_xor(v, o);
    return v;
}
__device__ __forceinline__ float sigmoidf_(float x) { return 1.f / (1.f + __expf(-x)); }
__device__ __forceinline__ float siluf_(float x) { return x / (1.f + __expf(-x)); }

struct TJob { const float* src; bf16* dst; int ldw, K, Ndst, ldo, mode, arg, nvalid, tile0; };
struct TJobs { TJob j[16]; int n, total; };

__global__ void __launch_bounds__(256) k_convert(TJobs J) {
    __shared__ float tile[64][65];
    const int tid = threadIdx.x;
    for (int t = blockIdx.x; t < J.total; t += gridDim.x) {
        int ji = 0;
        for (int q = 1; q < J.n; ++q) if (t >= J.j[q].tile0) ji = q;
        const TJob jb = J.j[ji];
        const int local = t - jb.tile0, nkt = jb.K / 64, tn = local / nkt, tk = local % nkt;
        const int tx = tid & 63, ty = tid >> 6;
        const int n = tn * 64 + tx;
        int sc;
        if (jb.mode == 0) sc = (n < jb.nvalid) ? n + jb.arg : -1;
        else { const int tl = n >> 7, wn = (n >> 6) & 1, nj = (n >> 5) & 1, j = n & 31; sc = nj * DFF + tl * 64 + wn * 32 + j; }
        for (int kk = ty; kk < 64; kk += 4) tile[kk][tx] = (sc >= 0) ? jb.src[(size_t)(tk * 64 + kk) * jb.ldw + sc] : 0.f;
        __syncthreads();
        for (int i = 0; i < 2; ++i) {
            const int q = tid + i * 256, r = q >> 3, c8 = q & 7;
            unsigned w[4];
            for (int j = 0; j < 4; ++j) w[j] = (unsigned)f2bf(tile[c8 * 8 + 2 * j][r]) | ((unsigned)f2bf(tile[c8 * 8 + 2 * j + 1][r]) << 16);
            *(uint4*)(jb.dst + (size_t)(tn * 64 + r) * jb.ldo + tk * 64 + c8 * 8) = make_uint4(w[0], w[1], w[2], w[3]);
        }
        __syncthreads();
    }
}

__global__ void __launch_bounds__(256) k_mod(P p) {
    __shared__ float cs[3][1024];
    __shared__ float red[4][3][64];
    const int tid = threadIdx.x;
    float* mod = (float*)(p.ws + WS_MOD);
    for (int i = tid; i < 3072; i += 256) { const int r = i >> 10, k = i & 1023; const float v = (r == 0) ? p.c_ctx[k] : p.c[(r - 1) * 1024 + k]; cs[r][k] = siluf_(v); }
    __syncthreads();
    for (int it = blockIdx.x; it < 192; it += gridDim.x) {
        const int l = it / 96, cg = it % 96, col = cg * 64 + (tid & 63), kq = tid >> 6;
        float a0 = 0.f, a1 = 0.f, a2 = 0.f;
        const float* w = p.w_mod + ((size_t)l * 1024 + kq * 256) * 6144 + col;
        for (int k = 0; k < 256; ++k) { const float wv = w[(size_t)k * 6144]; a0 += cs[0][kq * 256 + k] * wv; a1 += cs[1][kq * 256 + k] * wv; a2 += cs[2][kq * 256 + k] * wv; }
        red[kq][0][tid & 63] = a0; red[kq][1][tid & 63] = a1; red[kq][2][tid & 63] = a2;
        __syncthreads();
        if (tid < 192) { const int r = tid >> 6, cc = tid & 63; const float s = red[0][r][cc] + red[1][r][cc] + red[2][r][cc] + red[3][r][cc] + p.b_mod[l * 6144 + cg * 64 + cc]; mod[(l * 3 + r) * 6144 + cg * 64 + cc] = s; }
        __syncthreads();
    }
    if (blockIdx.x == 0) {
        float* tab = (float*)(p.ws + WS_TAB);
        for (int i = tid; i < 64 * 16; i += 256) { const int pos = i >> 4, f = i & 15; const float inv = powf(10000.f, -(float)f / 16.f); float s, c; sincosf((float)pos * inv, &s, &c); tab[i] = c; tab[1024 + i] = s; }
        for (int i = tid; i < 64 * 8; i += 256) { const int pos = i >> 3, f = i & 7; const float inv = powf(10000.f, -(float)f / 8.f); float s, c; sincosf((float)pos * inv, &s, &c); tab[2048 + i] = c; tab[2560 + i] = s; }
    }
}

__device__ __forceinline__ const float* xrow_in(const P& p, int row) { return row < NPROMPT ? p.x_prompt + (size_t)row * DM : p.x_sample + (size_t)(row - NPROMPT) * DM; }
__device__ __forceinline__ int cond_row(int row) { return row < NPROMPT ? 0 : 1 + ((row - NPROMPT) >> 12); }

__global__ void __launch_bounds__(256) k_prenorm(P p, int l) {
    const int lane = threadIdx.x & 63;
    const float* mod = (const float*)(p.ws + WS_MOD);
    bf16* H = (bf16*)(p.ws + WS_H);
    for (int row = blockIdx.x * 4 + (threadIdx.x >> 6); row < NTOK; row += gridDim.x * 4) {
        const float* xr = (l == 0) ? xrow_in(p, row) : p.out + (size_t)row * DM;
        float4 v[4]; float ss = 0.f;
        for (int i = 0; i < 4; ++i) { v[i] = *(const float4*)(xr + i * 256 + lane * 4); ss += v[i].x * v[i].x + v[i].y * v[i].y + v[i].z * v[i].z + v[i].w * v[i].w; }
        ss = wave_sum(ss);
        const float rinv = rsqrtf(ss * (1.f / 1024.f) + EPS);
        const float* md = mod + (l * 3 + cond_row(row)) * 6144;
        for (int i = 0; i < 4; ++i) {
            const int col = i * 256 + lane * 4;
            const float4 g = *(const float4*)(p.g_pre1 + l * 1024 + col), sc = *(const float4*)(md + 1024 + col), sh = *(const float4*)(md + col);
            const float h0 = v[i].x * rinv * g.x * (1.f + sc.x) + sh.x, h1 = v[i].y * rinv * g.y * (1.f + sc.y) + sh.y;
            const float h2 = v[i].z * rinv * g.z * (1.f + sc.z) + sh.z, h3 = v[i].w * rinv * g.w * (1.f + sc.w) + sh.w;
            *(uint2*)(H + (size_t)row * DM + col) = make_uint2((unsigned)f2bf(h0) | ((unsigned)f2bf(h1) << 16), (unsigned)f2bf(h2) | ((unsigned)f2bf(h3) << 16));
        }
    }
}

__global__ void __launch_bounds__(256) k_post(P p, int l, int which) {
    const int lane = threadIdx.x & 63;
    const float* mod = (const float*)(p.ws + WS_MOD);
    bf16* H = (bf16*)(p.ws + WS_H);
    const bf16* src = (const bf16*)(p.ws + WS_BR);
    const float* gpost = (which == 1 ? p.g_post1 : p.g_post2) + l * 1024;
    const int ga_off = which == 1 ? 2048 : 5120;
    const bool donext = (which == 1) || (l == 0);
    const int ln = which == 1 ? l : l + 1;
    const float* gpre = (which == 1 ? p.g_pre2 : p.g_pre1) + ln * 1024;
    const int sc_off = which == 1 ? 4096 : 1024, sh_off = which == 1 ? 3072 : 0;
    for (int row = blockIdx.x * 4 + (threadIdx.x >> 6); row < NTOK; row += gridDim.x * 4) {
        const float* xr = (l == 0 && which == 1) ? xrow_in(p, row) : p.out + (size_t)row * DM;
        const int cr = cond_row(row);
        const float* md = mod + (l * 3 + cr) * 6144;
        float4 x[4], s[4]; float ss = 0.f;
        for (int i = 0; i < 4; ++i) {
            const int col = i * 256 + lane * 4;
            x[i] = *(const float4*)(xr + col);
            const uint2 raw = *(const uint2*)(src + (size_t)row * DM + col);
            s[i] = make_float4(bf2f((bf16)(raw.x & 0xffff)), bf2f((bf16)(raw.x >> 16)), bf2f((bf16)(raw.y & 0xffff)), bf2f((bf16)(raw.y >> 16)));
            ss += s[i].x * s[i].x + s[i].y * s[i].y + s[i].z * s[i].z + s[i].w * s[i].w;
        }
        ss = wave_sum(ss);
        const float rinv = rsqrtf(ss * (1.f / 1024.f) + EPS);
        float ss2 = 0.f;
        for (int i = 0; i < 4; ++i) {
            const int col = i * 256 + lane * 4;
            const float4 g = *(const float4*)(gpost + col), ga = *(const float4*)(md + ga_off + col);
            x[i].x += ga.x * s[i].x * rinv * g.x; x[i].y += ga.y * s[i].y * rinv * g.y; x[i].z += ga.z * s[i].z * rinv * g.z; x[i].w += ga.w * s[i].w * rinv * g.w;
            *(float4*)(p.out + (size_t)row * DM + col) = x[i];
            ss2 += x[i].x * x[i].x + x[i].y * x[i].y + x[i].z * x[i].z + x[i].w * x[i].w;
        }
        if (donext) {
            ss2 = wave_sum(ss2);
            const float rinv2 = rsqrtf(ss2 * (1.f / 1024.f) + EPS);
            const float* md2 = mod + (ln * 3 + cr) * 6144;
            for (int i = 0; i < 4; ++i) {
                const int col = i * 256 + lane * 4;
                const float4 g = *(const float4*)(gpre + col), sc = *(const float4*)(md2 + sc_off + col), sh = *(const float4*)(md2 + sh_off + col);
                const float h0 = x[i].x * rinv2 * g.x * (1.f + sc.x) + sh.x, h1 = x[i].y * rinv2 * g.y * (1.f + sc.y) + sh.y;
                const float h2 = x[i].z * rinv2 * g.z * (1.f + sc.z) + sh.z, h3 = x[i].w * rinv2 * g.w * (1.f + sc.w) + sh.w;
                *(uint2*)(H + (size_t)row * DM + col) = make_uint2((unsigned)f2bf(h0) | ((unsigned)f2bf(h1) << 16), (unsigned)f2bf(h2) | ((unsigned)f2bf(h3) << 16));
            }
        }
    }
}

struct GemmArgs { const bf16* A; const bf16* Bt; int lda, ldb, M, N, K, pad; };

struct EpiStore {
    bf16* C; int ldc, nvalid;
    __device__ __forceinline__ void operator()(const f32x16 (&acc)[2][2], int rowbase, int colbase, int tn, int wn, int lane) const {
        _Pragma("unroll") for (int mi = 0; mi < 2; ++mi) _Pragma("unroll") for (int nj = 0; nj < 2; ++nj) {
            const int col = colbase + nj * 32 + (lane & 31);
            if (col < nvalid) _Pragma("unroll") for (int r = 0; r < 16; ++r) { const int row = rowbase + mi * 32 + (r & 3) + 8 * (r >> 2) + 4 * (lane >> 5); C[(size_t)row * ldc + col] = f2bf(acc[mi][nj][r]); }
        }
    }
};
struct EpiGate {
    bf16* C; int ldc;
    __device__ __forceinline__ void operator()(const f32x16 (&acc)[2][2], int rowbase, int colbase, int tn, int wn, int lane) const {
        _Pragma("unroll") for (int mi = 0; mi < 2; ++mi) _Pragma("unroll") for (int nj = 0; nj < 2; ++nj) {
            const int col = colbase + nj * 32 + (lane & 31);
            _Pragma("unroll") for (int r = 0; r < 16; ++r) { const int row = rowbase + mi * 32 + (r & 3) + 8 * (r >> 2) + 4 * (lane >> 5); bf16* q = C + (size_t)row * ldc + col; *q = f2bf(sigmoidf_(acc[mi][nj][r]) * bf2f(*q)); }
        }
    }
};
struct EpiSwiglu {
    bf16* C; int ldc;
    __device__ __forceinline__ void operator()(const f32x16 (&acc)[2][2], int rowbase, int colbase, int tn, int wn, int lane) const {
        const int col = tn * 64 + wn * 32 + (lane & 31);
        _Pragma("unroll") for (int mi = 0; mi < 2; ++mi) _Pragma("unroll") for (int r = 0; r < 16; ++r) {
            const int row = rowbase + mi * 32 + (r & 3) + 8 * (r >> 2) + 4 * (lane >> 5);
            C[(size_t)row * ldc + col] = f2bf(siluf_(acc[mi][0][r]) * acc[mi][1][r]);
        }
    }
};

template <class Epi>
__device__ __forceinline__ void gemm_tiles(const GemmArgs g, const Epi epi, unsigned char* smem) {
    bf16* As = (bf16*)smem;
    bf16* Bs = As + 2 * 128 * 64;
    const int tid = threadIdx.x, lane = tid & 63, w = tid >> 6, wm = w >> 1, wn = w & 1;
    const int nM = g.M / 128, nN = g.N / 128, nK = g.K / 64, ntiles = nM * nN;
    for (int t = blockIdx.x; t < ntiles; t += gridDim.x) {
        const int grp = t / (16 * nN), first = grp * 16, gsz = (nM - first) < 16 ? (nM - first) : 16, r0 = t - grp * 16 * nN;
        const int tm = first + r0 % gsz, tn = r0 / gsz;
        const bf16* Ag = g.A + (size_t)(tm * 128) * g.lda;
        const bf16* Bg = g.Bt + (size_t)(tn * 128) * g.ldb;
        typedef unsigned u32x4 __attribute__((ext_vector_type(4)));
        u32x4 ra0, ra1, ra2, ra3, rb0, rb1, rb2, rb3;
        f32x16 acc[2][2];
        _Pragma("unroll") for (int mi = 0; mi < 2; ++mi) _Pragma("unroll") for (int nj = 0; nj < 2; ++nj) _Pragma("unroll") for (int r = 0; r < 16; ++r) acc[mi][nj][r] = 0.f;
        const int lrow = tid >> 3, lch = tid & 7;
        const bf16* Ap = Ag + (size_t)lrow * g.lda + lch * 8;
        const bf16* Bp = Bg + (size_t)lrow * g.ldb + lch * 8;
        const size_t a32 = (size_t)32 * g.lda, b32 = (size_t)32 * g.ldb;
#define GLOAD(k0) { ra0 = *(const u32x4*)(Ap + (k0)); ra1 = *(const u32x4*)(Ap + a32 + (k0)); ra2 = *(const u32x4*)(Ap + 2 * a32 + (k0)); ra3 = *(const u32x4*)(Ap + 3 * a32 + (k0)); \
                    rb0 = *(const u32x4*)(Bp + (k0)); rb1 = *(const u32x4*)(Bp + b32 + (k0)); rb2 = *(const u32x4*)(Bp + 2 * b32 + (k0)); rb3 = *(const u32x4*)(Bp + 3 * b32 + (k0)); }
        GLOAD(0)
        const int soff = lrow * 64 + ((lch ^ (lrow & 7)) << 3);
        for (int kt = 0; kt < nK; ++kt) {
            bf16* Ab = As + (kt & 1) * 8192; bf16* Bb = Bs + (kt & 1) * 8192;
            *(u32x4*)(Ab + soff) = ra0; *(u32x4*)(Ab + soff + 2048) = ra1; *(u32x4*)(Ab + soff + 4096) = ra2; *(u32x4*)(Ab + soff + 6144) = ra3;
            *(u32x4*)(Bb + soff) = rb0; *(u32x4*)(Bb + soff + 2048) = rb1; *(u32x4*)(Bb + soff + 4096) = rb2; *(u32x4*)(Bb + soff + 6144) = rb3;
            __syncthreads();
            if (kt + 1 < nK) GLOAD((kt + 1) * 64)
#pragma unroll
            for (int kk = 0; kk < 4; ++kk) {
                bf16x8 a[2], b[2];
                const int ch = kk * 2 + (lane >> 5);
#pragma unroll
                for (int mi = 0; mi < 2; ++mi) { const int row = wm * 64 + mi * 32 + (lane & 31); a[mi] = *(const bf16x8*)(Ab + row * 64 + ((ch ^ (row & 7)) << 3)); }
#pragma unroll
                for (int nj = 0; nj < 2; ++nj) { const int row = wn * 64 + nj * 32 + (lane & 31); b[nj] = *(const bf16x8*)(Bb + row * 64 + ((ch ^ (row & 7)) << 3)); }
#pragma unroll
                for (int mi = 0; mi < 2; ++mi)
#pragma unroll
                    for (int nj = 0; nj < 2; ++nj) acc[mi][nj] = __builtin_amdgcn_mfma_f32_32x32x16_bf16(a[mi], b[nj], acc[mi][nj], 0, 0, 0);
            }
        }
        epi(acc, tm * 128 + wm * 64, tn * 128 + wn * 64, tn, wn, lane);
        __syncthreads();
    }
}

template <class Epi>
__global__ void __launch_bounds__(256) k_gemm(GemmArgs g, Epi epi) {
    __shared__ __attribute__((aligned(16))) unsigned char smem[65536];
    gemm_tiles(g, epi, smem);
}

__global__ void __launch_bounds__(256) k_postproj(P p, int l) {
    const int lane = threadIdx.x & 63;
    const bf16* proj = (const bf16*)(p.ws + WS_BIG + B_PROJ);
    bf16* cq = (bf16*)(p.ws + WS_BIG + B_CQ);
    bf16* ckv = (bf16*)(p.ws + WS_BIG + B_CKV);
    for (int row = blockIdx.x * 4 + (threadIdx.x >> 6); row < NKVROWS; row += gridDim.x * 4) {
        if (row >= NTOK) {
            const int r = row - NTOK, b = r >> 8, s = r & 255;
            const float* src = p.cache_b_ckv + ((size_t)(b * 2 + l) * 256 + s) * 128;
            ckv[(size_t)row * 128 + lane] = f2bf(src[lane]); ckv[(size_t)row * 128 + 64 + lane] = f2bf(src[64 + lane]);
            continue;
        }
        const bf16* pr = proj + (size_t)row * PLD;
        float a0 = bf2f(pr[C_BCQ + lane]), a1 = bf2f(pr[C_BCQ + 64 + lane]), a2 = bf2f(pr[C_BCQ + 128 + lane]);
        float ss = wave_sum(a0 * a0 + a1 * a1 + a2 * a2);
        float rinv = rsqrtf(ss * (1.f / 192.f) + EPS);
        const float* gq = p.b_g_cq + l * 192;
        cq[(size_t)row * 192 + lane] = f2bf(a0 * rinv * gq[lane]); cq[(size_t)row * 192 + 64 + lane] = f2bf(a1 * rinv * gq[64 + lane]); cq[(size_t)row * 192 + 128 + lane] = f2bf(a2 * rinv * gq[128 + lane]);
        float k0 = bf2f(pr[C_BCKV + lane]), k1 = bf2f(pr[C_BCKV + 64 + lane]);
        ss = wave_sum(k0 * k0 + k1 * k1);
        rinv = rsqrtf(ss * (1.f / 128.f) + EPS);
        const float* gk = p.b_g_ckv + l * 128;
        k0 = k0 * rinv * gk[lane]; k1 = k1 * rinv * gk[64 + lane];
        ckv[(size_t)row * 128 + lane] = f2bf(k0); ckv[(size_t)row * 128 + 64 + lane] = f2bf(k1);
        if (row < NPROMPT) {
            const int b = row >> 8, s = row & 255;
            const size_t ci = (size_t)(b * 2 + l) * 256 + s;
            p.out[O_CKV + ci * 128 + lane] = k0; p.out[O_CKV + ci * 128 + 64 + lane] = k1;
            p.out[O_CAK + ci * 128 + lane] = bf2f(pr[C_AK + lane]); p.out[O_CAK + ci * 128 + 64 + lane] = bf2f(pr[C_AK + 64 + lane]);
            p.out[O_CAV + ci * 128 + lane] = bf2f(pr[C_AV + lane]); p.out[O_CAV + ci * 128 + 64 + lane] = bf2f(pr[C_AV + 64 + lane]);
            if (lane < 32) p.out[O_KR + ci * 32 + lane] = bf2f(pr[C_BKR + lane]);
        }
    }
}

__global__ void __launch_bounds__(256) k_prep2(P p, int l) {
    const int lane = threadIdx.x & 63;
    const float* tab = (const float*)(p.ws + WS_TAB);
    const bf16* proj = (const bf16*)(p.ws + WS_BIG + B_PROJ);
    const bf16* qb = (const bf16*)(p.ws + WS_BIG + B_QB);
    const bf16* kv = (const bf16*)(p.ws + WS_BIG + B_KV);
    bf16* qa1s = (bf16*)(p.ws + WS_BIG + B_QA1S);
    bf16* ka1s = (bf16*)(p.ws + WS_BIG + B_KA1S);
    bf16* qb1s = (bf16*)(p.ws + WS_BIG + B_CQ);
    bf16* kb = (bf16*)(p.ws + WS_BIG + B_KB);
    bf16* kac = (bf16*)(p.ws + WS_KAC);
    bf16* vac = (bf16*)(p.ws + WS_VAC);
    for (int row = blockIdx.x * 4 + (threadIdx.x >> 6); row < NKVROWS; row += gridDim.x * 4) {
        for (int h = 0; h < 4; ++h) kb[(size_t)row * 384 + h * 96 + lane] = kv[(size_t)row * 512 + h * 128 + lane];
        if (row >= NTOK) {
            const int r = row - NTOK, b = r >> 8, s = r & 255;
            if (lane < 32) { const bf16 v = f2bf(p.cache_b_krope[((size_t)(b * 2 + l) * 256 + s) * 32 + lane]); for (int h = 0; h < 4; ++h) kb[(size_t)row * 384 + h * 96 + 64 + lane] = v; }
            const size_t ci = ((size_t)(b * 2 + l) * 256 + s) * 128;
            kac[(size_t)r * 128 + lane] = f2bf(p.cache_a_k[ci + lane]); kac[(size_t)r * 128 + 64 + lane] = f2bf(p.cache_a_k[ci + 64 + lane]);
            vac[(size_t)r * 128 + lane] = f2bf(p.cache_a_v[ci + lane]); vac[(size_t)r * 128 + 64 + lane] = f2bf(p.cache_a_v[ci + 64 + lane]);
            continue;
        }
        const bf16* pr = proj + (size_t)row * PLD;
        if (row < NPROMPT) {
            if (lane < 32) { const bf16 v = pr[C_BKR + lane]; for (int h = 0; h < 4; ++h) kb[(size_t)row * 384 + h * 96 + 64 + lane] = v; }
            continue;
        }
        const int rs = row - NPROMPT, t = rs & 4095, gr = t >> 6, gc = t & 63;
        {
            if (lane < 32) {
                const int d = lane, qtr = d >> 3, f = d & 7, pos = (qtr < 2) ? gr : gc;
                const float c = tab[2048 + pos * 8 + f], s = tab[2560 + pos * 8 + f];
                const float x = bf2f(pr[C_BKR + d]);
                const float y = bf2f(pr[C_BKR + (d ^ 8)]);
                const float o = (qtr & 1) ? (x * c + y * s) : (x * c - y * s);
                const bf16 v = f2bf(o);
                for (int h = 0; h < 4; ++h) kb[(size_t)row * 384 + h * 96 + 64 + d] = v;
                for (int h = 0; h < 4; ++h) {
                    const float qx = bf2f(qb[(size_t)row * 384 + h * 96 + 64 + d]), qy = bf2f(qb[(size_t)row * 384 + h * 96 + 64 + (d ^ 8)]);
                    qb1s[(size_t)rs * 384 + h * 96 + 64 + d] = f2bf((qtr & 1) ? (qx * c + qy * s) : (qx * c - qy * s));
                }
            }
            for (int h = 0; h < 4; ++h) qb1s[(size_t)rs * 384 + h * 96 + lane] = qb[(size_t)row * 384 + h * 96 + lane];
        }
        {
            const int d = lane, qtr = d >> 4, f = d & 15, pos = (qtr < 2) ? gr : gc;
            const float c = tab[pos * 16 + f], s = tab[1024 + pos * 16 + f];
            for (int h = 0; h < 4; ++h) {
                const float x = bf2f(pr[C_AQ + h * 64 + d]), y = bf2f(pr[C_AQ + h * 64 + (d ^ 16)]);
                qa1s[(size_t)rs * 256 + h * 64 + d] = f2bf((qtr & 1) ? (x * c + y * s) : (x * c - y * s));
            }
            for (int h = 0; h < 2; ++h) {
                const float x = bf2f(pr[C_AK + h * 64 + d]), y = bf2f(pr[C_AK + h * 64 + (d ^ 16)]);
                ka1s[(size_t)rs * 128 + h * 64 + d] = f2bf((qtr & 1) ? (x * c + y * s) : (x * c - y * s));
            }
        }
    }
}

struct AttnJob {
    const bf16 *q1, *q2, *k1, *v1, *k2, *v2;
    const float* sink;
    bf16* out;
    int ldq1, ldq2, ldk1, ldv1, ldk2, ldv2;
    int kstride, vstride, kvgroup, nbatch, T, nk2, window, outcol;
    float scale; int pad;
};

template <int DQK>
__global__ void __launch_bounds__(256) k_attn(AttnJob j) {
    __shared__ __attribute__((aligned(16))) float Ks[32 * DQK];
    __shared__ __attribute__((aligned(16))) float Vs[32 * 64];
    const int tid = threadIdx.x;
    const int nqb = j.T / 256;
    const int blk = blockIdx.x, b = blk / (4 * nqb), h = (blk / nqb) % 4, qb0 = (blk % nqb) * 256;
    const int kh = h / j.kvgroup;
    const int t = qb0 + tid;
    float q[DQK], o[64];
    float m = -1e30f, lsum = 0.f;
    for (int e = 0; e < 64; ++e) o[e] = 0.f;
    for (int set = 0; set < 2; ++set) {
        if (set == 1 && j.nk2 == 0) break;
        const bf16* qp = (set == 0) ? j.q1 + ((size_t)b * j.T + t) * j.ldq1 + h * DQK : j.q2 + ((size_t)b * j.T + t) * j.ldq2 + h * DQK;
        for (int d = 0; d < DQK; d += 4) { const uint2 raw = *(const uint2*)(qp + d); q[d] = bf2f((bf16)(raw.x & 0xffff)) * j.scale; q[d + 1] = bf2f((bf16)(raw.x >> 16)) * j.scale; q[d + 2] = bf2f((bf16)(raw.y & 0xffff)) * j.scale; q[d + 3] = bf2f((bf16)(raw.y >> 16)) * j.scale; }
        const bf16* kp = (set == 0) ? j.k1 + (size_t)b * j.T * j.ldk1 + kh * j.kstride : j.k2 + (size_t)b * j.nk2 * j.ldk2 + kh * j.kstride;
        const bf16* vp = (set == 0) ? j.v1 + (size_t)b * j.T * j.ldv1 + kh * j.vstride : j.v2 + (size_t)b * j.nk2 * j.ldv2 + kh * j.vstride;
        const int ldk = (set == 0) ? j.ldk1 : j.ldk2, ldv = (set == 0) ? j.ldv1 : j.ldv2;
        int kbeg = 0, kend = (set == 0) ? j.T : j.nk2;
        const bool win = (set == 0) && j.window;
        if (win) { kbeg = qb0 - 128 < 0 ? 0 : qb0 - 128; kend = qb0 + 256 + 128 > j.T ? j.T : qb0 + 256 + 128; }
        for (int ks = kbeg; ks < kend; ks += 32) {
            __syncthreads();
            for (int e = tid; e < 32 * DQK / 4; e += 256) {
                const int key = e / (DQK / 4), c4 = e % (DQK / 4), s = ks + key;
                float4 val = make_float4(0.f, 0.f, 0.f, 0.f);
                if (s < kend) { const uint2 raw = *(const uint2*)(kp + (size_t)s * ldk + c4 * 4); val = make_float4(bf2f((bf16)(raw.x & 0xffff)), bf2f((bf16)(raw.x >> 16)), bf2f((bf16)(raw.y & 0xffff)), bf2f((bf16)(raw.y >> 16))); }
                *(float4*)&Ks[key * DQK + c4 * 4] = val;
            }
            for (int e = tid; e < 32 * 16; e += 256) {
                const int key = e >> 4, c4 = e & 15, s = ks + key;
                float4 val = make_float4(0.f, 0.f, 0.f, 0.f);
                if (s < kend) { const uint2 raw = *(const uint2*)(vp + (size_t)s * ldv + c4 * 4); val = make_float4(bf2f((bf16)(raw.x & 0xffff)), bf2f((bf16)(raw.x >> 16)), bf2f((bf16)(raw.y & 0xffff)), bf2f((bf16)(raw.y >> 16))); }
                *(float4*)&Vs[key * 64 + c4 * 4] = val;
            }
            __syncthreads();
            const int nk = (kend - ks) < 32 ? (kend - ks) : 32;
            for (int key = 0; key < nk; ++key) {
                const int s = ks + key;
                if (win) { const int dlt = t - s; if (dlt > 128 || dlt < -128) continue; }
                float sc = 0.f;
#pragma unroll
                for (int d = 0; d < DQK; d += 4) { const float4 kk = *(const float4*)&Ks[key * DQK + d]; sc += q[d] * kk.x + q[d + 1] * kk.y + q[d + 2] * kk.z + q[d + 3] * kk.w; }
                if (sc > m) { const float c = __expf(m - sc); lsum *= c;
#pragma unroll
                    for (int e = 0; e < 64; ++e) o[e] *= c;
                    m = sc; }
                const float pp = __expf(sc - m);
                lsum += pp;
#pragma unroll
                for (int e = 0; e < 64; e += 4) { const float4 vv = *(const float4*)&Vs[key * 64 + e]; o[e] += pp * vv.x; o[e + 1] += pp * vv.y; o[e + 2] += pp * vv.z; o[e + 3] += pp * vv.w; }
            }
        }
    }
    if (j.sink) {
        const float sk = j.sink[h];
        const float mf = sk > m ? sk : m;
        const float c = __expf(m - mf);
        lsum = lsum * c + __expf(sk - mf);
#pragma unroll
        for (int e = 0; e < 64; ++e) o[e] *= c;
    }
    const float inv = 1.f / lsum;
    bf16* op = j.out + ((size_t)b * j.T + t) * 1024 + j.outcol + h * 64;
#pragma unroll
    for (int e = 0; e < 64; e += 2) *(unsigned*)(op + e) = (unsigned)f2bf(o[e] * inv) | ((unsigned)f2bf(o[e + 1] * inv) << 16);
}

__global__ void __launch_bounds__(256) k_pool(P p, int l) {
    __shared__ float df[32][257];
    const int tid = threadIdx.x;
    const bf16* proj = (const bf16*)(p.ws + WS_BIG + B_PROJ);
    bf16* br = (bf16*)(p.ws + WS_BR);
    for (int tile = blockIdx.x; tile < NTOK / 32; tile += gridDim.x) {
        const int row0 = tile * 32;
        int base, T;
        if (row0 < NPROMPT) { base = (row0 >> 8) << 8; T = 256; } else { base = NPROMPT + (((row0 - NPROMPT) >> 12) << 12); T = 4096; }
        __syncthreads();
        {
            const int c = tid, g = c >> 6, hw = 1 << g;
            for (int i = 0; i < 32; ++i) {
                const int t = row0 + i - base;
                const int lo = t - hw < 0 ? 0 : t - hw, hi = t + hw > T ? T : t + hw;
                float s = 0.f;
                for (int u = lo; u < hi; ++u) s += bf2f(proj[(size_t)(base + u) * PLD + C_CIN + c]);
                df[i][c] = s / (float)(hi - lo) - bf2f(proj[(size_t)(base + t) * PLD + C_CIN + c]);
            }
        }
        __syncthreads();
        {
            const int g = tid >> 6, d = tid & 63;
            float acc[32];
            for (int i = 0; i < 32; ++i) acc[i] = 0.f;
            const float* wp = p.c_w_pool + ((size_t)(l * 4 + g) * 64) * 64 + d;
            for (int c = 0; c < 64; ++c) {
                const float w = wp[c * 64];
#pragma unroll
                for (int i = 0; i < 32; ++i) acc[i] += df[i][g * 64 + c] * w;
            }
            const float sc = p.c_scale[l * 256 + tid];
#pragma unroll
            for (int i = 0; i < 32; ++i) br[(size_t)(row0 + i) * 1024 + 512 + tid] = f2bf(acc[i] * sc);
        }
    }
}

#define GLD 65
__global__ void __launch_bounds__(256) k_gdn(P p, int l) {
    extern __shared__ float sm[];
    float* qs = sm; float* ks = qs + 64 * GLD; float* us = ks + 64 * GLD; float* wsm = us + 64 * GLD; float* Lm = wsm + 64 * GLD;
    float* Ss = Lm + 64 * GLD; float* Vn = Ss + 64 * GLD; float* gcs = Vn + 64 * GLD; float* betas = gcs + 64; float* rqk = betas + 64; float* qdec = rqk + 128; float* kdec = qdec + 64;
    const int tid = threadIdx.x, lane = tid & 63, wv = tid >> 6;
    const bf16* proj = (const bf16*)(p.ws + WS_BIG + B_PROJ);
    float* ofw = (float*)(p.ws + WS_BIG + B_OFW);
    bf16* br = (bf16*)(p.ws + WS_BR);
    const int job = blockIdx.x;
    int b, h, T, base; bool samp;
    if (job < 8) { samp = true; b = job >> 2; h = job & 3; T = 4096; base = NPROMPT + b * 4096; }
    else { samp = false; b = (job - 8) >> 2; h = (job - 8) & 3; T = 256; base = b * 256; }
    const int N = T / 64;
    for (int dir = 0; dir < 2; ++dir) {
        __syncthreads();
        for (int idx = tid; idx < 4096; idx += 256) { const int d = idx >> 6, e = idx & 63; Ss[d * GLD + e] = samp ? (dir ? p.state_b : p.state_f)[((size_t)(b * 2 + l) * 4 + h) * 4096 + idx] : 0.f; }
        const float Aexp = expf(p.d_a_log[(l * 2 + dir) * 4 + h]);
        const float dtb = p.d_dt_bias[(l * 2 + dir) * 4 + h];
        for (int n = 0; n < N; ++n) {
            const int cidx = dir ? N - 1 - n : n;
            __syncthreads();
            for (int idx = tid; idx < 64 * 192; idx += 256) {
                const int i = idx / 192, cc = idx % 192, part = cc >> 6, d = cc & 63;
                const int tt = cidx * 64 + (dir ? 63 - i : i);
                const int ch = part * 256 + h * 64 + d;
                float a = 0.f;
                for (int jj = 0; jj < 5; ++jj) { const int ts = tt + jj - 2; if (ts >= 0 && ts < T) a += p.d_conv[(l * 5 + jj) * 768 + ch] * bf2f(proj[(size_t)(base + ts) * PLD + C_DQKV + ch]); }
                const float u = siluf_(a);
                (part == 0 ? qs : part == 1 ? ks : us)[i * GLD + d] = u;
            }
            if (tid < 64) {
                const int i = tid, tt = cidx * 64 + (dir ? 63 - i : i);
                const bf16* pr = proj + (size_t)(base + tt) * PLD;
                betas[i] = sigmoidf_(bf2f(pr[C_DBETA + dir * 4 + h]));
                const float al = bf2f(pr[C_DALPHA + dir * 4 + h]) + dtb;
                const float sp = al > 20.f ? al : log1pf(expf(al));
                gcs[i] = -Aexp * sp;
            }
            __syncthreads();
            if (tid < 128) { const int i = tid & 63; const float* src = tid < 64 ? qs : ks; float ss = 0.f; for (int d = 0; d < 64; ++d) ss += src[i * GLD + d] * src[i * GLD + d]; rqk[tid] = rsqrtf(ss + EPS) * (tid < 64 ? 0.125f : 1.f); }
            if (tid == 128) { float run = 0.f; for (int i = 0; i < 64; ++i) { run += gcs[i]; gcs[i] = run; } }
            __syncthreads();
            for (int idx = tid; idx < 4096; idx += 256) { const int i = idx >> 6, d = idx & 63; qs[i * GLD + d] *= rqk[i]; ks[i * GLD + d] *= rqk[64 + i]; }
            if (tid < 64) { qdec[tid] = expf(gcs[tid]); kdec[tid] = expf(gcs[63] - gcs[tid]); }
            __syncthreads();
            for (int idx = tid; idx < 4096; idx += 256) {
                const int i = idx >> 6, jx = idx & 63; float v = 0.f;
                if (jx < i) { float dot = 0.f; for (int d = 0; d < 64; ++d) dot += ks[i * GLD + d] * ks[jx * GLD + d]; v = betas[i] * dot * expf(gcs[i] - gcs[jx]); }
                Lm[i * GLD + jx] = v;
            }
            for (int idx = tid; idx < 4096; idx += 256) { const int i = idx >> 6, d = idx & 63; us[i * GLD + d] *= betas[i]; wsm[i * GLD + d] = ks[i * GLD + d] * betas[i] * qdec[i]; }
            __syncthreads();
            if (tid < 128) {
                float* X = tid < 64 ? us : wsm; const int col = tid & 63;
                for (int i = 1; i < 64; ++i) { float a = X[i * GLD + col]; for (int jx = 0; jx < i; ++jx) a -= Lm[i * GLD + jx] * X[jx * GLD + col]; X[i * GLD + col] = a; }
            }
            __syncthreads();
            for (int idx = tid; idx < 4096; idx += 256) {
                const int i = idx >> 6, jx = idx & 63; float v = 0.f;
                if (jx <= i) { float dot = 0.f; for (int d = 0; d < 64; ++d) dot += qs[i * GLD + d] * ks[jx * GLD + d]; v = dot * expf(gcs[i] - gcs[jx]); }
                Lm[i * GLD + jx] = v;
            }
            for (int idx = tid; idx < 4096; idx += 256) {
                const int i = idx >> 6, e = idx & 63; float a = us[i * GLD + e];
                for (int d = 0; d < 64; ++d) a -= wsm[i * GLD + d] * Ss[d * GLD + e];
                Vn[i * GLD + e] = a;
            }
            __syncthreads();
            for (int it = 0; it < 16; ++it) {
                const int i = it * 4 + wv, e = lane;
                float a = 0.f;
                for (int d = 0; d < 64; ++d) a += qs[i * GLD + d] * Ss[d * GLD + e];
                a *= qdec[i];
                for (int jx = 0; jx <= i; ++jx) a += Lm[i * GLD + jx] * Vn[jx * GLD + e];
                const int tt = cidx * 64 + (dir ? 63 - i : i);
                const size_t row = (size_t)(base + tt);
                if (dir == 0) ofw[row * 256 + h * 64 + e] = a;
                else {
                    a += ofw[row * 256 + h * 64 + e];
                    const float ss = wave_sum(a * a);
                    const float rinv = rsqrtf(ss * (1.f / 64.f) + EPS);
                    const float z = bf2f(proj[row * PLD + C_DZ + h * 64 + e]);
                    br[row * 1024 + 768 + h * 64 + e] = f2bf(a * rinv * p.d_g_norm[l * 64 + e] * siluf_(z));
                }
            }
            __syncthreads();
            {
                const float gl = qdec[63];
                for (int idx = tid; idx < 4096; idx += 256) {
                    const int d = idx >> 6, e = idx & 63; float a = Ss[d * GLD + e] * gl;
                    for (int i = 0; i < 64; ++i) a += ks[i * GLD + d] * kdec[i] * Vn[i * GLD + e];
                    Ss[d * GLD + e] = a;
                }
            }
        }
        __syncthreads();
        if (!samp) { float* so = p.out + (dir ? O_SB : O_SF) + ((size_t)(b * 2 + l) * 4 + h) * 4096; for (int idx = tid; idx < 4096; idx += 256) so[idx] = Ss[(idx >> 6) * GLD + (idx & 63)]; }
    }
}
#define GDN_LDS ((7 * 64 * GLD + 64 * 6) * 4)

static void add_job(TJobs& J, const float* src, bf16* dst, int ldw, int K, int Ndst, int ldo, int mode, int arg, int nvalid) {
    TJob& j = J.j[J.n]; j.src = src; j.dst = dst; j.ldw = ldw; j.K = K; j.Ndst = Ndst; j.ldo = ldo; j.mode = mode; j.arg = arg; j.nvalid = nvalid; j.tile0 = J.total;
    J.total += (Ndst / 64) * (K / 64); J.n++;
}

extern "C" void kernel_launch(void* const* d_in, const int* in_sizes, int n_in, void* d_out, int out_size, void* d_ws, size_t ws_size, hipStream_t stream) {
    if (n_in != 32 || ws_size < WS_NEED) { fprintf(stderr, "kernel_launch: unexpected n_in %d or ws_size %zu (need %zu)\n", n_in, ws_size, (size_t)WS_NEED); return; }
    static bool attr = false;
    if (!attr) { hipFuncSetAttribute((const void*)k_gdn, hipFuncAttributeMaxDynamicSharedMemorySize, GDN_LDS); attr = true; }
    P p{};
    const float** pf = (const float**)&p;
    for (int i = 0; i < 32; ++i) pf[i] = (const float*)d_in[i];
    p.out = (float*)d_out; p.ws = (unsigned char*)d_ws;
    unsigned char* ws = p.ws;
    bf16* Wb = (bf16*)(ws + WS_W);
    const int G = 512;
    k_mod<<<192, 256, 0, stream>>>(p);
    for (int l = 0; l < 2; ++l) {
        TJobs J{};
        add_job(J, p.w_in + (size_t)l * 1024 * PIN, (bf16*)((char*)Wb + W_A), PIN, 1024, 2176, 1024, 0, 0, 2160);
        add_job(J, p.w_in + (size_t)l * 1024 * PIN, (bf16*)((char*)Wb + W_G), PIN, 1024, 4096, 1024, 0, C_GATE, 4096);
        for (int m = 0; m < 4; ++m) add_job(J, p.w_br + ((size_t)l * 4 + m) * 256 * 1024, (bf16*)((char*)Wb + W_BR) + (size_t)m * 1024 * 256, 1024, 256, 1024, 256, 0, 0, 1024);
        for (int m = 0; m < 4; ++m) add_job(J, p.w_o + (size_t)l * 1024 * 1024, (bf16*)((char*)Wb + W_O4) + m * 1024, 1024, 1024, 1024, 4096, 0, 0, 1024);
        add_job(J, p.w_up + (size_t)l * 1024 * 5632, (bf16*)((char*)Wb + W_UP), 5632, 1024, 5632, 1024, 1, 0, 5632);
        add_job(J, p.w_down + (size_t)l * DFF * 1024, (bf16*)((char*)Wb + W_DN), 1024, DFF, 1024, DFF, 0, 0, 1024);
        add_job(J, p.b_w_uq + (size_t)l * 192 * 384, (bf16*)((char*)Wb + W_UQ), 384, 192, 384, 192, 0, 0, 384);
        add_job(J, p.b_w_ukv + (size_t)l * 128 * 512, (bf16*)((char*)Wb + W_UKV), 512, 128, 512, 128, 0, 0, 512);
        k_convert<<<1024, 256, 0, stream>>>(J);
        if (l == 0) k_prenorm<<<G, 256, 0, stream>>>(p, 0);
        bf16* H = (bf16*)(ws + WS_H);
        bf16* BRb = (bf16*)(ws + WS_BR);
        unsigned char* big = ws + WS_BIG;
        bf16* proj = (bf16*)(big + B_PROJ);
        { GemmArgs g{H, (bf16*)((char*)Wb + W_A), 1024, 1024, NTOK, 2176, 1024, 0}; EpiStore e{proj, PLD, PLD}; k_gemm<<<G, 256, 0, stream>>>(g, e); }
        k_postproj<<<G, 256, 0, stream>>>(p, l);
        { GemmArgs g{(bf16*)(big + B_CQ), (bf16*)((char*)Wb + W_UQ), 192, 192, NTOK, 384, 192, 0}; EpiStore e{(bf16*)(big + B_QB), 384, 384}; k_gemm<<<G, 256, 0, stream>>>(g, e); }
        { GemmArgs g{(bf16*)(big + B_CKV), (bf16*)((char*)Wb + W_UKV), 128, 128, NKVROWS, 512, 128, 0}; EpiStore e{(bf16*)(big + B_KV), 512, 512}; k_gemm<<<G, 256, 0, stream>>>(g, e); }
        k_prep2<<<G, 256, 0, stream>>>(p, l);
        {
            AttnJob j{}; j.q1 = proj + C_AQ; j.ldq1 = PLD; j.k1 = proj + C_AK; j.ldk1 = PLD; j.v1 = proj + C_AV; j.ldv1 = PLD; j.kstride = 64; j.vstride = 64; j.kvgroup = 2;
            j.nbatch = 32; j.T = 256; j.nk2 = 0; j.window = 0; j.sink = p.a_sink + l * 4; j.scale = 0.125f; j.out = BRb; j.outcol = 0;
            k_attn<64><<<32 * 4, 256, 0, stream>>>(j);
        }
        {
            AttnJob j{}; j.q1 = (bf16*)(big + B_QA1S); j.ldq1 = 256; j.q2 = proj + (size_t)NPROMPT * PLD + C_AQ; j.ldq2 = PLD;
            j.k1 = (bf16*)(big + B_KA1S); j.ldk1 = 128; j.v1 = proj + (size_t)NPROMPT * PLD + C_AV; j.ldv1 = PLD;
            j.k2 = (bf16*)(ws + WS_KAC); j.ldk2 = 128; j.v2 = (bf16*)(ws + WS_VAC); j.ldv2 = 128; j.kstride = 64; j.vstride = 64; j.kvgroup = 2;
            j.nbatch = 2; j.T = 4096; j.nk2 = 256; j.window = 1; j.sink = p.a_sink + l * 4; j.scale = 0.125f; j.out = BRb + (size_t)NPROMPT * 1024; j.outcol = 0;
            k_attn<64><<<2 * 4 * 16, 256, 0, stream>>>(j);
        }
        const float bscale = 0.10206207261596575f;
        {
            AttnJob j{}; j.q1 = (bf16*)(big + B_QB); j.ldq1 = 384; j.k1 = (bf16*)(big + B_KB); j.ldk1 = 384; j.v1 = (bf16*)(big + B_KV) + 64; j.ldv1 = 512; j.kstride = 96; j.vstride = 128; j.kvgroup = 1;
            j.nbatch = 32; j.T = 256; j.nk2 = 0; j.window = 0; j.sink = nullptr; j.scale = bscale; j.out = BRb; j.outcol = 256;
            k_attn<96><<<32 * 4, 256, 0, stream>>>(j);
        }
        {
            AttnJob j{}; j.q1 = (bf16*)(big + B_CQ); j.ldq1 = 384; j.q2 = (bf16*)(big + B_QB) + (size_t)NPROMPT * 384; j.ldq2 = 384;
            j.k1 = (bf16*)(big + B_KB) + (size_t)NPROMPT * 384; j.ldk1 = 384; j.v1 = (bf16*)(big + B_KV) + (size_t)NPROMPT * 512 + 64; j.ldv1 = 512;
            j.k2 = (bf16*)(big + B_KB) + (size_t)NTOK * 384; j.ldk2 = 384; j.v2 = (bf16*)(big + B_KV) + (size_t)NTOK * 512 + 64; j.ldv2 = 512; j.kstride = 96; j.vstride = 128; j.kvgroup = 1;
            j.nbatch = 2; j.T = 4096; j.nk2 = 256; j.window = 0; j.sink = nullptr; j.scale = bscale; j.out = BRb + (size_t)NPROMPT * 1024; j.outcol = 256;
            k_attn<96><<<2 * 4 * 16, 256, 0, stream>>>(j);
        }
        k_pool<<<G, 256, 0, stream>>>(p, l);
        k_gdn<<<136, 256, GDN_LDS, stream>>>(p, l);
        bf16* prod = (bf16*)(big + B_PROD);
        for (int m = 0; m < 4; ++m) { GemmArgs g{BRb + m * 256, (bf16*)((char*)Wb + W_BR) + (size_t)m * 1024 * 256, 1024, 256, NTOK, 1024, 256, 0}; EpiStore e{prod + m * 1024, 4096, 1 << 30}; k_gemm<<<G, 256, 0, stream>>>(g, e); }
        { GemmArgs g{H, (bf16*)((char*)Wb + W_G), 1024, 1024, NTOK, 4096, 1024, 0}; EpiGate e{prod, 4096}; k_gemm<<<G, 256, 0, stream>>>(g, e); }
        { GemmArgs g{prod, (bf16*)((char*)Wb + W_O4), 4096, 4096, NTOK, 1024, 4096, 0}; EpiStore e{BRb, 1024, 1024}; k_gemm<<<G, 256, 0, stream>>>(g, e); }
        k_post<<<G, 256, 0, stream>>>(p, l, 1);
        { GemmArgs g{H, (bf16*)((char*)Wb + W_UP), 1024, 1024, NTOK, 5632, 1024, 0}; EpiSwiglu e{(bf16*)(big + B_HID), DFF}; k_gemm<<<G, 256, 0, stream>>>(g, e); }
        { GemmArgs g{(bf16*)(big + B_HID), (bf16*)((char*)Wb + W_DN), DFF, DFF, NTOK, 1024, DFF, 0}; EpiStore e{BRb, 1024, 1024}; k_gemm<<<G, 256, 0, stream>>>(g, e); }
        k_post<<<G, 256, 0, stream>>>(p, l, 2);
    }
}
```

```cpp
#include <hip/hip_runtime.h>
#include <hip/hip_cooperative_groups.h>
namespace cg = cooperative_groups;
#define NT 512
#define NWV 8
#define LDS_BYTES 147456
#include <stdint.h>
#include <stdio.h>

typedef unsigned short bf16;
typedef short bf16x8 __attribute__((ext_vector_type(8)));
typedef float f32x16 __attribute__((ext_vector_type(16)));

#define DM 1024
#define NTOK 16384
#define NPROMPT 8192
#define PLD 2176
#define C_AQ 0
#define C_AK 256
#define C_AV 384
#define C_BCQ 512
#define C_BCKV 704
#define C_BKR 832
#define C_CIN 864
#define C_DQKV 1120
#define C_DZ 1888
#define C_DBETA 2144
#define C_DALPHA 2152
#define C_GATE 2160
#define PIN 6256
#define DFF 2816
#define EPS 1e-6f
#define NKVROWS 16896

#define O_Y 0
#define O_CAK 16777216
#define O_CAV 18874368
#define O_CKV 20971520
#define O_KR 23068672
#define O_SF 23592960
#define O_SB 24641536

#define MB(x) ((size_t)(x) * 1024 * 1024)
#define WS_MOD 0
#define WS_TAB (WS_MOD + 147456)
#define WS_KAC (WS_TAB + 12288)
#define WS_VAC (WS_KAC + 512 * 128 * 2)
#define WS_W (MB(1))
#define W_A 0
#define W_G (W_A + 2176 * 1024 * 2)
#define W_BR (W_G + 4096 * 1024 * 2)
#define W_O4 (W_BR + 4 * 1024 * 256 * 2)
#define W_UP (W_O4 + 1024 * 4096 * 2)
#define W_DN (W_UP + 5632 * 1024 * 2)
#define W_UQ (W_DN + 1024 * 2816 * 2)
#define W_UKV (W_UQ + 384 * 192 * 2)
#define W_END (W_UKV + 512 * 128 * 2)
#define WS_H (MB(42))
#define WS_BR (MB(74))
#define WS_BIG (MB(106))
#define B_PROJ 0
#define B_CQ (B_PROJ + (size_t)16384 * 2176 * 2)
#define B_CKV (B_CQ + (size_t)16384 * 192 * 2)
#define B_QB (B_CKV + (size_t)16896 * 128 * 2)
#define B_KV (B_QB + (size_t)16384 * 384 * 2)
#define B_QA1S (B_KV + (size_t)16896 * 512 * 2)
#define B_KA1S (B_QA1S + (size_t)8192 * 256 * 2)
#define B_KB (B_KA1S + (size_t)8192 * 128 * 2)
#define B_OFW (B_KB + (size_t)16896 * 384 * 2)
#define B_END_A (B_OFW + (size_t)16384 * 256 * 4)
#define B_PROD 0
#define B_HID 0
#define WS_NEED (WS_BIG + B_END_A)

struct P {
    const float *x_prompt, *x_sample, *cache_a_k, *cache_a_v, *cache_b_ckv, *cache_b_krope, *state_f, *state_b, *c, *c_ctx;
    const float *w_mod, *b_mod, *g_pre1, *g_post1, *g_pre2, *g_post2, *w_in, *a_sink, *b_g_cq, *b_g_ckv, *b_w_uq, *b_w_ukv;
    const float *c_w_pool, *c_scale, *d_conv, *d_a_log, *d_dt_bias, *d_g_norm, *w_br, *w_o, *w_up, *w_down;
    float* out;
    unsigned char* ws;
};


typedef const __attribute__((address_space(4))) unsigned char* kargp_t;
__device__ __forceinline__ P fence_P() {
    kargp_t kp = (kargp_t)__builtin_amdgcn_kernarg_segment_ptr();
    asm volatile("" : "+s"(kp));
    const __attribute__((address_space(4))) P* pp = (const __attribute__((address_space(4))) P*)kp;
    P q;
    q.x_prompt = pp->x_prompt;
    q.x_sample = pp->x_sample;
    q.cache_a_k = pp->cache_a_k;
    q.cache_a_v = pp->cache_a_v;
    q.cache_b_ckv = pp->cache_b_ckv;
    q.cache_b_krope = pp->cache_b_krope;
    q.state_f = pp->state_f;
    q.state_b = pp->state_b;
    q.c = pp->c;
    q.c_ctx = pp->c_ctx;
    q.w_mod = pp->w_mod;
    q.b_mod = pp->b_mod;
    q.g_pre1 = pp->g_pre1;
    q.g_post1 = pp->g_post1;
    q.g_pre2 = pp->g_pre2;
    q.g_post2 = pp->g_post2;
    q.w_in = pp->w_in;
    q.a_sink = pp->a_sink;
    q.b_g_cq = pp->b_g_cq;
    q.b_g_ckv = pp->b_g_ckv;
    q.b_w_uq = pp->b_w_uq;
    q.b_w_ukv = pp->b_w_ukv;
    q.c_w_pool = pp->c_w_pool;
    q.c_scale = pp->c_scale;
    q.d_conv = pp->d_conv;
    q.d_a_log = pp->d_a_log;
    q.d_dt_bias = pp->d_dt_bias;
    q.d_g_norm = pp->d_g_norm;
    q.w_br = pp->w_br;
    q.w_o = pp->w_o;
    q.w_up = pp->w_up;
    q.w_down = pp->w_down;
    q.out = pp->out;
    q.ws = pp->ws;
    return q;
}

__device__ __forceinline__ bf16 f2bf(float f) {
    unsigned u = __float_as_uint(f);
    u += 0x7fffu + ((u >> 16) & 1u);
    return (bf16)(u >> 16);
}
__device__ __forceinline__ float bf2f(bf16 h) { return __uint_as_float(((unsigned)h) << 16); }
__device__ __forceinline__ float wave_sum(float v) {
#pragma unroll
    for (int o = 32; o > 0; o >>= 1) v += __shfl_xor(v, o);
    return v;
}

__device__ __forceinline__ int tidx() { int t = threadIdx.x; asm volatile("" : "+v"(t)); return t; }
__device__ __forceinline__ float sigmoidf_(float x) { return 1.f / (1.f + __expf(-x)); }
__device__ __forceinline__ float siluf_(float x) { return x / (1.f + __expf(-x)); }

struct TJob { const float* src; bf16* dst; int ldw, K, Ndst, ldo, mode, arg, nvalid, tile0; };
struct TJobs { TJob j[16]; int n, total; };

__device__ __forceinline__ void ph_convert(const TJobs& J, unsigned char* smem) {
    float (*tile)[65] = (float (*)[65])smem;
    const int tid = tidx();
    for (int t = blockIdx.x; t < J.total; t += gridDim.x) {
        int ji = 0;
        for (int q = 1; q < J.n; ++q) if (t >= J.j[q].tile0) ji = q;
        const TJob jb = J.j[ji];
        const int local = t - jb.tile0, nkt = jb.K / 64, tn = local / nkt, tk = local % nkt;
        const int tx = tid & 63, ty = tid >> 6;
        const int n = tn * 64 + tx;
        int sc;
        if (jb.mode == 0) sc = (n < jb.nvalid) ? n + jb.arg : -1;
        else { const int tl = n >> 7, wn = (n >> 6) & 1, nj = (n >> 5) & 1, j = n & 31; sc = nj * DFF + tl * 64 + wn * 32 + j; }
        for (int kk = ty; kk < 64; kk += NWV) tile[kk][tx] = (sc >= 0) ? jb.src[(size_t)(tk * 64 + kk) * jb.ldw + sc] : 0.f;
        __syncthreads();
        {
            const int q = tid, r = q >> 3, c8 = q & 7;
            unsigned w[4];
            for (int j = 0; j < 4; ++j) w[j] = (unsigned)f2bf(tile[c8 * 8 + 2 * j][r]) | ((unsigned)f2bf(tile[c8 * 8 + 2 * j + 1][r]) << 16);
            *(uint4*)(jb.dst + (size_t)(tn * 64 + r) * jb.ldo + tk * 64 + c8 * 8) = make_uint4(w[0], w[1], w[2], w[3]);
        }
        __syncthreads();
    }
}

__device__ __forceinline__ void ph_mod(const P& p, unsigned char* smem) {
    float (*cs)[1024] = (float (*)[1024])smem;
    float (*red)[3][64] = (float (*)[3][64])(smem + 3 * 1024 * 4);
    const int tid = tidx();
    float* mod = (float*)(p.ws + WS_MOD);
    for (int i = tid; i < 3072; i += NT) { const int r = i >> 10, k = i & 1023; const float v = (r == 0) ? p.c_ctx[k] : p.c[(r - 1) * 1024 + k]; cs[r][k] = siluf_(v); }
    __syncthreads();
    for (int it = blockIdx.x; it < 192; it += gridDim.x) {
        const int l = it / 96, cg = it % 96, col = cg * 64 + (tid & 63), kq = tid >> 6;
        float a0 = 0.f, a1 = 0.f, a2 = 0.f;
        const float* w = p.w_mod + ((size_t)l * 1024 + kq * 128) * 6144 + col;
        for (int k = 0; k < 128; ++k) { const float wv = w[(size_t)k * 6144]; a0 += cs[0][kq * 128 + k] * wv; a1 += cs[1][kq * 128 + k] * wv; a2 += cs[2][kq * 128 + k] * wv; }
        red[kq][0][tid & 63] = a0; red[kq][1][tid & 63] = a1; red[kq][2][tid & 63] = a2;
        __syncthreads();
        if (tid < 192) { const int r = tid >> 6, cc = tid & 63; const float s = red[0][r][cc] + red[1][r][cc] + red[2][r][cc] + red[3][r][cc] + red[4][r][cc] + red[5][r][cc] + red[6][r][cc] + red[7][r][cc] + p.b_mod[l * 6144 + cg * 64 + cc]; mod[(l * 3 + r) * 6144 + cg * 64 + cc] = s; }
        __syncthreads();
    }
    if (blockIdx.x == 0) {
        float* tab = (float*)(p.ws + WS_TAB);
        for (int i = tid; i < 64 * 16; i += NT) { const int pos = i >> 4, f = i & 15; const float inv = powf(10000.f, -(float)f / 16.f); float s, c; sincosf((float)pos * inv, &s, &c); tab[i] = c; tab[1024 + i] = s; }
        for (int i = tid; i < 64 * 8; i += NT) { const int pos = i >> 3, f = i & 7; const float inv = powf(10000.f, -(float)f / 8.f); float s, c; sincosf((float)pos * inv, &s, &c); tab[2048 + i] = c; tab[2560 + i] = s; }
    }
}

__device__ __forceinline__ const float* xrow_in(const P& p, int row) { return row < NPROMPT ? p.x_prompt + (size_t)row * DM : p.x_sample + (size_t)(row - NPROMPT) * DM; }
__device__ __forceinline__ int cond_row(int row) { return row < NPROMPT ? 0 : 1 + ((row - NPROMPT) >> 12); }

__device__ __forceinline__ void ph_prenorm(const P& p, int l) {
    const int lane = tidx() & 63;
    const float* mod = (const float*)(p.ws + WS_MOD);
    bf16* H = (bf16*)(p.ws + WS_H);
    for (int row = blockIdx.x * NWV + (tidx() >> 6); row < NTOK; row += gridDim.x * NWV) {
        const float* xr = (l == 0) ? xrow_in(p, row) : p.out + (size_t)row * DM;
        float4 v[4]; float ss = 0.f;
        for (int i = 0; i < 4; ++i) { v[i] = *(const float4*)(xr + i * 256 + lane * 4); ss += v[i].x * v[i].x + v[i].y * v[i].y + v[i].z * v[i].z + v[i].w * v[i].w; }
        ss = wave_sum(ss);
        const float rinv = rsqrtf(ss * (1.f / 1024.f) + EPS);
        const float* md = mod + (l * 3 + cond_row(row)) * 6144;
        for (int i = 0; i < 4; ++i) {
            const int col = i * 256 + lane * 4;
            const float4 g = *(const float4*)(p.g_pre1 + l * 1024 + col), sc = *(const float4*)(md + 1024 + col), sh = *(const float4*)(md + col);
            const float h0 = v[i].x * rinv * g.x * (1.f + sc.x) + sh.x, h1 = v[i].y * rinv * g.y * (1.f + sc.y) + sh.y;
            const float h2 = v[i].z * rinv * g.z * (1.f + sc.z) + sh.z, h3 = v[i].w * rinv * g.w * (1.f + sc.w) + sh.w;
            *(uint2*)(H + (size_t)row * DM + col) = make_uint2((unsigned)f2bf(h0) | ((unsigned)f2bf(h1) << 16), (unsigned)f2bf(h2) | ((unsigned)f2bf(h3) << 16));
        }
    }
}

__device__ __forceinline__ void ph_post(const P& p, int l, int which) {
    const int lane = tidx() & 63;
    const float* mod = (const float*)(p.ws + WS_MOD);
    bf16* H = (bf16*)(p.ws + WS_H);
    const bf16* src = (const bf16*)(p.ws + WS_BR);
    const float* gpost = (which == 1 ? p.g_post1 : p.g_post2) + l * 1024;
    const int ga_off = which == 1 ? 2048 : 5120;
    const bool donext = (which == 1) || (l == 0);
    const int ln = which == 1 ? l : l + 1;
    const float* gpre = (which == 1 ? p.g_pre2 : p.g_pre1) + ln * 1024;
    const int sc_off = which == 1 ? 4096 : 1024, sh_off = which == 1 ? 3072 : 0;
    for (int row = blockIdx.x * NWV + (tidx() >> 6); row < NTOK; row += gridDim.x * NWV) {
        const float* xr = (l == 0 && which == 1) ? xrow_in(p, row) : p.out + (size_t)row * DM;
        const int cr = cond_row(row);
        const float* md = mod + (l * 3 + cr) * 6144;
        float4 x[4], s[4]; float ss = 0.f;
        for (int i = 0; i < 4; ++i) {
            const int col = i * 256 + lane * 4;
            x[i] = *(const float4*)(xr + col);
            const uint2 raw = *(const uint2*)(src + (size_t)row * DM + col);
            s[i] = make_float4(bf2f((bf16)(raw.x & 0xffff)), bf2f((bf16)(raw.x >> 16)), bf2f((bf16)(raw.y & 0xffff)), bf2f((bf16)(raw.y >> 16)));
            ss += s[i].x * s[i].x + s[i].y * s[i].y + s[i].z * s[i].z + s[i].w * s[i].w;
        }
        ss = wave_sum(ss);
        const float rinv = rsqrtf(ss * (1.f / 1024.f) + EPS);
        float ss2 = 0.f;
        for (int i = 0; i < 4; ++i) {
            const int col = i * 256 + lane * 4;
            const float4 g = *(const float4*)(gpost + col), ga = *(const float4*)(md + ga_off + col);
            x[i].x += ga.x * s[i].x * rinv * g.x; x[i].y += ga.y * s[i].y * rinv * g.y; x[i].z += ga.z * s[i].z * rinv * g.z; x[i].w += ga.w * s[i].w * rinv * g.w;
            *(float4*)(p.out + (size_t)row * DM + col) = x[i];
            ss2 += x[i].x * x[i].x + x[i].y * x[i].y + x[i].z * x[i].z + x[i].w * x[i].w;
        }
        if (donext) {
            ss2 = wave_sum(ss2);
            const float rinv2 = rsqrtf(ss2 * (1.f / 1024.f) + EPS);
            const float* md2 = mod + (ln * 3 + cr) * 6144;
            for (int i = 0; i < 4; ++i) {
                const int col = i * 256 + lane * 4;
                const float4 g = *(const float4*)(gpre + col), sc = *(const float4*)(md2 + sc_off + col), sh = *(const float4*)(md2 + sh_off + col);
                const float h0 = x[i].x * rinv2 * g.x * (1.f + sc.x) + sh.x, h1 = x[i].y * rinv2 * g.y * (1.f + sc.y) + sh.y;
                const float h2 = x[i].z * rinv2 * g.z * (1.f + sc.z) + sh.z, h3 = x[i].w * rinv2 * g.w * (1.f + sc.w) + sh.w;
                *(uint2*)(H + (size_t)row * DM + col) = make_uint2((unsigned)f2bf(h0) | ((unsigned)f2bf(h1) << 16), (unsigned)f2bf(h2) | ((unsigned)f2bf(h3) << 16));
            }
        }
    }
}

struct GemmArgs { const bf16* A; const bf16* Bt; int lda, ldb, M, N, K, pad; };

struct EpiStore {
    bf16* C; int ldc, nvalid;
    __device__ __forceinline__ void operator()(const f32x16 (&acc)[2][2], int rowbase, int colbase, int tn, int wn, int lane) const {
        _Pragma("unroll") for (int mi = 0; mi < 2; ++mi) _Pragma("unroll") for (int nj = 0; nj < 2; ++nj) {
            const int col = colbase + nj * 32 + (lane & 31);
            if (col < nvalid) _Pragma("unroll") for (int r = 0; r < 16; ++r) { const int row = rowbase + mi * 32 + (r & 3) + 8 * (r >> 2) + 4 * (lane >> 5); C[(size_t)row * ldc + col] = f2bf(acc[mi][nj][r]); }
        }
    }
};
struct EpiGate {
    bf16* C; int ldc;
    __device__ __forceinline__ void operator()(const f32x16 (&acc)[2][2], int rowbase, int colbase, int tn, int wn, int lane) const {
        _Pragma("unroll") for (int mi = 0; mi < 2; ++mi) _Pragma("unroll") for (int nj = 0; nj < 2; ++nj) {
            const int col = colbase + nj * 32 + (lane & 31);
            _Pragma("unroll") for (int r = 0; r < 16; ++r) { const int row = rowbase + mi * 32 + (r & 3) + 8 * (r >> 2) + 4 * (lane >> 5); bf16* q = C + (size_t)row * ldc + col; *q = f2bf(sigmoidf_(acc[mi][nj][r]) * bf2f(*q)); }
        }
    }
};
struct EpiSwiglu {
    bf16* C; int ldc;
    __device__ __forceinline__ void operator()(const f32x16 (&acc)[2][2], int rowbase, int colbase, int tn, int wn, int lane) const {
        const int col = tn * 64 + wn * 32 + (lane & 31);
        _Pragma("unroll") for (int mi = 0; mi < 2; ++mi) _Pragma("unroll") for (int r = 0; r < 16; ++r) {
            const int row = rowbase + mi * 32 + (r & 3) + 8 * (r >> 2) + 4 * (lane >> 5);
            C[(size_t)row * ldc + col] = f2bf(siluf_(acc[mi][0][r]) * acc[mi][1][r]);
        }
    }
};

template <class Epi>
__device__ __forceinline__ void gemm_tiles(const GemmArgs g, const Epi epi, unsigned char* smem) {
    const int vb = tidx() >> 8, tid = tidx() & 255, lane = tid & 63, w = tid >> 6, wm = w >> 1, wn = w & 1;
    bf16* As = (bf16*)(smem + vb * 65536);
    bf16* Bs = As + 2 * 128 * 64;
    const int nM = g.M / 128, nN = g.N / 128, nK = g.K / 64, ntiles = nM * nN;
    const int nvb = gridDim.x * 2, iters = (ntiles + nvb - 1) / nvb;
    for (int it = 0; it < iters; ++it) {
        const int t0 = it * nvb + blockIdx.x * 2 + vb;
        const bool valid = t0 < ntiles;
        const int t = valid ? t0 : 0;
        const int grp = t / (16 * nN), first = grp * 16, gsz = (nM - first) < 16 ? (nM - first) : 16, r0 = t - grp * 16 * nN;
        const int tm = first + r0 % gsz, tn = r0 / gsz;
        const bf16* Ag = g.A + (size_t)(tm * 128) * g.lda;
        const bf16* Bg = g.Bt + (size_t)(tn * 128) * g.ldb;
        typedef unsigned u32x4 __attribute__((ext_vector_type(4)));
        u32x4 ra0, ra1, ra2, ra3, rb0, rb1, rb2, rb3;
        f32x16 acc[2][2];
        _Pragma("unroll") for (int mi = 0; mi < 2; ++mi) _Pragma("unroll") for (int nj = 0; nj < 2; ++nj) _Pragma("unroll") for (int r = 0; r < 16; ++r) acc[mi][nj][r] = 0.f;
        const int lrow = tid >> 3, lch = tid & 7;
        const bf16* Ap = Ag + (size_t)lrow * g.lda + lch * 8;
        const bf16* Bp = Bg + (size_t)lrow * g.ldb + lch * 8;
        const size_t a32 = (size_t)32 * g.lda, b32 = (size_t)32 * g.ldb;
#define GLOAD(k0) { ra0 = *(const u32x4*)(Ap + (k0)); ra1 = *(const u32x4*)(Ap + a32 + (k0)); ra2 = *(const u32x4*)(Ap + 2 * a32 + (k0)); ra3 = *(const u32x4*)(Ap + 3 * a32 + (k0)); \
                    rb0 = *(const u32x4*)(Bp + (k0)); rb1 = *(const u32x4*)(Bp + b32 + (k0)); rb2 = *(const u32x4*)(Bp + 2 * b32 + (k0)); rb3 = *(const u32x4*)(Bp + 3 * b32 + (k0)); }
        GLOAD(0)
        const int soff = lrow * 64 + ((lch ^ (lrow & 7)) << 3);
        for (int kt = 0; kt < nK; ++kt) {
            bf16* Ab = As + (kt & 1) * 8192; bf16* Bb = Bs + (kt & 1) * 8192;
            *(u32x4*)(Ab + soff) = ra0; *(u32x4*)(Ab + soff + 2048) = ra1; *(u32x4*)(Ab + soff + 4096) = ra2; *(u32x4*)(Ab + soff + 6144) = ra3;
            *(u32x4*)(Bb + soff) = rb0; *(u32x4*)(Bb + soff + 2048) = rb1; *(u32x4*)(Bb + soff + 4096) = rb2; *(u32x4*)(Bb + soff + 6144) = rb3;
            __syncthreads();
            if (kt + 1 < nK) GLOAD((kt + 1) * 64)
#pragma unroll
            for (int kk = 0; kk < 4; ++kk) {
                bf16x8 a[2], b[2];
                const int ch = kk * 2 + (lane >> 5);
#pragma unroll
                for (int mi = 0; mi < 2; ++mi) { const int row = wm * 64 + mi * 32 + (lane & 31); a[mi] = *(const bf16x8*)(Ab + row * 64 + ((ch ^ (row & 7)) << 3)); }
#pragma unroll
                for (int nj = 0; nj < 2; ++nj) { const int row = wn * 64 + nj * 32 + (lane & 31); b[nj] = *(const bf16x8*)(Bb + row * 64 + ((ch ^ (row & 7)) << 3)); }
#pragma unroll
                for (int mi = 0; mi < 2; ++mi)
#pragma unroll
                    for (int nj = 0; nj < 2; ++nj) acc[mi][nj] = __builtin_amdgcn_mfma_f32_32x32x16_bf16(a[mi], b[nj], acc[mi][nj], 0, 0, 0);
            }
        }
        if (valid) epi(acc, tm * 128 + wm * 64, tn * 128 + wn * 64, tn, wn, lane);
        __syncthreads();
    }
}

__device__ __forceinline__ void ph_postproj(const P& p, int l) {
    const int lane = tidx() & 63;
    const bf16* proj = (const bf16*)(p.ws + WS_BIG + B_PROJ);
    bf16* cq = (bf16*)(p.ws + WS_BIG + B_CQ);
    bf16* ckv = (bf16*)(p.ws + WS_BIG + B_CKV);
    for (int row = blockIdx.x * NWV + (tidx() >> 6); row < NKVROWS; row += gridDim.x * NWV) {
        if (row >= NTOK) {
            const int r = row - NTOK, b = r >> 8, s = r & 255;
            const float* src = p.cache_b_ckv + ((size_t)(b * 2 + l) * 256 + s) * 128;
            ckv[(size_t)row * 128 + lane] = f2bf(src[lane]); ckv[(size_t)row * 128 + 64 + lane] = f2bf(src[64 + lane]);
            continue;
        }
        const bf16* pr = proj + (size_t)row * PLD;
        float a0 = bf2f(pr[C_BCQ + lane]), a1 = bf2f(pr[C_BCQ + 64 + lane]), a2 = bf2f(pr[C_BCQ + 128 + lane]);
        float ss = wave_sum(a0 * a0 + a1 * a1 + a2 * a2);
        float rinv = rsqrtf(ss * (1.f / 192.f) + EPS);
        const float* gq = p.b_g_cq + l * 192;
        cq[(size_t)row * 192 + lane] = f2bf(a0 * rinv * gq[lane]); cq[(size_t)row * 192 + 64 + lane] = f2bf(a1 * rinv * gq[64 + lane]); cq[(size_t)row * 192 + 128 + lane] = f2bf(a2 * rinv * gq[128 + lane]);
        float k0 = bf2f(pr[C_BCKV + lane]), k1 = bf2f(pr[C_BCKV + 64 + lane]);
        ss = wave_sum(k0 * k0 + k1 * k1);
        rinv = rsqrtf(ss * (1.f / 128.f) + EPS);
        const float* gk = p.b_g_ckv + l * 128;
        k0 = k0 * rinv * gk[lane]; k1 = k1 * rinv * gk[64 + lane];
        ckv[(size_t)row * 128 + lane] = f2bf(k0); ckv[(size_t)row * 128 + 64 + lane] = f2bf(k1);
        if (row < NPROMPT) {
            const int b = row >> 8, s = row & 255;
            const size_t ci = (size_t)(b * 2 + l) * 256 + s;
            p.out[O_CKV + ci * 128 + lane] = k0; p.out[O_CKV + ci * 128 + 64 + lane] = k1;
            p.out[O_CAK + ci * 128 + lane] = bf2f(pr[C_AK + lane]); p.out[O_CAK + ci * 128 + 64 + lane] = bf2f(pr[C_AK + 64 + lane]);
            p.out[O_CAV + ci * 128 + lane] = bf2f(pr[C_AV + lane]); p.out[O_CAV + ci * 128 + 64 + lane] = bf2f(pr[C_AV + 64 + lane]);
            if (lane < 32) p.out[O_KR + ci * 32 + lane] = bf2f(pr[C_BKR + lane]);
        }
    }
}

__device__ __forceinline__ void ph_prep2(const P& p, int l) {
    const int lane = tidx() & 63;
    const float* tab = (const float*)(p.ws + WS_TAB);
    const bf16* proj = (const bf16*)(p.ws + WS_BIG + B_PROJ);
    const bf16* qb = (const bf16*)(p.ws + WS_BIG + B_QB);
    const bf16* kv = (const bf16*)(p.ws + WS_BIG + B_KV);
    bf16* qa1s = (bf16*)(p.ws + WS_BIG + B_QA1S);
    bf16* ka1s = (bf16*)(p.ws + WS_BIG + B_KA1S);
    bf16* qb1s = (bf16*)(p.ws + WS_BIG + B_CQ);
    bf16* kb = (bf16*)(p.ws + WS_BIG + B_KB);
    bf16* kac = (bf16*)(p.ws + WS_KAC);
    bf16* vac = (bf16*)(p.ws + WS_VAC);
    for (int row = blockIdx.x * NWV + (tidx() >> 6); row < NKVROWS; row += gridDim.x * NWV) {
        for (int h = 0; h < 4; ++h) kb[(size_t)row * 384 + h * 96 + lane] = kv[(size_t)row * 512 + h * 128 + lane];
        if (row >= NTOK) {
            const int r = row - NTOK, b = r >> 8, s = r & 255;
            if (lane < 32) { const bf16 v = f2bf(p.cache_b_krope[((size_t)(b * 2 + l) * 256 + s) * 32 + lane]); for (int h = 0; h < 4; ++h) kb[(size_t)row * 384 + h * 96 + 64 + lane] = v; }
            const size_t ci = ((size_t)(b * 2 + l) * 256 + s) * 128;
            kac[(size_t)r * 128 + lane] = f2bf(p.cache_a_k[ci + lane]); kac[(size_t)r * 128 + 64 + lane] = f2bf(p.cache_a_k[ci + 64 + lane]);
            vac[(size_t)r * 128 + lane] = f2bf(p.cache_a_v[ci + lane]); vac[(size_t)r * 128 + 64 + lane] = f2bf(p.cache_a_v[ci + 64 + lane]);
            continue;
        }
        const bf16* pr = proj + (size_t)row * PLD;
        if (row < NPROMPT) {
            if (lane < 32) { const bf16 v = pr[C_BKR + lane]; for (int h = 0; h < 4; ++h) kb[(size_t)row * 384 + h * 96 + 64 + lane] = v; }
            continue;
        }
        const int rs = row - NPROMPT, t = rs & 4095, gr = t >> 6, gc = t & 63;
        {
            if (lane < 32) {
                const int d = lane, qtr = d >> 3, f = d & 7, pos = (qtr < 2) ? gr : gc;
                const float c = tab[2048 + pos * 8 + f], s = tab[2560 + pos * 8 + f];
                const float x = bf2f(pr[C_BKR + d]);
                const float y = bf2f(pr[C_BKR + (d ^ 8)]);
                const float o = (qtr & 1) ? (x * c + y * s) : (x * c - y * s);
                const bf16 v = f2bf(o);
                for (int h = 0; h < 4; ++h) kb[(size_t)row * 384 + h * 96 + 64 + d] = v;
                for (int h = 0; h < 4; ++h) {
                    const float qx = bf2f(qb[(size_t)row * 384 + h * 96 + 64 + d]), qy = bf2f(qb[(size_t)row * 384 + h * 96 + 64 + (d ^ 8)]);
                    qb1s[(size_t)rs * 384 + h * 96 + 64 + d] = f2bf((qtr & 1) ? (qx * c + qy * s) : (qx * c - qy * s));
                }
            }
            for (int h = 0; h < 4; ++h) qb1s[(size_t)rs * 384 + h * 96 + lane] = qb[(size_t)row * 384 + h * 96 + lane];
        }
        {
            const int d = lane, qtr = d >> 4, f = d & 15, pos = (qtr < 2) ? gr : gc;
            const float c = tab[pos * 16 + f], s = tab[1024 + pos * 16 + f];
            for (int h = 0; h < 4; ++h) {
                const float x = bf2f(pr[C_AQ + h * 64 + d]), y = bf2f(pr[C_AQ + h * 64 + (d ^ 16)]);
                qa1s[(size_t)rs * 256 + h * 64 + d] = f2bf((qtr & 1) ? (x * c + y * s) : (x * c - y * s));
            }
            for (int h = 0; h < 2; ++h) {
                const float x = bf2f(pr[C_AK + h * 64 + d]), y = bf2f(pr[C_AK + h * 64 + (d ^ 16)]);
                ka1s[(size_t)rs * 128 + h * 64 + d] = f2bf((qtr & 1) ? (x * c + y * s) : (x * c - y * s));
            }
        }
    }
}

struct AttnJob {
    const bf16 *q1, *q2, *k1, *v1, *k2, *v2;
    const float* sink;
    bf16* out;
    int ldq1, ldq2, ldk1, ldv1, ldk2, ldv2;
    int kstride, vstride, kvgroup, nbatch, T, nk2, window, outcol;
    float scale; int pad;
};

template <int DQK>
__device__ __forceinline__ void attn_item(const AttnJob& j, int blk, unsigned char* smem) {
    float* Ks = (float*)smem;
    float* Vs = Ks + 32 * DQK;
    const int tid = tidx(), eh = (tid >> 8) * 32;
    const int nqb = j.T / 256;
    const int b = blk / (4 * nqb), h = (blk / nqb) % 4, qb0 = (blk % nqb) * 256;
    const int kh = h / j.kvgroup;
    const int t = qb0 + (tid & 255);
    float q[DQK], o[32];
    float m = -1e30f, lsum = 0.f;
#pragma unroll
    for (int e = 0; e < 32; ++e) o[e] = 0.f;
    for (int set = 0; set < 2; ++set) {
        if (set == 1 && j.nk2 == 0) break;
        const bf16* qp = (set == 0) ? j.q1 + ((size_t)b * j.T + t) * j.ldq1 + h * DQK : j.q2 + ((size_t)b * j.T + t) * j.ldq2 + h * DQK;
#pragma unroll
        for (int d = 0; d < DQK; d += 4) { const uint2 raw = *(const uint2*)(qp + d); q[d] = bf2f((bf16)(raw.x & 0xffff)) * j.scale; q[d + 1] = bf2f((bf16)(raw.x >> 16)) * j.scale; q[d + 2] = bf2f((bf16)(raw.y & 0xffff)) * j.scale; q[d + 3] = bf2f((bf16)(raw.y >> 16)) * j.scale; }
        const bf16* kp = (set == 0) ? j.k1 + (size_t)b * j.T * j.ldk1 + kh * j.kstride : j.k2 + (size_t)b * j.nk2 * j.ldk2 + kh * j.kstride;
        const bf16* vp = (set == 0) ? j.v1 + (size_t)b * j.T * j.ldv1 + kh * j.vstride : j.v2 + (size_t)b * j.nk2 * j.ldv2 + kh * j.vstride;
        const int ldk = (set == 0) ? j.ldk1 : j.ldk2, ldv = (set == 0) ? j.ldv1 : j.ldv2;
        int kbeg = 0, kend = (set == 0) ? j.T : j.nk2;
        const bool win = (set == 0) && j.window;
        if (win) { kbeg = qb0 - 128 < 0 ? 0 : qb0 - 128; kend = qb0 + 256 + 128 > j.T ? j.T : qb0 + 256 + 128; }
        for (int ks = kbeg; ks < kend; ks += 32) {
            __syncthreads();
            for (int e = tid; e < 32 * DQK / 4; e += NT) {
                const int key = e / (DQK / 4), c4 = e % (DQK / 4), s = ks + key;
                float4 val = make_float4(0.f, 0.f, 0.f, 0.f);
                if (s < kend) { const uint2 raw = *(const uint2*)(kp + (size_t)s * ldk + c4 * 4); val = make_float4(bf2f((bf16)(raw.x & 0xffff)), bf2f((bf16)(raw.x >> 16)), bf2f((bf16)(raw.y & 0xffff)), bf2f((bf16)(raw.y >> 16))); }
                *(float4*)&Ks[key * DQK + c4 * 4] = val;
            }
            for (int e = tid; e < 32 * 16; e += NT) {
                const int key = e >> 4, c4 = e & 15, s = ks + key;
                float4 val = make_float4(0.f, 0.f, 0.f, 0.f);
                if (s < kend) { const uint2 raw = *(const uint2*)(vp + (size_t)s * ldv + c4 * 4); val = make_float4(bf2f((bf16)(raw.x & 0xffff)), bf2f((bf16)(raw.x >> 16)), bf2f((bf16)(raw.y & 0xffff)), bf2f((bf16)(raw.y >> 16))); }
                *(float4*)&Vs[key * 64 + c4 * 4] = val;
            }
            __syncthreads();
            const int nk = (kend - ks) < 32 ? (kend - ks) : 32;
            for (int key = 0; key < nk; ++key) {
                const int s = ks + key;
                if (win) { const int dlt = t - s; if (dlt > 128 || dlt < -128) continue; }
                float sc = 0.f;
#pragma unroll
                for (int d = 0; d < DQK; d += 4) { const float4 kk = *(const float4*)&Ks[key * DQK + d]; sc += q[d] * kk.x + q[d + 1] * kk.y + q[d + 2] * kk.z + q[d + 3] * kk.w; }
                if (sc > m) { const float c = __expf(m - sc); lsum *= c;
#pragma unroll
                    for (int e = 0; e < 32; ++e) o[e] *= c;
                    m = sc; }
                const float pp = __expf(sc - m);
                lsum += pp;
#pragma unroll
                for (int e = 0; e < 32; e += 4) { const float4 vv = *(const float4*)&Vs[key * 64 + eh + e]; o[e] += pp * vv.x; o[e + 1] += pp * vv.y; o[e + 2] += pp * vv.z; o[e + 3] += pp * vv.w; }
            }
        }
    }
    if (j.sink) {
        const float sk = j.sink[h];
        const float mf = sk > m ? sk : m;
        const float c = __expf(m - mf);
        lsum = lsum * c + __expf(sk - mf);
#pragma unroll
        for (int e = 0; e < 32; ++e) o[e] *= c;
    }
    const float inv = 1.f / lsum;
    bf16* op = j.out + ((size_t)b * j.T + t) * 1024 + j.outcol + h * 64 + eh;
#pragma unroll
    for (int e = 0; e < 32; e += 2) *(unsigned*)(op + e) = (unsigned)f2bf(o[e] * inv) | ((unsigned)f2bf(o[e + 1] * inv) << 16);
}

__device__ __forceinline__ void ph_pool(const P& p, int l, unsigned char* smem) {
    float (*df)[257] = (float (*)[257])smem;
    const int tid = tidx(), half = tid >> 8, c256 = tid & 255;
    const bf16* proj = (const bf16*)(p.ws + WS_BIG + B_PROJ);
    bf16* br = (bf16*)(p.ws + WS_BR);
    for (int tile = blockIdx.x; tile < NTOK / 32; tile += gridDim.x) {
        const int row0 = tile * 32;
        int base, T;
        if (row0 < NPROMPT) { base = (row0 >> 8) << 8; T = 256; } else { base = NPROMPT + (((row0 - NPROMPT) >> 12) << 12); T = 4096; }
        __syncthreads();
        {
            const int c = c256, g = c >> 6, hw = 1 << g;
            for (int i = half * 16; i < half * 16 + 16; ++i) {
                const int t = row0 + i - base;
                const int lo = t - hw < 0 ? 0 : t - hw, hi = t + hw > T ? T : t + hw;
                float sacc = 0.f;
                for (int u = lo; u < hi; ++u) sacc += bf2f(proj[(size_t)(base + u) * PLD + C_CIN + c]);
                df[i][c] = sacc / (float)(hi - lo) - bf2f(proj[(size_t)(base + t) * PLD + C_CIN + c]);
            }
        }
        __syncthreads();
        {
            const int g = c256 >> 6, d = c256 & 63;
            float acc[16];
#pragma unroll
            for (int i = 0; i < 16; ++i) acc[i] = 0.f;
            const float* wp = p.c_w_pool + ((size_t)(l * 4 + g) * 64) * 64 + d;
            for (int c = 0; c < 64; ++c) {
                const float w = wp[c * 64];
#pragma unroll
                for (int i = 0; i < 16; ++i) acc[i] += df[half * 16 + i][g * 64 + c] * w;
            }
            const float sc = p.c_scale[l * 256 + c256];
#pragma unroll
            for (int i = 0; i < 16; ++i) br[(size_t)(row0 + half * 16 + i) * 1024 + 512 + c256] = f2bf(acc[i] * sc);
        }
    }
}

#define GLD 65
__device__ __forceinline__ void gdn_job(const P& p, int l, int job, unsigned char* smem) {
    float* sm = (float*)smem;
    float* qs = sm; float* ks = qs + 64 * GLD; float* us = ks + 64 * GLD; float* wsm = us + 64 * GLD; float* Lm = wsm + 64 * GLD;
    float* Ss = Lm + 64 * GLD; float* Vn = Ss + 64 * GLD; float* gcs = Vn + 64 * GLD; float* betas = gcs + 64; float* rqk = betas + 64; float* qdec = rqk + 128; float* kdec = qdec + 64;
    const int tid = tidx(), lane = tid & 63, wv = tid >> 6;
    const bf16* proj = (const bf16*)(p.ws + WS_BIG + B_PROJ);
    float* ofw = (float*)(p.ws + WS_BIG + B_OFW);
    bf16* br = (bf16*)(p.ws + WS_BR);
    int b, h, T, base; bool samp;
    if (job < 8) { samp = true; b = job >> 2; h = job & 3; T = 4096; base = NPROMPT + b * 4096; }
    else { samp = false; b = (job - 8) >> 2; h = (job - 8) & 3; T = 256; base = b * 256; }
    const int N = T / 64;
    for (int dir = 0; dir < 2; ++dir) {
        __syncthreads();
        const float* stp = (const float*)((uintptr_t)p.state_f + (uintptr_t)dir * ((uintptr_t)p.state_b - (uintptr_t)p.state_f));
        for (int idx = tid; idx < 4096; idx += NT) { const int d = idx >> 6, e = idx & 63; Ss[d * GLD + e] = samp ? stp[((size_t)(b * 2 + l) * 4 + h) * 4096 + idx] : 0.f; }
        const float Aexp = expf(p.d_a_log[(l * 2 + dir) * 4 + h]);
        const float dtb = p.d_dt_bias[(l * 2 + dir) * 4 + h];
        for (int n = 0; n < N; ++n) {
            const int cidx = dir ? N - 1 - n : n;
            __syncthreads();
            for (int idx = tid; idx < 64 * 192; idx += NT) {
                const int i = idx / 192, cc = idx % 192, part = cc >> 6, d = cc & 63;
                const int tt = cidx * 64 + (dir ? 63 - i : i);
                const int ch = part * 256 + h * 64 + d;
                float a = 0.f;
                for (int jj = 0; jj < 5; ++jj) { const int ts = tt + jj - 2; if (ts >= 0 && ts < T) a += p.d_conv[(l * 5 + jj) * 768 + ch] * bf2f(proj[(size_t)(base + ts) * PLD + C_DQKV + ch]); }
                const float u = siluf_(a);
                (part == 0 ? qs : part == 1 ? ks : us)[i * GLD + d] = u;
            }
            if (tid < 64) {
                const int i = tid, tt = cidx * 64 + (dir ? 63 - i : i);
                const bf16* pr = proj + (size_t)(base + tt) * PLD;
                betas[i] = sigmoidf_(bf2f(pr[C_DBETA + dir * 4 + h]));
                const float al = bf2f(pr[C_DALPHA + dir * 4 + h]) + dtb;
                const float sp = al > 20.f ? al : log1pf(expf(al));
                gcs[i] = -Aexp * sp;
            }
            __syncthreads();
            if (tid < 128) { const int i = tid & 63; const float* src = tid < 64 ? qs : ks; float ss = 0.f; for (int d = 0; d < 64; ++d) ss += src[i * GLD + d] * src[i * GLD + d]; rqk[tid] = rsqrtf(ss + EPS) * (tid < 64 ? 0.125f : 1.f); }
            if (tid == 128) { float run = 0.f; for (int i = 0; i < 64; ++i) { run += gcs[i]; gcs[i] = run; } }
            __syncthreads();
            for (int idx = tid; idx < 4096; idx += NT) { const int i = idx >> 6, d = idx & 63; qs[i * GLD + d] *= rqk[i]; ks[i * GLD + d] *= rqk[64 + i]; }
            if (tid < 64) { qdec[tid] = expf(gcs[tid]); kdec[tid] = expf(gcs[63] - gcs[tid]); }
            __syncthreads();
            for (int idx = tid; idx < 4096; idx += NT) {
                const int i = idx >> 6, jx = idx & 63; float v = 0.f;
                if (jx < i) { float dot = 0.f; for (int d = 0; d < 64; ++d) dot += ks[i * GLD + d] * ks[jx * GLD + d]; v = betas[i] * dot * expf(gcs[i] - gcs[jx]); }
                Lm[i * GLD + jx] = v;
            }
            for (int idx = tid; idx < 4096; idx += NT) { const int i = idx >> 6, d = idx & 63; us[i * GLD + d] *= betas[i]; wsm[i * GLD + d] = ks[i * GLD + d] * betas[i] * qdec[i]; }
            __syncthreads();
            if (tid < 128) {
                float* X = tid < 64 ? us : wsm; const int col = tid & 63;
                for (int i = 1; i < 64; ++i) { float a = X[i * GLD + col]; for (int jx = 0; jx < i; ++jx) a -= Lm[i * GLD + jx] * X[jx * GLD + col]; X[i * GLD + col] = a; }
            }
            __syncthreads();
            for (int idx = tid; idx < 4096; idx += NT) {
                const int i = idx >> 6, jx = idx & 63; float v = 0.f;
                if (jx <= i) { float dot = 0.f; for (int d = 0; d < 64; ++d) dot += qs[i * GLD + d] * ks[jx * GLD + d]; v = dot * expf(gcs[i] - gcs[jx]); }
                Lm[i * GLD + jx] = v;
            }
            for (int idx = tid; idx < 4096; idx += NT) {
                const int i = idx >> 6, e = idx & 63; float a = us[i * GLD + e];
                for (int d = 0; d < 64; ++d) a -= wsm[i * GLD + d] * Ss[d * GLD + e];
                Vn[i * GLD + e] = a;
            }
            __syncthreads();
            for (int it = 0; it < 8; ++it) {
                const int i = it * 8 + wv, e = lane;
                float a = 0.f;
                for (int d = 0; d < 64; ++d) a += qs[i * GLD + d] * Ss[d * GLD + e];
                a *= qdec[i];
                for (int jx = 0; jx <= i; ++jx) a += Lm[i * GLD + jx] * Vn[jx * GLD + e];
                const int tt = cidx * 64 + (dir ? 63 - i : i);
                const size_t row = (size_t)(base + tt);
                if (dir == 0) ofw[row * 256 + h * 64 + e] = a;
                else {
                    a += ofw[row * 256 + h * 64 + e];
                    const float ss = wave_sum(a * a);
                    const float rinv = rsqrtf(ss * (1.f / 64.f) + EPS);
                    const float z = bf2f(proj[row * PLD + C_DZ + h * 64 + e]);
                    br[row * 1024 + 768 + h * 64 + e] = f2bf(a * rinv * p.d_g_norm[l * 64 + e] * siluf_(z));
                }
            }
            __syncthreads();
            {
                const float gl = qdec[63];
                for (int idx = tid; idx < 4096; idx += NT) {
                    const int d = idx >> 6, e = idx & 63; float a = Ss[d * GLD + e] * gl;
                    for (int i = 0; i < 64; ++i) a += ks[i * GLD + d] * kdec[i] * Vn[i * GLD + e];
                    Ss[d * GLD + e] = a;
                }
            }
        }
        __syncthreads();
        if (!samp) { float* so = p.out + (dir ? O_SB : O_SF) + ((size_t)(b * 2 + l) * 4 + h) * 4096; for (int idx = tid; idx < 4096; idx += NT) so[idx] = Ss[(idx >> 6) * GLD + (idx & 63)]; }
    }
}

struct KArgs { P p; TJobs J[2]; };

__device__ __forceinline__ AttnJob make_job(const P& p, int l, int variant) {
    unsigned char* ws = p.ws; unsigned char* big = ws + WS_BIG;
    bf16* proj = (bf16*)(big + B_PROJ); bf16* BRb = (bf16*)(ws + WS_BR);
    const float bscale = 0.10206207261596575f;
    AttnJob j{};
    if (variant == 0) {
        j.q1 = proj + C_AQ; j.ldq1 = PLD; j.k1 = proj + C_AK; j.ldk1 = PLD; j.v1 = proj + C_AV; j.ldv1 = PLD; j.kstride = 64; j.vstride = 64; j.kvgroup = 2;
        j.nbatch = 32; j.T = 256; j.nk2 = 0; j.window = 0; j.sink = p.a_sink + l * 4; j.scale = 0.125f; j.out = BRb; j.outcol = 0;
    } else if (variant == 1) {
        j.q1 = (bf16*)(big + B_QA1S); j.ldq1 = 256; j.q2 = proj + (size_t)NPROMPT * PLD + C_AQ; j.ldq2 = PLD;
        j.k1 = (bf16*)(big + B_KA1S); j.ldk1 = 128; j.v1 = proj + (size_t)NPROMPT * PLD + C_AV; j.ldv1 = PLD;
        j.k2 = (bf16*)(ws + WS_KAC); j.ldk2 = 128; j.v2 = (bf16*)(ws + WS_VAC); j.ldv2 = 128; j.kstride = 64; j.vstride = 64; j.kvgroup = 2;
        j.nbatch = 2; j.T = 4096; j.nk2 = 256; j.window = 1; j.sink = p.a_sink + l * 4; j.scale = 0.125f; j.out = BRb + (size_t)NPROMPT * 1024; j.outcol = 0;
    } else if (variant == 2) {
        j.q1 = (bf16*)(big + B_QB); j.ldq1 = 384; j.k1 = (bf16*)(big + B_KB); j.ldk1 = 384; j.v1 = (bf16*)(big + B_KV) + 64; j.ldv1 = 512; j.kstride = 96; j.vstride = 128; j.kvgroup = 1;
        j.nbatch = 32; j.T = 256; j.nk2 = 0; j.window = 0; j.sink = nullptr; j.scale = bscale; j.out = BRb; j.outcol = 256;
    } else {
        j.q1 = (bf16*)(big + B_CQ); j.ldq1 = 384; j.q2 = (bf16*)(big + B_QB) + (size_t)NPROMPT * 384; j.ldq2 = 384;
        j.k1 = (bf16*)(big + B_KB) + (size_t)NPROMPT * 384; j.ldk1 = 384; j.v1 = (bf16*)(big + B_KV) + (size_t)NPROMPT * 512 + 64; j.ldv1 = 512;
        j.k2 = (bf16*)(big + B_KB) + (size_t)NTOK * 384; j.ldk2 = 384; j.v2 = (bf16*)(big + B_KV) + (size_t)NTOK * 512 + 64; j.ldv2 = 512; j.kstride = 96; j.vstride = 128; j.kvgroup = 1;
        j.nbatch = 2; j.T = 4096; j.nk2 = 256; j.window = 0; j.sink = nullptr; j.scale = bscale; j.out = BRb + (size_t)NPROMPT * 1024; j.outcol = 256;
    }
    return j;
}

__device__ __forceinline__ void ph_gemm_proj(const P& p, unsigned char* smem) {
    GemmArgs g{(bf16*)(p.ws + WS_H), (bf16*)(p.ws + WS_W + W_A), 1024, 1024, NTOK, 2176, 1024, 0}; EpiStore e{(bf16*)(p.ws + WS_BIG + B_PROJ), PLD, PLD}; gemm_tiles(g, e, smem);
}
__device__ __forceinline__ void ph_gemm_mla(const P& p, unsigned char* smem) {
    unsigned char* big = p.ws + WS_BIG;
    { GemmArgs g{(bf16*)(big + B_CQ), (bf16*)(p.ws + WS_W + W_UQ), 192, 192, NTOK, 384, 192, 0}; EpiStore e{(bf16*)(big + B_QB), 384, 384}; gemm_tiles(g, e, smem); }
    { GemmArgs g{(bf16*)(big + B_CKV), (bf16*)(p.ws + WS_W + W_UKV), 128, 128, NKVROWS, 512, 128, 0}; EpiStore e{(bf16*)(big + B_KV), 512, 512}; gemm_tiles(g, e, smem); }
}
__device__ __forceinline__ void ph_gemm_br(const P& p, unsigned char* smem) {
    bf16* BRb = (bf16*)(p.ws + WS_BR); bf16* prod = (bf16*)(p.ws + WS_BIG + B_PROD);
    for (int m = 0; m < 4; ++m) { GemmArgs g{BRb + m * 256, (bf16*)(p.ws + WS_W + W_BR) + (size_t)m * 1024 * 256, 1024, 256, NTOK, 1024, 256, 0}; EpiStore e{prod + m * 1024, 4096, 1 << 30}; gemm_tiles(g, e, smem); }
}
__device__ __forceinline__ void ph_gemm_gate(const P& p, unsigned char* smem) {
    GemmArgs g{(bf16*)(p.ws + WS_H), (bf16*)(p.ws + WS_W + W_G), 1024, 1024, NTOK, 4096, 1024, 0}; EpiGate e{(bf16*)(p.ws + WS_BIG + B_PROD), 4096}; gemm_tiles(g, e, smem);
}
__device__ __forceinline__ void ph_gemm_wo(const P& p, unsigned char* smem) {
    GemmArgs g{(bf16*)(p.ws + WS_BIG + B_PROD), (bf16*)(p.ws + WS_W + W_O4), 4096, 4096, NTOK, 1024, 4096, 0}; EpiStore e{(bf16*)(p.ws + WS_BR), 1024, 1024}; gemm_tiles(g, e, smem);
}
__device__ __forceinline__ void ph_gemm_up(const P& p, unsigned char* smem) {
    GemmArgs g{(bf16*)(p.ws + WS_H), (bf16*)(p.ws + WS_W + W_UP), 1024, 1024, NTOK, 5632, 1024, 0}; EpiSwiglu e{(bf16*)(p.ws + WS_BIG + B_HID), DFF}; gemm_tiles(g, e, smem);
}
__device__ __forceinline__ void ph_gemm_down(const P& p, unsigned char* smem) {
    GemmArgs g{(bf16*)(p.ws + WS_BIG + B_HID), (bf16*)(p.ws + WS_W + W_DN), DFF, DFF, NTOK, 1024, DFF, 0}; EpiStore e{(bf16*)(p.ws + WS_BR), 1024, 1024}; gemm_tiles(g, e, smem);
}
__device__ __forceinline__ void ph_mixers(const P& p, int l, unsigned char* smem) {
    if ((int)blockIdx.x >= (int)gridDim.x - 136) gdn_job(p, l, (int)gridDim.x - 1 - (int)blockIdx.x, smem);
    for (int item = blockIdx.x; item < 512; item += gridDim.x) {
        const int vi = item >> 7, blk = item & 127;
        const int variant = vi == 0 ? 3 : vi == 1 ? 1 : vi == 2 ? 2 : 0;
        __syncthreads();
        if (variant == 0) { const AttnJob j = make_job(p, l, 0); attn_item<64>(j, blk, smem); }
        else if (variant == 1) { const AttnJob j = make_job(p, l, 1); attn_item<64>(j, blk, smem); }
        else if (variant == 2) { const AttnJob j = make_job(p, l, 2); attn_item<96>(j, blk, smem); }
        else { const AttnJob j = make_job(p, l, 3); attn_item<96>(j, blk, smem); }
    }
    __syncthreads();
    ph_pool(p, l, smem);
}

#define GSYNC() grid.sync()
__global__ void __launch_bounds__(NT) mega(KArgs a) {
    extern __shared__ __attribute__((aligned(16))) unsigned char smem[];
    cg::grid_group grid = cg::this_grid();
    { const P p = fence_P(); ph_mod(p, smem); }
    __syncthreads();
    ph_convert(a.J[0], smem);
    GSYNC();
    { const P p = fence_P(); ph_prenorm(p, 0); }
    GSYNC();
#pragma unroll 1
    for (int l = 0; l < 2; ++l) {
        { const P p = fence_P(); ph_gemm_proj(p, smem); }
        GSYNC();
        { const P p = fence_P(); ph_postproj(p, l); }
        GSYNC();
        { const P p = fence_P(); ph_gemm_mla(p, smem); }
        GSYNC();
        { const P p = fence_P(); ph_prep2(p, l); }
        GSYNC();
        { const P p = fence_P(); ph_mixers(p, l, smem); }
        GSYNC();
        { const P p = fence_P(); ph_gemm_br(p, smem); }
        GSYNC();
        { const P p = fence_P(); ph_gemm_gate(p, smem); }
        GSYNC();
        { const P p = fence_P(); ph_gemm_wo(p, smem); }
        GSYNC();
        { const P p = fence_P(); ph_post(p, l, 1); }
        GSYNC();
        { const P p = fence_P(); ph_gemm_up(p, smem); }
        GSYNC();
        { const P p = fence_P(); ph_gemm_down(p, smem); }
        GSYNC();
        { const P p = fence_P(); ph_post(p, l, 2); }
        if (l == 0) { __syncthreads(); ph_convert(a.J[1], smem); GSYNC(); }
    }
}

static void add_job(TJobs& J, const float* src, bf16* dst, int ldw, int K, int Ndst, int ldo, int mode, int arg, int nvalid) {
    TJob& j = J.j[J.n]; j.src = src; j.dst = dst; j.ldw = ldw; j.K = K; j.Ndst = Ndst; j.ldo = ldo; j.mode = mode; j.arg = arg; j.nvalid = nvalid; j.tile0 = J.total;
    J.total += (Ndst / 64) * (K / 64); J.n++;
}

extern "C" void kernel_launch(void* const* d_in, const int* in_sizes, int n_in, void* d_out, int out_size, void* d_ws, size_t ws_size, hipStream_t stream) {
    if (n_in != 32 || ws_size < WS_NEED) { fprintf(stderr, "kernel_launch: unexpected n_in %d or ws_size %zu (need %zu)\n", n_in, ws_size, (size_t)WS_NEED); return; }
    static int grid = 0;
    if (grid == 0) {
        int dev = 0, cus = 0, per_cu = 0;
        (void)hipGetDevice(&dev);
        (void)hipDeviceGetAttribute(&cus, hipDeviceAttributeMultiprocessorCount, dev);
        (void)hipFuncSetAttribute((const void*)mega, hipFuncAttributeMaxDynamicSharedMemorySize, LDS_BYTES);
        (void)hipOccupancyMaxActiveBlocksPerMultiprocessor(&per_cu, (const void*)mega, NT, LDS_BYTES);
        if (per_cu < 1) { fprintf(stderr, "kernel_launch: occupancy query says %d blocks/CU\n", per_cu); per_cu = 1; }
        if (per_cu > 1) per_cu = 1;
        grid = cus * per_cu;
    }
    KArgs a{};
    const float** pf = (const float**)&a.p;
    for (int i = 0; i < 32; ++i) pf[i] = (const float*)d_in[i];
    a.p.out = (float*)d_out; a.p.ws = (unsigned char*)d_ws;
    const P& p = a.p;
    bf16* Wb = (bf16*)(a.p.ws + WS_W);
    for (int l = 0; l < 2; ++l) {
        TJobs& J = a.J[l];
        add_job(J, p.w_in + (size_t)l * 1024 * PIN, (bf16*)((char*)Wb + W_A), PIN, 1024, 2176, 1024, 0, 0, 2160);
        add_job(J, p.w_in + (size_t)l * 1024 * PIN, (bf16*)((char*)Wb + W_G), PIN, 1024, 4096, 1024, 0, C_GATE, 4096);
        for (int m = 0; m < 4; ++m) add_job(J, p.w_br + ((size_t)l * 4 + m) * 256 * 1024, (bf16*)((char*)Wb + W_BR) + (size_t)m * 1024 * 256, 1024, 256, 1024, 256, 0, 0, 1024);
        for (int m = 0; m < 4; ++m) add_job(J, p.w_o + (size_t)l * 1024 * 1024, (bf16*)((char*)Wb + W_O4) + m * 1024, 1024, 1024, 1024, 4096, 0, 0, 1024);
        add_job(J, p.w_up + (size_t)l * 1024 * 5632, (bf16*)((char*)Wb + W_UP), 5632, 1024, 5632, 1024, 1, 0, 5632);
        add_job(J, p.w_down + (size_t)l * DFF * 1024, (bf16*)((char*)Wb + W_DN), 1024, DFF, 1024, DFF, 0, 0, 1024);
        add_job(J, p.b_w_uq + (size_t)l * 192 * 384, (bf16*)((char*)Wb + W_UQ), 384, 192, 384, 192, 0, 0, 384);
        add_job(J, p.b_w_ukv + (size_t)l * 128 * 512, (bf16*)((char*)Wb + W_UKV), 512, 128, 512, 128, 0, 0, 512);
    }
    void* args[] = {&a};
    hipError_t e = hipLaunchCooperativeKernel((const void*)mega, dim3(grid), dim3(NT), args, LDS_BYTES, stream);
    if (e != hipSuccess) fprintf(stderr, "cooperative launch failed: %s (grid %d)\n", hipGetErrorString(e), grid);
}
```

```cpp
#include <hip/hip_runtime.h>
#include <hip/hip_cooperative_groups.h>
namespace cg = cooperative_groups;
#define NT 512
#define NWV 8
#define LDS_BYTES 147456
#include <stdint.h>
#include <stdio.h>

typedef unsigned short bf16;
typedef short bf16x8 __attribute__((ext_vector_type(8)));
typedef float f32x16 __attribute__((ext_vector_type(16)));

#define DM 1024
#define NTOK 16384
#define NPROMPT 8192
#define PLD 2176
#define C_AQ 0
#define C_AK 256
#define C_AV 384
#define C_BCQ 512
#define C_BCKV 704
#define C_BKR 832
#define C_CIN 864
#define C_DQKV 1120
#define C_DZ 1888
#define C_DBETA 2144
#define C_DALPHA 2152
#define C_GATE 2160
#define PIN 6256
#define DFF 2816
#define EPS 1e-6f
#define NKVROWS 16896

#define O_Y 0
#define O_CAK 16777216
#define O_CAV 18874368
#define O_CKV 20971520
#define O_KR 23068672
#define O_SF 23592960
#define O_SB 24641536

#define MB(x) ((size_t)(x) * 1024 * 1024)
#define WS_MOD 0
#define WS_TAB (WS_MOD + 147456)
#define WS_KAC (WS_TAB + 12288)
#define WS_VAC (WS_KAC + 512 * 128 * 2)
#define WS_GGC (WS_VAC + 512 * 128 * 2)
#define WS_W (MB(1))
#define W_A 0
#define W_G (W_A + 2176 * 1024 * 2)
#define W_BR (W_G + 4096 * 1024 * 2)
#define W_O4 (W_BR + 4 * 1024 * 256 * 2)
#define W_UP (W_O4 + 1024 * 4096 * 2)
#define W_DN (W_UP + 5632 * 1024 * 2)
#define W_UQ (W_DN + 1024 * 2816 * 2)
#define W_UKV (W_UQ + 384 * 192 * 2)
#define W_END (W_UKV + 512 * 128 * 2)
#define WS_H (MB(42))
#define WS_BR (MB(74))
#define WS_BIG (MB(106))
#define B_PROJ 0
#define B_CQ (B_PROJ + (size_t)16384 * 2176 * 2)
#define B_CKV (B_CQ + (size_t)16384 * 192 * 2)
#define B_QB (B_CKV + (size_t)16896 * 128 * 2)
#define B_KV (B_QB + (size_t)16384 * 384 * 2)
#define B_QA1S (B_KV + (size_t)16896 * 512 * 2)
#define B_KA1S (B_QA1S + (size_t)8192 * 256 * 2)
#define B_KB (B_KA1S + (size_t)8192 * 128 * 2)
#define B_GQK (B_KB + (size_t)16896 * 384 * 2)
#define B_GUW (B_GQK + (size_t)8192 * 512 * 2)
#define B_END_A (B_GUW + (size_t)1024 * 8192 * 2)
#define B_GOB B_CKV
#define B_PROD 0
#define B_HID 0
#define WS_NEED (WS_BIG + B_END_A)

struct P {
    const float *x_prompt, *x_sample, *cache_a_k, *cache_a_v, *cache_b_ckv, *cache_b_krope, *state_f, *state_b, *c, *c_ctx;
    const float *w_mod, *b_mod, *g_pre1, *g_post1, *g_pre2, *g_post2, *w_in, *a_sink, *b_g_cq, *b_g_ckv, *b_w_uq, *b_w_ukv;
    const float *c_w_pool, *c_scale, *d_conv, *d_a_log, *d_dt_bias, *d_g_norm, *w_br, *w_o, *w_up, *w_down;
    float* out;
    unsigned char* ws;
};


typedef const __attribute__((address_space(4))) unsigned char* kargp_t;
__device__ __forceinline__ P fence_P() {
    kargp_t kp = (kargp_t)__builtin_amdgcn_kernarg_segment_ptr();
    asm volatile("" : "+s"(kp));
    const __attribute__((address_space(4))) P* pp = (const __attribute__((address_space(4))) P*)kp;
    P q;
    q.x_prompt = pp->x_prompt;
    q.x_sample = pp->x_sample;
    q.cache_a_k = pp->cache_a_k;
    q.cache_a_v = pp->cache_a_v;
    q.cache_b_ckv = pp->cache_b_ckv;
    q.cache_b_krope = pp->cache_b_krope;
    q.state_f = pp->state_f;
    q.state_b = pp->state_b;
    q.c = pp->c;
    q.c_ctx = pp->c_ctx;
    q.w_mod = pp->w_mod;
    q.b_mod = pp->b_mod;
    q.g_pre1 = pp->g_pre1;
    q.g_post1 = pp->g_post1;
    q.g_pre2 = pp->g_pre2;
    q.g_post2 = pp->g_post2;
    q.w_in = pp->w_in;
    q.a_sink = pp->a_sink;
    q.b_g_cq = pp->b_g_cq;
    q.b_g_ckv = pp->b_g_ckv;
    q.b_w_uq = pp->b_w_uq;
    q.b_w_ukv = pp->b_w_ukv;
    q.c_w_pool = pp->c_w_pool;
    q.c_scale = pp->c_scale;
    q.d_conv = pp->d_conv;
    q.d_a_log = pp->d_a_log;
    q.d_dt_bias = pp->d_dt_bias;
    q.d_g_norm = pp->d_g_norm;
    q.w_br = pp->w_br;
    q.w_o = pp->w_o;
    q.w_up = pp->w_up;
    q.w_down = pp->w_down;
    q.out = pp->out;
    q.ws = pp->ws;
    return q;
}

__device__ __forceinline__ bf16 f2bf(float f) {
    unsigned u = __float_as_uint(f);
    u += 0x7fffu + ((u >> 16) & 1u);
    return (bf16)(u >> 16);
}
__device__ __forceinline__ float bf2f(bf16 h) { return __uint_as_float(((unsigned)h) << 16); }
__device__ __forceinline__ float wave_sum(float v) {
#pragma unroll
    for (int o = 32; o > 0; o >>= 1) v += __shfl_xor(v, o);
    return v;
}

__device__ __forceinline__ unsigned vzero() { unsigned z = 0; asm volatile("" : "+v"(z)); return z; }
__device__ __forceinline__ int tidx() { int t = threadIdx.x; asm volatile("" : "+v"(t)); return t; }
__device__ __forceinline__ float sigmoidf_(float x) { return 1.f / (1.f + __expf(-x)); }
__device__ __forceinline__ float siluf_(float x) { return x / (1.f + __expf(-x)); }

struct TJob { const float* src; bf16* dst; int ldw, K, Ndst, ldo, mode, arg, nvalid, tile0; };
struct TJobs { TJob j[16]; int n, total; };

__device__ __forceinline__ void ph_convert(const TJobs& J, unsigned char* smem) {
    float (*tile)[65] = (float (*)[65])smem;
    const int tid = tidx();
    for (int t = blockIdx.x; t < J.total; t += gridDim.x) {
        int ji = 0;
        for (int q = 1; q < J.n; ++q) if (t >= J.j[q].tile0) ji = q;
        const TJob jb = J.j[ji];
        const int local = t - jb.tile0, nkt = jb.K / 64, tn = local / nkt, tk = local % nkt;
        const int tx = tid & 63, ty = tid >> 6;
        const int n = tn * 64 + tx;
        int sc;
        if (jb.mode == 0) sc = (n < jb.nvalid) ? n + jb.arg : -1;
        else { const int tl = n >> 7, wn = (n >> 6) & 1, nj = (n >> 5) & 1, j = n & 31; sc = nj * DFF + tl * 64 + wn * 32 + j; }
        for (int kk = ty; kk < 64; kk += NWV) tile[kk][tx] = (sc >= 0) ? jb.src[(size_t)(tk * 64 + kk) * jb.ldw + sc] : 0.f;
        __syncthreads();
        {
            const int q = tid, r = q >> 3, c8 = q & 7;
            unsigned w[4];
            for (int j = 0; j < 4; ++j) w[j] = (unsigned)f2bf(tile[c8 * 8 + 2 * j][r]) | ((unsigned)f2bf(tile[c8 * 8 + 2 * j + 1][r]) << 16);
            *(uint4*)(jb.dst + (size_t)(tn * 64 + r) * jb.ldo + tk * 64 + c8 * 8) = make_uint4(w[0], w[1], w[2], w[3]);
        }
        __syncthreads();
    }
}

__device__ __forceinline__ void ph_mod(const P& p, unsigned char* smem) {
    float (*cs)[1024] = (float (*)[1024])smem;
    float (*red)[3][64] = (float (*)[3][64])(smem + 3 * 1024 * 4);
    const int tid = tidx();
    float* mod = (float*)(p.ws + WS_MOD);
    for (int i = tid; i < 3072; i += NT) { const int r = i >> 10, k = i & 1023; const float v = (r == 0) ? p.c_ctx[k] : p.c[(r - 1) * 1024 + k]; cs[r][k] = siluf_(v); }
    __syncthreads();
    for (int it = blockIdx.x; it < 192; it += gridDim.x) {
        const int l = it / 96, cg = it % 96, col = cg * 64 + (tid & 63), kq = tid >> 6;
        float a0 = 0.f, a1 = 0.f, a2 = 0.f;
        const float* w = p.w_mod + ((size_t)l * 1024 + kq * 128) * 6144 + col;
        for (int k = 0; k < 128; ++k) { const float wv = w[(size_t)k * 6144]; a0 += cs[0][kq * 128 + k] * wv; a1 += cs[1][kq * 128 + k] * wv; a2 += cs[2][kq * 128 + k] * wv; }
        red[kq][0][tid & 63] = a0; red[kq][1][tid & 63] = a1; red[kq][2][tid & 63] = a2;
        __syncthreads();
        if (tid < 192) { const int r = tid >> 6, cc = tid & 63; const float s = red[0][r][cc] + red[1][r][cc] + red[2][r][cc] + red[3][r][cc] + red[4][r][cc] + red[5][r][cc] + red[6][r][cc] + red[7][r][cc] + p.b_mod[l * 6144 + cg * 64 + cc]; mod[(l * 3 + r) * 6144 + cg * 64 + cc] = s; }
        __syncthreads();
    }
    if (blockIdx.x == 0) {
        float* tab = (float*)(p.ws + WS_TAB);
        for (int i = tid; i < 64 * 16; i += NT) { const int pos = i >> 4, f = i & 15; const float inv = powf(10000.f, -(float)f / 16.f); float s, c; sincosf((float)pos * inv, &s, &c); tab[i] = c; tab[1024 + i] = s; }
        for (int i = tid; i < 64 * 8; i += NT) { const int pos = i >> 3, f = i & 7; const float inv = powf(10000.f, -(float)f / 8.f); float s, c; sincosf((float)pos * inv, &s, &c); tab[2048 + i] = c; tab[2560 + i] = s; }
    }
}

__device__ __forceinline__ const float* xrow_in(const P& p, int row) { return row < NPROMPT ? p.x_prompt + (size_t)row * DM : p.x_sample + (size_t)(row - NPROMPT) * DM; }
__device__ __forceinline__ int cond_row(int row) { return row < NPROMPT ? 0 : 1 + ((row - NPROMPT) >> 12); }

__device__ __forceinline__ void ph_prenorm(const P& p, int l) {
    const int lane = tidx() & 63;
    const float* mod = (const float*)(p.ws + WS_MOD);
    bf16* H = (bf16*)(p.ws + WS_H);
    for (int row = blockIdx.x * NWV + (tidx() >> 6); row < NTOK; row += gridDim.x * NWV) {
        const float* xr = (l == 0) ? xrow_in(p, row) : p.out + (size_t)row * DM;
        float4 v[4]; float ss = 0.f;
        for (int i = 0; i < 4; ++i) { v[i] = *(const float4*)(xr + i * 256 + lane * 4); ss += v[i].x * v[i].x + v[i].y * v[i].y + v[i].z * v[i].z + v[i].w * v[i].w; }
        ss = wave_sum(ss);
        const float rinv = rsqrtf(ss * (1.f / 1024.f) + EPS);
        const float* md = mod + (l * 3 + cond_row(row)) * 6144;
        for (int i = 0; i < 4; ++i) {
            const int col = i * 256 + lane * 4;
            const float4 g = *(const float4*)(p.g_pre1 + l * 1024 + col), sc = *(const float4*)(md + 1024 + col), sh = *(const float4*)(md + col);
            const float h0 = v[i].x * rinv * g.x * (1.f + sc.x) + sh.x, h1 = v[i].y * rinv * g.y * (1.f + sc.y) + sh.y;
            const float h2 = v[i].z * rinv * g.z * (1.f + sc.z) + sh.z, h3 = v[i].w * rinv * g.w * (1.f + sc.w) + sh.w;
            *(uint2*)(H + (size_t)row * DM + col) = make_uint2((unsigned)f2bf(h0) | ((unsigned)f2bf(h1) << 16), (unsigned)f2bf(h2) | ((unsigned)f2bf(h3) << 16));
        }
    }
}

__device__ __forceinline__ void ph_post(const P& p, int l, int which) {
    const int lane = tidx() & 63;
    const float* mod = (const float*)(p.ws + WS_MOD);
    bf16* H = (bf16*)(p.ws + WS_H);
    const bf16* src = (const bf16*)(p.ws + WS_BR);
    const float* gpost = (which == 1 ? p.g_post1 : p.g_post2) + l * 1024;
    const int ga_off = which == 1 ? 2048 : 5120;
    const bool donext = (which == 1) || (l == 0);
    const int ln = which == 1 ? l : l + 1;
    const float* gpre = (which == 1 ? p.g_pre2 : p.g_pre1) + ln * 1024;
    const int sc_off = which == 1 ? 4096 : 1024, sh_off = which == 1 ? 3072 : 0;
    for (int row = blockIdx.x * NWV + (tidx() >> 6); row < NTOK; row += gridDim.x * NWV) {
        const float* xr = (l == 0 && which == 1) ? xrow_in(p, row) : p.out + (size_t)row * DM;
        const int cr = cond_row(row);
        const float* md = mod + (l * 3 + cr) * 6144;
        float4 x[4], s[4]; float ss = 0.f;
        for (int i = 0; i < 4; ++i) {
            const int col = i * 256 + lane * 4;
            x[i] = *(const float4*)(xr + col);
            const uint2 raw = *(const uint2*)(src + (size_t)row * DM + col);
            s[i] = make_float4(bf2f((bf16)(raw.x & 0xffff)), bf2f((bf16)(raw.x >> 16)), bf2f((bf16)(raw.y & 0xffff)), bf2f((bf16)(raw.y >> 16)));
            ss += s[i].x * s[i].x + s[i].y * s[i].y + s[i].z * s[i].z + s[i].w * s[i].w;
        }
        ss = wave_sum(ss);
        const float rinv = rsqrtf(ss * (1.f / 1024.f) + EPS);
        float ss2 = 0.f;
        for (int i = 0; i < 4; ++i) {
            const int col = i * 256 + lane * 4;
            const float4 g = *(const float4*)(gpost + col), ga = *(const float4*)(md + ga_off + col);
            x[i].x += ga.x * s[i].x * rinv * g.x; x[i].y += ga.y * s[i].y * rinv * g.y; x[i].z += ga.z * s[i].z * rinv * g.z; x[i].w += ga.w * s[i].w * rinv * g.w;
            *(float4*)(p.out + (size_t)row * DM + col) = x[i];
            ss2 += x[i].x * x[i].x + x[i].y * x[i].y + x[i].z * x[i].z + x[i].w * x[i].w;
        }
        if (donext) {
            ss2 = wave_sum(ss2);
            const float rinv2 = rsqrtf(ss2 * (1.f / 1024.f) + EPS);
            const float* md2 = mod + (ln * 3 + cr) * 6144;
            for (int i = 0; i < 4; ++i) {
                const int col = i * 256 + lane * 4;
                const float4 g = *(const float4*)(gpre + col), sc = *(const float4*)(md2 + sc_off + col), sh = *(const float4*)(md2 + sh_off + col);
                const float h0 = x[i].x * rinv2 * g.x * (1.f + sc.x) + sh.x, h1 = x[i].y * rinv2 * g.y * (1.f + sc.y) + sh.y;
                const float h2 = x[i].z * rinv2 * g.z * (1.f + sc.z) + sh.z, h3 = x[i].w * rinv2 * g.w * (1.f + sc.w) + sh.w;
                *(uint2*)(H + (size_t)row * DM + col) = make_uint2((unsigned)f2bf(h0) | ((unsigned)f2bf(h1) << 16), (unsigned)f2bf(h2) | ((unsigned)f2bf(h3) << 16));
            }
        }
    }
}

struct GemmArgs { const bf16* A; const bf16* Bt; int lda, ldb, M, N, K, pad; };

struct EpiStore {
    bf16* C; int ldc, nvalid;
    __device__ __forceinline__ void operator()(const f32x16 (&acc)[2][2], int rowbase, int colbase, int tn, int wn, int lane) const {
        _Pragma("unroll") for (int mi = 0; mi < 2; ++mi) _Pragma("unroll") for (int nj = 0; nj < 2; ++nj) {
            const int col = colbase + nj * 32 + (lane & 31);
            if (col < nvalid) _Pragma("unroll") for (int r = 0; r < 16; ++r) { const int row = rowbase + mi * 32 + (r & 3) + 8 * (r >> 2) + 4 * (lane >> 5); C[(size_t)row * ldc + col] = f2bf(acc[mi][nj][r]); }
        }
    }
};
struct EpiGate {
    bf16* C; int ldc;
    __device__ __forceinline__ void operator()(const f32x16 (&acc)[2][2], int rowbase, int colbase, int tn, int wn, int lane) const {
        _Pragma("unroll") for (int mi = 0; mi < 2; ++mi) _Pragma("unroll") for (int nj = 0; nj < 2; ++nj) {
            const int col = colbase + nj * 32 + (lane & 31);
            _Pragma("unroll") for (int r = 0; r < 16; ++r) { const int row = rowbase + mi * 32 + (r & 3) + 8 * (r >> 2) + 4 * (lane >> 5); bf16* q = C + (size_t)row * ldc + col; *q = f2bf(sigmoidf_(acc[mi][nj][r]) * bf2f(*q)); }
        }
    }
};
struct EpiSwiglu {
    bf16* C; int ldc;
    __device__ __forceinline__ void operator()(const f32x16 (&acc)[2][2], int rowbase, int colbase, int tn, int wn, int lane) const {
        const int col = tn * 64 + wn * 32 + (lane & 31);
        _Pragma("unroll") for (int mi = 0; mi < 2; ++mi) _Pragma("unroll") for (int r = 0; r < 16; ++r) {
            const int row = rowbase + mi * 32 + (r & 3) + 8 * (r >> 2) + 4 * (lane >> 5);
            C[(size_t)row * ldc + col] = f2bf(siluf_(acc[mi][0][r]) * acc[mi][1][r]);
        }
    }
};

template <class Epi>
__device__ __forceinline__ void gemm_tiles(const GemmArgs g, const Epi epi, unsigned char* smem) {
    const int vb = tidx() >> 8, tid = tidx() & 255, lane = tid & 63, w = tid >> 6, wm = w >> 1, wn = w & 1;
    bf16* As = (bf16*)(smem + vb * 65536);
    bf16* Bs = As + 2 * 128 * 64;
    const int nM = g.M / 128, nN = g.N / 128, nK = g.K / 64, ntiles = nM * nN;
    const int nvb = gridDim.x * 2, iters = (ntiles + nvb - 1) / nvb;
    for (int it = 0; it < iters; ++it) {
        const int t0 = it * nvb + blockIdx.x * 2 + vb;
        const bool valid = t0 < ntiles;
        const int t = valid ? t0 : 0;
        const int grp = t / (16 * nN), first = grp * 16, gsz = (nM - first) < 16 ? (nM - first) : 16, r0 = t - grp * 16 * nN;
        const int tm = first + r0 % gsz, tn = r0 / gsz;
        const bf16* Ag = g.A + (size_t)(tm * 128) * g.lda;
        const bf16* Bg = g.Bt + (size_t)(tn * 128) * g.ldb;
        typedef unsigned u32x4 __attribute__((ext_vector_type(4)));
        u32x4 ra0, ra1, ra2, ra3, rb0, rb1, rb2, rb3;
        f32x16 acc[2][2];
        _Pragma("unroll") for (int mi = 0; mi < 2; ++mi) _Pragma("unroll") for (int nj = 0; nj < 2; ++nj) _Pragma("unroll") for (int r = 0; r < 16; ++r) acc[mi][nj][r] = 0.f;
        const int lrow = tid >> 3, lch = tid & 7;
        const bf16* Ap = Ag + (size_t)lrow * g.lda + lch * 8;
        const bf16* Bp = Bg + (size_t)lrow * g.ldb + lch * 8;
        const size_t a32 = (size_t)32 * g.lda, b32 = (size_t)32 * g.ldb;
#define GLOAD(k0) { ra0 = *(const u32x4*)(Ap + (k0)); ra1 = *(const u32x4*)(Ap + a32 + (k0)); ra2 = *(const u32x4*)(Ap + 2 * a32 + (k0)); ra3 = *(const u32x4*)(Ap + 3 * a32 + (k0)); \
                    rb0 = *(const u32x4*)(Bp + (k0)); rb1 = *(const u32x4*)(Bp + b32 + (k0)); rb2 = *(const u32x4*)(Bp + 2 * b32 + (k0)); rb3 = *(const u32x4*)(Bp + 3 * b32 + (k0)); }
        GLOAD(0)
        const int soff = lrow * 64 + ((lch ^ (lrow & 7)) << 3);
        for (int kt = 0; kt < nK; ++kt) {
            bf16* Ab = As + (kt & 1) * 8192; bf16* Bb = Bs + (kt & 1) * 8192;
            *(u32x4*)(Ab + soff) = ra0; *(u32x4*)(Ab + soff + 2048) = ra1; *(u32x4*)(Ab + soff + 4096) = ra2; *(u32x4*)(Ab + soff + 6144) = ra3;
            *(u32x4*)(Bb + soff) = rb0; *(u32x4*)(Bb + soff + 2048) = rb1; *(u32x4*)(Bb + soff + 4096) = rb2; *(u32x4*)(Bb + soff + 6144) = rb3;
            __syncthreads();
            if (kt + 1 < nK) GLOAD((kt + 1) * 64)
#pragma unroll
            for (int kk = 0; kk < 4; ++kk) {
                bf16x8 a[2], b[2];
                const int ch = kk * 2 + (lane >> 5);
#pragma unroll
                for (int mi = 0; mi < 2; ++mi) { const int row = wm * 64 + mi * 32 + (lane & 31); a[mi] = *(const bf16x8*)(Ab + row * 64 + ((ch ^ (row & 7)) << 3)); }
#pragma unroll
                for (int nj = 0; nj < 2; ++nj) { const int row = wn * 64 + nj * 32 + (lane & 31); b[nj] = *(const bf16x8*)(Bb + row * 64 + ((ch ^ (row & 7)) << 3)); }
#pragma unroll
                for (int mi = 0; mi < 2; ++mi)
#pragma unroll
                    for (int nj = 0; nj < 2; ++nj) acc[mi][nj] = __builtin_amdgcn_mfma_f32_32x32x16_bf16(a[mi], b[nj], acc[mi][nj], 0, 0, 0);
            }
        }
        if (valid) epi(acc, tm * 128 + wm * 64, tn * 128 + wn * 64, tn, wn, lane);
        __syncthreads();
    }
}

__device__ __forceinline__ void ph_postproj(const P& p, int l) {
    const int lane = tidx() & 63;
    const bf16* proj = (const bf16*)(p.ws + WS_BIG + B_PROJ);
    bf16* cq = (bf16*)(p.ws + WS_BIG + B_CQ);
    bf16* ckv = (bf16*)(p.ws + WS_BIG + B_CKV);
    for (int row = blockIdx.x * NWV + (tidx() >> 6); row < NKVROWS; row += gridDim.x * NWV) {
        if (row >= NTOK) {
            const int r = row - NTOK, b = r >> 8, s = r & 255;
            const float* src = p.cache_b_ckv + ((size_t)(b * 2 + l) * 256 + s) * 128;
            ckv[(size_t)row * 128 + lane] = f2bf(src[lane]); ckv[(size_t)row * 128 + 64 + lane] = f2bf(src[64 + lane]);
            continue;
        }
        const bf16* pr = proj + (size_t)row * PLD;
        float a0 = bf2f(pr[C_BCQ + lane]), a1 = bf2f(pr[C_BCQ + 64 + lane]), a2 = bf2f(pr[C_BCQ + 128 + lane]);
        float ss = wave_sum(a0 * a0 + a1 * a1 + a2 * a2);
        float rinv = rsqrtf(ss * (1.f / 192.f) + EPS);
        const float* gq = p.b_g_cq + l * 192;
        cq[(size_t)row * 192 + lane] = f2bf(a0 * rinv * gq[lane]); cq[(size_t)row * 192 + 64 + lane] = f2bf(a1 * rinv * gq[64 + lane]); cq[(size_t)row * 192 + 128 + lane] = f2bf(a2 * rinv * gq[128 + lane]);
        float k0 = bf2f(pr[C_BCKV + lane]), k1 = bf2f(pr[C_BCKV + 64 + lane]);
        ss = wave_sum(k0 * k0 + k1 * k1);
        rinv = rsqrtf(ss * (1.f / 128.f) + EPS);
        const float* gk = p.b_g_ckv + l * 128;
        k0 = k0 * rinv * gk[lane]; k1 = k1 * rinv * gk[64 + lane];
        ckv[(size_t)row * 128 + lane] = f2bf(k0); ckv[(size_t)row * 128 + 64 + lane] = f2bf(k1);
        if (row < NPROMPT) {
            const int b = row >> 8, s = row & 255;
            const size_t ci = (size_t)(b * 2 + l) * 256 + s;
            p.out[O_CKV + ci * 128 + lane] = k0; p.out[O_CKV + ci * 128 + 64 + lane] = k1;
            p.out[O_CAK + ci * 128 + lane] = bf2f(pr[C_AK + lane]); p.out[O_CAK + ci * 128 + 64 + lane] = bf2f(pr[C_AK + 64 + lane]);
            p.out[O_CAV + ci * 128 + lane] = bf2f(pr[C_AV + lane]); p.out[O_CAV + ci * 128 + 64 + lane] = bf2f(pr[C_AV + 64 + lane]);
            if (lane < 32) p.out[O_KR + ci * 32 + lane] = bf2f(pr[C_BKR + lane]);
        }
    }
}

__device__ __forceinline__ void ph_prep2(const P& p, int l) {
    const int lane = tidx() & 63;
    const float* tab = (const float*)(p.ws + WS_TAB);
    const bf16* proj = (const bf16*)(p.ws + WS_BIG + B_PROJ);
    const bf16* qb = (const bf16*)(p.ws + WS_BIG + B_QB);
    const bf16* kv = (const bf16*)(p.ws + WS_BIG + B_KV);
    bf16* qa1s = (bf16*)(p.ws + WS_BIG + B_QA1S);
    bf16* ka1s = (bf16*)(p.ws + WS_BIG + B_KA1S);
    bf16* qb1s = (bf16*)(p.ws + WS_BIG + B_CQ);
    bf16* kb = (bf16*)(p.ws + WS_BIG + B_KB);
    bf16* kac = (bf16*)(p.ws + WS_KAC);
    bf16* vac = (bf16*)(p.ws + WS_VAC);
    for (int row = blockIdx.x * NWV + (tidx() >> 6); row < NKVROWS; row += gridDim.x * NWV) {
        for (int h = 0; h < 4; ++h) kb[(size_t)row * 384 + h * 96 + lane] = kv[(size_t)row * 512 + h * 128 + lane];
        if (row >= NTOK) {
            const int r = row - NTOK, b = r >> 8, s = r & 255;
            if (lane < 32) { const bf16 v = f2bf(p.cache_b_krope[((size_t)(b * 2 + l) * 256 + s) * 32 + lane]); for (int h = 0; h < 4; ++h) kb[(size_t)row * 384 + h * 96 + 64 + lane] = v; }
            const size_t ci = ((size_t)(b * 2 + l) * 256 + s) * 128;
            kac[(size_t)r * 128 + lane] = f2bf(p.cache_a_k[ci + lane]); kac[(size_t)r * 128 + 64 + lane] = f2bf(p.cache_a_k[ci + 64 + lane]);
            vac[(size_t)r * 128 + lane] = f2bf(p.cache_a_v[ci + lane]); vac[(size_t)r * 128 + 64 + lane] = f2bf(p.cache_a_v[ci + 64 + lane]);
            continue;
        }
        const bf16* pr = proj + (size_t)row * PLD;
        if (row < NPROMPT) {
            if (lane < 32) { const bf16 v = pr[C_BKR + lane]; for (int h = 0; h < 4; ++h) kb[(size_t)row * 384 + h * 96 + 64 + lane] = v; }
            continue;
        }
        const int rs = row - NPROMPT, t = rs & 4095, gr = t >> 6, gc = t & 63;
        {
            if (lane < 32) {
                const int d = lane, qtr = d >> 3, f = d & 7, pos = (qtr < 2) ? gr : gc;
                const float c = tab[2048 + pos * 8 + f], s = tab[2560 + pos * 8 + f];
                const float x = bf2f(pr[C_BKR + d]);
                const float y = bf2f(pr[C_BKR + (d ^ 8)]);
                const float o = (qtr & 1) ? (x * c + y * s) : (x * c - y * s);
                const bf16 v = f2bf(o);
                for (int h = 0; h < 4; ++h) kb[(size_t)row * 384 + h * 96 + 64 + d] = v;
                for (int h = 0; h < 4; ++h) {
                    const float qx = bf2f(qb[(size_t)row * 384 + h * 96 + 64 + d]), qy = bf2f(qb[(size_t)row * 384 + h * 96 + 64 + (d ^ 8)]);
                    qb1s[(size_t)rs * 384 + h * 96 + 64 + d] = f2bf((qtr & 1) ? (qx * c + qy * s) : (qx * c - qy * s));
                }
            }
            for (int h = 0; h < 4; ++h) qb1s[(size_t)rs * 384 + h * 96 + lane] = qb[(size_t)row * 384 + h * 96 + lane];
        }
        {
            const int d = lane, qtr = d >> 4, f = d & 15, pos = (qtr < 2) ? gr : gc;
            const float c = tab[pos * 16 + f], s = tab[1024 + pos * 16 + f];
            for (int h = 0; h < 4; ++h) {
                const float x = bf2f(pr[C_AQ + h * 64 + d]), y = bf2f(pr[C_AQ + h * 64 + (d ^ 16)]);
                qa1s[(size_t)rs * 256 + h * 64 + d] = f2bf((qtr & 1) ? (x * c + y * s) : (x * c - y * s));
            }
            for (int h = 0; h < 2; ++h) {
                const float x = bf2f(pr[C_AK + h * 64 + d]), y = bf2f(pr[C_AK + h * 64 + (d ^ 16)]);
                ka1s[(size_t)rs * 128 + h * 64 + d] = f2bf((qtr & 1) ? (x * c + y * s) : (x * c - y * s));
            }
        }
    }
}

struct AttnJob {
    const bf16 *q1, *q2, *k1, *v1, *k2, *v2;
    const float* sink;
    bf16* out;
    int ldq1, ldq2, ldk1, ldv1, ldk2, ldv2;
    int kstride, vstride, kvgroup, nbatch, T, nk2, window, outcol;
    float scale; int pad;
};

template <int DQK>
__device__ __forceinline__ void attn_item(const AttnJob& j, int blk, unsigned char* smem) {
    float* Ks = (float*)smem;
    float* Vs = Ks + 32 * DQK;
    const int tid = tidx(), eh = (tid >> 8) * 32;
    const int nqb = j.T / 256;
    const int b = blk / (4 * nqb), h = (blk / nqb) % 4, qb0 = (blk % nqb) * 256;
    const int kh = h / j.kvgroup;
    const int t = qb0 + (tid & 255);
    float q[DQK], o[32];
    float m = -1e30f, lsum = 0.f;
#pragma unroll
    for (int e = 0; e < 32; ++e) o[e] = 0.f;
    for (int set = 0; set < 2; ++set) {
        if (set == 1 && j.nk2 == 0) break;
        const bf16* qp = (set == 0) ? j.q1 + ((size_t)b * j.T + t) * j.ldq1 + h * DQK : j.q2 + ((size_t)b * j.T + t) * j.ldq2 + h * DQK;
#pragma unroll
        for (int d = 0; d < DQK; d += 4) { const uint2 raw = *(const uint2*)(qp + d); q[d] = bf2f((bf16)(raw.x & 0xffff)) * j.scale; q[d + 1] = bf2f((bf16)(raw.x >> 16)) * j.scale; q[d + 2] = bf2f((bf16)(raw.y & 0xffff)) * j.scale; q[d + 3] = bf2f((bf16)(raw.y >> 16)) * j.scale; }
        const bf16* kp = (set == 0) ? j.k1 + (size_t)b * j.T * j.ldk1 + kh * j.kstride : j.k2 + (size_t)b * j.nk2 * j.ldk2 + kh * j.kstride;
        const bf16* vp = (set == 0) ? j.v1 + (size_t)b * j.T * j.ldv1 + kh * j.vstride : j.v2 + (size_t)b * j.nk2 * j.ldv2 + kh * j.vstride;
        const int ldk = (set == 0) ? j.ldk1 : j.ldk2, ldv = (set == 0) ? j.ldv1 : j.ldv2;
        int kbeg = 0, kend = (set == 0) ? j.T : j.nk2;
        const bool win = (set == 0) && j.window;
        if (win) { kbeg = qb0 - 128 < 0 ? 0 : qb0 - 128; kend = qb0 + 256 + 128 > j.T ? j.T : qb0 + 256 + 128; }
        for (int ks = kbeg; ks < kend; ks += 32) {
            __syncthreads();
            for (int e = tid; e < 32 * DQK / 4; e += NT) {
                const int key = e / (DQK / 4), c4 = e % (DQK / 4), s = ks + key;
                float4 val = make_float4(0.f, 0.f, 0.f, 0.f);
                if (s < kend) { const uint2 raw = *(const uint2*)(kp + (size_t)s * ldk + c4 * 4); val = make_float4(bf2f((bf16)(raw.x & 0xffff)), bf2f((bf16)(raw.x >> 16)), bf2f((bf16)(raw.y & 0xffff)), bf2f((bf16)(raw.y >> 16))); }
                *(float4*)&Ks[key * DQK + c4 * 4] = val;
            }
            for (int e = tid; e < 32 * 16; e += NT) {
                const int key = e >> 4, c4 = e & 15, s = ks + key;
                float4 val = make_float4(0.f, 0.f, 0.f, 0.f);
                if (s < kend) { const uint2 raw = *(const uint2*)(vp + (size_t)s * ldv + c4 * 4); val = make_float4(bf2f((bf16)(raw.x & 0xffff)), bf2f((bf16)(raw.x >> 16)), bf2f((bf16)(raw.y & 0xffff)), bf2f((bf16)(raw.y >> 16))); }
                *(float4*)&Vs[key * 64 + c4 * 4] = val;
            }
            __syncthreads();
            const int nk = (kend - ks) < 32 ? (kend - ks) : 32;
            for (int key = 0; key < nk; ++key) {
                const int s = ks + key;
                if (win) { const int dlt = t - s; if (dlt > 128 || dlt < -128) continue; }
                float sc = 0.f;
#pragma unroll
                for (int d = 0; d < DQK; d += 4) { const float4 kk = *(const float4*)&Ks[key * DQK + d]; sc += q[d] * kk.x + q[d + 1] * kk.y + q[d + 2] * kk.z + q[d + 3] * kk.w; }
                if (sc > m) { const float c = __expf(m - sc); lsum *= c;
#pragma unroll
                    for (int e = 0; e < 32; ++e) o[e] *= c;
                    m = sc; }
                const float pp = __expf(sc - m);
                lsum += pp;
#pragma unroll
                for (int e = 0; e < 32; e += 4) { const float4 vv = *(const float4*)&Vs[key * 64 + eh + e]; o[e] += pp * vv.x; o[e + 1] += pp * vv.y; o[e + 2] += pp * vv.z; o[e + 3] += pp * vv.w; }
            }
        }
    }
    if (j.sink) {
        const float sk = j.sink[h];
        const float mf = sk > m ? sk : m;
        const float c = __expf(m - mf);
        lsum = lsum * c + __expf(sk - mf);
#pragma unroll
        for (int e = 0; e < 32; ++e) o[e] *= c;
    }
    const float inv = 1.f / lsum;
    bf16* op = j.out + ((size_t)b * j.T + t) * 1024 + j.outcol + h * 64 + eh;
#pragma unroll
    for (int e = 0; e < 32; e += 2) *(unsigned*)(op + e) = (unsigned)f2bf(o[e] * inv) | ((unsigned)f2bf(o[e + 1] * inv) << 16);
}

__device__ __forceinline__ void ph_pool(const P& p, int l, unsigned char* smem) {
    float (*df)[257] = (float (*)[257])smem;
    const int tid = tidx(), half = tid >> 8, c256 = tid & 255;
    const bf16* proj = (const bf16*)(p.ws + WS_BIG + B_PROJ);
    bf16* br = (bf16*)(p.ws + WS_BR);
    for (int tile = blockIdx.x; tile < NTOK / 32; tile += gridDim.x) {
        const int row0 = tile * 32;
        int base, T;
        if (row0 < NPROMPT) { base = (row0 >> 8) << 8; T = 256; } else { base = NPROMPT + (((row0 - NPROMPT) >> 12) << 12); T = 4096; }
        __syncthreads();
        {
            const int c = c256, g = c >> 6, hw = 1 << g;
            for (int i = half * 16; i < half * 16 + 16; ++i) {
                const int t = row0 + i - base;
                const int lo = t - hw < 0 ? 0 : t - hw, hi = t + hw > T ? T : t + hw;
                float sacc = 0.f;
                for (int u = lo; u < hi; ++u) sacc += bf2f(proj[(size_t)(base + u) * PLD + C_CIN + c]);
                df[i][c] = sacc / (float)(hi - lo) - bf2f(proj[(size_t)(base + t) * PLD + C_CIN + c]);
            }
        }
        __syncthreads();
        {
            const int g = c256 >> 6, d = c256 & 63;
            float acc[16];
#pragma unroll
            for (int i = 0; i < 16; ++i) acc[i] = 0.f;
            const float* wp = p.c_w_pool + ((size_t)(l * 4 + g) * 64) * 64 + d;
            for (int c = 0; c < 64; ++c) {
                const float w = wp[c * 64];
#pragma unroll
                for (int i = 0; i < 16; ++i) acc[i] += df[half * 16 + i][g * 64 + c] * w;
            }
            const float sc = p.c_scale[l * 256 + c256];
#pragma unroll
            for (int i = 0; i < 16; ++i) br[(size_t)(row0 + half * 16 + i) * 1024 + 512 + c256] = f2bf(acc[i] * sc);
        }
    }
}

#define GS_KN 0
#define GS_QN 8192
#define GS_W 16384
#define GS_QG 24576
#define GS_KDT 32768
#define GS_ST 49152
#define GS_VNT 57344
#define GS_A 65536
#define GS_U 73728
#define GS_V 90112
#define GS_L 107520
#define GS_SM 123904

__device__ __forceinline__ int swz(int r, int c) { return r * 64 + ((((c) >> 3) ^ (r & 7)) << 3) + (c & 7); }
__device__ __forceinline__ unsigned pk2(float a, float b) { return (unsigned)f2bf(a) | ((unsigned)f2bf(b) << 16); }

__device__ __forceinline__ f32x16 mm_tile(const bf16* A, int m0, const bf16* B, int n0, f32x16 acc, int lane) {
    const int ra = m0 + (lane & 31), rb = n0 + (lane & 31), hh = lane >> 5;
#pragma unroll
    for (int kk = 0; kk < 4; ++kk) {
        const int ch = kk * 2 + hh;
        const bf16x8 a = *(const bf16x8*)(A + ra * 64 + ((ch ^ (ra & 7)) << 3));
        const bf16x8 b = *(const bf16x8*)(B + rb * 64 + ((ch ^ (rb & 7)) << 3));
        acc = __builtin_amdgcn_mfma_f32_32x32x16_bf16(a, b, acc, 0, 0, 0);
    }
    return acc;
}
__device__ __forceinline__ f32x16 zero16() { f32x16 z; _Pragma("unroll") for (int r = 0; r < 16; ++r) z[r] = 0.f; return z; }

struct GdnCtx { int base, T, h, dir, cidx, l; };

__device__ __forceinline__ void gdn_prep(const P& p, const GdnCtx& c, unsigned char* smem_) {
    unsigned char* smem = smem_ + vzero();
    const int tid = tidx(), lane = tid & 63, wv = tid >> 6;
    bf16* KN = (bf16*)(smem + GS_KN); bf16* QN = (bf16*)(smem + GS_QN); bf16* Wl = (bf16*)(smem + GS_W);
    float* Ul = (float*)(smem + GS_U); float* Vl = (float*)(smem + GS_V); float* Lm = (float*)(smem + GS_L);
    float* gcs = (float*)(smem + GS_SM); float* betas = gcs + 64; float* qdec = gcs + 128; float* kdec = gcs + 192; float* bexp = gcs + 256;
    const bf16* proj = (const bf16*)(p.ws + WS_BIG + B_PROJ);
    const float* convw = p.d_conv + (size_t)c.l * 5 * 768;
#pragma unroll 1
    for (int r = 0; r < 3; ++r) {
        const int w = tid + NT * r, i = w / 24, rem = w - i * 24, part = rem >> 3, g8 = rem & 7;
        const int tt = c.cidx * 64 + (c.dir ? 63 - i : i);
        const int ch = part * 256 + c.h * 64 + g8 * 8;
        float u[8];
#pragma unroll
        for (int k = 0; k < 8; ++k) u[k] = 0.f;
#pragma unroll
        for (int j = 0; j < 5; ++j) {
            const int ts = tt + j - 2;
            if (ts >= 0 && ts < c.T) {
                const uint4 raw = *(const uint4*)(proj + (size_t)(c.base + ts) * PLD + C_DQKV + ch);
                const float4 w0 = *(const float4*)(convw + j * 768 + ch), w1 = *(const float4*)(convw + j * 768 + ch + 4);
                u[0] += w0.x * bf2f((bf16)(raw.x & 0xffff)); u[1] += w0.y * bf2f((bf16)(raw.x >> 16)); u[2] += w0.z * bf2f((bf16)(raw.y & 0xffff)); u[3] += w0.w * bf2f((bf16)(raw.y >> 16));
                u[4] += w1.x * bf2f((bf16)(raw.z & 0xffff)); u[5] += w1.y * bf2f((bf16)(raw.z >> 16)); u[6] += w1.z * bf2f((bf16)(raw.w & 0xffff)); u[7] += w1.w * bf2f((bf16)(raw.w >> 16));
            }
        }
        float ss = 0.f;
#pragma unroll
        for (int k = 0; k < 8; ++k) { u[k] = siluf_(u[k]); ss += u[k] * u[k]; }
        ss += __shfl_xor(ss, 1); ss += __shfl_xor(ss, 2); ss += __shfl_xor(ss, 4);
        if (part < 2) {
            const float sc = rsqrtf(ss + EPS) * (part == 0 ? 0.125f : 1.f);
            bf16* dst = (part == 0 ? QN : KN) + i * 64 + ((g8 ^ (i & 7)) << 3);
            *(uint4*)dst = make_uint4(pk2(u[0] * sc, u[1] * sc), pk2(u[2] * sc, u[3] * sc), pk2(u[4] * sc, u[5] * sc), pk2(u[6] * sc, u[7] * sc));
        } else {
            *(float4*)(Vl + i * 68 + g8 * 8) = make_float4(u[0], u[1], u[2], u[3]);
            *(float4*)(Vl + i * 68 + g8 * 8 + 4) = make_float4(u[4], u[5], u[6], u[7]);
        }
    }
    if (wv == 0) {
        const int i = lane, tt = c.cidx * 64 + (c.dir ? 63 - i : i);
        const bf16* pr = proj + (size_t)(c.base + tt) * PLD;
        const float Aexp = expf(p.d_a_log[(c.l * 2 + c.dir) * 4 + c.h]), dtb = p.d_dt_bias[(c.l * 2 + c.dir) * 4 + c.h];
        const float beta = sigmoidf_(bf2f(pr[C_DBETA + c.dir * 4 + c.h]));
        const float al = bf2f(pr[C_DALPHA + c.dir * 4 + c.h]) + dtb;
        float g = -Aexp * (al > 20.f ? al : log1pf(expf(al)));
#pragma unroll
        for (int o = 1; o < 64; o <<= 1) { const float t = __shfl_up(g, o); if (lane >= o) g += t; }
        const float g63 = __shfl(g, 63);
        const float eg = expf(g);
        gcs[i] = g; betas[i] = beta; qdec[i] = eg; kdec[i] = expf(g63 - g); bexp[i] = beta * eg;
    }
    __syncthreads();
    if (wv < 4) {
        const int mt = wv >> 1, nt = wv & 1, hh = lane >> 5, j = nt * 32 + (lane & 31);
        f32x16 acc = zero16();
        if (nt <= mt) acc = mm_tile(KN, mt * 32, KN, nt * 32, acc, lane);
        const float gj = gcs[j];
#pragma unroll
        for (int r = 0; r < 16; ++r) {
            const int i = mt * 32 + (r & 3) + 8 * (r >> 2) + 4 * hh;
            Lm[i * 64 + j] = (j < i) ? betas[i] * acc[r] * __expf(gcs[i] - gj) : 0.f;
        }
    }
    __syncthreads();
    if (wv < 2) {
        const int col = lane; const bool isW = wv == 1;
        float x[64];
#pragma unroll
        for (int i = 0; i < 64; ++i) x[i] = isW ? bf2f(KN[swz(i, col)]) * bexp[i] : Vl[i * 68 + col] * betas[i];
#pragma unroll
        for (int i = 1; i < 64; ++i) {
            float a = x[i];
#pragma unroll
            for (int j4 = 0; j4 < (i + 3) / 4; ++j4) {
                const float4 lv = *(const float4*)&Lm[i * 64 + j4 * 4];
                a -= lv.x * x[j4 * 4]; a -= lv.y * x[j4 * 4 + 1]; a -= lv.z * x[j4 * 4 + 2]; a -= lv.w * x[j4 * 4 + 3];
            }
            x[i] = a;
        }
        if (isW) {
#pragma unroll
            for (int i = 0; i < 64; ++i) Wl[swz(i, col)] = f2bf(x[i]);
        } else {
#pragma unroll
            for (int i = 0; i < 64; ++i) Ul[i * 64 + col] = x[i];
        }
    }
    __syncthreads();
}

__device__ __forceinline__ void gdn_t0(unsigned char* smem_, int kb) {
    unsigned char* smem = smem_ + vzero();
    const int tid = tidx(), i = tid >> 3, cc = tid & 7;
    const bf16* KN = (const bf16*)(smem + GS_KN); const bf16* QN = (const bf16*)(smem + GS_QN);
    bf16* QG = (bf16*)(smem + GS_QG); bf16* KDT = (bf16*)(smem + GS_KDT + kb * 8192);
    const float* gcs = (const float*)(smem + GS_SM); const float qd = gcs[128 + i], kd = gcs[192 + i];
    const int off = i * 64 + ((cc ^ (i & 7)) << 3);
    const uint4 q = *(const uint4*)(QN + off), k = *(const uint4*)(KN + off);
    const unsigned qa[4] = {q.x, q.y, q.z, q.w}, ka[4] = {k.x, k.y, k.z, k.w};
    unsigned qo[4];
#pragma unroll
    for (int t = 0; t < 4; ++t) {
        qo[t] = pk2(bf2f((bf16)(qa[t] & 0xffff)) * qd, bf2f((bf16)(qa[t] >> 16)) * qd);
        KDT[swz(cc * 8 + 2 * t, i)] = f2bf(bf2f((bf16)(ka[t] & 0xffff)) * kd);
        KDT[swz(cc * 8 + 2 * t + 1, i)] = f2bf(bf2f((bf16)(ka[t] >> 16)) * kd);
    }
    *(uint4*)(QG + off) = make_uint4(qo[0], qo[1], qo[2], qo[3]);
}

__device__ __forceinline__ void gdn_t12(const P& p, const GdnCtx& c, unsigned char* smem_, int kb, f32x16& Sreg, int mode) {
    unsigned char* smem = smem_ + vzero();
    const int tid = tidx(), lane = tid & 63, wv = tid >> 6, hh = lane >> 5, l31 = lane & 31;
    const bf16* KN = (const bf16*)(smem + GS_KN); const bf16* QN = (const bf16*)(smem + GS_QN); const bf16* Wl = (const bf16*)(smem + GS_W);
    const bf16* QG = (const bf16*)(smem + GS_QG); const bf16* KDT = (const bf16*)(smem + GS_KDT + kb * 8192);
    bf16* ST = (bf16*)(smem + GS_ST); bf16* VNT = (bf16*)(smem + GS_VNT); bf16* Al = (bf16*)(smem + GS_A);
    const float* Ul = (const float*)(smem + GS_U); const float* gcs = (const float*)(smem + GS_SM);
    f32x16 O0 = zero16(), O1 = zero16();
    const float gl = gcs[128 + 63];
    if (wv < 4) {
        const int mt = wv >> 1, nt = wv & 1, e = nt * 32 + l31;
        f32x16 acc = mm_tile(Wl, mt * 32, ST, nt * 32, zero16(), lane);
#pragma unroll
        for (int rg = 0; rg < 4; ++rg) {
            const int i0 = mt * 32 + 8 * rg + 4 * hh;
            const float v0 = Ul[(i0) * 64 + e] - acc[rg * 4], v1 = Ul[(i0 + 1) * 64 + e] - acc[rg * 4 + 1], v2 = Ul[(i0 + 2) * 64 + e] - acc[rg * 4 + 2], v3 = Ul[(i0 + 3) * 64 + e] - acc[rg * 4 + 3];
            *(uint2*)(VNT + swz(e, i0)) = make_uint2(pk2(v0, v1), pk2(v2, v3));
        }
    } else if (wv < 6) {
        const int mt = wv - 4;
        O0 = mm_tile(QG, mt * 32, ST, 0, O0, lane);
        O1 = mm_tile(QG, mt * 32, ST, 32, O1, lane);
    } else {
        const int mt = wv - 6;
#pragma unroll
        for (int nt = 0; nt < 2; ++nt) {
            f32x16 acc = zero16();
            if (nt <= mt) acc = mm_tile(QN, mt * 32, KN, nt * 32, acc, lane);
            const int j = nt * 32 + l31; const float gj = gcs[j];
#pragma unroll
            for (int r = 0; r < 16; ++r) {
                const int i = mt * 32 + (r & 3) + 8 * (r >> 2) + 4 * hh;
                Al[swz(i, j)] = f2bf((j <= i) ? acc[r] * __expf(gcs[i] - gj) : 0.f);
            }
        }
    }
    __syncthreads();
    if (wv < 4) {
        const int mt = wv >> 1, nt = wv & 1, e = nt * 32 + l31;
#pragma unroll
        for (int r = 0; r < 16; ++r) Sreg[r] *= gl;
        Sreg = mm_tile(KDT, mt * 32, VNT, nt * 32, Sreg, lane);
#pragma unroll
        for (int rg = 0; rg < 4; ++rg) {
            const int d0 = mt * 32 + 8 * rg + 4 * hh;
            *(uint2*)(ST + swz(e, d0)) = make_uint2(pk2(Sreg[rg * 4], Sreg[rg * 4 + 1]), pk2(Sreg[rg * 4 + 2], Sreg[rg * 4 + 3]));
        }
    } else if (wv < 6) {
        const int mt = wv - 4;
        O0 = mm_tile(Al, mt * 32, VNT, 0, O0, lane);
        O1 = mm_tile(Al, mt * 32, VNT, 32, O1, lane);
        bf16* br = (bf16*)(p.ws + WS_BR);
        bf16* gob = (bf16*)(p.ws + WS_BIG + B_GOB);
        const bf16* proj = (const bf16*)(p.ws + WS_BIG + B_PROJ);
#pragma unroll
        for (int r = 0; r < 16; ++r) {
            const int i = mt * 32 + (r & 3) + 8 * (r >> 2) + 4 * hh;
            const int tt = c.cidx * 64 + (c.dir ? 63 - i : i);
            const size_t row = (size_t)(c.base + tt);
            bf16* b0 = br + row * 1024 + 768 + c.h * 64 + l31;
            if (mode == 0) { b0[0] = f2bf(O0[r]); b0[32] = f2bf(O1[r]); }
            else if (mode == 1) { bf16* g0 = gob + (row - NPROMPT) * 256 + c.h * 64 + l31; g0[0] = f2bf(O0[r]); g0[32] = f2bf(O1[r]); }
            else {
                const float a0 = O0[r] + bf2f(b0[0]), a1 = O1[r] + bf2f(b0[32]);
                float ss = a0 * a0 + a1 * a1;
                ss += __shfl_xor(ss, 1); ss += __shfl_xor(ss, 2); ss += __shfl_xor(ss, 4); ss += __shfl_xor(ss, 8); ss += __shfl_xor(ss, 16);
                const float rinv = rsqrtf(ss * (1.f / 64.f) + EPS);
                const bf16* zp = proj + row * PLD + C_DZ + c.h * 64 + l31;
                b0[0] = f2bf(a0 * rinv * p.d_g_norm[c.l * 64 + l31] * siluf_(bf2f(zp[0])));
                b0[32] = f2bf(a1 * rinv * p.d_g_norm[c.l * 64 + 32 + l31] * siluf_(bf2f(zp[32])));
            }
        }
    }
}

__device__ __forceinline__ void gdn_prompt_item(const P& p, int l, int item, unsigned char* smem_) {
    unsigned char* smem = smem_ + vzero();
    const int tid = tidx(), lane = tid & 63, wv = tid >> 6, hh = lane >> 5, l31 = lane & 31;
    const int b = item >> 2, h = item & 3;
    bf16* ST = (bf16*)(smem + GS_ST);
    f32x16 Sreg = zero16();
    int kb = 0;
#pragma unroll 1
    for (int s = 0; s < 8; ++s) {
        const int dir = s >> 2, n = s & 3;
        GdnCtx c; c.base = b * 256; c.T = 256; c.h = h; c.dir = dir; c.cidx = dir ? 3 - n : n; c.l = l;
        __syncthreads();
        if (n == 0) {
            Sreg = zero16();
            for (int q = tid; q < 2048; q += NT) ((unsigned*)ST)[q] = 0u;
        }
        gdn_prep(p, c, smem);
        gdn_t0(smem, kb);
        __syncthreads();
        gdn_t12(p, c, smem, kb, Sreg, dir ? 2 : 0);
        kb ^= 1;
        if (n == 3 && wv < 4) {
            const int mt = wv >> 1, nt = wv & 1;
            float* so = p.out + (dir ? O_SB : O_SF) + ((size_t)(b * 2 + l) * 4 + h) * 4096;
#pragma unroll
            for (int r = 0; r < 16; ++r) so[(mt * 32 + (r & 3) + 8 * (r >> 2) + 4 * hh) * 64 + nt * 32 + l31] = Sreg[r];
        }
    }
    __syncthreads();
}

__device__ __forceinline__ void gdn_sample_prep_item(const P& p, int l, int item, unsigned char* smem_) {
    unsigned char* smem = smem_ + vzero();
    const int tid = tidx();
    const int n = item & 63, dir = (item >> 6) & 1, h = (item >> 7) & 3, b = item >> 9;
    GdnCtx c; c.base = NPROMPT + b * 4096; c.T = 4096; c.h = h; c.dir = dir; c.cidx = dir ? 63 - n : n; c.l = l;
    __syncthreads();
    gdn_prep(p, c, smem);
    const bf16* KN = (const bf16*)(smem + GS_KN); const bf16* QN = (const bf16*)(smem + GS_QN); const bf16* Wl = (const bf16*)(smem + GS_W);
    const float* Ul = (const float*)(smem + GS_U); const float* gcs = (const float*)(smem + GS_SM);
    bf16* gqk = (bf16*)(p.ws + WS_BIG + B_GQK); bf16* guw = (bf16*)(p.ws + WS_BIG + B_GUW); float* ggc = (float*)(p.ws + WS_GGC);
    const int i = tid >> 3, cc = tid & 7, off = i * 64 + ((cc ^ (i & 7)) << 3);
    if (dir == 0) {
        const size_t tok = (size_t)b * 4096 + c.cidx * 64 + i;
        *(uint4*)(gqk + ((tok * 4 + h) * 2 + 0) * 64 + cc * 8) = *(const uint4*)(QN + off);
        *(uint4*)(gqk + ((tok * 4 + h) * 2 + 1) * 64 + cc * 8) = *(const uint4*)(KN + off);
    }
    bf16* uw = guw + (size_t)item * 8192;
    const float4 u0 = *(const float4*)(Ul + i * 64 + cc * 8), u1 = *(const float4*)(Ul + i * 64 + cc * 8 + 4);
    *(uint4*)(uw + i * 64 + cc * 8) = make_uint4(pk2(u0.x, u0.y), pk2(u0.z, u0.w), pk2(u1.x, u1.y), pk2(u1.z, u1.w));
    *(uint4*)(uw + 4096 + i * 64 + cc * 8) = *(const uint4*)(Wl + off);
    if (tid < 64) ggc[(size_t)item * 64 + tid] = gcs[tid];
}

__device__ __forceinline__ void gdn_sample_chain(const P& p, int l, int chain, unsigned char* smem_) {
    unsigned char* smem = smem_ + vzero();
    const int tid = tidx(), lane = tid & 63, wv = tid >> 6, hh = lane >> 5, l31 = lane & 31;
    const int dir = chain & 1, h = (chain >> 1) & 3, b = chain >> 3;
    bf16* KN = (bf16*)(smem + GS_KN); bf16* QN = (bf16*)(smem + GS_QN); bf16* Wl = (bf16*)(smem + GS_W); bf16* QG = (bf16*)(smem + GS_QG);
    bf16* ST = (bf16*)(smem + GS_ST); float* Ul = (float*)(smem + GS_U); float* gcs = (float*)(smem + GS_SM);
    const bf16* gqk = (const bf16*)(p.ws + WS_BIG + B_GQK); const bf16* guw = (const bf16*)(p.ws + WS_BIG + B_GUW); const float* ggc = (const float*)(p.ws + WS_GGC);
    const float* stp = (const float*)((uintptr_t)p.state_f + (uintptr_t)dir * ((uintptr_t)p.state_b - (uintptr_t)p.state_f)) + ((size_t)(b * 2 + l) * 4 + h) * 4096;
    f32x16 Sreg = zero16();
    __syncthreads();
    if (wv < 4) {
        const int mt = wv >> 1, nt = wv & 1, e = nt * 32 + l31;
#pragma unroll
        for (int r = 0; r < 16; ++r) Sreg[r] = stp[(mt * 32 + (r & 3) + 8 * (r >> 2) + 4 * hh) * 64 + e];
#pragma unroll
        for (int rg = 0; rg < 4; ++rg) { const int d0 = mt * 32 + 8 * rg + 4 * hh; *(uint2*)(ST + swz(e, d0)) = make_uint2(pk2(Sreg[rg * 4], Sreg[rg * 4 + 1]), pk2(Sreg[rg * 4 + 2], Sreg[rg * 4 + 3])); }
    }
    const int i = tid >> 3, cc = tid & 7, off = i * 64 + ((cc ^ (i & 7)) << 3);
    const int item0 = ((b * 4 + h) * 2 + dir) * 64;
    uint4 rq, rk, ru, rw; float rg_i, rg_l;
#define GDN_LOAD(n) { const int cidx_ = dir ? 63 - (n) : (n); const size_t tok_ = (size_t)b * 4096 + cidx_ * 64 + (dir ? 63 - i : i); \
        rq = *(const uint4*)(gqk + ((tok_ * 4 + h) * 2 + 0) * 64 + cc * 8); rk = *(const uint4*)(gqk + ((tok_ * 4 + h) * 2 + 1) * 64 + cc * 8); \
        const bf16* uw_ = guw + (size_t)(item0 + (n)) * 8192; ru = *(const uint4*)(uw_ + i * 64 + cc * 8); rw = *(const uint4*)(uw_ + 4096 + i * 64 + cc * 8); \
        rg_i = ggc[(size_t)(item0 + (n)) * 64 + i]; rg_l = ggc[(size_t)(item0 + (n)) * 64 + 63]; }
    GDN_LOAD(0)
#pragma unroll 1
    for (int n = 0; n < 64; ++n) {
        const int kb = n & 1;
        bf16* KDT = (bf16*)(smem + GS_KDT + kb * 8192);
        {
            const float qd = __expf(rg_i), kd = __expf(rg_l - rg_i);
            *(uint4*)(QN + off) = rq; *(uint4*)(KN + off) = rk; *(uint4*)(Wl + off) = rw;
            const unsigned qa[4] = {rq.x, rq.y, rq.z, rq.w}, ka[4] = {rk.x, rk.y, rk.z, rk.w}, ua[4] = {ru.x, ru.y, ru.z, ru.w};
            unsigned qo[4];
#pragma unroll
            for (int t = 0; t < 4; ++t) {
                qo[t] = pk2(bf2f((bf16)(qa[t] & 0xffff)) * qd, bf2f((bf16)(qa[t] >> 16)) * qd);
                KDT[swz(cc * 8 + 2 * t, i)] = f2bf(bf2f((bf16)(ka[t] & 0xffff)) * kd);
                KDT[swz(cc * 8 + 2 * t + 1, i)] = f2bf(bf2f((bf16)(ka[t] >> 16)) * kd);
            }
            *(uint4*)(QG + off) = make_uint4(qo[0], qo[1], qo[2], qo[3]);
            *(float4*)(Ul + i * 64 + cc * 8) = make_float4(bf2f((bf16)(ua[0] & 0xffff)), bf2f((bf16)(ua[0] >> 16)), bf2f((bf16)(ua[1] & 0xffff)), bf2f((bf16)(ua[1] >> 16)));
            *(float4*)(Ul + i * 64 + cc * 8 + 4) = make_float4(bf2f((bf16)(ua[2] & 0xffff)), bf2f((bf16)(ua[2] >> 16)), bf2f((bf16)(ua[3] & 0xffff)), bf2f((bf16)(ua[3] >> 16)));
            if (cc == 0) { gcs[i] = rg_i; if (i == 63) gcs[128 + 63] = qd; }
        }
        if (n + 1 < 64) GDN_LOAD(n + 1)
        __syncthreads();
        GdnCtx c; c.base = NPROMPT + b * 4096; c.T = 4096; c.h = h; c.dir = dir; c.cidx = dir ? 63 - n : n; c.l = l;
        gdn_t12(p, c, smem, kb, Sreg, dir);
    }
#undef GDN_LOAD
    __syncthreads();
}

__device__ __forceinline__ void ph_gdn_finalize(const P& p, int l) {
    const int tid = tidx(), lane = tid & 63;
    bf16* br = (bf16*)(p.ws + WS_BR);
    const bf16* gob = (const bf16*)(p.ws + WS_BIG + B_GOB);
    const bf16* proj = (const bf16*)(p.ws + WS_BIG + B_PROJ);
    for (int it = blockIdx.x * NWV + (tid >> 6); it < 8192 * 4; it += gridDim.x * NWV) {
        const int rs = it >> 2, h = it & 3; const size_t row = (size_t)NPROMPT + rs;
        bf16* b0 = br + row * 1024 + 768 + h * 64 + lane;
        const float a = bf2f(*b0) + bf2f(gob[(size_t)rs * 256 + h * 64 + lane]);
        const float ss = wave_sum(a * a);
        const float rinv = rsqrtf(ss * (1.f / 64.f) + EPS);
        const float z = bf2f(proj[row * PLD + C_DZ + h * 64 + lane]);
        *b0 = f2bf(a * rinv * p.d_g_norm[l * 64 + lane] * siluf_(z));
    }
}

struct KArgs { P p; TJobs J[2]; };

__device__ __forceinline__ AttnJob make_job(const P& p, int l, int variant) {
    unsigned char* ws = p.ws; unsigned char* big = ws + WS_BIG;
    bf16* proj = (bf16*)(big + B_PROJ); bf16* BRb = (bf16*)(ws + WS_BR);
    const float bscale = 0.10206207261596575f;
    AttnJob j{};
    if (variant == 0) {
        j.q1 = proj + C_AQ; j.ldq1 = PLD; j.k1 = proj + C_AK; j.ldk1 = PLD; j.v1 = proj + C_AV; j.ldv1 = PLD; j.kstride = 64; j.vstride = 64; j.kvgroup = 2;
        j.nbatch = 32; j.T = 256; j.nk2 = 0; j.window = 0; j.sink = p.a_sink + l * 4; j.scale = 0.125f; j.out = BRb; j.outcol = 0;
    } else if (variant == 1) {
        j.q1 = (bf16*)(big + B_QA1S); j.ldq1 = 256; j.q2 = proj + (size_t)NPROMPT * PLD + C_AQ; j.ldq2 = PLD;
        j.k1 = (bf16*)(big + B_KA1S); j.ldk1 = 128; j.v1 = proj + (size_t)NPROMPT * PLD + C_AV; j.ldv1 = PLD;
        j.k2 = (bf16*)(ws + WS_KAC); j.ldk2 = 128; j.v2 = (bf16*)(ws + WS_VAC); j.ldv2 = 128; j.kstride = 64; j.vstride = 64; j.kvgroup = 2;
        j.nbatch = 2; j.T = 4096; j.nk2 = 256; j.window = 1; j.sink = p.a_sink + l * 4; j.scale = 0.125f; j.out = BRb + (size_t)NPROMPT * 1024; j.outcol = 0;
    } else if (variant == 2) {
        j.q1 = (bf16*)(big + B_QB); j.ldq1 = 384; j.k1 = (bf16*)(big + B_KB); j.ldk1 = 384; j.v1 = (bf16*)(big + B_KV) + 64; j.ldv1 = 512; j.kstride = 96; j.vstride = 128; j.kvgroup = 1;
        j.nbatch = 32; j.T = 256; j.nk2 = 0; j.window = 0; j.sink = nullptr; j.scale = bscale; j.out = BRb; j.outcol = 256;
    } else {
        j.q1 = (bf16*)(big + B_CQ); j.ldq1 = 384; j.q2 = (bf16*)(big + B_QB) + (size_t)NPROMPT * 384; j.ldq2 = 384;
        j.k1 = (bf16*)(big + B_KB) + (size_t)NPROMPT * 384; j.ldk1 = 384; j.v1 = (bf16*)(big + B_KV) + (size_t)NPROMPT * 512 + 64; j.ldv1 = 512;
        j.k2 = (bf16*)(big + B_KB) + (size_t)NTOK * 384; j.ldk2 = 384; j.v2 = (bf16*)(big + B_KV) + (size_t)NTOK * 512 + 64; j.ldv2 = 512; j.kstride = 96; j.vstride = 128; j.kvgroup = 1;
        j.nbatch = 2; j.T = 4096; j.nk2 = 256; j.window = 0; j.sink = nullptr; j.scale = bscale; j.out = BRb + (size_t)NPROMPT * 1024; j.outcol = 256;
    }
    return j;
}

__device__ __forceinline__ void ph_gemm_proj(const P& p, unsigned char* smem) {
    GemmArgs g{(bf16*)(p.ws + WS_H), (bf16*)(p.ws + WS_W + W_A), 1024, 1024, NTOK, 2176, 1024, 0}; EpiStore e{(bf16*)(p.ws + WS_BIG + B_PROJ), PLD, PLD}; gemm_tiles(g, e, smem);
}
__device__ __forceinline__ void ph_gemm_mla(const P& p, unsigned char* smem) {
    unsigned char* big = p.ws + WS_BIG;
    { GemmArgs g{(bf16*)(big + B_CQ), (bf16*)(p.ws + WS_W + W_UQ), 192, 192, NTOK, 384, 192, 0}; EpiStore e{(bf16*)(big + B_QB), 384, 384}; gemm_tiles(g, e, smem); }
    { GemmArgs g{(bf16*)(big + B_CKV), (bf16*)(p.ws + WS_W + W_UKV), 128, 128, NKVROWS, 512, 128, 0}; EpiStore e{(bf16*)(big + B_KV), 512, 512}; gemm_tiles(g, e, smem); }
}
__device__ __forceinline__ void ph_gemm_br(const P& p, unsigned char* smem) {
    bf16* BRb = (bf16*)(p.ws + WS_BR); bf16* prod = (bf16*)(p.ws + WS_BIG + B_PROD);
    for (int m = 0; m < 4; ++m) { GemmArgs g{BRb + m * 256, (bf16*)(p.ws + WS_W + W_BR) + (size_t)m * 1024 * 256, 1024, 256, NTOK, 1024, 256, 0}; EpiStore e{prod + m * 1024, 4096, 1 << 30}; gemm_tiles(g, e, smem); }
}
__device__ __forceinline__ void ph_gemm_gate(const P& p, unsigned char* smem) {
    GemmArgs g{(bf16*)(p.ws + WS_H), (bf16*)(p.ws + WS_W + W_G), 1024, 1024, NTOK, 4096, 1024, 0}; EpiGate e{(bf16*)(p.ws + WS_BIG + B_PROD), 4096}; gemm_tiles(g, e, smem);
}
__device__ __forceinline__ void ph_gemm_wo(const P& p, unsigned char* smem) {
    GemmArgs g{(bf16*)(p.ws + WS_BIG + B_PROD), (bf16*)(p.ws + WS_W + W_O4), 4096, 4096, NTOK, 1024, 4096, 0}; EpiStore e{(bf16*)(p.ws + WS_BR), 1024, 1024}; gemm_tiles(g, e, smem);
}
__device__ __forceinline__ void ph_gemm_up(const P& p, unsigned char* smem) {
    GemmArgs g{(bf16*)(p.ws + WS_H), (bf16*)(p.ws + WS_W + W_UP), 1024, 1024, NTOK, 5632, 1024, 0}; EpiSwiglu e{(bf16*)(p.ws + WS_BIG + B_HID), DFF}; gemm_tiles(g, e, smem);
}
__device__ __forceinline__ void ph_gemm_down(const P& p, unsigned char* smem) {
    GemmArgs g{(bf16*)(p.ws + WS_BIG + B_HID), (bf16*)(p.ws + WS_W + W_DN), DFF, DFF, NTOK, 1024, DFF, 0}; EpiStore e{(bf16*)(p.ws + WS_BR), 1024, 1024}; gemm_tiles(g, e, smem);
}
__device__ __forceinline__ void attn_dispatch(const P& p, int l, int variant, int blk, unsigned char* smem) {
    __syncthreads();
    if (variant == 0) { const AttnJob j = make_job(p, l, 0); attn_item<64>(j, blk, smem); }
    else if (variant == 1) { const AttnJob j = make_job(p, l, 1); attn_item<64>(j, blk, smem); }
    else if (variant == 2) { const AttnJob j = make_job(p, l, 2); attn_item<96>(j, blk, smem); }
    else { const AttnJob j = make_job(p, l, 3); attn_item<96>(j, blk, smem); }
}
__device__ __forceinline__ void ph_mixers1(const P& p, int l, unsigned char* smem) {
    for (int item = blockIdx.x; item < 1024; item += gridDim.x) gdn_sample_prep_item(p, l, item, smem);
    for (int item = blockIdx.x; item < 384; item += gridDim.x) { const int vi = item >> 7; attn_dispatch(p, l, vi == 0 ? 1 : vi == 1 ? 2 : 0, item & 127, smem); }
    __syncthreads();
    ph_pool(p, l, smem);
}
__device__ __forceinline__ void ph_mixers2(const P& p, int l, unsigned char* smem) {
    const int nb = gridDim.x, bid = blockIdx.x;
    if (bid < 16) { gdn_sample_chain(p, l, bid, smem); return; }
    const int nw = nb - 16, wi = bid - 16;
    for (int item = wi; item < 256; item += nw) {
        if (item < 128) gdn_prompt_item(p, l, item, smem);
        else attn_dispatch(p, l, 3, item - 128, smem);
    }
}

#define GSYNC() grid.sync()
__global__ void __launch_bounds__(NT) mega(KArgs a) {
    extern __shared__ __attribute__((aligned(16))) unsigned char smem[];
    cg::grid_group grid = cg::this_grid();
    { const P p = fence_P(); ph_mod(p, smem); }
    __syncthreads();
    ph_convert(a.J[0], smem);
    GSYNC();
    { const P p = fence_P(); ph_prenorm(p, 0); }
    GSYNC();
#pragma unroll 1
    for (int l = 0; l < 2; ++l) {
        { const P p = fence_P(); ph_gemm_proj(p, smem); }
        GSYNC();
        { const P p = fence_P(); ph_postproj(p, l); }
        GSYNC();
        { const P p = fence_P(); ph_gemm_mla(p, smem); }
        GSYNC();
        { const P p = fence_P(); ph_prep2(p, l); }
        GSYNC();
        { const P p = fence_P(); ph_mixers1(p, l, smem); }
        GSYNC();
        { const P p = fence_P(); ph_mixers2(p, l, smem); }
        GSYNC();
        { const P p = fence_P(); ph_gdn_finalize(p, l); }
        GSYNC();
        { const P p = fence_P(); ph_gemm_br(p, smem); }
        GSYNC();
        { const P p = fence_P(); ph_gemm_gate(p, smem); }
        GSYNC();
        { const P p = fence_P(); ph_gemm_wo(p, smem); }
        GSYNC();
        { const P p = fence_P(); ph_post(p, l, 1); }
        GSYNC();
        { const P p = fence_P(); ph_gemm_up(p, smem); }
        GSYNC();
        { const P p = fence_P(); ph_gemm_down(p, smem); }
        GSYNC();
        { const P p = fence_P(); ph_post(p, l, 2); }
        if (l == 0) { __syncthreads(); ph_convert(a.J[1], smem); GSYNC(); }
    }
}

static void add_job(TJobs& J, const float* src, bf16* dst, int ldw, int K, int Ndst, int ldo, int mode, int arg, int nvalid) {
    TJob& j = J.j[J.n]; j.src = src; j.dst = dst; j.ldw = ldw; j.K = K; j.Ndst = Ndst; j.ldo = ldo; j.mode = mode; j.arg = arg; j.nvalid = nvalid; j.tile0 = J.total;
    J.total += (Ndst / 64) * (K / 64); J.n++;
}

extern "C" void kernel_launch(void* const* d_in, const int* in_sizes, int n_in, void* d_out, int out_size, void* d_ws, size_t ws_size, hipStream_t stream) {
    if (n_in != 32 || ws_size < WS_NEED) { fprintf(stderr, "kernel_launch: unexpected n_in %d or ws_size %zu (need %zu)\n", n_in, ws_size, (size_t)WS_NEED); return; }
    static int grid = 0;
    if (grid == 0) {
        int dev = 0, cus = 0, per_cu = 0;
        (void)hipGetDevice(&dev);
        (void)hipDeviceGetAttribute(&cus, hipDeviceAttributeMultiprocessorCount, dev);
        (void)hipFuncSetAttribute((const void*)mega, hipFuncAttributeMaxDynamicSharedMemorySize, LDS_BYTES);
        (void)hipOccupancyMaxActiveBlocksPerMultiprocessor(&per_cu, (const void*)mega, NT, LDS_BYTES);
        if (per_cu < 1) { fprintf(stderr, "kernel_launch: occupancy query says %d blocks/CU\n", per_cu); per_cu = 1; }
        if (per_cu > 1) per_cu = 1;
        grid = cus * per_cu;
    }
    KArgs a{};
    const float** pf = (const float**)&a.p;
    for (int i = 0; i < 32; ++i) pf[i] = (const float*)d_in[i];
    a.p.out = (float*)d_out; a.p.ws = (unsigned char*)d_ws;
    const P& p = a.p;
    bf16* Wb = (bf16*)(a.p.ws + WS_W);
    for (int l = 0; l < 2; ++l) {
        TJobs& J = a.J[l];
        add_job(J, p.w_in + (size_t)l * 1024 * PIN, (bf16*)((char*)Wb + W_A), PIN, 1024, 2176, 1024, 0, 0, 2160);
        add_job(J, p.w_in + (size_t)l * 1024 * PIN, (bf16*)((char*)Wb + W_G), PIN, 1024, 4096, 1024, 0, C_GATE, 4096);
        for (int m = 0; m < 4; ++m) add_job(J, p.w_br + ((size_t)l * 4 + m) * 256 * 1024, (bf16*)((char*)Wb + W_BR) + (size_t)m * 1024 * 256, 1024, 256, 1024, 256, 0, 0, 1024);
        for (int m = 0; m < 4; ++m) add_job(J, p.w_o + (size_t)l * 1024 * 1024, (bf16*)((char*)Wb + W_O4) + m * 1024, 1024, 1024, 1024, 4096, 0, 0, 1024);
        add_job(J, p.w_up + (size_t)l * 1024 * 5632, (bf16*)((char*)Wb + W_UP), 5632, 1024, 5632, 1024, 1, 0, 5632);
        add_job(J, p.w_down + (size_t)l * DFF * 1024, (bf16*)((char*)Wb + W_DN), 1024, DFF, 1024, DFF, 0, 0, 1024);
        add_job(J, p.b_w_uq + (size_t)l * 192 * 384, (bf16*)((char*)Wb + W_UQ), 384, 192, 384, 192, 0, 0, 384);
        add_job(J, p.b_w_ukv + (size_t)l * 128 * 512, (bf16*)((char*)Wb + W_UKV), 512, 128, 512, 128, 0, 0, 512);
    }
    void* args[] = {&a};
    hipError_t e = hipLaunchCooperativeKernel((const void*)mega, dim3(grid), dim3(NT), args, LDS_BYTES, stream);
    if (e != hipSuccess) fprintf(stderr, "cooperative launch failed: %s (grid %d)\n", hipGetErrorString(e), grid);
}
```

```cpp
#include <hip/hip_runtime.h>
#include <hip/hip_cooperative_groups.h>
namespace cg = cooperative_groups;
#define NT 512
#define NWV 8
#define LDS_BYTES 147456
#include <stdint.h>
#include <stdio.h>

typedef unsigned short bf16;
typedef short bf16x8 __attribute__((ext_vector_type(8)));
typedef float f32x16 __attribute__((ext_vector_type(16)));

#define DM 1024
#define NTOK 16384
#define NPROMPT 8192
#define PLD 2176
#define C_AQ 0
#define C_AK 256
#define C_AV 384
#define C_BCQ 512
#define C_BCKV 704
#define C_BKR 832
#define C_CIN 864
#define C_DQKV 1120
#define C_DZ 1888
#define C_DBETA 2144
#define C_DALPHA 2152
#define C_GATE 2160
#define PIN 6256
#define DFF 2816
#define EPS 1e-6f
#define NKVROWS 16896

#define O_Y 0
#define O_CAK 16777216
#define O_CAV 18874368
#define O_CKV 20971520
#define O_KR 23068672
#define O_SF 23592960
#define O_SB 24641536

#define MB(x) ((size_t)(x) * 1024 * 1024)
#define WS_MOD 0
#define WS_TAB (WS_MOD + 147456)
#define WS_KAC (WS_TAB + 12288)
#define WS_VAC (WS_KAC + 512 * 128 * 2)
#define WS_GGC (WS_VAC + 512 * 128 * 2)
#define WS_W (MB(1))
#define W_A 0
#define W_G (W_A + 2176 * 1024 * 2)
#define W_BR (W_G + 4096 * 1024 * 2)
#define W_O4 (W_BR + 4 * 1024 * 256 * 2)
#define W_UP (W_O4 + 1024 * 4096 * 2)
#define W_DN (W_UP + 5632 * 1024 * 2)
#define W_UQ (W_DN + 1024 * 2816 * 2)
#define W_UKV (W_UQ + 384 * 192 * 2)
#define W_END (W_UKV + 512 * 128 * 2)
#define WS_H (MB(42))
#define WS_BR (MB(74))
#define WS_BIG (MB(106))
#define B_PROJ 0
#define B_CQ (B_PROJ + (size_t)16384 * 2176 * 2)
#define B_CKV (B_CQ + (size_t)16384 * 192 * 2)
#define B_QB (B_CKV + (size_t)16896 * 128 * 2)
#define B_KV (B_QB + (size_t)16384 * 384 * 2)
#define B_QA1S (B_KV + (size_t)16896 * 512 * 2)
#define B_KA1S (B_QA1S + (size_t)8192 * 256 * 2)
#define B_KB (B_KA1S + (size_t)8192 * 128 * 2)
#define B_GQK (B_KB + (size_t)16896 * 384 * 2)
#define B_GUW (B_GQK + (size_t)8192 * 512 * 2)
#define B_END_A (B_GUW + (size_t)1024 * 8192 * 2)
#define B_GOB B_CKV
#define B_PROD 0
#define B_HID 0
#define WS_NEED (WS_BIG + B_END_A)

struct P {
    const float *x_prompt, *x_sample, *cache_a_k, *cache_a_v, *cache_b_ckv, *cache_b_krope, *state_f, *state_b, *c, *c_ctx;
    const float *w_mod, *b_mod, *g_pre1, *g_post1, *g_pre2, *g_post2, *w_in, *a_sink, *b_g_cq, *b_g_ckv, *b_w_uq, *b_w_ukv;
    const float *c_w_pool, *c_scale, *d_conv, *d_a_log, *d_dt_bias, *d_g_norm, *w_br, *w_o, *w_up, *w_down;
    float* out;
    unsigned char* ws;
};


typedef const __attribute__((address_space(4))) unsigned char* kargp_t;
__device__ __forceinline__ P fence_P() {
    kargp_t kp = (kargp_t)__builtin_amdgcn_kernarg_segment_ptr();
    asm volatile("" : "+s"(kp));
    const __attribute__((address_space(4))) P* pp = (const __attribute__((address_space(4))) P*)kp;
    P q;
    q.x_prompt = pp->x_prompt;
    q.x_sample = pp->x_sample;
    q.cache_a_k = pp->cache_a_k;
    q.cache_a_v = pp->cache_a_v;
    q.cache_b_ckv = pp->cache_b_ckv;
    q.cache_b_krope = pp->cache_b_krope;
    q.state_f = pp->state_f;
    q.state_b = pp->state_b;
    q.c = pp->c;
    q.c_ctx = pp->c_ctx;
    q.w_mod = pp->w_mod;
    q.b_mod = pp->b_mod;
    q.g_pre1 = pp->g_pre1;
    q.g_post1 = pp->g_post1;
    q.g_pre2 = pp->g_pre2;
    q.g_post2 = pp->g_post2;
    q.w_in = pp->w_in;
    q.a_sink = pp->a_sink;
    q.b_g_cq = pp->b_g_cq;
    q.b_g_ckv = pp->b_g_ckv;
    q.b_w_uq = pp->b_w_uq;
    q.b_w_ukv = pp->b_w_ukv;
    q.c_w_pool = pp->c_w_pool;
    q.c_scale = pp->c_scale;
    q.d_conv = pp->d_conv;
    q.d_a_log = pp->d_a_log;
    q.d_dt_bias = pp->d_dt_bias;
    q.d_g_norm = pp->d_g_norm;
    q.w_br = pp->w_br;
    q.w_o = pp->w_o;
    q.w_up = pp->w_up;
    q.w_down = pp->w_down;
    q.out = pp->out;
    q.ws = pp->ws;
    return q;
}

__device__ __forceinline__ bf16 f2bf(float f) {
    unsigned u = __float_as_uint(f);
    u += 0x7fffu + ((u >> 16) & 1u);
    return (bf16)(u >> 16);
}
__device__ __forceinline__ float bf2f(bf16 h) { return __uint_as_float(((unsigned)h) << 16); }
__device__ __forceinline__ float wave_sum(float v) {
#pragma unroll
    for (int o = 32; o > 0; o >>= 1) v += __shfl_xor(v, o);
    return v;
}

__device__ __forceinline__ unsigned vzero() { unsigned z = 0; asm volatile("" : "+v"(z)); return z; }
__device__ __forceinline__ int tidx() { int t = threadIdx.x; asm volatile("" : "+v"(t)); return t; }
__device__ __forceinline__ float sigmoidf_(float x) { return 1.f / (1.f + __expf(-x)); }
__device__ __forceinline__ float siluf_(float x) { return x / (1.f + __expf(-x)); }

struct TJob { const float* src; bf16* dst; int ldw, K, Ndst, ldo, mode, arg, nvalid, tile0; };
struct TJobs { TJob j[16]; int n, total; };

__device__ __forceinline__ void ph_convert(const TJobs& J, unsigned char* smem) {
    float (*tile)[65] = (float (*)[65])smem;
    const int tid = tidx();
    for (int t = blockIdx.x; t < J.total; t += gridDim.x) {
        int ji = 0;
        for (int q = 1; q < J.n; ++q) if (t >= J.j[q].tile0) ji = q;
        const TJob jb = J.j[ji];
        const int local = t - jb.tile0, nkt = jb.K / 64, tn = local / nkt, tk = local % nkt;
        const int tx = tid & 63, ty = tid >> 6;
        const int n = tn * 64 + tx;
        int sc;
        if (jb.mode == 0) sc = (n < jb.nvalid) ? n + jb.arg : -1;
        else { const int tl = n >> 7, wn = (n >> 6) & 1, nj = (n >> 5) & 1, j = n & 31; sc = nj * DFF + tl * 64 + wn * 32 + j; }
        for (int kk = ty; kk < 64; kk += NWV) tile[kk][tx] = (sc >= 0) ? jb.src[(size_t)(tk * 64 + kk) * jb.ldw + sc] : 0.f;
        __syncthreads();
        {
            const int q = tid, r = q >> 3, c8 = q & 7;
            unsigned w[4];
            for (int j = 0; j < 4; ++j) w[j] = (unsigned)f2bf(tile[c8 * 8 + 2 * j][r]) | ((unsigned)f2bf(tile[c8 * 8 + 2 * j + 1][r]) << 16);
            *(uint4*)(jb.dst + (size_t)(tn * 64 + r) * jb.ldo + tk * 64 + c8 * 8) = make_uint4(w[0], w[1], w[2], w[3]);
        }
        __syncthreads();
    }
}

__device__ __forceinline__ void ph_mod(const P& p, unsigned char* smem) {
    float (*cs)[1024] = (float (*)[1024])smem;
    float (*red)[3][64] = (float (*)[3][64])(smem + 3 * 1024 * 4);
    const int tid = tidx();
    float* mod = (float*)(p.ws + WS_MOD);
    for (int i = tid; i < 3072; i += NT) { const int r = i >> 10, k = i & 1023; const float v = (r == 0) ? p.c_ctx[k] : p.c[(r - 1) * 1024 + k]; cs[r][k] = siluf_(v); }
    __syncthreads();
    for (int it = blockIdx.x; it < 192; it += gridDim.x) {
        const int l = it / 96, cg = it % 96, col = cg * 64 + (tid & 63), kq = tid >> 6;
        float a0 = 0.f, a1 = 0.f, a2 = 0.f;
        const float* w = p.w_mod + ((size_t)l * 1024 + kq * 128) * 6144 + col;
        for (int k = 0; k < 128; ++k) { const float wv = w[(size_t)k * 6144]; a0 += cs[0][kq * 128 + k] * wv; a1 += cs[1][kq * 128 + k] * wv; a2 += cs[2][kq * 128 + k] * wv; }
        red[kq][0][tid & 63] = a0; red[kq][1][tid & 63] = a1; red[kq][2][tid & 63] = a2;
        __syncthreads();
        if (tid < 192) { const int r = tid >> 6, cc = tid & 63; const float s = red[0][r][cc] + red[1][r][cc] + red[2][r][cc] + red[3][r][cc] + red[4][r][cc] + red[5][r][cc] + red[6][r][cc] + red[7][r][cc] + p.b_mod[l * 6144 + cg * 64 + cc]; mod[(l * 3 + r) * 6144 + cg * 64 + cc] = s; }
        __syncthreads();
    }
    if (blockIdx.x == 0) {
        float* tab = (float*)(p.ws + WS_TAB);
        for (int i = tid; i < 64 * 16; i += NT) { const int pos = i >> 4, f = i & 15; const float inv = powf(10000.f, -(float)f / 16.f); float s, c; sincosf((float)pos * inv, &s, &c); tab[i] = c; tab[1024 + i] = s; }
        for (int i = tid; i < 64 * 8; i += NT) { const int pos = i >> 3, f = i & 7; const float inv = powf(10000.f, -(float)f / 8.f); float s, c; sincosf((float)pos * inv, &s, &c); tab[2048 + i] = c; tab[2560 + i] = s; }
    }
}

__device__ __forceinline__ const float* xrow_in(const P& p, int row) { return row < NPROMPT ? p.x_prompt + (size_t)row * DM : p.x_sample + (size_t)(row - NPROMPT) * DM; }
__device__ __forceinline__ int cond_row(int row) { return row < NPROMPT ? 0 : 1 + ((row - NPROMPT) >> 12); }

__device__ __forceinline__ void ph_prenorm(const P& p, int l) {
    const int lane = tidx() & 63;
    const float* mod = (const float*)(p.ws + WS_MOD);
    bf16* H = (bf16*)(p.ws + WS_H);
    for (int row = blockIdx.x * NWV + (tidx() >> 6); row < NTOK; row += gridDim.x * NWV) {
        const float* xr = (l == 0) ? xrow_in(p, row) : p.out + (size_t)row * DM;
        float4 v[4]; float ss = 0.f;
        for (int i = 0; i < 4; ++i) { v[i] = *(const float4*)(xr + i * 256 + lane * 4); ss += v[i].x * v[i].x + v[i].y * v[i].y + v[i].z * v[i].z + v[i].w * v[i].w; }
        ss = wave_sum(ss);
        const float rinv = rsqrtf(ss * (1.f / 1024.f) + EPS);
        const float* md = mod + (l * 3 + cond_row(row)) * 6144;
        for (int i = 0; i < 4; ++i) {
            const int col = i * 256 + lane * 4;
            const float4 g = *(const float4*)(p.g_pre1 + l * 1024 + col), sc = *(const float4*)(md + 1024 + col), sh = *(const float4*)(md + col);
            const float h0 = v[i].x * rinv * g.x * (1.f + sc.x) + sh.x, h1 = v[i].y * rinv * g.y * (1.f + sc.y) + sh.y;
            const float h2 = v[i].z * rinv * g.z * (1.f + sc.z) + sh.z, h3 = v[i].w * rinv * g.w * (1.f + sc.w) + sh.w;
            *(uint2*)(H + (size_t)row * DM + col) = make_uint2((unsigned)f2bf(h0) | ((unsigned)f2bf(h1) << 16), (unsigned)f2bf(h2) | ((unsigned)f2bf(h3) << 16));
        }
    }
}

__device__ __forceinline__ void ph_post(const P& p, int l, int which) {
    const int lane = tidx() & 63;
    const float* mod = (const float*)(p.ws + WS_MOD);
    bf16* H = (bf16*)(p.ws + WS_H);
    const bf16* src = (const bf16*)(p.ws + WS_BR);
    const float* gpost = (which == 1 ? p.g_post1 : p.g_post2) + l * 1024;
    const int ga_off = which == 1 ? 2048 : 5120;
    const bool donext = (which == 1) || (l == 0);
    const int ln = which == 1 ? l : l + 1;
    const float* gpre = (which == 1 ? p.g_pre2 : p.g_pre1) + ln * 1024;
    const int sc_off = which == 1 ? 4096 : 1024, sh_off = which == 1 ? 3072 : 0;
    for (int row = blockIdx.x * NWV + (tidx() >> 6); row < NTOK; row += gridDim.x * NWV) {
        const float* xr = (l == 0 && which == 1) ? xrow_in(p, row) : p.out + (size_t)row * DM;
        const int cr = cond_row(row);
        const float* md = mod + (l * 3 + cr) * 6144;
        float4 x[4], s[4]; float ss = 0.f;
        for (int i = 0; i < 4; ++i) {
            const int col = i * 256 + lane * 4;
            x[i] = *(const float4*)(xr + col);
            const uint2 raw = *(const uint2*)(src + (size_t)row * DM + col);
            s[i] = make_float4(bf2f((bf16)(raw.x & 0xffff)), bf2f((bf16)(raw.x >> 16)), bf2f((bf16)(raw.y & 0xffff)), bf2f((bf16)(raw.y >> 16)));
            ss += s[i].x * s[i].x + s[i].y * s[i].y + s[i].z * s[i].z + s[i].w * s[i].w;
        }
        ss = wave_sum(ss);
        const float rinv = rsqrtf(ss * (1.f / 1024.f) + EPS);
        float ss2 = 0.f;
        for (int i = 0; i < 4; ++i) {
            const int col = i * 256 + lane * 4;
            const float4 g = *(const float4*)(gpost + col), ga = *(const float4*)(md + ga_off + col);
            x[i].x += ga.x * s[i].x * rinv * g.x; x[i].y += ga.y * s[i].y * rinv * g.y; x[i].z += ga.z * s[i].z * rinv * g.z; x[i].w += ga.w * s[i].w * rinv * g.w;
            *(float4*)(p.out + (size_t)row * DM + col) = x[i];
            ss2 += x[i].x * x[i].x + x[i].y * x[i].y + x[i].z * x[i].z + x[i].w * x[i].w;
        }
        if (donext) {
            ss2 = wave_sum(ss2);
            const float rinv2 = rsqrtf(ss2 * (1.f / 1024.f) + EPS);
            const float* md2 = mod + (ln * 3 + cr) * 6144;
            for (int i = 0; i < 4; ++i) {
                const int col = i * 256 + lane * 4;
                const float4 g = *(const float4*)(gpre + col), sc = *(const float4*)(md2 + sc_off + col), sh = *(const float4*)(md2 + sh_off + col);
                const float h0 = x[i].x * rinv2 * g.x * (1.f + sc.x) + sh.x, h1 = x[i].y * rinv2 * g.y * (1.f + sc.y) + sh.y;
                const float h2 = x[i].z * rinv2 * g.z * (1.f + sc.z) + sh.z, h3 = x[i].w * rinv2 * g.w * (1.f + sc.w) + sh.w;
                *(uint2*)(H + (size_t)row * DM + col) = make_uint2((unsigned)f2bf(h0) | ((unsigned)f2bf(h1) << 16), (unsigned)f2bf(h2) | ((unsigned)f2bf(h3) << 16));
            }
        }
    }
}

struct GemmArgs { const bf16* A; const bf16* Bt; int lda, ldb, M, N, K, pad; };

struct EpiStore {
    bf16* C; int ldc, nvalid;
    __device__ __forceinline__ void operator()(const f32x16 (&acc)[2][2], int rowbase, int colbase, int tn, int wn, int lane) const {
        _Pragma("unroll") for (int mi = 0; mi < 2; ++mi) _Pragma("unroll") for (int nj = 0; nj < 2; ++nj) {
            const int col = colbase + nj * 32 + (lane & 31);
            if (col < nvalid) _Pragma("unroll") for (int r = 0; r < 16; ++r) { const int row = rowbase + mi * 32 + (r & 3) + 8 * (r >> 2) + 4 * (lane >> 5); C[(size_t)row * ldc + col] = f2bf(acc[mi][nj][r]); }
        }
    }
};
struct EpiGate {
    bf16* C; int ldc;
    __device__ __forceinline__ void operator()(const f32x16 (&acc)[2][2], int rowbase, int colbase, int tn, int wn, int lane) const {
        _Pragma("unroll") for (int mi = 0; mi < 2; ++mi) _Pragma("unroll") for (int nj = 0; nj < 2; ++nj) {
            const int col = colbase + nj * 32 + (lane & 31);
            _Pragma("unroll") for (int r = 0; r < 16; ++r) { const int row = rowbase + mi * 32 + (r & 3) + 8 * (r >> 2) + 4 * (lane >> 5); bf16* q = C + (size_t)row * ldc + col; *q = f2bf(sigmoidf_(acc[mi][nj][r]) * bf2f(*q)); }
        }
    }
};
struct EpiSwiglu {
    bf16* C; int ldc;
    __device__ __forceinline__ void operator()(const f32x16 (&acc)[2][2], int rowbase, int colbase, int tn, int wn, int lane) const {
        const int col = tn * 64 + wn * 32 + (lane & 31);
        _Pragma("unroll") for (int mi = 0; mi < 2; ++mi) _Pragma("unroll") for (int r = 0; r < 16; ++r) {
            const int row = rowbase + mi * 32 + (r & 3) + 8 * (r >> 2) + 4 * (lane >> 5);
            C[(size_t)row * ldc + col] = f2bf(siluf_(acc[mi][0][r]) * acc[mi][1][r]);
        }
    }
};

template <class Epi>
__device__ __forceinline__ void gemm_tiles(const GemmArgs g, const Epi epi, unsigned char* smem) {
    const int vb = tidx() >> 8, tid = tidx() & 255, lane = tid & 63, w = tid >> 6, wm = w >> 1, wn = w & 1;
    bf16* As = (bf16*)(smem + vb * 65536);
    bf16* Bs = As + 2 * 128 * 64;
    const int nM = g.M / 128, nN = g.N / 128, nK = g.K / 64, ntiles = nM * nN;
    const int nvb = gridDim.x * 2, iters = (ntiles + nvb - 1) / nvb;
    for (int it = 0; it < iters; ++it) {
        const int t0 = it * nvb + blockIdx.x * 2 + vb;
        const bool valid = t0 < ntiles;
        const int t = valid ? t0 : 0;
        const int grp = t / (16 * nN), first = grp * 16, gsz = (nM - first) < 16 ? (nM - first) : 16, r0 = t - grp * 16 * nN;
        const int tm = first + r0 % gsz, tn = r0 / gsz;
        const bf16* Ag = g.A + (size_t)(tm * 128) * g.lda;
        const bf16* Bg = g.Bt + (size_t)(tn * 128) * g.ldb;
        typedef unsigned u32x4 __attribute__((ext_vector_type(4)));
        u32x4 ra0, ra1, ra2, ra3, rb0, rb1, rb2, rb3;
        f32x16 acc[2][2];
        _Pragma("unroll") for (int mi = 0; mi < 2; ++mi) _Pragma("unroll") for (int nj = 0; nj < 2; ++nj) _Pragma("unroll") for (int r = 0; r < 16; ++r) acc[mi][nj][r] = 0.f;
        const int lrow = tid >> 3, lch = tid & 7;
        const bf16* Ap = Ag + (size_t)lrow * g.lda + lch * 8;
        const bf16* Bp = Bg + (size_t)lrow * g.ldb + lch * 8;
        const size_t a32 = (size_t)32 * g.lda, b32 = (size_t)32 * g.ldb;
#define GLOAD(k0) { ra0 = *(const u32x4*)(Ap + (k0)); ra1 = *(const u32x4*)(Ap + a32 + (k0)); ra2 = *(const u32x4*)(Ap + 2 * a32 + (k0)); ra3 = *(const u32x4*)(Ap + 3 * a32 + (k0)); \
                    rb0 = *(const u32x4*)(Bp + (k0)); rb1 = *(const u32x4*)(Bp + b32 + (k0)); rb2 = *(const u32x4*)(Bp + 2 * b32 + (k0)); rb3 = *(const u32x4*)(Bp + 3 * b32 + (k0)); }
        GLOAD(0)
        const int soff = lrow * 64 + ((lch ^ (lrow & 7)) << 3);
        for (int kt = 0; kt < nK; ++kt) {
            bf16* Ab = As + (kt & 1) * 8192; bf16* Bb = Bs + (kt & 1) * 8192;
            *(u32x4*)(Ab + soff) = ra0; *(u32x4*)(Ab + soff + 2048) = ra1; *(u32x4*)(Ab + soff + 4096) = ra2; *(u32x4*)(Ab + soff + 6144) = ra3;
            *(u32x4*)(Bb + soff) = rb0; *(u32x4*)(Bb + soff + 2048) = rb1; *(u32x4*)(Bb + soff + 4096) = rb2; *(u32x4*)(Bb + soff + 6144) = rb3;
            __syncthreads();
            if (kt + 1 < nK) GLOAD((kt + 1) * 64)
#pragma unroll
            for (int kk = 0; kk < 4; ++kk) {
                bf16x8 a[2], b[2];
                const int ch = kk * 2 + (lane >> 5);
#pragma unroll
                for (int mi = 0; mi < 2; ++mi) { const int row = wm * 64 + mi * 32 + (lane & 31); a[mi] = *(const bf16x8*)(Ab + row * 64 + ((ch ^ (row & 7)) << 3)); }
#pragma unroll
                for (int nj = 0; nj < 2; ++nj) { const int row = wn * 64 + nj * 32 + (lane & 31); b[nj] = *(const bf16x8*)(Bb + row * 64 + ((ch ^ (row & 7)) << 3)); }
#pragma unroll
                for (int mi = 0; mi < 2; ++mi)
#pragma unroll
                    for (int nj = 0; nj < 2; ++nj) acc[mi][nj] = __builtin_amdgcn_mfma_f32_32x32x16_bf16(a[mi], b[nj], acc[mi][nj], 0, 0, 0);
            }
        }
        if (valid) epi(acc, tm * 128 + wm * 64, tn * 128 + wn * 64, tn, wn, lane);
        __syncthreads();
    }
}

__device__ __forceinline__ void ph_postproj(const P& p, int l) {
    const int lane = tidx() & 63;
    const bf16* proj = (const bf16*)(p.ws + WS_BIG + B_PROJ);
    bf16* cq = (bf16*)(p.ws + WS_BIG + B_CQ);
    bf16* ckv = (bf16*)(p.ws + WS_BIG + B_CKV);
    for (int row = blockIdx.x * NWV + (tidx() >> 6); row < NKVROWS; row += gridDim.x * NWV) {
        if (row >= NTOK) {
            const int r = row - NTOK, b = r >> 8, s = r & 255;
            const float* src = p.cache_b_ckv + ((size_t)(b * 2 + l) * 256 + s) * 128;
            ckv[(size_t)row * 128 + lane] = f2bf(src[lane]); ckv[(size_t)row * 128 + 64 + lane] = f2bf(src[64 + lane]);
            continue;
        }
        const bf16* pr = proj + (size_t)row * PLD;
        float a0 = bf2f(pr[C_BCQ + lane]), a1 = bf2f(pr[C_BCQ + 64 + lane]), a2 = bf2f(pr[C_BCQ + 128 + lane]);
        float ss = wave_sum(a0 * a0 + a1 * a1 + a2 * a2);
        float rinv = rsqrtf(ss * (1.f / 192.f) + EPS);
        const float* gq = p.b_g_cq + l * 192;
        cq[(size_t)row * 192 + lane] = f2bf(a0 * rinv * gq[lane]); cq[(size_t)row * 192 + 64 + lane] = f2bf(a1 * rinv * gq[64 + lane]); cq[(size_t)row * 192 + 128 + lane] = f2bf(a2 * rinv * gq[128 + lane]);
        float k0 = bf2f(pr[C_BCKV + lane]), k1 = bf2f(pr[C_BCKV + 64 + lane]);
        ss = wave_sum(k0 * k0 + k1 * k1);
        rinv = rsqrtf(ss * (1.f / 128.f) + EPS);
        const float* gk = p.b_g_ckv + l * 128;
        k0 = k0 * rinv * gk[lane]; k1 = k1 * rinv * gk[64 + lane];
        ckv[(size_t)row * 128 + lane] = f2bf(k0); ckv[(size_t)row * 128 + 64 + lane] = f2bf(k1);
        if (row < NPROMPT) {
            const int b = row >> 8, s = row & 255;
            const size_t ci = (size_t)(b * 2 + l) * 256 + s;
            p.out[O_CKV + ci * 128 + lane] = k0; p.out[O_CKV + ci * 128 + 64 + lane] = k1;
            p.out[O_CAK + ci * 128 + lane] = bf2f(pr[C_AK + lane]); p.out[O_CAK + ci * 128 + 64 + lane] = bf2f(pr[C_AK + 64 + lane]);
            p.out[O_CAV + ci * 128 + lane] = bf2f(pr[C_AV + lane]); p.out[O_CAV + ci * 128 + 64 + lane] = bf2f(pr[C_AV + 64 + lane]);
            if (lane < 32) p.out[O_KR + ci * 32 + lane] = bf2f(pr[C_BKR + lane]);
        }
    }
}

__device__ __forceinline__ void ph_prep2(const P& p, int l) {
    const int lane = tidx() & 63;
    const float* tab = (const float*)(p.ws + WS_TAB);
    const bf16* proj = (const bf16*)(p.ws + WS_BIG + B_PROJ);
    const bf16* qb = (const bf16*)(p.ws + WS_BIG + B_QB);
    const bf16* kv = (const bf16*)(p.ws + WS_BIG + B_KV);
    bf16* qa1s = (bf16*)(p.ws + WS_BIG + B_QA1S);
    bf16* ka1s = (bf16*)(p.ws + WS_BIG + B_KA1S);
    bf16* qb1s = (bf16*)(p.ws + WS_BIG + B_CQ);
    bf16* kb = (bf16*)(p.ws + WS_BIG + B_KB);
    bf16* kac = (bf16*)(p.ws + WS_KAC);
    bf16* vac = (bf16*)(p.ws + WS_VAC);
    for (int row = blockIdx.x * NWV + (tidx() >> 6); row < NKVROWS; row += gridDim.x * NWV) {
        for (int h = 0; h < 4; ++h) kb[(size_t)row * 384 + h * 96 + lane] = kv[(size_t)row * 512 + h * 128 + lane];
        if (row >= NTOK) {
            const int r = row - NTOK, b = r >> 8, s = r & 255;
            if (lane < 32) { const bf16 v = f2bf(p.cache_b_krope[((size_t)(b * 2 + l) * 256 + s) * 32 + lane]); for (int h = 0; h < 4; ++h) kb[(size_t)row * 384 + h * 96 + 64 + lane] = v; }
            const size_t ci = ((size_t)(b * 2 + l) * 256 + s) * 128;
            kac[(size_t)r * 128 + lane] = f2bf(p.cache_a_k[ci + lane]); kac[(size_t)r * 128 + 64 + lane] = f2bf(p.cache_a_k[ci + 64 + lane]);
            vac[(size_t)r * 128 + lane] = f2bf(p.cache_a_v[ci + lane]); vac[(size_t)r * 128 + 64 + lane] = f2bf(p.cache_a_v[ci + 64 + lane]);
            continue;
        }
        const bf16* pr = proj + (size_t)row * PLD;
        if (row < NPROMPT) {
            if (lane < 32) { const bf16 v = pr[C_BKR + lane]; for (int h = 0; h < 4; ++h) kb[(size_t)row * 384 + h * 96 + 64 + lane] = v; }
            continue;
        }
        const int rs = row - NPROMPT, t = rs & 4095, gr = t >> 6, gc = t & 63;
        {
            if (lane < 32) {
                const int d = lane, qtr = d >> 3, f = d & 7, pos = (qtr < 2) ? gr : gc;
                const float c = tab[2048 + pos * 8 + f], s = tab[2560 + pos * 8 + f];
                const float x = bf2f(pr[C_BKR + d]);
                const float y = bf2f(pr[C_BKR + (d ^ 8)]);
                const float o = (qtr & 1) ? (x * c + y * s) : (x * c - y * s);
                const bf16 v = f2bf(o);
                for (int h = 0; h < 4; ++h) kb[(size_t)row * 384 + h * 96 + 64 + d] = v;
                for (int h = 0; h < 4; ++h) {
                    const float qx = bf2f(qb[(size_t)row * 384 + h * 96 + 64 + d]), qy = bf2f(qb[(size_t)row * 384 + h * 96 + 64 + (d ^ 8)]);
                    qb1s[(size_t)rs * 384 + h * 96 + 64 + d] = f2bf((qtr & 1) ? (qx * c + qy * s) : (qx * c - qy * s));
                }
            }
            for (int h = 0; h < 4; ++h) qb1s[(size_t)rs * 384 + h * 96 + lane] = qb[(size_t)row * 384 + h * 96 + lane];
        }
        {
            const int d = lane, qtr = d >> 4, f = d & 15, pos = (qtr < 2) ? gr : gc;
            const float c = tab[pos * 16 + f], s = tab[1024 + pos * 16 + f];
            for (int h = 0; h < 4; ++h) {
                const float x = bf2f(pr[C_AQ + h * 64 + d]), y = bf2f(pr[C_AQ + h * 64 + (d ^ 16)]);
                qa1s[(size_t)rs * 256 + h * 64 + d] = f2bf((qtr & 1) ? (x * c + y * s) : (x * c - y * s));
            }
            for (int h = 0; h < 2; ++h) {
                const float x = bf2f(pr[C_AK + h * 64 + d]), y = bf2f(pr[C_AK + h * 64 + (d ^ 16)]);
                ka1s[(size_t)rs * 128 + h * 64 + d] = f2bf((qtr & 1) ? (x * c + y * s) : (x * c - y * s));
            }
        }
    }
}

struct AttnJob {
    const bf16 *q1, *q2, *k1, *v1, *k2, *v2;
    const float* sink;
    bf16* out;
    int ldq1, ldq2, ldk1, ldv1, ldk2, ldv2;
    int kstride, vstride, kvgroup, nbatch, T, nk2, window, outcol;
    float scale; int pad;
};

template <int DQK>
__device__ __forceinline__ void attn_item(const AttnJob& j, int blk, unsigned char* smem) {
    float* Ks = (float*)smem;
    float* Vs = Ks + 32 * DQK;
    const int tid = tidx(), eh = (tid >> 8) * 32;
    const int nqb = j.T / 256;
    const int b = blk / (4 * nqb), h = (blk / nqb) % 4, qb0 = (blk % nqb) * 256;
    const int kh = h / j.kvgroup;
    const int t = qb0 + (tid & 255);
    float q[DQK], o[32];
    float m = -1e30f, lsum = 0.f;
#pragma unroll
    for (int e = 0; e < 32; ++e) o[e] = 0.f;
    for (int set = 0; set < 2; ++set) {
        if (set == 1 && j.nk2 == 0) break;
        const bf16* qp = (set == 0) ? j.q1 + ((size_t)b * j.T + t) * j.ldq1 + h * DQK : j.q2 + ((size_t)b * j.T + t) * j.ldq2 + h * DQK;
#pragma unroll
        for (int d = 0; d < DQK; d += 4) { const uint2 raw = *(const uint2*)(qp + d); q[d] = bf2f((bf16)(raw.x & 0xffff)) * j.scale; q[d + 1] = bf2f((bf16)(raw.x >> 16)) * j.scale; q[d + 2] = bf2f((bf16)(raw.y & 0xffff)) * j.scale; q[d + 3] = bf2f((bf16)(raw.y >> 16)) * j.scale; }
        const bf16* kp = (set == 0) ? j.k1 + (size_t)b * j.T * j.ldk1 + kh * j.kstride : j.k2 + (size_t)b * j.nk2 * j.ldk2 + kh * j.kstride;
        const bf16* vp = (set == 0) ? j.v1 + (size_t)b * j.T * j.ldv1 + kh * j.vstride : j.v2 + (size_t)b * j.nk2 * j.ldv2 + kh * j.vstride;
        const int ldk = (set == 0) ? j.ldk1 : j.ldk2, ldv = (set == 0) ? j.ldv1 : j.ldv2;
        int kbeg = 0, kend = (set == 0) ? j.T : j.nk2;
        const bool win = (set == 0) && j.window;
        if (win) { kbeg = qb0 - 128 < 0 ? 0 : qb0 - 128; kend = qb0 + 256 + 128 > j.T ? j.T : qb0 + 256 + 128; }
        for (int ks = kbeg; ks < kend; ks += 32) {
            __syncthreads();
            for (int e = tid; e < 32 * DQK / 4; e += NT) {
                const int key = e / (DQK / 4), c4 = e % (DQK / 4), s = ks + key;
                float4 val = make_float4(0.f, 0.f, 0.f, 0.f);
                if (s < kend) { const uint2 raw = *(const uint2*)(kp + (size_t)s * ldk + c4 * 4); val = make_float4(bf2f((bf16)(raw.x & 0xffff)), bf2f((bf16)(raw.x >> 16)), bf2f((bf16)(raw.y & 0xffff)), bf2f((bf16)(raw.y >> 16))); }
                *(float4*)&Ks[key * DQK + c4 * 4] = val;
            }
            for (int e = tid; e < 32 * 16; e += NT) {
                const int key = e >> 4, c4 = e & 15, s = ks + key;
                float4 val = make_float4(0.f, 0.f, 0.f, 0.f);
                if (s < kend) { const uint2 raw = *(const uint2*)(vp + (size_t)s * ldv + c4 * 4); val = make_float4(bf2f((bf16)(raw.x & 0xffff)), bf2f((bf16)(raw.x >> 16)), bf2f((bf16)(raw.y & 0xffff)), bf2f((bf16)(raw.y >> 16))); }
                *(float4*)&Vs[key * 64 + c4 * 4] = val;
            }
            __syncthreads();
            const int nk = (kend - ks) < 32 ? (kend - ks) : 32;
            for (int key = 0; key < nk; ++key) {
                const int s = ks + key;
                if (win) { const int dlt = t - s; if (dlt > 128 || dlt < -128) continue; }
                float sc = 0.f;
#pragma unroll
                for (int d = 0; d < DQK; d += 4) { const float4 kk = *(const float4*)&Ks[key * DQK + d]; sc += q[d] * kk.x + q[d + 1] * kk.y + q[d + 2] * kk.z + q[d + 3] * kk.w; }
                if (sc > m) { const float c = __expf(m - sc); lsum *= c;
#pragma unroll
                    for (int e = 0; e < 32; ++e) o[e] *= c;
                    m = sc; }
                const float pp = __expf(sc - m);
                lsum += pp;
#pragma unroll
                for (int e = 0; e < 32; e += 4) { const float4 vv = *(const float4*)&Vs[key * 64 + eh + e]; o[e] += pp * vv.x; o[e + 1] += pp * vv.y; o[e + 2] += pp * vv.z; o[e + 3] += pp * vv.w; }
            }
        }
    }
    if (j.sink) {
        const float sk = j.sink[h];
        const float mf = sk > m ? sk : m;
        const float c = __expf(m - mf);
        lsum = lsum * c + __expf(sk - mf);
#pragma unroll
        for (int e = 0; e < 32; ++e) o[e] *= c;
    }
    const float inv = 1.f / lsum;
    bf16* op = j.out + ((size_t)b * j.T + t) * 1024 + j.outcol + h * 64 + eh;
#pragma unroll
    for (int e = 0; e < 32; e += 2) *(unsigned*)(op + e) = (unsigned)f2bf(o[e] * inv) | ((unsigned)f2bf(o[e + 1] * inv) << 16);
}

__device__ __forceinline__ void ph_pool(const P& p, int l, unsigned char* smem) {
    float (*df)[257] = (float (*)[257])smem;
    const int tid = tidx(), half = tid >> 8, c256 = tid & 255;
    const bf16* proj = (const bf16*)(p.ws + WS_BIG + B_PROJ);
    bf16* br = (bf16*)(p.ws + WS_BR);
    for (int tile = blockIdx.x; tile < NTOK / 32; tile += gridDim.x) {
        const int row0 = tile * 32;
        int base, T;
        if (row0 < NPROMPT) { base = (row0 >> 8) << 8; T = 256; } else { base = NPROMPT + (((row0 - NPROMPT) >> 12) << 12); T = 4096; }
        __syncthreads();
        {
            const int c = c256, g = c >> 6, hw = 1 << g;
            for (int i = half * 16; i < half * 16 + 16; ++i) {
                const int t = row0 + i - base;
                const int lo = t - hw < 0 ? 0 : t - hw, hi = t + hw > T ? T : t + hw;
                float sacc = 0.f;
                for (int u = lo; u < hi; ++u) sacc += bf2f(proj[(size_t)(base + u) * PLD + C_CIN + c]);
                df[i][c] = sacc / (float)(hi - lo) - bf2f(proj[(size_t)(base + t) * PLD + C_CIN + c]);
            }
        }
        __syncthreads();
        {
            const int g = c256 >> 6, d = c256 & 63;
            float acc[16];
#pragma unroll
            for (int i = 0; i < 16; ++i) acc[i] = 0.f;
            const float* wp = p.c_w_pool + ((size_t)(l * 4 + g) * 64) * 64 + d;
            for (int c = 0; c < 64; ++c) {
                const float w = wp[c * 64];
#pragma unroll
                for (int i = 0; i < 16; ++i) acc[i] += df[half * 16 + i][g * 64 + c] * w;
            }
            const float sc = p.c_scale[l * 256 + c256];
#pragma unroll
            for (int i = 0; i < 16; ++i) br[(size_t)(row0 + half * 16 + i) * 1024 + 512 + c256] = f2bf(acc[i] * sc);
        }
    }
}

#define GS_KN 0
#define GS_QN 8192
#define GS_W 16384
#define GS_QG 24576
#define GS_KDT 32768
#define GS_ST 49152
#define GS_VNT 57344
#define GS_A 65536
#define GS_U 73728
#define GS_V 90112
#define GS_L 107520
#define GS_SM 123904

__device__ __forceinline__ int swz(int r, int c) { return r * 64 + ((((c) >> 3) ^ (r & 7)) << 3) + (c & 7); }
__device__ __forceinline__ unsigned pk2(float a, float b) { return (unsigned)f2bf(a) | ((unsigned)f2bf(b) << 16); }

__device__ __forceinline__ f32x16 mm_tile(const bf16* A, int m0, const bf16* B, int n0, f32x16 acc, int lane) {
    const int ra = m0 + (lane & 31), rb = n0 + (lane & 31), hh = lane >> 5;
#pragma unroll
    for (int kk = 0; kk < 4; ++kk) {
        const int ch = kk * 2 + hh;
        const bf16x8 a = *(const bf16x8*)(A + ra * 64 + ((ch ^ (ra & 7)) << 3));
        const bf16x8 b = *(const bf16x8*)(B + rb * 64 + ((ch ^ (rb & 7)) << 3));
        acc = __builtin_amdgcn_mfma_f32_32x32x16_bf16(a, b, acc, 0, 0, 0);
    }
    return acc;
}
__device__ __forceinline__ f32x16 zero16() { f32x16 z; _Pragma("unroll") for (int r = 0; r < 16; ++r) z[r] = 0.f; return z; }

struct GdnCtx { int base, T, h, dir, cidx, l; };

__device__ __forceinline__ void gdn_prep(const P& p, const GdnCtx& c, unsigned char* smem_) {
    unsigned char* smem = smem_ + vzero();
    const int tid = tidx(), lane = tid & 63, wv = tid >> 6;
    bf16* KN = (bf16*)(smem + GS_KN); bf16* QN = (bf16*)(smem + GS_QN); bf16* Wl = (bf16*)(smem + GS_W);
    float* Ul = (float*)(smem + GS_U); float* Vl = (float*)(smem + GS_V); float* Lm = (float*)(smem + GS_L);
    float* gcs = (float*)(smem + GS_SM); float* betas = gcs + 64; float* qdec = gcs + 128; float* kdec = gcs + 192; float* bexp = gcs + 256;
    const bf16* proj = (const bf16*)(p.ws + WS_BIG + B_PROJ);
    const float* convw = p.d_conv + (size_t)c.l * 5 * 768;
#pragma unroll 1
    for (int r = 0; r < 3; ++r) {
        const int w = tid + NT * r, i = w / 24, rem = w - i * 24, part = rem >> 3, g8 = rem & 7;
        const int tt = c.cidx * 64 + (c.dir ? 63 - i : i);
        const int ch = part * 256 + c.h * 64 + g8 * 8;
        float u[8];
#pragma unroll
        for (int k = 0; k < 8; ++k) u[k] = 0.f;
#pragma unroll
        for (int j = 0; j < 5; ++j) {
            const int ts = tt + j - 2;
            if (ts >= 0 && ts < c.T) {
                const uint4 raw = *(const uint4*)(proj + (size_t)(c.base + ts) * PLD + C_DQKV + ch);
                const float4 w0 = *(const float4*)(convw + j * 768 + ch), w1 = *(const float4*)(convw + j * 768 + ch + 4);
                u[0] += w0.x * bf2f((bf16)(raw.x & 0xffff)); u[1] += w0.y * bf2f((bf16)(raw.x >> 16)); u[2] += w0.z * bf2f((bf16)(raw.y & 0xffff)); u[3] += w0.w * bf2f((bf16)(raw.y >> 16));
                u[4] += w1.x * bf2f((bf16)(raw.z & 0xffff)); u[5] += w1.y * bf2f((bf16)(raw.z >> 16)); u[6] += w1.z * bf2f((bf16)(raw.w & 0xffff)); u[7] += w1.w * bf2f((bf16)(raw.w >> 16));
            }
        }
        float ss = 0.f;
#pragma unroll
        for (int k = 0; k < 8; ++k) { u[k] = siluf_(u[k]); ss += u[k] * u[k]; }
        ss += __shfl_xor(ss, 1); ss += __shfl_xor(ss, 2); ss += __shfl_xor(ss, 4);
        if (part < 2) {
            const float sc = rsqrtf(ss + EPS) * (part == 0 ? 0.125f : 1.f);
            bf16* dst = (part == 0 ? QN : KN) + i * 64 + ((g8 ^ (i & 7)) << 3);
            *(uint4*)dst = make_uint4(pk2(u[0] * sc, u[1] * sc), pk2(u[2] * sc, u[3] * sc), pk2(u[4] * sc, u[5] * sc), pk2(u[6] * sc, u[7] * sc));
        } else {
            *(float4*)(Vl + i * 68 + g8 * 8) = make_float4(u[0], u[1], u[2], u[3]);
            *(float4*)(Vl + i * 68 + g8 * 8 + 4) = make_float4(u[4], u[5], u[6], u[7]);
        }
    }
    if (wv == 0) {
        const int i = lane, tt = c.cidx * 64 + (c.dir ? 63 - i : i);
        const bf16* pr = proj + (size_t)(c.base + tt) * PLD;
        const float Aexp = expf(p.d_a_log[(c.l * 2 + c.dir) * 4 + c.h]), dtb = p.d_dt_bias[(c.l * 2 + c.dir) * 4 + c.h];
        const float beta = sigmoidf_(bf2f(pr[C_DBETA + c.dir * 4 + c.h]));
        const float al = bf2f(pr[C_DALPHA + c.dir * 4 + c.h]) + dtb;
        float g = -Aexp * (al > 20.f ? al : log1pf(expf(al)));
#pragma unroll
        for (int o = 1; o < 64; o <<= 1) { const float t = __shfl_up(g, o); if (lane >= o) g += t; }
        const float g63 = __shfl(g, 63);
        const float eg = expf(g);
        gcs[i] = g; betas[i] = beta; qdec[i] = eg; kdec[i] = expf(g63 - g); bexp[i] = beta * eg;
    }
    __syncthreads();
    if (wv < 4) {
        const int mt = wv >> 1, nt = wv & 1, hh = lane >> 5, j = nt * 32 + (lane & 31);
        f32x16 acc = zero16();
        if (nt <= mt) acc = mm_tile(KN, mt * 32, KN, nt * 32, acc, lane);
        const float gj = gcs[j];
#pragma unroll
        for (int r = 0; r < 16; ++r) {
            const int i = mt * 32 + (r & 3) + 8 * (r >> 2) + 4 * hh;
            Lm[i * 64 + j] = (j < i) ? betas[i] * acc[r] * __expf(gcs[i] - gj) : 0.f;
        }
    }
    __syncthreads();
    if (wv < 2) {
        const int col = lane; const bool isW = wv == 1;
        float x[64];
#pragma unroll
        for (int i = 0; i < 64; ++i) x[i] = isW ? bf2f(KN[swz(i, col)]) * bexp[i] : Vl[i * 68 + col] * betas[i];
#pragma unroll
        for (int i = 1; i < 64; ++i) {
            float a = x[i];
#pragma unroll
            for (int j4 = 0; j4 < (i + 3) / 4; ++j4) {
                const float4 lv = *(const float4*)&Lm[i * 64 + j4 * 4];
                a -= lv.x * x[j4 * 4]; a -= lv.y * x[j4 * 4 + 1]; a -= lv.z * x[j4 * 4 + 2]; a -= lv.w * x[j4 * 4 + 3];
            }
            x[i] = a;
        }
        if (isW) {
#pragma unroll
            for (int i = 0; i < 64; ++i) Wl[swz(i, col)] = f2bf(x[i]);
        } else {
#pragma unroll
            for (int i = 0; i < 64; ++i) Ul[i * 64 + col] = x[i];
        }
    }
    __syncthreads();
}

__device__ __forceinline__ void gdn_t0(unsigned char* smem_, int kb) {
    unsigned char* smem = smem_ + vzero();
    const int tid = tidx(), i = tid >> 3, cc = tid & 7;
    const bf16* KN = (const bf16*)(smem + GS_KN); const bf16* QN = (const bf16*)(smem + GS_QN);
    bf16* QG = (bf16*)(smem + GS_QG); bf16* KDT = (bf16*)(smem + GS_KDT + kb * 8192);
    const float* gcs = (const float*)(smem + GS_SM); const float qd = gcs[128 + i], kd = gcs[192 + i];
    const int off = i * 64 + ((cc ^ (i & 7)) << 3);
    const uint4 q = *(const uint4*)(QN + off), k = *(const uint4*)(KN + off);
    const unsigned qa[4] = {q.x, q.y, q.z, q.w}, ka[4] = {k.x, k.y, k.z, k.w};
    unsigned qo[4];
#pragma unroll
    for (int t = 0; t < 4; ++t) {
        qo[t] = pk2(bf2f((bf16)(qa[t] & 0xffff)) * qd, bf2f((bf16)(qa[t] >> 16)) * qd);
        KDT[swz(cc * 8 + 2 * t, i)] = f2bf(bf2f((bf16)(ka[t] & 0xffff)) * kd);
        KDT[swz(cc * 8 + 2 * t + 1, i)] = f2bf(bf2f((bf16)(ka[t] >> 16)) * kd);
    }
    *(uint4*)(QG + off) = make_uint4(qo[0], qo[1], qo[2], qo[3]);
}

__device__ __forceinline__ void gdn_t12(const P& p, const GdnCtx& c, unsigned char* smem_, int kb, f32x16& Sreg, int mode) {
    unsigned char* smem = smem_ + vzero();
    const int tid = tidx(), lane = tid & 63, wv = tid >> 6, hh = lane >> 5, l31 = lane & 31;
    const bf16* KN = (const bf16*)(smem + GS_KN); const bf16* QN = (const bf16*)(smem + GS_QN); const bf16* Wl = (const bf16*)(smem + GS_W);
    const bf16* QG = (const bf16*)(smem + GS_QG); const bf16* KDT = (const bf16*)(smem + GS_KDT + kb * 8192);
    bf16* ST = (bf16*)(smem + GS_ST); bf16* VNT = (bf16*)(smem + GS_VNT); bf16* Al = (bf16*)(smem + GS_A);
    const float* Ul = (const float*)(smem + GS_U); const float* gcs = (const float*)(smem + GS_SM);
    f32x16 O0 = zero16(), O1 = zero16();
    const float gl = gcs[128 + 63];
    if (wv < 4) {
        const int mt = wv >> 1, nt = wv & 1, e = nt * 32 + l31;
        f32x16 acc = mm_tile(Wl, mt * 32, ST, nt * 32, zero16(), lane);
#pragma unroll
        for (int rg = 0; rg < 4; ++rg) {
            const int i0 = mt * 32 + 8 * rg + 4 * hh;
            const float v0 = Ul[(i0) * 64 + e] - acc[rg * 4], v1 = Ul[(i0 + 1) * 64 + e] - acc[rg * 4 + 1], v2 = Ul[(i0 + 2) * 64 + e] - acc[rg * 4 + 2], v3 = Ul[(i0 + 3) * 64 + e] - acc[rg * 4 + 3];
            *(uint2*)(VNT + swz(e, i0)) = make_uint2(pk2(v0, v1), pk2(v2, v3));
        }
    } else if (wv < 6) {
        const int mt = wv - 4;
        O0 = mm_tile(QG, mt * 32, ST, 0, O0, lane);
        O1 = mm_tile(QG, mt * 32, ST, 32, O1, lane);
    } else {
        const int mt = wv - 6;
#pragma unroll
        for (int nt = 0; nt < 2; ++nt) {
            f32x16 acc = zero16();
            if (nt <= mt) acc = mm_tile(QN, mt * 32, KN, nt * 32, acc, lane);
            const int j = nt * 32 + l31; const float gj = gcs[j];
#pragma unroll
            for (int r = 0; r < 16; ++r) {
                const int i = mt * 32 + (r & 3) + 8 * (r >> 2) + 4 * hh;
                Al[swz(i, j)] = f2bf((j <= i) ? acc[r] * __expf(gcs[i] - gj) : 0.f);
            }
        }
    }
    __syncthreads();
    if (wv < 4) {
        const int mt = wv >> 1, nt = wv & 1, e = nt * 32 + l31;
#pragma unroll
        for (int r = 0; r < 16; ++r) Sreg[r] *= gl;
        Sreg = mm_tile(KDT, mt * 32, VNT, nt * 32, Sreg, lane);
#pragma unroll
        for (int rg = 0; rg < 4; ++rg) {
            const int d0 = mt * 32 + 8 * rg + 4 * hh;
            *(uint2*)(ST + swz(e, d0)) = make_uint2(pk2(Sreg[rg * 4], Sreg[rg * 4 + 1]), pk2(Sreg[rg * 4 + 2], Sreg[rg * 4 + 3]));
        }
    } else if (wv < 6) {
        const int mt = wv - 4;
        O0 = mm_tile(Al, mt * 32, VNT, 0, O0, lane);
        O1 = mm_tile(Al, mt * 32, VNT, 32, O1, lane);
        bf16* br = (bf16*)(p.ws + WS_BR);
        bf16* gob = (bf16*)(p.ws + WS_BIG + B_GOB);
        const bf16* proj = (const bf16*)(p.ws + WS_BIG + B_PROJ);
#pragma unroll
        for (int r = 0; r < 16; ++r) {
            const int i = mt * 32 + (r & 3) + 8 * (r >> 2) + 4 * hh;
            const int tt = c.cidx * 64 + (c.dir ? 63 - i : i);
            const size_t row = (size_t)(c.base + tt);
            bf16* b0 = br + row * 1024 + 768 + c.h * 64 + l31;
            if (mode == 0) { b0[0] = f2bf(O0[r]); b0[32] = f2bf(O1[r]); }
            else if (mode == 1) { bf16* g0 = gob + (row - NPROMPT) * 256 + c.h * 64 + l31; g0[0] = f2bf(O0[r]); g0[32] = f2bf(O1[r]); }
            else {
                const float a0 = O0[r] + bf2f(b0[0]), a1 = O1[r] + bf2f(b0[32]);
                float ss = a0 * a0 + a1 * a1;
                ss += __shfl_xor(ss, 1); ss += __shfl_xor(ss, 2); ss += __shfl_xor(ss, 4); ss += __shfl_xor(ss, 8); ss += __shfl_xor(ss, 16);
                const float rinv = rsqrtf(ss * (1.f / 64.f) + EPS);
                const bf16* zp = proj + row * PLD + C_DZ + c.h * 64 + l31;
                b0[0] = f2bf(a0 * rinv * p.d_g_norm[c.l * 64 + l31] * siluf_(bf2f(zp[0])));
                b0[32] = f2bf(a1 * rinv * p.d_g_norm[c.l * 64 + 32 + l31] * siluf_(bf2f(zp[32])));
            }
        }
    }
}

__device__ __forceinline__ void gdn_prompt_item(const P& p, int l, int item, unsigned char* smem_) {
    unsigned char* smem = smem_ + vzero();
    const int tid = tidx(), lane = tid & 63, wv = tid >> 6, hh = lane >> 5, l31 = lane & 31;
    const int b = item >> 2, h = item & 3;
    bf16* ST = (bf16*)(smem + GS_ST);
    f32x16 Sreg = zero16();
    int kb = 0;
#pragma unroll 1
    for (int s = 0; s < 8; ++s) {
        const int dir = s >> 2, n = s & 3;
        GdnCtx c; c.base = b * 256; c.T = 256; c.h = h; c.dir = dir; c.cidx = dir ? 3 - n : n; c.l = l;
        __syncthreads();
        if (n == 0) {
            Sreg = zero16();
            for (int q = tid; q < 2048; q += NT) ((unsigned*)ST)[q] = 0u;
        }
        gdn_prep(p, c, smem);
        gdn_t0(smem, kb);
        __syncthreads();
        gdn_t12(p, c, smem, kb, Sreg, dir ? 2 : 0);
        kb ^= 1;
        if (n == 3 && wv < 4) {
            const int mt = wv >> 1, nt = wv & 1;
            float* so = p.out + (dir ? O_SB : O_SF) + ((size_t)(b * 2 + l) * 4 + h) * 4096;
#pragma unroll
            for (int r = 0; r < 16; ++r) so[(mt * 32 + (r & 3) + 8 * (r >> 2) + 4 * hh) * 64 + nt * 32 + l31] = Sreg[r];
        }
    }
    __syncthreads();
}

__device__ __forceinline__ void gdn_sample_prep_item(const P& p, int l, int item, unsigned char* smem_) {
    unsigned char* smem = smem_ + vzero();
    const int tid = tidx();
    const int n = item & 63, dir = (item >> 6) & 1, h = (item >> 7) & 3, b = item >> 9;
    GdnCtx c; c.base = NPROMPT + b * 4096; c.T = 4096; c.h = h; c.dir = dir; c.cidx = dir ? 63 - n : n; c.l = l;
    __syncthreads();
    gdn_prep(p, c, smem);
    const bf16* KN = (const bf16*)(smem + GS_KN); const bf16* QN = (const bf16*)(smem + GS_QN); const bf16* Wl = (const bf16*)(smem + GS_W);
    const float* Ul = (const float*)(smem + GS_U); const float* gcs = (const float*)(smem + GS_SM);
    bf16* gqk = (bf16*)(p.ws + WS_BIG + B_GQK); bf16* guw = (bf16*)(p.ws + WS_BIG + B_GUW); float* ggc = (float*)(p.ws + WS_GGC);
    const int i = tid >> 3, cc = tid & 7, off = i * 64 + ((cc ^ (i & 7)) << 3);
    if (dir == 0) {
        const size_t tok = (size_t)b * 4096 + c.cidx * 64 + i;
        *(uint4*)(gqk + ((tok * 4 + h) * 2 + 0) * 64 + cc * 8) = *(const uint4*)(QN + off);
        *(uint4*)(gqk + ((tok * 4 + h) * 2 + 1) * 64 + cc * 8) = *(const uint4*)(KN + off);
    }
    bf16* uw = guw + (size_t)item * 8192;
    const float4 u0 = *(const float4*)(Ul + i * 64 + cc * 8), u1 = *(const float4*)(Ul + i * 64 + cc * 8 + 4);
    *(uint4*)(uw + i * 64 + cc * 8) = make_uint4(pk2(u0.x, u0.y), pk2(u0.z, u0.w), pk2(u1.x, u1.y), pk2(u1.z, u1.w));
    *(uint4*)(uw + 4096 + i * 64 + cc * 8) = *(const uint4*)(Wl + off);
    if (tid < 64) ggc[(size_t)item * 64 + tid] = gcs[tid];
}

__device__ __forceinline__ void gdn_sample_chain(const P& p, int l, int chain, unsigned char* smem_) {
    unsigned char* smem = smem_ + vzero();
    const int tid = tidx(), lane = tid & 63, wv = tid >> 6, hh = lane >> 5, l31 = lane & 31;
    const int dir = chain & 1, h = (chain >> 1) & 3, b = chain >> 3;
    bf16* KN = (bf16*)(smem + GS_KN); bf16* QN = (bf16*)(smem + GS_QN); bf16* Wl = (bf16*)(smem + GS_W); bf16* QG = (bf16*)(smem + GS_QG);
    bf16* ST = (bf16*)(smem + GS_ST); float* Ul = (float*)(smem + GS_U); float* gcs = (float*)(smem + GS_SM);
    const bf16* gqk = (const bf16*)(p.ws + WS_BIG + B_GQK); const bf16* guw = (const bf16*)(p.ws + WS_BIG + B_GUW); const float* ggc = (const float*)(p.ws + WS_GGC);
    const float* stp = (const float*)((uintptr_t)p.state_f + (uintptr_t)dir * ((uintptr_t)p.state_b - (uintptr_t)p.state_f)) + ((size_t)(b * 2 + l) * 4 + h) * 4096;
    f32x16 Sreg = zero16();
    __syncthreads();
    if (wv < 4) {
        const int mt = wv >> 1, nt = wv & 1, e = nt * 32 + l31;
#pragma unroll
        for (int r = 0; r < 16; ++r) Sreg[r] = stp[(mt * 32 + (r & 3) + 8 * (r >> 2) + 4 * hh) * 64 + e];
#pragma unroll
        for (int rg = 0; rg < 4; ++rg) { const int d0 = mt * 32 + 8 * rg + 4 * hh; *(uint2*)(ST + swz(e, d0)) = make_uint2(pk2(Sreg[rg * 4], Sreg[rg * 4 + 1]), pk2(Sreg[rg * 4 + 2], Sreg[rg * 4 + 3])); }
    }
    const int i = tid >> 3, cc = tid & 7, off = i * 64 + ((cc ^ (i & 7)) << 3);
    const int item0 = ((b * 4 + h) * 2 + dir) * 64;
    uint4 rq, rk, ru, rw; float rg_i, rg_l;
#define GDN_LOAD(n) { const int cidx_ = dir ? 63 - (n) : (n); const size_t tok_ = (size_t)b * 4096 + cidx_ * 64 + (dir ? 63 - i : i); \
        rq = *(const uint4*)(gqk + ((tok_ * 4 + h) * 2 + 0) * 64 + cc * 8); rk = *(const uint4*)(gqk + ((tok_ * 4 + h) * 2 + 1) * 64 + cc * 8); \
        const bf16* uw_ = guw + (size_t)(item0 + (n)) * 8192; ru = *(const uint4*)(uw_ + i * 64 + cc * 8); rw = *(const uint4*)(uw_ + 4096 + i * 64 + cc * 8); \
        rg_i = ggc[(size_t)(item0 + (n)) * 64 + i]; rg_l = ggc[(size_t)(item0 + (n)) * 64 + 63]; }
    GDN_LOAD(0)
#pragma unroll 1
    for (int n = 0; n < 64; ++n) {
        const int kb = n & 1;
        bf16* KDT = (bf16*)(smem + GS_KDT + kb * 8192);
        {
            const float qd = __expf(rg_i), kd = __expf(rg_l - rg_i);
            *(uint4*)(QN + off) = rq; *(uint4*)(KN + off) = rk; *(uint4*)(Wl + off) = rw;
            const unsigned qa[4] = {rq.x, rq.y, rq.z, rq.w}, ka[4] = {rk.x, rk.y, rk.z, rk.w}, ua[4] = {ru.x, ru.y, ru.z, ru.w};
            unsigned qo[4];
#pragma unroll
            for (int t = 0; t < 4; ++t) {
                qo[t] = pk2(bf2f((bf16)(qa[t] & 0xffff)) * qd, bf2f((bf16)(qa[t] >> 16)) * qd);
                KDT[swz(cc * 8 + 2 * t, i)] = f2bf(bf2f((bf16)(ka[t] & 0xffff)) * kd);
                KDT[swz(cc * 8 + 2 * t + 1, i)] = f2bf(bf2f((bf16)(ka[t] >> 16)) * kd);
            }
            *(uint4*)(QG + off) = make_uint4(qo[0], qo[1], qo[2], qo[3]);
            *(float4*)(Ul + i * 64 + cc * 8) = make_float4(bf2f((bf16)(ua[0] & 0xffff)), bf2f((bf16)(ua[0] >> 16)), bf2f((bf16)(ua[1] & 0xffff)), bf2f((bf16)(ua[1] >> 16)));
            *(float4*)(Ul + i * 64 + cc * 8 + 4) = make_float4(bf2f((bf16)(ua[2] & 0xffff)), bf2f((bf16)(ua[2] >> 16)), bf2f((bf16)(ua[3] & 0xffff)), bf2f((bf16)(ua[3] >> 16)));
            if (cc == 0) { gcs[i] = rg_i; if (i == 63) gcs[128 + 63] = qd; }
        }
        if (n + 1 < 64) GDN_LOAD(n + 1)
        __syncthreads();
        GdnCtx c; c.base = NPROMPT + b * 4096; c.T = 4096; c.h = h; c.dir = dir; c.cidx = dir ? 63 - n : n; c.l = l;
        gdn_t12(p, c, smem, kb, Sreg, dir);
    }
#undef GDN_LOAD
    __syncthreads();
}

__device__ __forceinline__ void ph_gdn_finalize(const P& p, int l) {
    const int tid = tidx(), lane = tid & 63;
    bf16* br = (bf16*)(p.ws + WS_BR);
    const bf16* gob = (const bf16*)(p.ws + WS_BIG + B_GOB);
    const bf16* proj = (const bf16*)(p.ws + WS_BIG + B_PROJ);
    for (int it = blockIdx.x * NWV + (tid >> 6); it < 8192 * 4; it += gridDim.x * NWV) {
        const int rs = it >> 2, h = it & 3; const size_t row = (size_t)NPROMPT + rs;
        bf16* b0 = br + row * 1024 + 768 + h * 64 + lane;
        const float a = bf2f(*b0) + bf2f(gob[(size_t)rs * 256 + h * 64 + lane]);
        const float ss = wave_sum(a * a);
        const float rinv = rsqrtf(ss * (1.f / 64.f) + EPS);
        const float z = bf2f(proj[row * PLD + C_DZ + h * 64 + lane]);
        *b0 = f2bf(a * rinv * p.d_g_norm[l * 64 + lane] * siluf_(z));
    }
}

template <int DQK>
__device__ __forceinline__ void attn_mfma_item(const AttnJob& j, int blk, unsigned char* smem_) {
    unsigned char* smem = smem_ + vzero();
    const int tid = tidx(), lane = tid & 63, wv = tid >> 6, grp = wv >> 2, wq = wv & 3, l31 = lane & 31, hh = lane >> 5, gt = tid & 255;
    constexpr int KLD = DQK + 8, NKC = DQK / 8, NKK = DQK / 16;
    constexpr int KBYTES = 64 * KLD * 2, VBYTES = 64 * 68 * 2, BUFB = KBYTES + VBYTES;
    constexpr int NKI = NKC * 64 / 256;
    const int nqb = j.T / 128;
    const int b = blk / (4 * nqb), h = (blk / nqb) % 4, q0 = (blk % nqb) * 128;
    const int kh = h / j.kvgroup;
    int kbeg = 0, kend = j.T;
    if (j.window) { kbeg = q0 - 128 < 0 ? 0 : q0 - 128; kend = q0 + 256 > j.T ? j.T : q0 + 256; }
    const int n1 = (kend - kbeg) >> 6, n2 = j.nk2 >> 6, nt = n1 + n2, nt0 = (nt + 1) >> 1;
    const int tbeg = grp ? nt0 : 0, tcnt = grp ? nt - nt0 : nt0;
    const int tq = q0 + wq * 32 + l31;
    const float sc2 = j.scale * 1.4426950408889634f;
    const bf16* k1p = j.k1 + (size_t)b * j.T * j.ldk1 + kh * j.kstride; const bf16* v1p = j.v1 + (size_t)b * j.T * j.ldv1 + kh * j.vstride;
    const bf16* k2p = j.k2 + (size_t)b * j.nk2 * j.ldk2 + kh * j.kstride; const bf16* v2p = j.v2 + (size_t)b * j.nk2 * j.ldv2 + kh * j.vstride;
    typedef unsigned u32x4 __attribute__((ext_vector_type(4)));
    u32x4 kr0, kr1, kr2, vr0, vr1;
    kr2 = (u32x4){0u, 0u, 0u, 0u};
#define ATT_LOAD(t_) { const int t__ = (t_); const bool s1__ = t__ < n1; const int ks__ = s1__ ? kbeg + t__ * 64 : (t__ - n1) * 64; \
        const bf16* kp__ = s1__ ? k1p : k2p; const bf16* vp__ = s1__ ? v1p : v2p; const int ldk__ = s1__ ? j.ldk1 : j.ldk2, ldv__ = s1__ ? j.ldv1 : j.ldv2; \
        { const int c_ = gt; kr0 = *(const u32x4*)(kp__ + (size_t)(ks__ + c_ / NKC) * ldk__ + (c_ % NKC) * 8); } \
        { const int c_ = gt + 256; kr1 = *(const u32x4*)(kp__ + (size_t)(ks__ + c_ / NKC) * ldk__ + (c_ % NKC) * 8); } \
        if (NKI > 2) { const int c_ = gt + 512; kr2 = *(const u32x4*)(kp__ + (size_t)(ks__ + c_ / NKC) * ldk__ + (c_ % NKC) * 8); } \
        { const int c_ = gt; vr0 = *(const u32x4*)(vp__ + (size_t)(ks__ + (c_ >> 3)) * ldv__ + (c_ & 7) * 8); } \
        { const int c_ = gt + 256; vr1 = *(const u32x4*)(vp__ + (size_t)(ks__ + (c_ >> 3)) * ldv__ + (c_ & 7) * 8); } }
#define ATT_VSCAT(vr_, c_) { const int key_ = (c_) >> 3, e0_ = ((c_) & 7) * 8; \
        VT[(e0_ + 0) * 68 + key_] = (bf16)(vr_[0] & 0xffff); VT[(e0_ + 1) * 68 + key_] = (bf16)(vr_[0] >> 16); VT[(e0_ + 2) * 68 + key_] = (bf16)(vr_[1] & 0xffff); VT[(e0_ + 3) * 68 + key_] = (bf16)(vr_[1] >> 16); \
        VT[(e0_ + 4) * 68 + key_] = (bf16)(vr_[2] & 0xffff); VT[(e0_ + 5) * 68 + key_] = (bf16)(vr_[2] >> 16); VT[(e0_ + 6) * 68 + key_] = (bf16)(vr_[3] & 0xffff); VT[(e0_ + 7) * 68 + key_] = (bf16)(vr_[3] >> 16); }
#define ATT_STORE(buf_) { bf16* Kl = (bf16*)(smem + ((buf_) * 2 + grp) * BUFB); bf16* VT = (bf16*)(smem + ((buf_) * 2 + grp) * BUFB + KBYTES); \
        { const int c_ = gt; *(u32x4*)(Kl + (c_ / NKC) * KLD + (c_ % NKC) * 8) = kr0; } \
        { const int c_ = gt + 256; *(u32x4*)(Kl + (c_ / NKC) * KLD + (c_ % NKC) * 8) = kr1; } \
        if (NKI > 2) { const int c_ = gt + 512; *(u32x4*)(Kl + (c_ / NKC) * KLD + (c_ % NKC) * 8) = kr2; } \
        ATT_VSCAT(vr0, gt) ATT_VSCAT(vr1, gt + 256) }
    bf16x8 qf[NKK];
    int qset = -1;
    f32x16 o0 = zero16(), o1 = zero16();
    float m = -1e30f, lsum = 0.f;
    __syncthreads();
    if (tcnt > 0) { ATT_LOAD(tbeg) ATT_STORE(0) }
    __syncthreads();
#pragma unroll 1
    for (int s = 0; s < nt0; ++s) {
        const bool has = s < tcnt, hasn = s + 1 < tcnt;
        if (hasn) ATT_LOAD(tbeg + s + 1)
        if (has) {
            const int t = tbeg + s; const bool s1 = t < n1; const int ks = s1 ? kbeg + t * 64 : (t - n1) * 64;
            const int set = s1 ? 0 : 1;
            if (set != qset) {
                qset = set;
                const bf16* qp = (set == 0 ? j.q1 + ((size_t)b * j.T + tq) * j.ldq1 : j.q2 + ((size_t)b * j.T + tq) * j.ldq2) + h * DQK;
#pragma unroll
                for (int kk = 0; kk < NKK; ++kk) qf[kk] = *(const bf16x8*)(qp + kk * 16 + hh * 8);
            }
            const bf16* Kl = (const bf16*)(smem + ((s & 1) * 2 + grp) * BUFB); const bf16* VT = (const bf16*)(smem + ((s & 1) * 2 + grp) * BUFB + KBYTES);
            f32x16 s0 = zero16(), s1v = zero16();
#pragma unroll
            for (int kk = 0; kk < NKK; ++kk) {
                const bf16x8 a0 = *(const bf16x8*)(Kl + l31 * KLD + kk * 16 + hh * 8);
                const bf16x8 a1 = *(const bf16x8*)(Kl + (32 + l31) * KLD + kk * 16 + hh * 8);
                s0 = __builtin_amdgcn_mfma_f32_32x32x16_bf16(a0, qf[kk], s0, 0, 0, 0);
                s1v = __builtin_amdgcn_mfma_f32_32x32x16_bf16(a1, qf[kk], s1v, 0, 0, 0);
            }
            const bool win = s1 && j.window;
            float mx = -INFINITY;
#pragma unroll
            for (int r = 0; r < 16; ++r) {
                float a = s0[r] * sc2, c = s1v[r] * sc2;
                if (win) { const int d0 = tq - (ks + (r & 3) + 8 * (r >> 2) + 4 * hh); if (d0 > 128 || d0 < -128) a = -INFINITY; const int d1 = d0 - 32; if (d1 > 128 || d1 < -128) c = -INFINITY; }
                s0[r] = a; s1v[r] = c; mx = fmaxf(mx, fmaxf(a, c));
            }
            mx = fmaxf(mx, __shfl_xor(mx, 32));
            const float mnew = fmaxf(m, mx), alpha = __builtin_amdgcn_exp2f(m - mnew);
            m = mnew;
            float ps = 0.f;
#pragma unroll
            for (int r = 0; r < 16; ++r) { s0[r] = __builtin_amdgcn_exp2f(s0[r] - mnew); s1v[r] = __builtin_amdgcn_exp2f(s1v[r] - mnew); ps += s0[r] + s1v[r]; }
            lsum = lsum * alpha + ps;
#pragma unroll
            for (int r = 0; r < 16; ++r) { o0[r] *= alpha; o1[r] *= alpha; }
#pragma unroll
            for (int k4 = 0; k4 < 4; ++k4) {
                const int sp = (k4 & 1) * 8;
                unsigned pw[4];
#pragma unroll
                for (int q2 = 0; q2 < 4; ++q2) pw[q2] = (k4 < 2) ? pk2(s0[sp + 2 * q2], s0[sp + 2 * q2 + 1]) : pk2(s1v[sp + 2 * q2], s1v[sp + 2 * q2 + 1]);
                const u32x4 pwv = {pw[0], pw[1], pw[2], pw[3]};
                const bf16x8 pf = __builtin_bit_cast(bf16x8, pwv);
                {
                    const uint2 x0 = *(const uint2*)(VT + l31 * 68 + 16 * k4 + 4 * hh), x1 = *(const uint2*)(VT + l31 * 68 + 16 * k4 + 8 + 4 * hh);
                    const u32x4 av = {x0.x, x0.y, x1.x, x1.y};
                    o0 = __builtin_amdgcn_mfma_f32_32x32x16_bf16(__builtin_bit_cast(bf16x8, av), pf, o0, 0, 0, 0);
                }
                {
                    const uint2 x0 = *(const uint2*)(VT + (32 + l31) * 68 + 16 * k4 + 4 * hh), x1 = *(const uint2*)(VT + (32 + l31) * 68 + 16 * k4 + 8 + 4 * hh);
                    const u32x4 av = {x0.x, x0.y, x1.x, x1.y};
                    o1 = __builtin_amdgcn_mfma_f32_32x32x16_bf16(__builtin_bit_cast(bf16x8, av), pf, o1, 0, 0, 0);
                }
            }
        }
        if (hasn) ATT_STORE((s + 1) & 1)
        __syncthreads();
    }
#undef ATT_LOAD
#undef ATT_VSCAT
#undef ATT_STORE
    lsum += __shfl_xor(lsum, 32);
    float* CO = (float*)smem;
    if (grp == 1) {
#pragma unroll
        for (int r = 0; r < 16; ++r) { CO[((wq * 34 + r) * 64 + lane)] = o0[r]; CO[((wq * 34 + 16 + r) * 64 + lane)] = o1[r]; }
        CO[((wq * 34 + 32) * 64 + lane)] = m; CO[((wq * 34 + 33) * 64 + lane)] = lsum;
    }
    __syncthreads();
    if (grp == 0) {
        const float m1 = CO[((wq * 34 + 32) * 64 + lane)], l1 = CO[((wq * 34 + 33) * 64 + lane)];
        float mf = fmaxf(m, m1);
        float sk2 = 0.f;
        if (j.sink) { sk2 = j.sink[h] * 1.4426950408889634f; mf = fmaxf(mf, sk2); }
        const float a0 = __builtin_amdgcn_exp2f(m - mf), a1 = __builtin_amdgcn_exp2f(m1 - mf);
        float lt = lsum * a0 + l1 * a1;
        if (j.sink) lt += __builtin_amdgcn_exp2f(sk2 - mf);
        const float inv = 1.f / lt;
        bf16* op = j.out + ((size_t)b * j.T + tq) * 1024 + j.outcol + h * 64;
#pragma unroll
        for (int rg = 0; rg < 4; ++rg) {
            float v[8];
#pragma unroll
            for (int k = 0; k < 4; ++k) {
                v[k] = (o0[rg * 4 + k] * a0 + CO[((wq * 34 + rg * 4 + k) * 64 + lane)] * a1) * inv;
                v[4 + k] = (o1[rg * 4 + k] * a0 + CO[((wq * 34 + 16 + rg * 4 + k) * 64 + lane)] * a1) * inv;
            }
            *(uint2*)(op + 8 * rg + 4 * hh) = make_uint2(pk2(v[0], v[1]), pk2(v[2], v[3]));
            *(uint2*)(op + 32 + 8 * rg + 4 * hh) = make_uint2(pk2(v[4], v[5]), pk2(v[6], v[7]));
        }
    }
}

struct KArgs { P p; TJobs J[2]; };

__device__ __forceinline__ AttnJob make_job(const P& p, int l, int variant) {
    unsigned char* ws = p.ws; unsigned char* big = ws + WS_BIG;
    bf16* proj = (bf16*)(big + B_PROJ); bf16* BRb = (bf16*)(ws + WS_BR);
    const float bscale = 0.10206207261596575f;
    AttnJob j{};
    if (variant == 0) {
        j.q1 = proj + C_AQ; j.ldq1 = PLD; j.k1 = proj + C_AK; j.ldk1 = PLD; j.v1 = proj + C_AV; j.ldv1 = PLD; j.kstride = 64; j.vstride = 64; j.kvgroup = 2;
        j.nbatch = 32; j.T = 256; j.nk2 = 0; j.window = 0; j.sink = p.a_sink + l * 4; j.scale = 0.125f; j.out = BRb; j.outcol = 0;
    } else if (variant == 1) {
        j.q1 = (bf16*)(big + B_QA1S); j.ldq1 = 256; j.q2 = proj + (size_t)NPROMPT * PLD + C_AQ; j.ldq2 = PLD;
        j.k1 = (bf16*)(big + B_KA1S); j.ldk1 = 128; j.v1 = proj + (size_t)NPROMPT * PLD + C_AV; j.ldv1 = PLD;
        j.k2 = (bf16*)(ws + WS_KAC); j.ldk2 = 128; j.v2 = (bf16*)(ws + WS_VAC); j.ldv2 = 128; j.kstride = 64; j.vstride = 64; j.kvgroup = 2;
        j.nbatch = 2; j.T = 4096; j.nk2 = 256; j.window = 1; j.sink = p.a_sink + l * 4; j.scale = 0.125f; j.out = BRb + (size_t)NPROMPT * 1024; j.outcol = 0;
    } else if (variant == 2) {
        j.q1 = (bf16*)(big + B_QB); j.ldq1 = 384; j.k1 = (bf16*)(big + B_KB); j.ldk1 = 384; j.v1 = (bf16*)(big + B_KV) + 64; j.ldv1 = 512; j.kstride = 96; j.vstride = 128; j.kvgroup = 1;
        j.nbatch = 32; j.T = 256; j.nk2 = 0; j.window = 0; j.sink = nullptr; j.scale = bscale; j.out = BRb; j.outcol = 256;
    } else {
        j.q1 = (bf16*)(big + B_CQ); j.ldq1 = 384; j.q2 = (bf16*)(big + B_QB) + (size_t)NPROMPT * 384; j.ldq2 = 384;
        j.k1 = (bf16*)(big + B_KB) + (size_t)NPROMPT * 384; j.ldk1 = 384; j.v1 = (bf16*)(big + B_KV) + (size_t)NPROMPT * 512 + 64; j.ldv1 = 512;
        j.k2 = (bf16*)(big + B_KB) + (size_t)NTOK * 384; j.ldk2 = 384; j.v2 = (bf16*)(big + B_KV) + (size_t)NTOK * 512 + 64; j.ldv2 = 512; j.kstride = 96; j.vstride = 128; j.kvgroup = 1;
        j.nbatch = 2; j.T = 4096; j.nk2 = 256; j.window = 0; j.sink = nullptr; j.scale = bscale; j.out = BRb + (size_t)NPROMPT * 1024; j.outcol = 256;
    }
    return j;
}

__device__ __forceinline__ void ph_gemm_proj(const P& p, unsigned char* smem) {
    GemmArgs g{(bf16*)(p.ws + WS_H), (bf16*)(p.ws + WS_W + W_A), 1024, 1024, NTOK, 2176, 1024, 0}; EpiStore e{(bf16*)(p.ws + WS_BIG + B_PROJ), PLD, PLD}; gemm_tiles(g, e, smem);
}
__device__ __forceinline__ void ph_gemm_mla(const P& p, unsigned char* smem) {
    unsigned char* big = p.ws + WS_BIG;
    { GemmArgs g{(bf16*)(big + B_CQ), (bf16*)(p.ws + WS_W + W_UQ), 192, 192, NTOK, 384, 192, 0}; EpiStore e{(bf16*)(big + B_QB), 384, 384}; gemm_tiles(g, e, smem); }
    { GemmArgs g{(bf16*)(big + B_CKV), (bf16*)(p.ws + WS_W + W_UKV), 128, 128, NKVROWS, 512, 128, 0}; EpiStore e{(bf16*)(big + B_KV), 512, 512}; gemm_tiles(g, e, smem); }
}
__device__ __forceinline__ void ph_gemm_br(const P& p, unsigned char* smem) {
    bf16* BRb = (bf16*)(p.ws + WS_BR); bf16* prod = (bf16*)(p.ws + WS_BIG + B_PROD);
    for (int m = 0; m < 4; ++m) { GemmArgs g{BRb + m * 256, (bf16*)(p.ws + WS_W + W_BR) + (size_t)m * 1024 * 256, 1024, 256, NTOK, 1024, 256, 0}; EpiStore e{prod + m * 1024, 4096, 1 << 30}; gemm_tiles(g, e, smem); }
}
__device__ __forceinline__ void ph_gemm_gate(const P& p, unsigned char* smem) {
    GemmArgs g{(bf16*)(p.ws + WS_H), (bf16*)(p.ws + WS_W + W_G), 1024, 1024, NTOK, 4096, 1024, 0}; EpiGate e{(bf16*)(p.ws + WS_BIG + B_PROD), 4096}; gemm_tiles(g, e, smem);
}
__device__ __forceinline__ void ph_gemm_wo(const P& p, unsigned char* smem) {
    GemmArgs g{(bf16*)(p.ws + WS_BIG + B_PROD), (bf16*)(p.ws + WS_W + W_O4), 4096, 4096, NTOK, 1024, 4096, 0}; EpiStore e{(bf16*)(p.ws + WS_BR), 1024, 1024}; gemm_tiles(g, e, smem);
}
__device__ __forceinline__ void ph_gemm_up(const P& p, unsigned char* smem) {
    GemmArgs g{(bf16*)(p.ws + WS_H), (bf16*)(p.ws + WS_W + W_UP), 1024, 1024, NTOK, 5632, 1024, 0}; EpiSwiglu e{(bf16*)(p.ws + WS_BIG + B_HID), DFF}; gemm_tiles(g, e, smem);
}
__device__ __forceinline__ void ph_gemm_down(const P& p, unsigned char* smem) {
    GemmArgs g{(bf16*)(p.ws + WS_BIG + B_HID), (bf16*)(p.ws + WS_W + W_DN), DFF, DFF, NTOK, 1024, DFF, 0}; EpiStore e{(bf16*)(p.ws + WS_BR), 1024, 1024}; gemm_tiles(g, e, smem);
}
__device__ __forceinline__ void attn_dispatch(const P& p, int l, int variant, int blk, unsigned char* smem) {
    if (variant == 0) { const AttnJob j = make_job(p, l, 0); attn_mfma_item<64>(j, blk, smem); }
    else if (variant == 1) { const AttnJob j = make_job(p, l, 1); attn_mfma_item<64>(j, blk, smem); }
    else if (variant == 2) { const AttnJob j = make_job(p, l, 2); attn_mfma_item<96>(j, blk, smem); }
    else { const AttnJob j = make_job(p, l, 3); attn_mfma_item<96>(j, blk, smem); }
}
__device__ __forceinline__ void ph_mixers1(const P& p, int l, unsigned char* smem) {
    for (int item = blockIdx.x; item < 1024; item += gridDim.x) gdn_sample_prep_item(p, l, item, smem);
    for (int item = blockIdx.x; item < 768; item += gridDim.x) { const int vi = item >> 8; attn_dispatch(p, l, vi == 0 ? 1 : vi == 1 ? 2 : 0, item & 255, smem); }
    __syncthreads();
    ph_pool(p, l, smem);
}
__device__ __forceinline__ void ph_mixers2(const P& p, int l, unsigned char* smem) {
    const int nb = gridDim.x, bid = blockIdx.x;
    if (bid < 16) { gdn_sample_chain(p, l, bid, smem); return; }
    const int nw = nb - 16, wi = bid - 16;
    for (int item = wi; item < 384; item += nw) {
        if (item < 128) gdn_prompt_item(p, l, item, smem);
        else attn_dispatch(p, l, 3, item - 128, smem);
    }
}

#define GSYNC() grid.sync()
__global__ void __launch_bounds__(NT) mega(KArgs a) {
    extern __shared__ __attribute__((aligned(16))) unsigned char smem[];
    cg::grid_group grid = cg::this_grid();
    { const P p = fence_P(); ph_mod(p, smem); }
    __syncthreads();
    ph_convert(a.J[0], smem);
    GSYNC();
    { const P p = fence_P(); ph_prenorm(p, 0); }
    GSYNC();
#pragma unroll 1
    for (int l = 0; l < 2; ++l) {
        { const P p = fence_P(); ph_gemm_proj(p, smem); }
        GSYNC();
        { const P p = fence_P(); ph_postproj(p, l); }
        GSYNC();
        { const P p = fence_P(); ph_gemm_mla(p, smem); }
        GSYNC();
        { const P p = fence_P(); ph_prep2(p, l); }
        GSYNC();
        { const P p = fence_P(); ph_mixers1(p, l, smem); }
        GSYNC();
        { const P p = fence_P(); ph_mixers2(p, l, smem); }
        GSYNC();
        { const P p = fence_P(); ph_gdn_finalize(p, l); }
        GSYNC();
        { const P p = fence_P(); ph_gemm_br(p, smem); }
        GSYNC();
        { const P p = fence_P(); ph_gemm_gate(p, smem); }
        GSYNC();
        { const P p = fence_P(); ph_gemm_wo(p, smem); }
        GSYNC();
        { const P p = fence_P(); ph_post(p, l, 1); }
        GSYNC();
        { const P p = fence_P(); ph_gemm_up(p, smem); }
        GSYNC();
        { const P p = fence_P(); ph_gemm_down(p, smem); }
        GSYNC();
        { const P p = fence_P(); ph_post(p, l, 2); }
        if (l == 0) { __syncthreads(); ph_convert(a.J[1], smem); GSYNC(); }
    }
}

static void add_job(TJobs& J, const float* src, bf16* dst, int ldw, int K, int Ndst, int ldo, int mode, int arg, int nvalid) {
    TJob& j = J.j[J.n]; j.src = src; j.dst = dst; j.ldw = ldw; j.K = K; j.Ndst = Ndst; j.ldo = ldo; j.mode = mode; j.arg = arg; j.nvalid = nvalid; j.tile0 = J.total;
    J.total += (Ndst / 64) * (K / 64); J.n++;
}

extern "C" void kernel_launch(void* const* d_in, const int* in_sizes, int n_in, void* d_out, int out_size, void* d_ws, size_t ws_size, hipStream_t stream) {
    if (n_in != 32 || ws_size < WS_NEED) { fprintf(stderr, "kernel_launch: unexpected n_in %d or ws_size %zu (need %zu)\n", n_in, ws_size, (size_t)WS_NEED); return; }
    static int grid = 0;
    if (grid == 0) {
        int dev = 0, cus = 0, per_cu = 0;
        (void)hipGetDevice(&dev);
        (void)hipDeviceGetAttribute(&cus, hipDeviceAttributeMultiprocessorCount, dev);
        (void)hipFuncSetAttribute((const void*)mega, hipFuncAttributeMaxDynamicSharedMemorySize, LDS_BYTES);
        (void)hipOccupancyMaxActiveBlocksPerMultiprocessor(&per_cu, (const void*)mega, NT, LDS_BYTES);
        if (per_cu < 1) { fprintf(stderr, "kernel_launch: occupancy query says %d blocks/CU\n", per_cu); per_cu = 1; }
        if (per_cu > 1) per_cu = 1;
        grid = cus * per_cu;
    }
    KArgs a{};
    const float** pf = (const float**)&a.p;
    for (int i = 0; i < 32; ++i) pf[i] = (const float*)d_in[i];
    a.p.out = (float*)d_out; a.p.ws = (unsigned char*)d_ws;
    const P& p = a.p;
    bf16* Wb = (bf16*)(a.p.ws + WS_W);
    for (int l = 0; l < 2; ++l) {
        TJobs& J = a.J[l];
        add_job(J, p.w_in + (size_t)l * 1024 * PIN, (bf16*)((char*)Wb + W_A), PIN, 1024, 2176, 1024, 0, 0, 2160);
        add_job(J, p.w_in + (size_t)l * 1024 * PIN, (bf16*)((char*)Wb + W_G), PIN, 1024, 4096, 1024, 0, C_GATE, 4096);
        for (int m = 0; m < 4; ++m) add_job(J, p.w_br + ((size_t)l * 4 + m) * 256 * 1024, (bf16*)((char*)Wb + W_BR) + (size_t)m * 1024 * 256, 1024, 256, 1024, 256, 0, 0, 1024);
        for (int m = 0; m < 4; ++m) add_job(J, p.w_o + (size_t)l * 1024 * 1024, (bf16*)((char*)Wb + W_O4) + m * 1024, 1024, 1024, 1024, 4096, 0, 0, 1024);
        add_job(J, p.w_up + (size_t)l * 1024 * 5632, (bf16*)((char*)Wb + W_UP), 5632, 1024, 5632, 1024, 1, 0, 5632);
        add_job(J, p.w_down + (size_t)l * DFF * 1024, (bf16*)((char*)Wb + W_DN), 1024, DFF, 1024, DFF, 0, 0, 1024);
        add_job(J, p.b_w_uq + (size_t)l * 192 * 384, (bf16*)((char*)Wb + W_UQ), 384, 192, 384, 192, 0, 0, 384);
        add_job(J, p.b_w_ukv + (size_t)l * 128 * 512, (bf16*)((char*)Wb + W_UKV), 512, 128, 512, 128, 0, 0, 512);
    }
    void* args[] = {&a};
    hipError_t e = hipLaunchCooperativeKernel((const void*)mega, dim3(grid), dim3(NT), args, LDS_BYTES, stream);
    if (e != hipSuccess) fprintf(stderr, "cooperative launch failed: %s (grid %d)\n", hipGetErrorString(e), grid);
}
```

```cpp
#include <hip/hip_runtime.h>
#include <hip/hip_cooperative_groups.h>
namespace cg = cooperative_groups;
#define NT 512
#define NWV 8
#define LDS_BYTES 147456
#include <stdint.h>
#include <stdio.h>

typedef unsigned short bf16;
typedef short bf16x8 __attribute__((ext_vector_type(8)));
typedef float f32x16 __attribute__((ext_vector_type(16)));

#define DM 1024
#define NTOK 16384
#define NPROMPT 8192
#define PLD 2176
#define C_AQ 0
#define C_AK 256
#define C_AV 384
#define C_BCQ 512
#define C_BCKV 704
#define C_BKR 832
#define C_CIN 864
#define C_DQKV 1120
#define C_DZ 1888
#define C_DBETA 2144
#define C_DALPHA 2152
#define C_GATE 2160
#define PIN 6256
#define DFF 2816
#define EPS 1e-6f
#define NKVROWS 16896

#define O_Y 0
#define O_CAK 16777216
#define O_CAV 18874368
#define O_CKV 20971520
#define O_KR 23068672
#define O_SF 23592960
#define O_SB 24641536

#define MB(x) ((size_t)(x) * 1024 * 1024)
#define WS_MOD 0
#define WS_TAB (WS_MOD + 147456)
#define WS_KAC (WS_TAB + 12288)
#define WS_VAC (WS_KAC + 512 * 128 * 2)
#define WS_GGC (WS_VAC + 512 * 128 * 2)
#define WS_W (MB(1))
#define W_A 0
#define W_G (W_A + 2304 * 1024 * 2)
#define W_BR (W_G + 4096 * 1024 * 2)
#define W_O (W_BR + 4 * 1024 * 256 * 2)
#define W_UP (W_O + 1024 * 1024 * 2)
#define W_DN (W_UP + 5632 * 1024 * 2)
#define W_UQ (W_DN + 1024 * 2816 * 2)
#define W_UKV (W_UQ + 384 * 192 * 2)
#define W_END (W_UKV + 512 * 128 * 2)
#define WS_H (MB(42))
#define WS_BR (MB(74))
#define WS_BIG (MB(106))
#define B_PROJ 0
#define B_CQ (B_PROJ + (size_t)16384 * 2176 * 2)
#define B_CKV (B_CQ + (size_t)16384 * 192 * 2)
#define B_QB (B_CKV + (size_t)16896 * 128 * 2)
#define B_KV (B_QB + (size_t)16384 * 384 * 2)
#define B_QA1S (B_KV + (size_t)16896 * 512 * 2)
#define B_KA1S (B_QA1S + (size_t)8192 * 256 * 2)
#define B_KB (B_KA1S + (size_t)8192 * 128 * 2)
#define B_GQK (B_KB + (size_t)16896 * 384 * 2)
#define B_GUW (B_GQK + (size_t)8192 * 512 * 2)
#define B_END_A (B_GUW + (size_t)1024 * 8192 * 2)
#define B_GOB B_CKV
#define B_BRB 0
#define B_HID 0
#define WS_NEED (WS_BIG + B_END_A)

struct P {
    const float *x_prompt, *x_sample, *cache_a_k, *cache_a_v, *cache_b_ckv, *cache_b_krope, *state_f, *state_b, *c, *c_ctx;
    const float *w_mod, *b_mod, *g_pre1, *g_post1, *g_pre2, *g_post2, *w_in, *a_sink, *b_g_cq, *b_g_ckv, *b_w_uq, *b_w_ukv;
    const float *c_w_pool, *c_scale, *d_conv, *d_a_log, *d_dt_bias, *d_g_norm, *w_br, *w_o, *w_up, *w_down;
    float* out;
    unsigned char* ws;
};


typedef const __attribute__((address_space(4))) unsigned char* kargp_t;
__device__ __forceinline__ P fence_P() {
    kargp_t kp = (kargp_t)__builtin_amdgcn_kernarg_segment_ptr();
    asm volatile("" : "+s"(kp));
    const __attribute__((address_space(4))) P* pp = (const __attribute__((address_space(4))) P*)kp;
    P q;
    q.x_prompt = pp->x_prompt;
    q.x_sample = pp->x_sample;
    q.cache_a_k = pp->cache_a_k;
    q.cache_a_v = pp->cache_a_v;
    q.cache_b_ckv = pp->cache_b_ckv;
    q.cache_b_krope = pp->cache_b_krope;
    q.state_f = pp->state_f;
    q.state_b = pp->state_b;
    q.c = pp->c;
    q.c_ctx = pp->c_ctx;
    q.w_mod = pp->w_mod;
    q.b_mod = pp->b_mod;
    q.g_pre1 = pp->g_pre1;
    q.g_post1 = pp->g_post1;
    q.g_pre2 = pp->g_pre2;
    q.g_post2 = pp->g_post2;
    q.w_in = pp->w_in;
    q.a_sink = pp->a_sink;
    q.b_g_cq = pp->b_g_cq;
    q.b_g_ckv = pp->b_g_ckv;
    q.b_w_uq = pp->b_w_uq;
    q.b_w_ukv = pp->b_w_ukv;
    q.c_w_pool = pp->c_w_pool;
    q.c_scale = pp->c_scale;
    q.d_conv = pp->d_conv;
    q.d_a_log = pp->d_a_log;
    q.d_dt_bias = pp->d_dt_bias;
    q.d_g_norm = pp->d_g_norm;
    q.w_br = pp->w_br;
    q.w_o = pp->w_o;
    q.w_up = pp->w_up;
    q.w_down = pp->w_down;
    q.out = pp->out;
    q.ws = pp->ws;
    return q;
}

__device__ __forceinline__ bf16 f2bf(float f) {
    unsigned u = __float_as_uint(f);
    u += 0x7fffu + ((u >> 16) & 1u);
    return (bf16)(u >> 16);
}
__device__ __forceinline__ float bf2f(bf16 h) { return __uint_as_float(((unsigned)h) << 16); }
__device__ __forceinline__ float wave_sum(float v) {
#pragma unroll
    for (int o = 32; o > 0; o >>= 1) v += __shfl_xor(v, o);
    return v;
}

__device__ __forceinline__ unsigned vzero() { unsigned z = 0; asm volatile("" : "+v"(z)); return z; }
__device__ __forceinline__ int tidx() { int t = threadIdx.x; asm volatile("" : "+v"(t)); return t; }
__device__ __forceinline__ float sigmoidf_(float x) { return 1.f / (1.f + __expf(-x)); }
__device__ __forceinline__ float siluf_(float x) { return x / (1.f + __expf(-x)); }

struct TJob { const float* src; bf16* dst; int ldw, K, Ndst, ldo, mode, arg, nvalid, tile0; };
struct TJobs { TJob j[16]; int n, total; };

__device__ __forceinline__ void ph_convert(const TJobs& J, unsigned char* smem) {
    float (*tile)[65] = (float (*)[65])smem;
    const int tid = tidx();
    for (int t = blockIdx.x; t < J.total; t += gridDim.x) {
        int ji = 0;
        for (int q = 1; q < J.n; ++q) if (t >= J.j[q].tile0) ji = q;
        const TJob jb = J.j[ji];
        const int local = t - jb.tile0, nkt = jb.K / 64, tn = local / nkt, tk = local % nkt;
        const int tx = tid & 63, ty = tid >> 6;
        const int n = tn * 64 + tx;
        int sc;
        if (jb.mode == 0) sc = (n < jb.nvalid) ? n + jb.arg : -1;
        else { const int pn = n >> 8, cc = n & 255, bj = cc >> 7, wc = (cc >> 5) & 3, nn = (cc >> 4) & 1, fq = (cc >> 2) & 3, ii = cc & 3;
            if (jb.mode == 1) sc = nn * DFF + pn * 128 + bj * 64 + wc * 16 + fq * 4 + ii;
            else sc = jb.arg + (2 * bj + nn) * 1024 + pn * 64 + wc * 16 + fq * 4 + ii; }
        for (int kk = ty; kk < 64; kk += NWV) tile[kk][tx] = (sc >= 0) ? jb.src[(size_t)(tk * 64 + kk) * jb.ldw + sc] : 0.f;
        __syncthreads();
        {
            const int q = tid, r = q >> 3, c8 = q & 7;
            unsigned w[4];
            for (int j = 0; j < 4; ++j) w[j] = (unsigned)f2bf(tile[c8 * 8 + 2 * j][r]) | ((unsigned)f2bf(tile[c8 * 8 + 2 * j + 1][r]) << 16);
            *(uint4*)(jb.dst + (size_t)(tn * 64 + r) * jb.ldo + tk * 64 + c8 * 8) = make_uint4(w[0], w[1], w[2], w[3]);
        }
        __syncthreads();
    }
}

__device__ __forceinline__ void ph_mod(const P& p, unsigned char* smem) {
    float (*cs)[1024] = (float (*)[1024])smem;
    float (*red)[3][64] = (float (*)[3][64])(smem + 3 * 1024 * 4);
    const int tid = tidx();
    float* mod = (float*)(p.ws + WS_MOD);
    for (int i = tid; i < 3072; i += NT) { const int r = i >> 10, k = i & 1023; const float v = (r == 0) ? p.c_ctx[k] : p.c[(r - 1) * 1024 + k]; cs[r][k] = siluf_(v); }
    __syncthreads();
    for (int it = blockIdx.x; it < 192; it += gridDim.x) {
        const int l = it / 96, cg = it % 96, col = cg * 64 + (tid & 63), kq = tid >> 6;
        float a0 = 0.f, a1 = 0.f, a2 = 0.f;
        const float* w = p.w_mod + ((size_t)l * 1024 + kq * 128) * 6144 + col;
        for (int k = 0; k < 128; ++k) { const float wv = w[(size_t)k * 6144]; a0 += cs[0][kq * 128 + k] * wv; a1 += cs[1][kq * 128 + k] * wv; a2 += cs[2][kq * 128 + k] * wv; }
        red[kq][0][tid & 63] = a0; red[kq][1][tid & 63] = a1; red[kq][2][tid & 63] = a2;
        __syncthreads();
        if (tid < 192) { const int r = tid >> 6, cc = tid & 63; const float s = red[0][r][cc] + red[1][r][cc] + red[2][r][cc] + red[3][r][cc] + red[4][r][cc] + red[5][r][cc] + red[6][r][cc] + red[7][r][cc] + p.b_mod[l * 6144 + cg * 64 + cc]; mod[(l * 3 + r) * 6144 + cg * 64 + cc] = s; }
        __syncthreads();
    }
    if (blockIdx.x == 0) {
        float* tab = (float*)(p.ws + WS_TAB);
        for (int i = tid; i < 64 * 16; i += NT) { const int pos = i >> 4, f = i & 15; const float inv = powf(10000.f, -(float)f / 16.f); float s, c; sincosf((float)pos * inv, &s, &c); tab[i] = c; tab[1024 + i] = s; }
        for (int i = tid; i < 64 * 8; i += NT) { const int pos = i >> 3, f = i & 7; const float inv = powf(10000.f, -(float)f / 8.f); float s, c; sincosf((float)pos * inv, &s, &c); tab[2048 + i] = c; tab[2560 + i] = s; }
    }
}

__device__ __forceinline__ const float* xrow_in(const P& p, int row) { return row < NPROMPT ? p.x_prompt + (size_t)row * DM : p.x_sample + (size_t)(row - NPROMPT) * DM; }
__device__ __forceinline__ int cond_row(int row) { return row < NPROMPT ? 0 : 1 + ((row - NPROMPT) >> 12); }

__device__ __forceinline__ void ph_prenorm(const P& p, int l) {
    const int lane = tidx() & 63;
    const float* mod = (const float*)(p.ws + WS_MOD);
    bf16* H = (bf16*)(p.ws + WS_H);
    for (int row = blockIdx.x * NWV + (tidx() >> 6); row < NTOK; row += gridDim.x * NWV) {
        const float* xr = (l == 0) ? xrow_in(p, row) : p.out + (size_t)row * DM;
        float4 v[4]; float ss = 0.f;
        for (int i = 0; i < 4; ++i) { v[i] = *(const float4*)(xr + i * 256 + lane * 4); ss += v[i].x * v[i].x + v[i].y * v[i].y + v[i].z * v[i].z + v[i].w * v[i].w; }
        ss = wave_sum(ss);
        const float rinv = rsqrtf(ss * (1.f / 1024.f) + EPS);
        const float* md = mod + (l * 3 + cond_row(row)) * 6144;
        for (int i = 0; i < 4; ++i) {
            const int col = i * 256 + lane * 4;
            const float4 g = *(const float4*)(p.g_pre1 + l * 1024 + col), sc = *(const float4*)(md + 1024 + col), sh = *(const float4*)(md + col);
            const float h0 = v[i].x * rinv * g.x * (1.f + sc.x) + sh.x, h1 = v[i].y * rinv * g.y * (1.f + sc.y) + sh.y;
            const float h2 = v[i].z * rinv * g.z * (1.f + sc.z) + sh.z, h3 = v[i].w * rinv * g.w * (1.f + sc.w) + sh.w;
            *(uint2*)(H + (size_t)row * DM + col) = make_uint2((unsigned)f2bf(h0) | ((unsigned)f2bf(h1) << 16), (unsigned)f2bf(h2) | ((unsigned)f2bf(h3) << 16));
        }
    }
}

__device__ __forceinline__ void ph_post(const P& p, int l, int which) {
    const int lane = tidx() & 63;
    const float* mod = (const float*)(p.ws + WS_MOD);
    bf16* H = (bf16*)(p.ws + WS_H);
    const bf16* src = (const bf16*)(p.ws + (which == 1 ? WS_H : WS_BR));
    const float* gpost = (which == 1 ? p.g_post1 : p.g_post2) + l * 1024;
    const int ga_off = which == 1 ? 2048 : 5120;
    const bool donext = (which == 1) || (l == 0);
    const int ln = which == 1 ? l : l + 1;
    const float* gpre = (which == 1 ? p.g_pre2 : p.g_pre1) + ln * 1024;
    const int sc_off = which == 1 ? 4096 : 1024, sh_off = which == 1 ? 3072 : 0;
    for (int row = blockIdx.x * NWV + (tidx() >> 6); row < NTOK; row += gridDim.x * NWV) {
        const float* xr = (l == 0 && which == 1) ? xrow_in(p, row) : p.out + (size_t)row * DM;
        const int cr = cond_row(row);
        const float* md = mod + (l * 3 + cr) * 6144;
        float4 x[4], s[4]; float ss = 0.f;
        for (int i = 0; i < 4; ++i) {
            const int col = i * 256 + lane * 4;
            x[i] = *(const float4*)(xr + col);
            const uint2 raw = *(const uint2*)(src + (size_t)row * DM + col);
            s[i] = make_float4(bf2f((bf16)(raw.x & 0xffff)), bf2f((bf16)(raw.x >> 16)), bf2f((bf16)(raw.y & 0xffff)), bf2f((bf16)(raw.y >> 16)));
            ss += s[i].x * s[i].x + s[i].y * s[i].y + s[i].z * s[i].z + s[i].w * s[i].w;
        }
        ss = wave_sum(ss);
        const float rinv = rsqrtf(ss * (1.f / 1024.f) + EPS);
        float ss2 = 0.f;
        for (int i = 0; i < 4; ++i) {
            const int col = i * 256 + lane * 4;
            const float4 g = *(const float4*)(gpost + col), ga = *(const float4*)(md + ga_off + col);
            x[i].x += ga.x * s[i].x * rinv * g.x; x[i].y += ga.y * s[i].y * rinv * g.y; x[i].z += ga.z * s[i].z * rinv * g.z; x[i].w += ga.w * s[i].w * rinv * g.w;
            *(float4*)(p.out + (size_t)row * DM + col) = x[i];
            ss2 += x[i].x * x[i].x + x[i].y * x[i].y + x[i].z * x[i].z + x[i].w * x[i].w;
        }
        if (donext) {
            ss2 = wave_sum(ss2);
            const float rinv2 = rsqrtf(ss2 * (1.f / 1024.f) + EPS);
            const float* md2 = mod + (ln * 3 + cr) * 6144;
            for (int i = 0; i < 4; ++i) {
                const int col = i * 256 + lane * 4;
                const float4 g = *(const float4*)(gpre + col), sc = *(const float4*)(md2 + sc_off + col), sh = *(const float4*)(md2 + sh_off + col);
                const float h0 = x[i].x * rinv2 * g.x * (1.f + sc.x) + sh.x, h1 = x[i].y * rinv2 * g.y * (1.f + sc.y) + sh.y;
                const float h2 = x[i].z * rinv2 * g.z * (1.f + sc.z) + sh.z, h3 = x[i].w * rinv2 * g.w * (1.f + sc.w) + sh.w;
                *(uint2*)(H + (size_t)row * DM + col) = make_uint2((unsigned)f2bf(h0) | ((unsigned)f2bf(h1) << 16), (unsigned)f2bf(h2) | ((unsigned)f2bf(h3) << 16));
            }
        }
    }
}

struct GemmArgs { const bf16* A; const bf16* Bt; int lda, ldb, M, N, K, pad; };

struct EpiStore {
    bf16* C; int ldc, nvalid;
    __device__ __forceinline__ void operator()(const f32x16 (&acc)[2][2], int rowbase, int colbase, int tn, int wn, int lane) const {
        _Pragma("unroll") for (int mi = 0; mi < 2; ++mi) _Pragma("unroll") for (int nj = 0; nj < 2; ++nj) {
            const int col = colbase + nj * 32 + (lane & 31);
            if (col < nvalid) _Pragma("unroll") for (int r = 0; r < 16; ++r) { const int row = rowbase + mi * 32 + (r & 3) + 8 * (r >> 2) + 4 * (lane >> 5); C[(size_t)row * ldc + col] = f2bf(acc[mi][nj][r]); }
        }
    }
};
struct EpiGate {
    bf16* C; int ldc;
    __device__ __forceinline__ void operator()(const f32x16 (&acc)[2][2], int rowbase, int colbase, int tn, int wn, int lane) const {
        _Pragma("unroll") for (int mi = 0; mi < 2; ++mi) _Pragma("unroll") for (int nj = 0; nj < 2; ++nj) {
            const int col = colbase + nj * 32 + (lane & 31);
            _Pragma("unroll") for (int r = 0; r < 16; ++r) { const int row = rowbase + mi * 32 + (r & 3) + 8 * (r >> 2) + 4 * (lane >> 5); bf16* q = C + (size_t)row * ldc + col; *q = f2bf(sigmoidf_(acc[mi][nj][r]) * bf2f(*q)); }
        }
    }
};
struct EpiSwiglu {
    bf16* C; int ldc;
    __device__ __forceinline__ void operator()(const f32x16 (&acc)[2][2], int rowbase, int colbase, int tn, int wn, int lane) const {
        const int col = tn * 64 + wn * 32 + (lane & 31);
        _Pragma("unroll") for (int mi = 0; mi < 2; ++mi) _Pragma("unroll") for (int r = 0; r < 16; ++r) {
            const int row = rowbase + mi * 32 + (r & 3) + 8 * (r >> 2) + 4 * (lane >> 5);
            C[(size_t)row * ldc + col] = f2bf(siluf_(acc[mi][0][r]) * acc[mi][1][r]);
        }
    }
};

template <class Epi>
__device__ __forceinline__ void gemm_tiles(const GemmArgs g, const Epi epi, unsigned char* smem) {
    const int vb = tidx() >> 8, tid = tidx() & 255, lane = tid & 63, w = tid >> 6, wm = w >> 1, wn = w & 1;
    bf16* As = (bf16*)(smem + vb * 65536);
    bf16* Bs = As + 2 * 128 * 64;
    const int nM = g.M / 128, nN = g.N / 128, nK = g.K / 64, ntiles = nM * nN;
    const int nvb = gridDim.x * 2, iters = (ntiles + nvb - 1) / nvb;
    for (int it = 0; it < iters; ++it) {
        const int t0 = it * nvb + blockIdx.x * 2 + vb;
        const bool valid = t0 < ntiles;
        const int t = valid ? t0 : 0;
        const int grp = t / (16 * nN), first = grp * 16, gsz = (nM - first) < 16 ? (nM - first) : 16, r0 = t - grp * 16 * nN;
        const int tm = first + r0 % gsz, tn = r0 / gsz;
        const bf16* Ag = g.A + (size_t)(tm * 128) * g.lda;
        const bf16* Bg = g.Bt + (size_t)(tn * 128) * g.ldb;
        typedef unsigned u32x4 __attribute__((ext_vector_type(4)));
        u32x4 ra0, ra1, ra2, ra3, rb0, rb1, rb2, rb3;
        f32x16 acc[2][2];
        _Pragma("unroll") for (int mi = 0; mi < 2; ++mi) _Pragma("unroll") for (int nj = 0; nj < 2; ++nj) _Pragma("unroll") for (int r = 0; r < 16; ++r) acc[mi][nj][r] = 0.f;
        const int lrow = tid >> 3, lch = tid & 7;
        const bf16* Ap = Ag + (size_t)lrow * g.lda + lch * 8;
        const bf16* Bp = Bg + (size_t)lrow * g.ldb + lch * 8;
        const size_t a32 = (size_t)32 * g.lda, b32 = (size_t)32 * g.ldb;
#define GLOAD(k0) { ra0 = *(const u32x4*)(Ap + (k0)); ra1 = *(const u32x4*)(Ap + a32 + (k0)); ra2 = *(const u32x4*)(Ap + 2 * a32 + (k0)); ra3 = *(const u32x4*)(Ap + 3 * a32 + (k0)); \
                    rb0 = *(const u32x4*)(Bp + (k0)); rb1 = *(const u32x4*)(Bp + b32 + (k0)); rb2 = *(const u32x4*)(Bp + 2 * b32 + (k0)); rb3 = *(const u32x4*)(Bp + 3 * b32 + (k0)); }
        GLOAD(0)
        const int soff = lrow * 64 + ((lch ^ (lrow & 7)) << 3);
        for (int kt = 0; kt < nK; ++kt) {
            bf16* Ab = As + (kt & 1) * 8192; bf16* Bb = Bs + (kt & 1) * 8192;
            *(u32x4*)(Ab + soff) = ra0; *(u32x4*)(Ab + soff + 2048) = ra1; *(u32x4*)(Ab + soff + 4096) = ra2; *(u32x4*)(Ab + soff + 6144) = ra3;
            *(u32x4*)(Bb + soff) = rb0; *(u32x4*)(Bb + soff + 2048) = rb1; *(u32x4*)(Bb + soff + 4096) = rb2; *(u32x4*)(Bb + soff + 6144) = rb3;
            __syncthreads();
            if (kt + 1 < nK) GLOAD((kt + 1) * 64)
#pragma unroll
            for (int kk = 0; kk < 4; ++kk) {
                bf16x8 a[2], b[2];
                const int ch = kk * 2 + (lane >> 5);
#pragma unroll
                for (int mi = 0; mi < 2; ++mi) { const int row = wm * 64 + mi * 32 + (lane & 31); a[mi] = *(const bf16x8*)(Ab + row * 64 + ((ch ^ (row & 7)) << 3)); }
#pragma unroll
                for (int nj = 0; nj < 2; ++nj) { const int row = wn * 64 + nj * 32 + (lane & 31); b[nj] = *(const bf16x8*)(Bb + row * 64 + ((ch ^ (row & 7)) << 3)); }
#pragma unroll
                for (int mi = 0; mi < 2; ++mi)
#pragma unroll
                    for (int nj = 0; nj < 2; ++nj) acc[mi][nj] = __builtin_amdgcn_mfma_f32_32x32x16_bf16(a[mi], b[nj], acc[mi][nj], 0, 0, 0);
            }
        }
        if (valid) epi(acc, tm * 128 + wm * 64, tn * 128 + wn * 64, tn, wn, lane);
        __syncthreads();
    }
}

namespace pg8 {
#define PG8_LAS __attribute__((address_space(3)))
typedef unsigned short bf16_t;
typedef short bf16x8 __attribute__((ext_vector_type(8)));
typedef float f32x4 __attribute__((ext_vector_type(4)));
typedef unsigned u32x4 __attribute__((ext_vector_type(4)));
constexpr int BM = 256, BK = 64, HALF = 128, HTB = HALF * BK * 2  , STAGE_BYTES = 8 * HTB, NXCD = 8, WGM = 8;

__host__ __device__ __forceinline__ int lds_byte(int r, int c) { const int st = (r >> 4) * 2 + (c >> 5), rr = r & 15, cc = c & 31, ob = rr * 64 + cc * 2; return st * 1024 + (ob ^ (((ob >> 9) & 1) << 5)); }
__host__ __device__ __forceinline__ void stage_rc(int b, int& R, int& C) { const int st = b / 1024, sb = b % 1024, swz = sb ^ (((sb >> 9) & 1) << 5); R = (st >> 1) * 16 + swz / 64; C = (st & 1) * 32 + (swz % 64) / 2; }
__host__ __device__ __forceinline__ int perm32(int rho) { const int n = rho >> 4, i = rho & 15; return 8 * (i >> 2) + 4 * n + (i & 3); }

struct Unit { int pm, pn; };
struct Gemm { const bf16_t* A; const bf16_t* Bt; int M, N, K, lda, ldb; };

struct StaticOrder {
    int nM, nN, nwg, G, c;
    __host__ __device__ void init(int M, int N, int G_, int c_) { nM = M / BM; nN = N / BM; nwg = nM * nN; G = G_; c = c_; }
    __host__ __device__ bool next(int i, Unit& u) const {
        const long L = (long)i * G + c; if (L >= nwg) return false;
        int wgid = (int)L; { const int q = nwg / NXCD, r = nwg % NXCD, xcd = wgid % NXCD, off = wgid / NXCD; wgid = (xcd < r ? xcd * (q + 1) : r * (q + 1) + (xcd - r) * q) + off; }
        const int nig = WGM * nN, gid = wgid / nig, fm = gid * WGM, gsz = (nM - fm) < WGM ? (nM - fm) : WGM;
        u.pm = fm + ((wgid % nig) % gsz); u.pn = (wgid % nig) / gsz; return true;
    }
    __device__ __forceinline__ void a_ready(const Unit&) const {}
    __device__ __forceinline__ void done(const Unit&) const {}
};

__device__ __forceinline__ unsigned cvt_pk_bf16(float lo, float hi) { unsigned r; asm volatile("v_cvt_pk_bf16_f32 %0, %1, %2" : "=v"(r) : "v"(lo), "v"(hi)); return r; }
template <class Epi, class Sched, bool ALIGN_EPI = false, bool SP2 = false>
__device__ __forceinline__ void gemm_phase(PG8_LAS unsigned char* lds, const Gemm g, const Sched& S, const Epi& E) {
    const int tid = tidx(), wid = __builtin_amdgcn_readfirstlane(tid >> 6), lane = tid & 63, wr = wid >> 2, wc = wid & 3, fr = lane & 15, fq = lane >> 4;
    const int K = g.K, nt = K / BK;
    unsigned voffA[2], voffB[2];
#pragma unroll
    for (int i = 0; i < 2; ++i) { int R, C; stage_rc(tid * 16 + i * 8192, R, C); const int Rb = Epi::PERM ? ((R & ~31) + perm32(R & 31)) : R;
        voffA[i] = (unsigned)(R * g.lda + C) * 2u; voffB[i] = (unsigned)(Rb * g.ldb + C) * 2u; }
    const size_t kstep = (size_t)(BK * 2);
    const size_t hstepA = (size_t)HALF * g.lda * 2, hstepB = (size_t)HALF * g.ldb * 2;
    const size_t tstepA = 2 * hstepA, tstepB = 2 * hstepB;
    const unsigned ldsw = (unsigned)wid * 1024u;
    const int aoff = lds_byte(wr * 64 + fr, fq * 8), boff = lds_byte(wc * 32 + fr, fq * 8);
#define PG8_SA(b, h) (((b) * 2 + (h)) * HTB)
#define PG8_SB(b, h) ((4 + (b) * 2 + (h)) * HTB)
#define PG8_STAGE(bufoff, gbase, voff) do { _Pragma("unroll") for (int _i = 0; _i < 2; ++_i) \
        __builtin_amdgcn_global_load_lds((const unsigned*)((const char*)(gbase) + (voff)[_i]), (PG8_LAS unsigned*)(lds + (bufoff) + ldsw + _i * 8192), 16, 0, 0); } while (0)
#define PG8_LDA(dst, b, h) do { _Pragma("unroll") for (int m = 0; m < 4; ++m) _Pragma("unroll") for (int k = 0; k < 2; ++k) dst[m][k] = *(const PG8_LAS bf16x8*)(lds + PG8_SA(b, h) + aoff + m * 2048 + k * 1024); } while (0)
#define PG8_LDB(dst, b, h) do { _Pragma("unroll") for (int n = 0; n < 2; ++n) _Pragma("unroll") for (int k = 0; k < 2; ++k) dst[n][k] = *(const PG8_LAS bf16x8*)(lds + PG8_SB(b, h) + boff + n * 2048 + k * 1024); } while (0)
#define PG8_MMA(ai, bj, At, Bt) do { __builtin_amdgcn_s_setprio(1); _Pragma("unroll") for (int m = 0; m < 4; ++m) _Pragma("unroll") for (int n = 0; n < 2; ++n) _Pragma("unroll") for (int k = 0; k < 2; ++k) \
        acc[ai][bj][m][n] = __builtin_amdgcn_mfma_f32_16x16x32_bf16(Bt[n][k], At[m][k], acc[ai][bj][m][n], 0, 0, 0); __builtin_amdgcn_s_setprio(0); } while (0)
#define PG8_WAIT_V(n) asm volatile("s_waitcnt vmcnt(" #n ")" ::: "memory")
#define PG8_WAIT_L(n) asm volatile("s_waitcnt lgkmcnt(" #n ")" ::: "memory")
#define PG8_BAR __builtin_amdgcn_s_barrier()
#define PG8_SCHED __builtin_amdgcn_sched_barrier(0)
    Unit cur, nxt; int ui = 0;
    if (!S.next(0, cur)) return;
    f32x4 acc[2][2][4][2];
#pragma unroll
    for (int a = 0; a < 2; ++a)
#pragma unroll
        for (int b = 0; b < 2; ++b)
#pragma unroll
            for (int m = 0; m < 4; ++m)
#pragma unroll
                for (int n = 0; n < 2; ++n) acc[a][b][m][n] = (f32x4){0.f, 0.f, 0.f, 0.f};
    bf16x8 At[4][2], B0[2][2], B1[2][2];
    const char* cA = (const char*)g.A + (size_t)cur.pm * tstepA; const char* cB = (const char*)g.Bt + (size_t)cur.pn * tstepB;
    S.a_ready(cur);
    if constexpr (SP2) {
        PG8_STAGE(PG8_SB(0, 0), cB, voffB); PG8_STAGE(PG8_SB(0, 1), cB + hstepB, voffB); PG8_STAGE(PG8_SA(0, 0), cA, voffA); PG8_STAGE(PG8_SA(0, 1), cA + hstepA, voffA);
        if (wr == 1) PG8_BAR;
        PG8_WAIT_V(2); PG8_BAR;
        PG8_STAGE(PG8_SB(1, 0), cB + kstep, voffB); PG8_STAGE(PG8_SA(1, 0), cA + kstep, voffA); PG8_STAGE(PG8_SB(1, 1), cB + hstepB + kstep, voffB);
        PG8_WAIT_V(6); PG8_BAR;
    } else {
        PG8_STAGE(PG8_SB(0, 0), cB, voffB); PG8_STAGE(PG8_SA(0, 0), cA, voffA); PG8_STAGE(PG8_SB(0, 1), cB + hstepB, voffB); PG8_STAGE(PG8_SA(0, 1), cA + hstepA, voffA);
        if (wr == 1) PG8_BAR;
        PG8_WAIT_V(4); PG8_BAR;
        PG8_STAGE(PG8_SB(1, 0), cB + kstep, voffB); PG8_STAGE(PG8_SA(1, 0), cA + kstep, voffA); PG8_STAGE(PG8_SB(1, 1), cB + hstepB + kstep, voffB);
        PG8_WAIT_V(6); PG8_BAR;
    }
    for (;;) {
        const bool has_next = S.next(ui + 1, nxt);
        const char* nA = has_next ? (const char*)g.A + (size_t)nxt.pm * tstepA : cA; const char* nB = has_next ? (const char*)g.Bt + (size_t)nxt.pn * tstepB : cB;
        for (int t = 0; t < nt; t += 2) {
            const bool last = (t == nt - 2);
            const char* a1 = cA + (size_t)(t + 1) * kstep;
            const char* a2 = last ? nA : cA + (size_t)(t + 2) * kstep; const char* b2 = last ? nB : cB + (size_t)(t + 2) * kstep;
            const char* a3 = a2 + kstep; const char* b3 = b2 + kstep;
            if (last && has_next) S.a_ready(nxt);
            if constexpr (SP2) {
            PG8_LDB(B0, 0, 0); PG8_LDB(B1, 0, 1); PG8_SCHED; PG8_LDA(At, 0, 0); PG8_STAGE(PG8_SA(1, 1), a1 + hstepA, voffA);
            PG8_WAIT_V(8); PG8_WAIT_L(0); PG8_BAR; PG8_MMA(0, 0, At, B0); PG8_MMA(0, 1, At, B1); PG8_BAR; PG8_SCHED;
            PG8_LDA(At, 0, 1); PG8_STAGE(PG8_SB(0, 0), b2, voffB); PG8_STAGE(PG8_SB(0, 1), b2 + hstepB, voffB); PG8_STAGE(PG8_SA(0, 0), a2, voffA);
            PG8_WAIT_V(8); PG8_WAIT_L(0); PG8_BAR; PG8_MMA(1, 0, At, B0); PG8_MMA(1, 1, At, B1); PG8_BAR; PG8_SCHED;
            PG8_LDB(B0, 1, 0); PG8_LDB(B1, 1, 1); PG8_SCHED; PG8_LDA(At, 1, 0); PG8_STAGE(PG8_SA(0, 1), a2 + hstepA, voffA);
            PG8_WAIT_V(8); PG8_WAIT_L(0); PG8_BAR; PG8_MMA(0, 0, At, B0); PG8_MMA(0, 1, At, B1); PG8_BAR; PG8_SCHED;
            PG8_LDA(At, 1, 1); PG8_STAGE(PG8_SB(1, 0), b3, voffB); PG8_STAGE(PG8_SB(1, 1), b3 + hstepB, voffB); PG8_STAGE(PG8_SA(1, 0), a3, voffA);
            PG8_WAIT_V(8); PG8_WAIT_L(0); PG8_BAR; PG8_MMA(1, 0, At, B0); PG8_MMA(1, 1, At, B1); PG8_BAR; PG8_SCHED;
            } else {
            PG8_LDB(B0, 0, 0); PG8_SCHED; PG8_LDA(At, 0, 0); PG8_STAGE(PG8_SA(1, 1), a1 + hstepA, voffA);
            PG8_WAIT_L(8); PG8_BAR; PG8_WAIT_L(0); PG8_MMA(0, 0, At, B0); PG8_BAR; PG8_SCHED;
            PG8_LDB(B1, 0, 1); PG8_STAGE(PG8_SB(0, 0), b2, voffB);
            PG8_BAR; PG8_WAIT_L(0); PG8_MMA(0, 1, At, B1); PG8_BAR;
            PG8_LDA(At, 0, 1); PG8_STAGE(PG8_SA(0, 0), a2, voffA);
            PG8_BAR; PG8_WAIT_L(0); PG8_MMA(1, 0, At, B0); PG8_BAR; PG8_SCHED;
            PG8_STAGE(PG8_SB(0, 1), b2 + hstepB, voffB);
            PG8_WAIT_V(6); PG8_BAR; PG8_MMA(1, 1, At, B1); PG8_BAR;
            PG8_LDB(B0, 1, 0); PG8_SCHED; PG8_LDA(At, 1, 0); PG8_STAGE(PG8_SA(0, 1), a2 + hstepA, voffA);
            PG8_WAIT_L(8); PG8_BAR; PG8_WAIT_L(0); PG8_MMA(0, 0, At, B0); PG8_BAR; PG8_SCHED;
            PG8_LDB(B1, 1, 1); PG8_STAGE(PG8_SB(1, 0), b3, voffB);
            PG8_BAR; PG8_WAIT_L(0); PG8_MMA(0, 1, At, B1); PG8_BAR;
            PG8_LDA(At, 1, 1); PG8_STAGE(PG8_SA(1, 0), a3, voffA);
            PG8_BAR; PG8_WAIT_L(0); PG8_MMA(1, 0, At, B0); PG8_BAR; PG8_SCHED;
            PG8_STAGE(PG8_SB(1, 1), b3 + hstepB, voffB);
            PG8_WAIT_V(6); PG8_BAR; PG8_MMA(1, 1, At, B1); PG8_BAR;
            }
        }
        if constexpr (ALIGN_EPI) { if (wr == 0) PG8_BAR; }
        if constexpr (!Epi::AFTER_DRAIN) { E(acc, cur, wr, wc, fr, fq); S.done(cur); }
        if (!has_next) break;
#pragma unroll
        for (int a = 0; a < 2; ++a)
#pragma unroll
            for (int b = 0; b < 2; ++b)
#pragma unroll
                for (int m = 0; m < 4; ++m)
#pragma unroll
                    for (int n = 0; n < 2; ++n) acc[a][b][m][n] = (f32x4){0.f, 0.f, 0.f, 0.f};
        cur = nxt; cA = nA; cB = nB; ++ui;
        if constexpr (ALIGN_EPI) { if (wr == 1) PG8_BAR; }
    }
    PG8_WAIT_V(0);
    if constexpr (!ALIGN_EPI) { if (wr == 0) PG8_BAR; }
    PG8_BAR;
    if constexpr (Epi::AFTER_DRAIN) { E.fused(acc, cur, wr, wc, fr, fq, lds, wid, lane); S.done(cur); }
#undef PG8_SA
#undef PG8_SB
#undef PG8_STAGE
#undef PG8_LDA
#undef PG8_LDB
#undef PG8_MMA
#undef PG8_WAIT_V
#undef PG8_WAIT_L
#undef PG8_BAR
#undef PG8_SCHED
}
}

namespace pg8 {
__device__ __forceinline__ float fsigmoid(float x) { return __builtin_amdgcn_rcpf(1.f + __expf(-x)); }
typedef unsigned u32x2 __attribute__((ext_vector_type(2)));
struct EpiStoreBf16 {
    static constexpr bool PERM = true, AFTER_DRAIN = false;
    bf16_t* O; int ldc, nvalid;
    __device__ __forceinline__ void operator()(const f32x4 (&acc)[2][2][4][2], const Unit& u, int wr, int wc, int fr, int fq) const {
        const int row0 = u.pm * BM + wr * 64 + fr, col0 = u.pn * BM + wc * 32 + 8 * fq;
#pragma unroll
        for (int ai = 0; ai < 2; ++ai)
#pragma unroll
            for (int m = 0; m < 4; ++m) { bf16_t* rowp = O + (size_t)(row0 + ai * HALF + m * 16) * ldc + col0;
#pragma unroll
                for (int bj = 0; bj < 2; ++bj) if (col0 + bj * HALF < nvalid) { const f32x4 v0 = acc[ai][bj][m][0], v1 = acc[ai][bj][m][1];
                    u32x4 w; w.x = cvt_pk_bf16(v0[0], v0[1]); w.y = cvt_pk_bf16(v0[2], v0[3]); w.z = cvt_pk_bf16(v1[0], v1[1]); w.w = cvt_pk_bf16(v1[2], v1[3]);
                    *(u32x4*)(rowp + bj * HALF) = w; } }
    }
};
struct EpiSwiglu {
    static constexpr bool PERM = false, AFTER_DRAIN = false;
    bf16_t* O; int ldc;
    __device__ __forceinline__ void operator()(const f32x4 (&acc)[2][2][4][2], const Unit& u, int wr, int wc, int fr, int fq) const {
        const int row0 = u.pm * BM + wr * 64 + fr, col0 = u.pn * 128 + wc * 16 + 4 * fq;
#pragma unroll
        for (int ai = 0; ai < 2; ++ai)
#pragma unroll
            for (int m = 0; m < 4; ++m) { bf16_t* rowp = O + (size_t)(row0 + ai * HALF + m * 16) * ldc + col0;
#pragma unroll
                for (int bj = 0; bj < 2; ++bj) { const f32x4 g = acc[ai][bj][m][0], v = acc[ai][bj][m][1];
                    u32x2 w; w.x = cvt_pk_bf16(g[0] * fsigmoid(g[0]) * v[0], g[1] * fsigmoid(g[1]) * v[1]); w.y = cvt_pk_bf16(g[2] * fsigmoid(g[2]) * v[2], g[3] * fsigmoid(g[3]) * v[3]);
                    *(u32x2*)(rowp + bj * 64) = w; } }
    }
};
struct EpiGateMix {
    static constexpr bool PERM = false, AFTER_DRAIN = false;
    const bf16_t* BRB; bf16_t* O;
    __device__ __forceinline__ void operator()(const f32x4 (&acc)[2][2][4][2], const Unit& u, int wr, int wc, int fr, int fq) const {
        const int row0 = u.pm * BM + wr * 64 + fr, d0 = u.pn * 64 + wc * 16 + 4 * fq;
#pragma unroll
        for (int ai = 0; ai < 2; ++ai)
#pragma unroll
            for (int m = 0; m < 4; ++m) { const size_t row = (size_t)(row0 + ai * HALF + m * 16);
                f32x4 s = {0.f, 0.f, 0.f, 0.f};
#pragma unroll
                for (int bj = 0; bj < 2; ++bj)
#pragma unroll
                    for (int n = 0; n < 2; ++n) { const u32x2 raw = *(const u32x2*)(BRB + row * 4096 + (2 * bj + n) * 1024 + d0); const f32x4 g = acc[ai][bj][m][n];
                        s[0] += fsigmoid(g[0]) * __uint_as_float(raw.x << 16); s[1] += fsigmoid(g[1]) * __uint_as_float(raw.x & 0xffff0000u);
                        s[2] += fsigmoid(g[2]) * __uint_as_float(raw.y << 16); s[3] += fsigmoid(g[3]) * __uint_as_float(raw.y & 0xffff0000u); }
                u32x2 w; w.x = cvt_pk_bf16(s[0], s[1]); w.y = cvt_pk_bf16(s[2], s[3]);
                *(u32x2*)(O + row * 1024 + d0) = w; }
    }
};
}

__device__ __forceinline__ void ph_postproj(const P& p, int l) {
    const int lane = tidx() & 63;
    const bf16* proj = (const bf16*)(p.ws + WS_BIG + B_PROJ);
    bf16* cq = (bf16*)(p.ws + WS_BIG + B_CQ);
    bf16* ckv = (bf16*)(p.ws + WS_BIG + B_CKV);
    for (int row = blockIdx.x * NWV + (tidx() >> 6); row < NKVROWS; row += gridDim.x * NWV) {
        if (row >= NTOK) {
            const int r = row - NTOK, b = r >> 8, s = r & 255;
            const float* src = p.cache_b_ckv + ((size_t)(b * 2 + l) * 256 + s) * 128;
            ckv[(size_t)row * 128 + lane] = f2bf(src[lane]); ckv[(size_t)row * 128 + 64 + lane] = f2bf(src[64 + lane]);
            continue;
        }
        const bf16* pr = proj + (size_t)row * PLD;
        float a0 = bf2f(pr[C_BCQ + lane]), a1 = bf2f(pr[C_BCQ + 64 + lane]), a2 = bf2f(pr[C_BCQ + 128 + lane]);
        float ss = wave_sum(a0 * a0 + a1 * a1 + a2 * a2);
        float rinv = rsqrtf(ss * (1.f / 192.f) + EPS);
        const float* gq = p.b_g_cq + l * 192;
        cq[(size_t)row * 192 + lane] = f2bf(a0 * rinv * gq[lane]); cq[(size_t)row * 192 + 64 + lane] = f2bf(a1 * rinv * gq[64 + lane]); cq[(size_t)row * 192 + 128 + lane] = f2bf(a2 * rinv * gq[128 + lane]);
        float k0 = bf2f(pr[C_BCKV + lane]), k1 = bf2f(pr[C_BCKV + 64 + lane]);
        ss = wave_sum(k0 * k0 + k1 * k1);
        rinv = rsqrtf(ss * (1.f / 128.f) + EPS);
        const float* gk = p.b_g_ckv + l * 128;
        k0 = k0 * rinv * gk[lane]; k1 = k1 * rinv * gk[64 + lane];
        ckv[(size_t)row * 128 + lane] = f2bf(k0); ckv[(size_t)row * 128 + 64 + lane] = f2bf(k1);
        if (row < NPROMPT) {
            const int b = row >> 8, s = row & 255;
            const size_t ci = (size_t)(b * 2 + l) * 256 + s;
            p.out[O_CKV + ci * 128 + lane] = k0; p.out[O_CKV + ci * 128 + 64 + lane] = k1;
            p.out[O_CAK + ci * 128 + lane] = bf2f(pr[C_AK + lane]); p.out[O_CAK + ci * 128 + 64 + lane] = bf2f(pr[C_AK + 64 + lane]);
            p.out[O_CAV + ci * 128 + lane] = bf2f(pr[C_AV + lane]); p.out[O_CAV + ci * 128 + 64 + lane] = bf2f(pr[C_AV + 64 + lane]);
            if (lane < 32) p.out[O_KR + ci * 32 + lane] = bf2f(pr[C_BKR + lane]);
        }
    }
}

__device__ __forceinline__ void ph_prep2(const P& p, int l) {
    const int lane = tidx() & 63;
    const float* tab = (const float*)(p.ws + WS_TAB);
    const bf16* proj = (const bf16*)(p.ws + WS_BIG + B_PROJ);
    const bf16* qb = (const bf16*)(p.ws + WS_BIG + B_QB);
    const bf16* kv = (const bf16*)(p.ws + WS_BIG + B_KV);
    bf16* qa1s = (bf16*)(p.ws + WS_BIG + B_QA1S);
    bf16* ka1s = (bf16*)(p.ws + WS_BIG + B_KA1S);
    bf16* qb1s = (bf16*)(p.ws + WS_BIG + B_CQ);
    bf16* kb = (bf16*)(p.ws + WS_BIG + B_KB);
    bf16* kac = (bf16*)(p.ws + WS_KAC);
    bf16* vac = (bf16*)(p.ws + WS_VAC);
    for (int row = blockIdx.x * NWV + (tidx() >> 6); row < NKVROWS; row += gridDim.x * NWV) {
        for (int h = 0; h < 4; ++h) kb[(size_t)row * 384 + h * 96 + lane] = kv[(size_t)row * 512 + h * 128 + lane];
        if (row >= NTOK) {
            const int r = row - NTOK, b = r >> 8, s = r & 255;
            if (lane < 32) { const bf16 v = f2bf(p.cache_b_krope[((size_t)(b * 2 + l) * 256 + s) * 32 + lane]); for (int h = 0; h < 4; ++h) kb[(size_t)row * 384 + h * 96 + 64 + lane] = v; }
            const size_t ci = ((size_t)(b * 2 + l) * 256 + s) * 128;
            kac[(size_t)r * 128 + lane] = f2bf(p.cache_a_k[ci + lane]); kac[(size_t)r * 128 + 64 + lane] = f2bf(p.cache_a_k[ci + 64 + lane]);
            vac[(size_t)r * 128 + lane] = f2bf(p.cache_a_v[ci + lane]); vac[(size_t)r * 128 + 64 + lane] = f2bf(p.cache_a_v[ci + 64 + lane]);
            continue;
        }
        const bf16* pr = proj + (size_t)row * PLD;
        if (row < NPROMPT) {
            if (lane < 32) { const bf16 v = pr[C_BKR + lane]; for (int h = 0; h < 4; ++h) kb[(size_t)row * 384 + h * 96 + 64 + lane] = v; }
            continue;
        }
        const int rs = row - NPROMPT, t = rs & 4095, gr = t >> 6, gc = t & 63;
        {
            if (lane < 32) {
                const int d = lane, qtr = d >> 3, f = d & 7, pos = (qtr < 2) ? gr : gc;
                const float c = tab[2048 + pos * 8 + f], s = tab[2560 + pos * 8 + f];
                const float x = bf2f(pr[C_BKR + d]);
                const float y = bf2f(pr[C_BKR + (d ^ 8)]);
                const float o = (qtr & 1) ? (x * c + y * s) : (x * c - y * s);
                const bf16 v = f2bf(o);
                for (int h = 0; h < 4; ++h) kb[(size_t)row * 384 + h * 96 + 64 + d] = v;
                for (int h = 0; h < 4; ++h) {
                    const float qx = bf2f(qb[(size_t)row * 384 + h * 96 + 64 + d]), qy = bf2f(qb[(size_t)row * 384 + h * 96 + 64 + (d ^ 8)]);
                    qb1s[(size_t)rs * 384 + h * 96 + 64 + d] = f2bf((qtr & 1) ? (qx * c + qy * s) : (qx * c - qy * s));
                }
            }
            for (int h = 0; h < 4; ++h) qb1s[(size_t)rs * 384 + h * 96 + lane] = qb[(size_t)row * 384 + h * 96 + lane];
        }
        {
            const int d = lane, qtr = d >> 4, f = d & 15, pos = (qtr < 2) ? gr : gc;
            const float c = tab[pos * 16 + f], s = tab[1024 + pos * 16 + f];
            for (int h = 0; h < 4; ++h) {
                const float x = bf2f(pr[C_AQ + h * 64 + d]), y = bf2f(pr[C_AQ + h * 64 + (d ^ 16)]);
                qa1s[(size_t)rs * 256 + h * 64 + d] = f2bf((qtr & 1) ? (x * c + y * s) : (x * c - y * s));
            }
            for (int h = 0; h < 2; ++h) {
                const float x = bf2f(pr[C_AK + h * 64 + d]), y = bf2f(pr[C_AK + h * 64 + (d ^ 16)]);
                ka1s[(size_t)rs * 128 + h * 64 + d] = f2bf((qtr & 1) ? (x * c + y * s) : (x * c - y * s));
            }
        }
    }
}

struct AttnJob {
    const bf16 *q1, *q2, *k1, *v1, *k2, *v2;
    const float* sink;
    bf16* out;
    int ldq1, ldq2, ldk1, ldv1, ldk2, ldv2;
    int kstride, vstride, kvgroup, nbatch, T, nk2, window, outcol;
    float scale; int pad;
};

template <int DQK>
__device__ __forceinline__ void attn_item(const AttnJob& j, int blk, unsigned char* smem) {
    float* Ks = (float*)smem;
    float* Vs = Ks + 32 * DQK;
    const int tid = tidx(), eh = (tid >> 8) * 32;
    const int nqb = j.T / 256;
    const int b = blk / (4 * nqb), h = (blk / nqb) % 4, qb0 = (blk % nqb) * 256;
    const int kh = h / j.kvgroup;
    const int t = qb0 + (tid & 255);
    float q[DQK], o[32];
    float m = -1e30f, lsum = 0.f;
#pragma unroll
    for (int e = 0; e < 32; ++e) o[e] = 0.f;
    for (int set = 0; set < 2; ++set) {
        if (set == 1 && j.nk2 == 0) break;
        const bf16* qp = (set == 0) ? j.q1 + ((size_t)b * j.T + t) * j.ldq1 + h * DQK : j.q2 + ((size_t)b * j.T + t) * j.ldq2 + h * DQK;
#pragma unroll
        for (int d = 0; d < DQK; d += 4) { const uint2 raw = *(const uint2*)(qp + d); q[d] = bf2f((bf16)(raw.x & 0xffff)) * j.scale; q[d + 1] = bf2f((bf16)(raw.x >> 16)) * j.scale; q[d + 2] = bf2f((bf16)(raw.y & 0xffff)) * j.scale; q[d + 3] = bf2f((bf16)(raw.y >> 16)) * j.scale; }
        const bf16* kp = (set == 0) ? j.k1 + (size_t)b * j.T * j.ldk1 + kh * j.kstride : j.k2 + (size_t)b * j.nk2 * j.ldk2 + kh * j.kstride;
        const bf16* vp = (set == 0) ? j.v1 + (size_t)b * j.T * j.ldv1 + kh * j.vstride : j.v2 + (size_t)b * j.nk2 * j.ldv2 + kh * j.vstride;
        const int ldk = (set == 0) ? j.ldk1 : j.ldk2, ldv = (set == 0) ? j.ldv1 : j.ldv2;
        int kbeg = 0, kend = (set == 0) ? j.T : j.nk2;
        const bool win = (set == 0) && j.window;
        if (win) { kbeg = qb0 - 128 < 0 ? 0 : qb0 - 128; kend = qb0 + 256 + 128 > j.T ? j.T : qb0 + 256 + 128; }
        for (int ks = kbeg; ks < kend; ks += 32) {
            __syncthreads();
            for (int e = tid; e < 32 * DQK / 4; e += NT) {
                const int key = e / (DQK / 4), c4 = e % (DQK / 4), s = ks + key;
                float4 val = make_float4(0.f, 0.f, 0.f, 0.f);
                if (s < kend) { const uint2 raw = *(const uint2*)(kp + (size_t)s * ldk + c4 * 4); val = make_float4(bf2f((bf16)(raw.x & 0xffff)), bf2f((bf16)(raw.x >> 16)), bf2f((bf16)(raw.y & 0xffff)), bf2f((bf16)(raw.y >> 16))); }
                *(float4*)&Ks[key * DQK + c4 * 4] = val;
            }
            for (int e = tid; e < 32 * 16; e += NT) {
                const int key = e >> 4, c4 = e & 15, s = ks + key;
                float4 val = make_float4(0.f, 0.f, 0.f, 0.f);
                if (s < kend) { const uint2 raw = *(const uint2*)(vp + (size_t)s * ldv + c4 * 4); val = make_float4(bf2f((bf16)(raw.x & 0xffff)), bf2f((bf16)(raw.x >> 16)), bf2f((bf16)(raw.y & 0xffff)), bf2f((bf16)(raw.y >> 16))); }
                *(float4*)&Vs[key * 64 + c4 * 4] = val;
            }
            __syncthreads();
            const int nk = (kend - ks) < 32 ? (kend - ks) : 32;
            for (int key = 0; key < nk; ++key) {
                const int s = ks + key;
                if (win) { const int dlt = t - s; if (dlt > 128 || dlt < -128) continue; }
                float sc = 0.f;
#pragma unroll
                for (int d = 0; d < DQK; d += 4) { const float4 kk = *(const float4*)&Ks[key * DQK + d]; sc += q[d] * kk.x + q[d + 1] * kk.y + q[d + 2] * kk.z + q[d + 3] * kk.w; }
                if (sc > m) { const float c = __expf(m - sc); lsum *= c;
#pragma unroll
                    for (int e = 0; e < 32; ++e) o[e] *= c;
                    m = sc; }
                const float pp = __expf(sc - m);
                lsum += pp;
#pragma unroll
                for (int e = 0; e < 32; e += 4) { const float4 vv = *(const float4*)&Vs[key * 64 + eh + e]; o[e] += pp * vv.x; o[e + 1] += pp * vv.y; o[e + 2] += pp * vv.z; o[e + 3] += pp * vv.w; }
            }
        }
    }
    if (j.sink) {
        const float sk = j.sink[h];
        const float mf = sk > m ? sk : m;
        const float c = __expf(m - mf);
        lsum = lsum * c + __expf(sk - mf);
#pragma unroll
        for (int e = 0; e < 32; ++e) o[e] *= c;
    }
    const float inv = 1.f / lsum;
    bf16* op = j.out + ((size_t)b * j.T + t) * 1024 + j.outcol + h * 64 + eh;
#pragma unroll
    for (int e = 0; e < 32; e += 2) *(unsigned*)(op + e) = (unsigned)f2bf(o[e] * inv) | ((unsigned)f2bf(o[e + 1] * inv) << 16);
}

__device__ __forceinline__ void ph_pool(const P& p, int l, unsigned char* smem) {
    float (*df)[257] = (float (*)[257])smem;
    const int tid = tidx(), half = tid >> 8, c256 = tid & 255;
    const bf16* proj = (const bf16*)(p.ws + WS_BIG + B_PROJ);
    bf16* br = (bf16*)(p.ws + WS_BR);
    for (int tile = blockIdx.x; tile < NTOK / 32; tile += gridDim.x) {
        const int row0 = tile * 32;
        int base, T;
        if (row0 < NPROMPT) { base = (row0 >> 8) << 8; T = 256; } else { base = NPROMPT + (((row0 - NPROMPT) >> 12) << 12); T = 4096; }
        __syncthreads();
        {
            const int c = c256, g = c >> 6, hw = 1 << g;
            for (int i = half * 16; i < half * 16 + 16; ++i) {
                const int t = row0 + i - base;
                const int lo = t - hw < 0 ? 0 : t - hw, hi = t + hw > T ? T : t + hw;
                float sacc = 0.f;
                for (int u = lo; u < hi; ++u) sacc += bf2f(proj[(size_t)(base + u) * PLD + C_CIN + c]);
                df[i][c] = sacc / (float)(hi - lo) - bf2f(proj[(size_t)(base + t) * PLD + C_CIN + c]);
            }
        }
        __syncthreads();
        {
            const int g = c256 >> 6, d = c256 & 63;
            float acc[16];
#pragma unroll
            for (int i = 0; i < 16; ++i) acc[i] = 0.f;
            const float* wp = p.c_w_pool + ((size_t)(l * 4 + g) * 64) * 64 + d;
            for (int c = 0; c < 64; ++c) {
                const float w = wp[c * 64];
#pragma unroll
                for (int i = 0; i < 16; ++i) acc[i] += df[half * 16 + i][g * 64 + c] * w;
            }
            const float sc = p.c_scale[l * 256 + c256];
#pragma unroll
            for (int i = 0; i < 16; ++i) br[(size_t)(row0 + half * 16 + i) * 1024 + 512 + c256] = f2bf(acc[i] * sc);
        }
    }
}

#define GS_KN 0
#define GS_QN 8192
#define GS_W 16384
#define GS_QG 24576
#define GS_KDT 32768
#define GS_ST 49152
#define GS_VNT 57344
#define GS_A 65536
#define GS_U 73728
#define GS_V 90112
#define GS_L 107520
#define GS_SM 123904

__device__ __forceinline__ int swz(int r, int c) { return r * 64 + ((((c) >> 3) ^ (r & 7)) << 3) + (c & 7); }
__device__ __forceinline__ unsigned pk2(float a, float b) { return (unsigned)f2bf(a) | ((unsigned)f2bf(b) << 16); }

__device__ __forceinline__ f32x16 mm_tile(const bf16* A, int m0, const bf16* B, int n0, f32x16 acc, int lane) {
    const int ra = m0 + (lane & 31), rb = n0 + (lane & 31), hh = lane >> 5;
#pragma unroll
    for (int kk = 0; kk < 4; ++kk) {
        const int ch = kk * 2 + hh;
        const bf16x8 a = *(const bf16x8*)(A + ra * 64 + ((ch ^ (ra & 7)) << 3));
        const bf16x8 b = *(const bf16x8*)(B + rb * 64 + ((ch ^ (rb & 7)) << 3));
        acc = __builtin_amdgcn_mfma_f32_32x32x16_bf16(a, b, acc, 0, 0, 0);
    }
    return acc;
}
__device__ __forceinline__ f32x16 zero16() { f32x16 z; _Pragma("unroll") for (int r = 0; r < 16; ++r) z[r] = 0.f; return z; }

struct GdnCtx { int base, T, h, dir, cidx, l; };

__device__ __forceinline__ void gdn_prep(const P& p, const GdnCtx& c, unsigned char* smem_) {
    unsigned char* smem = smem_ + vzero();
    const int tid = tidx(), lane = tid & 63, wv = tid >> 6;
    bf16* KN = (bf16*)(smem + GS_KN); bf16* QN = (bf16*)(smem + GS_QN); bf16* Wl = (bf16*)(smem + GS_W);
    float* Ul = (float*)(smem + GS_U); float* Vl = (float*)(smem + GS_V); float* Lm = (float*)(smem + GS_L);
    float* gcs = (float*)(smem + GS_SM); float* betas = gcs + 64; float* qdec = gcs + 128; float* kdec = gcs + 192; float* bexp = gcs + 256;
    const bf16* proj = (const bf16*)(p.ws + WS_BIG + B_PROJ);
    const float* convw = p.d_conv + (size_t)c.l * 5 * 768;
#pragma unroll 1
    for (int r = 0; r < 3; ++r) {
        const int w = tid + NT * r, i = w / 24, rem = w - i * 24, part = rem >> 3, g8 = rem & 7;
        const int tt = c.cidx * 64 + (c.dir ? 63 - i : i);
        const int ch = part * 256 + c.h * 64 + g8 * 8;
        float u[8];
#pragma unroll
        for (int k = 0; k < 8; ++k) u[k] = 0.f;
#pragma unroll
        for (int j = 0; j < 5; ++j) {
            const int ts = tt + j - 2;
            if (ts >= 0 && ts < c.T) {
                const uint4 raw = *(const uint4*)(proj + (size_t)(c.base + ts) * PLD + C_DQKV + ch);
                const float4 w0 = *(const float4*)(convw + j * 768 + ch), w1 = *(const float4*)(convw + j * 768 + ch + 4);
                u[0] += w0.x * bf2f((bf16)(raw.x & 0xffff)); u[1] += w0.y * bf2f((bf16)(raw.x >> 16)); u[2] += w0.z * bf2f((bf16)(raw.y & 0xffff)); u[3] += w0.w * bf2f((bf16)(raw.y >> 16));
                u[4] += w1.x * bf2f((bf16)(raw.z & 0xffff)); u[5] += w1.y * bf2f((bf16)(raw.z >> 16)); u[6] += w1.z * bf2f((bf16)(raw.w & 0xffff)); u[7] += w1.w * bf2f((bf16)(raw.w >> 16));
            }
        }
        float ss = 0.f;
#pragma unroll
        for (int k = 0; k < 8; ++k) { u[k] = siluf_(u[k]); ss += u[k] * u[k]; }
        ss += __shfl_xor(ss, 1); ss += __shfl_xor(ss, 2); ss += __shfl_xor(ss, 4);
        if (part < 2) {
            const float sc = rsqrtf(ss + EPS) * (part == 0 ? 0.125f : 1.f);
            bf16* dst = (part == 0 ? QN : KN) + i * 64 + ((g8 ^ (i & 7)) << 3);
            *(uint4*)dst = make_uint4(pk2(u[0] * sc, u[1] * sc), pk2(u[2] * sc, u[3] * sc), pk2(u[4] * sc, u[5] * sc), pk2(u[6] * sc, u[7] * sc));
        } else {
            *(float4*)(Vl + i * 68 + g8 * 8) = make_float4(u[0], u[1], u[2], u[3]);
            *(float4*)(Vl + i * 68 + g8 * 8 + 4) = make_float4(u[4], u[5], u[6], u[7]);
        }
    }
    if (wv == 0) {
        const int i = lane, tt = c.cidx * 64 + (c.dir ? 63 - i : i);
        const bf16* pr = proj + (size_t)(c.base + tt) * PLD;
        const float Aexp = expf(p.d_a_log[(c.l * 2 + c.dir) * 4 + c.h]), dtb = p.d_dt_bias[(c.l * 2 + c.dir) * 4 + c.h];
        const float beta = sigmoidf_(bf2f(pr[C_DBETA + c.dir * 4 + c.h]));
        const float al = bf2f(pr[C_DALPHA + c.dir * 4 + c.h]) + dtb;
        float g = -Aexp * (al > 20.f ? al : log1pf(expf(al)));
#pragma unroll
        for (int o = 1; o < 64; o <<= 1) { const float t = __shfl_up(g, o); if (lane >= o) g += t; }
        const float g63 = __shfl(g, 63);
        const float eg = expf(g);
        gcs[i] = g; betas[i] = beta; qdec[i] = eg; kdec[i] = expf(g63 - g); bexp[i] = beta * eg;
    }
    __syncthreads();
    if (wv < 4) {
        const int mt = wv >> 1, nt = wv & 1, hh = lane >> 5, j = nt * 32 + (lane & 31);
        f32x16 acc = zero16();
        if (nt <= mt) acc = mm_tile(KN, mt * 32, KN, nt * 32, acc, lane);
        const float gj = gcs[j];
#pragma unroll
        for (int r = 0; r < 16; ++r) {
            const int i = mt * 32 + (r & 3) + 8 * (r >> 2) + 4 * hh;
            Lm[i * 64 + j] = (j < i) ? betas[i] * acc[r] * __expf(gcs[i] - gj) : 0.f;
        }
    }
    __syncthreads();
    if (wv < 2) {
        const int col = lane; const bool isW = wv == 1;
        float x[64];
#pragma unroll
        for (int i = 0; i < 64; ++i) x[i] = isW ? bf2f(KN[swz(i, col)]) * bexp[i] : Vl[i * 68 + col] * betas[i];
#pragma unroll
        for (int i = 1; i < 64; ++i) {
            float a = x[i];
#pragma unroll
            for (int j4 = 0; j4 < (i + 3) / 4; ++j4) {
                const float4 lv = *(const float4*)&Lm[i * 64 + j4 * 4];
                a -= lv.x * x[j4 * 4]; a -= lv.y * x[j4 * 4 + 1]; a -= lv.z * x[j4 * 4 + 2]; a -= lv.w * x[j4 * 4 + 3];
            }
            x[i] = a;
        }
        if (isW) {
#pragma unroll
            for (int i = 0; i < 64; ++i) Wl[swz(i, col)] = f2bf(x[i]);
        } else {
#pragma unroll
            for (int i = 0; i < 64; ++i) Ul[i * 64 + col] = x[i];
        }
    }
    __syncthreads();
}

__device__ __forceinline__ void gdn_t0(unsigned char* smem_, int kb) {
    unsigned char* smem = smem_ + vzero();
    const int tid = tidx(), i = tid >> 3, cc = tid & 7;
    const bf16* KN = (const bf16*)(smem + GS_KN); const bf16* QN = (const bf16*)(smem + GS_QN);
    bf16* QG = (bf16*)(smem + GS_QG); bf16* KDT = (bf16*)(smem + GS_KDT + kb * 8192);
    const float* gcs = (const float*)(smem + GS_SM); const float qd = gcs[128 + i], kd = gcs[192 + i];
    const int off = i * 64 + ((cc ^ (i & 7)) << 3);
    const uint4 q = *(const uint4*)(QN + off), k = *(const uint4*)(KN + off);
    const unsigned qa[4] = {q.x, q.y, q.z, q.w}, ka[4] = {k.x, k.y, k.z, k.w};
    unsigned qo[4];
#pragma unroll
    for (int t = 0; t < 4; ++t) {
        qo[t] = pk2(bf2f((bf16)(qa[t] & 0xffff)) * qd, bf2f((bf16)(qa[t] >> 16)) * qd);
        KDT[swz(cc * 8 + 2 * t, i)] = f2bf(bf2f((bf16)(ka[t] & 0xffff)) * kd);
        KDT[swz(cc * 8 + 2 * t + 1, i)] = f2bf(bf2f((bf16)(ka[t] >> 16)) * kd);
    }
    *(uint4*)(QG + off) = make_uint4(qo[0], qo[1], qo[2], qo[3]);
}

__device__ __forceinline__ void gdn_t12(const P& p, const GdnCtx& c, unsigned char* smem_, int kb, f32x16& Sreg, int mode) {
    unsigned char* smem = smem_ + vzero();
    const int tid = tidx(), lane = tid & 63, wv = tid >> 6, hh = lane >> 5, l31 = lane & 31;
    const bf16* KN = (const bf16*)(smem + GS_KN); const bf16* QN = (const bf16*)(smem + GS_QN); const bf16* Wl = (const bf16*)(smem + GS_W);
    const bf16* QG = (const bf16*)(smem + GS_QG); const bf16* KDT = (const bf16*)(smem + GS_KDT + kb * 8192);
    bf16* ST = (bf16*)(smem + GS_ST); bf16* VNT = (bf16*)(smem + GS_VNT); bf16* Al = (bf16*)(smem + GS_A);
    const float* Ul = (const float*)(smem + GS_U); const float* gcs = (const float*)(smem + GS_SM);
    f32x16 O0 = zero16(), O1 = zero16();
    const float gl = gcs[128 + 63];
    if (wv < 4) {
        const int mt = wv >> 1, nt = wv & 1, e = nt * 32 + l31;
        f32x16 acc = mm_tile(Wl, mt * 32, ST, nt * 32, zero16(), lane);
#pragma unroll
        for (int rg = 0; rg < 4; ++rg) {
            const int i0 = mt * 32 + 8 * rg + 4 * hh;
            const float v0 = Ul[(i0) * 64 + e] - acc[rg * 4], v1 = Ul[(i0 + 1) * 64 + e] - acc[rg * 4 + 1], v2 = Ul[(i0 + 2) * 64 + e] - acc[rg * 4 + 2], v3 = Ul[(i0 + 3) * 64 + e] - acc[rg * 4 + 3];
            *(uint2*)(VNT + swz(e, i0)) = make_uint2(pk2(v0, v1), pk2(v2, v3));
        }
    } else if (wv < 6) {
        const int mt = wv - 4;
        O0 = mm_tile(QG, mt * 32, ST, 0, O0, lane);
        O1 = mm_tile(QG, mt * 32, ST, 32, O1, lane);
    } else {
        const int mt = wv - 6;
#pragma unroll
        for (int nt = 0; nt < 2; ++nt) {
            f32x16 acc = zero16();
            if (nt <= mt) acc = mm_tile(QN, mt * 32, KN, nt * 32, acc, lane);
            const int j = nt * 32 + l31; const float gj = gcs[j];
#pragma unroll
            for (int r = 0; r < 16; ++r) {
                const int i = mt * 32 + (r & 3) + 8 * (r >> 2) + 4 * hh;
                Al[swz(i, j)] = f2bf((j <= i) ? acc[r] * __expf(gcs[i] - gj) : 0.f);
            }
        }
    }
    __syncthreads();
    if (wv < 4) {
        const int mt = wv >> 1, nt = wv & 1, e = nt * 32 + l31;
#pragma unroll
        for (int r = 0; r < 16; ++r) Sreg[r] *= gl;
        Sreg = mm_tile(KDT, mt * 32, VNT, nt * 32, Sreg, lane);
#pragma unroll
        for (int rg = 0; rg < 4; ++rg) {
            const int d0 = mt * 32 + 8 * rg + 4 * hh;
            *(uint2*)(ST + swz(e, d0)) = make_uint2(pk2(Sreg[rg * 4], Sreg[rg * 4 + 1]), pk2(Sreg[rg * 4 + 2], Sreg[rg * 4 + 3]));
        }
    } else if (wv < 6) {
        const int mt = wv - 4;
        O0 = mm_tile(Al, mt * 32, VNT, 0, O0, lane);
        O1 = mm_tile(Al, mt * 32, VNT, 32, O1, lane);
        bf16* br = (bf16*)(p.ws + WS_BR);
        bf16* gob = (bf16*)(p.ws + WS_BIG + B_GOB);
        const bf16* proj = (const bf16*)(p.ws + WS_BIG + B_PROJ);
#pragma unroll
        for (int r = 0; r < 16; ++r) {
            const int i = mt * 32 + (r & 3) + 8 * (r >> 2) + 4 * hh;
            const int tt = c.cidx * 64 + (c.dir ? 63 - i : i);
            const size_t row = (size_t)(c.base + tt);
            bf16* b0 = br + row * 1024 + 768 + c.h * 64 + l31;
            if (mode == 0) { b0[0] = f2bf(O0[r]); b0[32] = f2bf(O1[r]); }
            else if (mode == 1) { bf16* g0 = gob + (row - NPROMPT) * 256 + c.h * 64 + l31; g0[0] = f2bf(O0[r]); g0[32] = f2bf(O1[r]); }
            else {
                const float a0 = O0[r] + bf2f(b0[0]), a1 = O1[r] + bf2f(b0[32]);
                float ss = a0 * a0 + a1 * a1;
                ss += __shfl_xor(ss, 1); ss += __shfl_xor(ss, 2); ss += __shfl_xor(ss, 4); ss += __shfl_xor(ss, 8); ss += __shfl_xor(ss, 16);
                const float rinv = rsqrtf(ss * (1.f / 64.f) + EPS);
                const bf16* zp = proj + row * PLD + C_DZ + c.h * 64 + l31;
                b0[0] = f2bf(a0 * rinv * p.d_g_norm[c.l * 64 + l31] * siluf_(bf2f(zp[0])));
                b0[32] = f2bf(a1 * rinv * p.d_g_norm[c.l * 64 + 32 + l31] * siluf_(bf2f(zp[32])));
            }
        }
    }
}

__device__ __forceinline__ void gdn_prompt_item(const P& p, int l, int item, unsigned char* smem_) {
    unsigned char* smem = smem_ + vzero();
    const int tid = tidx(), lane = tid & 63, wv = tid >> 6, hh = lane >> 5, l31 = lane & 31;
    const int b = item >> 2, h = item & 3;
    bf16* ST = (bf16*)(smem + GS_ST);
    f32x16 Sreg = zero16();
    int kb = 0;
#pragma unroll 1
    for (int s = 0; s < 8; ++s) {
        const int dir = s >> 2, n = s & 3;
        GdnCtx c; c.base = b * 256; c.T = 256; c.h = h; c.dir = dir; c.cidx = dir ? 3 - n : n; c.l = l;
        __syncthreads();
        if (n == 0) {
            Sreg = zero16();
            for (int q = tid; q < 2048; q += NT) ((unsigned*)ST)[q] = 0u;
        }
        gdn_prep(p, c, smem);
        gdn_t0(smem, kb);
        __syncthreads();
        gdn_t12(p, c, smem, kb, Sreg, dir ? 2 : 0);
        kb ^= 1;
        if (n == 3 && wv < 4) {
            const int mt = wv >> 1, nt = wv & 1;
            float* so = p.out + (dir ? O_SB : O_SF) + ((size_t)(b * 2 + l) * 4 + h) * 4096;
#pragma unroll
            for (int r = 0; r < 16; ++r) so[(mt * 32 + (r & 3) + 8 * (r >> 2) + 4 * hh) * 64 + nt * 32 + l31] = Sreg[r];
        }
    }
    __syncthreads();
}

__device__ __forceinline__ void gdn_sample_prep_item(const P& p, int l, int item, unsigned char* smem_) {
    unsigned char* smem = smem_ + vzero();
    const int tid = tidx();
    const int n = item & 63, dir = (item >> 6) & 1, h = (item >> 7) & 3, b = item >> 9;
    GdnCtx c; c.base = NPROMPT + b * 4096; c.T = 4096; c.h = h; c.dir = dir; c.cidx = dir ? 63 - n : n; c.l = l;
    __syncthreads();
    gdn_prep(p, c, smem);
    const bf16* KN = (const bf16*)(smem + GS_KN); const bf16* QN = (const bf16*)(smem + GS_QN); const bf16* Wl = (const bf16*)(smem + GS_W);
    const float* Ul = (const float*)(smem + GS_U); const float* gcs = (const float*)(smem + GS_SM);
    bf16* gqk = (bf16*)(p.ws + WS_BIG + B_GQK); bf16* guw = (bf16*)(p.ws + WS_BIG + B_GUW); float* ggc = (float*)(p.ws + WS_GGC);
    const int i = tid >> 3, cc = tid & 7, off = i * 64 + ((cc ^ (i & 7)) << 3);
    if (dir == 0) {
        const size_t tok = (size_t)b * 4096 + c.cidx * 64 + i;
        *(uint4*)(gqk + ((tok * 4 + h) * 2 + 0) * 64 + cc * 8) = *(const uint4*)(QN + off);
        *(uint4*)(gqk + ((tok * 4 + h) * 2 + 1) * 64 + cc * 8) = *(const uint4*)(KN + off);
    }
    bf16* uw = guw + (size_t)item * 8192;
    const float4 u0 = *(const float4*)(Ul + i * 64 + cc * 8), u1 = *(const float4*)(Ul + i * 64 + cc * 8 + 4);
    *(uint4*)(uw + i * 64 + cc * 8) = make_uint4(pk2(u0.x, u0.y), pk2(u0.z, u0.w), pk2(u1.x, u1.y), pk2(u1.z, u1.w));
    *(uint4*)(uw + 4096 + i * 64 + cc * 8) = *(const uint4*)(Wl + off);
    if (tid < 64) ggc[(size_t)item * 64 + tid] = gcs[tid];
}

__device__ __forceinline__ void gdn_sample_chain(const P& p, int l, int chain, unsigned char* smem_) {
    unsigned char* smem = smem_ + vzero();
    const int tid = tidx(), lane = tid & 63, wv = tid >> 6, hh = lane >> 5, l31 = lane & 31;
    const int dir = chain & 1, h = (chain >> 1) & 3, b = chain >> 3;
    bf16* KN = (bf16*)(smem + GS_KN); bf16* QN = (bf16*)(smem + GS_QN); bf16* Wl = (bf16*)(smem + GS_W); bf16* QG = (bf16*)(smem + GS_QG);
    bf16* ST = (bf16*)(smem + GS_ST); float* Ul = (float*)(smem + GS_U); float* gcs = (float*)(smem + GS_SM);
    const bf16* gqk = (const bf16*)(p.ws + WS_BIG + B_GQK); const bf16* guw = (const bf16*)(p.ws + WS_BIG + B_GUW); const float* ggc = (const float*)(p.ws + WS_GGC);
    const float* stp = (const float*)((uintptr_t)p.state_f + (uintptr_t)dir * ((uintptr_t)p.state_b - (uintptr_t)p.state_f)) + ((size_t)(b * 2 + l) * 4 + h) * 4096;
    f32x16 Sreg = zero16();
    __syncthreads();
    if (wv < 4) {
        const int mt = wv >> 1, nt = wv & 1, e = nt * 32 + l31;
#pragma unroll
        for (int r = 0; r < 16; ++r) Sreg[r] = stp[(mt * 32 + (r & 3) + 8 * (r >> 2) + 4 * hh) * 64 + e];
#pragma unroll
        for (int rg = 0; rg < 4; ++rg) { const int d0 = mt * 32 + 8 * rg + 4 * hh; *(uint2*)(ST + swz(e, d0)) = make_uint2(pk2(Sreg[rg * 4], Sreg[rg * 4 + 1]), pk2(Sreg[rg * 4 + 2], Sreg[rg * 4 + 3])); }
    }
    const int i = tid >> 3, cc = tid & 7, off = i * 64 + ((cc ^ (i & 7)) << 3);
    const int item0 = ((b * 4 + h) * 2 + dir) * 64;
    uint4 rq, rk, ru, rw; float rg_i, rg_l;
#define GDN_LOAD(n) { const int cidx_ = dir ? 63 - (n) : (n); const size_t tok_ = (size_t)b * 4096 + cidx_ * 64 + (dir ? 63 - i : i); \
        rq = *(const uint4*)(gqk + ((tok_ * 4 + h) * 2 + 0) * 64 + cc * 8); rk = *(const uint4*)(gqk + ((tok_ * 4 + h) * 2 + 1) * 64 + cc * 8); \
        const bf16* uw_ = guw + (size_t)(item0 + (n)) * 8192; ru = *(const uint4*)(uw_ + i * 64 + cc * 8); rw = *(const uint4*)(uw_ + 4096 + i * 64 + cc * 8); \
        rg_i = ggc[(size_t)(item0 + (n)) * 64 + i]; rg_l = ggc[(size_t)(item0 + (n)) * 64 + 63]; }
    GDN_LOAD(0)
#pragma unroll 1
    for (int n = 0; n < 64; ++n) {
        const int kb = n & 1;
        bf16* KDT = (bf16*)(smem + GS_KDT + kb * 8192);
        {
            const float qd = __expf(rg_i), kd = __expf(rg_l - rg_i);
            *(uint4*)(QN + off) = rq; *(uint4*)(KN + off) = rk; *(uint4*)(Wl + off) = rw;
            const unsigned qa[4] = {rq.x, rq.y, rq.z, rq.w}, ka[4] = {rk.x, rk.y, rk.z, rk.w}, ua[4] = {ru.x, ru.y, ru.z, ru.w};
            unsigned qo[4];
#pragma unroll
            for (int t = 0; t < 4; ++t) {
                qo[t] = pk2(bf2f((bf16)(qa[t] & 0xffff)) * qd, bf2f((bf16)(qa[t] >> 16)) * qd);
                KDT[swz(cc * 8 + 2 * t, i)] = f2bf(bf2f((bf16)(ka[t] & 0xffff)) * kd);
                KDT[swz(cc * 8 + 2 * t + 1, i)] = f2bf(bf2f((bf16)(ka[t] >> 16)) * kd);
            }
            *(uint4*)(QG + off) = make_uint4(qo[0], qo[1], qo[2], qo[3]);
            *(float4*)(Ul + i * 64 + cc * 8) = make_float4(bf2f((bf16)(ua[0] & 0xffff)), bf2f((bf16)(ua[0] >> 16)), bf2f((bf16)(ua[1] & 0xffff)), bf2f((bf16)(ua[1] >> 16)));
            *(float4*)(Ul + i * 64 + cc * 8 + 4) = make_float4(bf2f((bf16)(ua[2] & 0xffff)), bf2f((bf16)(ua[2] >> 16)), bf2f((bf16)(ua[3] & 0xffff)), bf2f((bf16)(ua[3] >> 16)));
            if (cc == 0) { gcs[i] = rg_i; if (i == 63) gcs[128 + 63] = qd; }
        }
        if (n + 1 < 64) GDN_LOAD(n + 1)
        __syncthreads();
        GdnCtx c; c.base = NPROMPT + b * 4096; c.T = 4096; c.h = h; c.dir = dir; c.cidx = dir ? 63 - n : n; c.l = l;
        gdn_t12(p, c, smem, kb, Sreg, dir);
    }
#undef GDN_LOAD
    __syncthreads();
}

__device__ __forceinline__ void ph_gdn_finalize(const P& p, int l) {
    const int tid = tidx(), lane = tid & 63;
    bf16* br = (bf16*)(p.ws + WS_BR);
    const bf16* gob = (const bf16*)(p.ws + WS_BIG + B_GOB);
    const bf16* proj = (const bf16*)(p.ws + WS_BIG + B_PROJ);
    for (int it = blockIdx.x * NWV + (tid >> 6); it < 8192 * 4; it += gridDim.x * NWV) {
        const int rs = it >> 2, h = it & 3; const size_t row = (size_t)NPROMPT + rs;
        bf16* b0 = br + row * 1024 + 768 + h * 64 + lane;
        const float a = bf2f(*b0) + bf2f(gob[(size_t)rs * 256 + h * 64 + lane]);
        const float ss = wave_sum(a * a);
        const float rinv = rsqrtf(ss * (1.f / 64.f) + EPS);
        const float z = bf2f(proj[row * PLD + C_DZ + h * 64 + lane]);
        *b0 = f2bf(a * rinv * p.d_g_norm[l * 64 + lane] * siluf_(z));
    }
}

template <int DQK>
__device__ __forceinline__ void attn_mfma_item(const AttnJob& j, int blk, unsigned char* smem_) {
    unsigned char* smem = smem_ + vzero();
    const int tid = tidx(), lane = tid & 63, wv = tid >> 6, grp = wv >> 2, wq = wv & 3, l31 = lane & 31, hh = lane >> 5, gt = tid & 255;
    constexpr int KLD = DQK + 8, NKC = DQK / 8, NKK = DQK / 16;
    constexpr int KBYTES = 64 * KLD * 2, VBYTES = 64 * 68 * 2, BUFB = KBYTES + VBYTES;
    constexpr int NKI = NKC * 64 / 256;
    const int nqb = j.T / 128;
    const int b = blk / (4 * nqb), h = (blk / nqb) % 4, q0 = (blk % nqb) * 128;
    const int kh = h / j.kvgroup;
    int kbeg = 0, kend = j.T;
    if (j.window) { kbeg = q0 - 128 < 0 ? 0 : q0 - 128; kend = q0 + 256 > j.T ? j.T : q0 + 256; }
    const int n1 = (kend - kbeg) >> 6, n2 = j.nk2 >> 6, nt = n1 + n2, nt0 = (nt + 1) >> 1;
    const int tbeg = grp ? nt0 : 0, tcnt = grp ? nt - nt0 : nt0;
    const int tq = q0 + wq * 32 + l31;
    const float sc2 = j.scale * 1.4426950408889634f;
    const bf16* k1p = j.k1 + (size_t)b * j.T * j.ldk1 + kh * j.kstride; const bf16* v1p = j.v1 + (size_t)b * j.T * j.ldv1 + kh * j.vstride;
    const bf16* k2p = j.k2 + (size_t)b * j.nk2 * j.ldk2 + kh * j.kstride; const bf16* v2p = j.v2 + (size_t)b * j.nk2 * j.ldv2 + kh * j.vstride;
    typedef unsigned u32x4 __attribute__((ext_vector_type(4)));
    u32x4 kr0, kr1, kr2, vr0, vr1;
    kr2 = (u32x4){0u, 0u, 0u, 0u};
#define ATT_LOAD(t_) { const int t__ = (t_); const bool s1__ = t__ < n1; const int ks__ = s1__ ? kbeg + t__ * 64 : (t__ - n1) * 64; \
        const bf16* kp__ = s1__ ? k1p : k2p; const bf16* vp__ = s1__ ? v1p : v2p; const int ldk__ = s1__ ? j.ldk1 : j.ldk2, ldv__ = s1__ ? j.ldv1 : j.ldv2; \
        { const int c_ = gt; kr0 = *(const u32x4*)(kp__ + (size_t)(ks__ + c_ / NKC) * ldk__ + (c_ % NKC) * 8); } \
        { const int c_ = gt + 256; kr1 = *(const u32x4*)(kp__ + (size_t)(ks__ + c_ / NKC) * ldk__ + (c_ % NKC) * 8); } \
        if (NKI > 2) { const int c_ = gt + 512; kr2 = *(const u32x4*)(kp__ + (size_t)(ks__ + c_ / NKC) * ldk__ + (c_ % NKC) * 8); } \
        { const int c_ = gt; vr0 = *(const u32x4*)(vp__ + (size_t)(ks__ + (c_ >> 3)) * ldv__ + (c_ & 7) * 8); } \
        { const int c_ = gt + 256; vr1 = *(const u32x4*)(vp__ + (size_t)(ks__ + (c_ >> 3)) * ldv__ + (c_ & 7) * 8); } }
#define ATT_VSCAT(vr_, c_) { const int key_ = (c_) >> 3, e0_ = ((c_) & 7) * 8; \
        VT[(e0_ + 0) * 68 + key_] = (bf16)(vr_[0] & 0xffff); VT[(e0_ + 1) * 68 + key_] = (bf16)(vr_[0] >> 16); VT[(e0_ + 2) * 68 + key_] = (bf16)(vr_[1] & 0xffff); VT[(e0_ + 3) * 68 + key_] = (bf16)(vr_[1] >> 16); \
        VT[(e0_ + 4) * 68 + key_] = (bf16)(vr_[2] & 0xffff); VT[(e0_ + 5) * 68 + key_] = (bf16)(vr_[2] >> 16); VT[(e0_ + 6) * 68 + key_] = (bf16)(vr_[3] & 0xffff); VT[(e0_ + 7) * 68 + key_] = (bf16)(vr_[3] >> 16); }
#define ATT_STORE(buf_) { bf16* Kl = (bf16*)(smem + ((buf_) * 2 + grp) * BUFB); bf16* VT = (bf16*)(smem + ((buf_) * 2 + grp) * BUFB + KBYTES); \
        { const int c_ = gt; *(u32x4*)(Kl + (c_ / NKC) * KLD + (c_ % NKC) * 8) = kr0; } \
        { const int c_ = gt + 256; *(u32x4*)(Kl + (c_ / NKC) * KLD + (c_ % NKC) * 8) = kr1; } \
        if (NKI > 2) { const int c_ = gt + 512; *(u32x4*)(Kl + (c_ / NKC) * KLD + (c_ % NKC) * 8) = kr2; } \
        ATT_VSCAT(vr0, gt) ATT_VSCAT(vr1, gt + 256) }
    bf16x8 qf[NKK];
    int qset = -1;
    f32x16 o0 = zero16(), o1 = zero16();
    float m = -1e30f, lsum = 0.f;
    __syncthreads();
    if (tcnt > 0) { ATT_LOAD(tbeg) ATT_STORE(0) }
    __syncthreads();
#pragma unroll 1
    for (int s = 0; s < nt0; ++s) {
        const bool has = s < tcnt, hasn = s + 1 < tcnt;
        if (hasn) ATT_LOAD(tbeg + s + 1)
        if (has) {
            const int t = tbeg + s; const bool s1 = t < n1; const int ks = s1 ? kbeg + t * 64 : (t - n1) * 64;
            const int set = s1 ? 0 : 1;
            if (set != qset) {
                qset = set;
                const bf16* qp = (set == 0 ? j.q1 + ((size_t)b * j.T + tq) * j.ldq1 : j.q2 + ((size_t)b * j.T + tq) * j.ldq2) + h * DQK;
#pragma unroll
                for (int kk = 0; kk < NKK; ++kk) qf[kk] = *(const bf16x8*)(qp + kk * 16 + hh * 8);
            }
            const bf16* Kl = (const bf16*)(smem + ((s & 1) * 2 + grp) * BUFB); const bf16* VT = (const bf16*)(smem + ((s & 1) * 2 + grp) * BUFB + KBYTES);
            f32x16 s0 = zero16(), s1v = zero16();
#pragma unroll
            for (int kk = 0; kk < NKK; ++kk) {
                const bf16x8 a0 = *(const bf16x8*)(Kl + l31 * KLD + kk * 16 + hh * 8);
                const bf16x8 a1 = *(const bf16x8*)(Kl + (32 + l31) * KLD + kk * 16 + hh * 8);
                s0 = __builtin_amdgcn_mfma_f32_32x32x16_bf16(a0, qf[kk], s0, 0, 0, 0);
                s1v = __builtin_amdgcn_mfma_f32_32x32x16_bf16(a1, qf[kk], s1v, 0, 0, 0);
            }
            const bool win = s1 && j.window;
            float mx = -INFINITY;
#pragma unroll
            for (int r = 0; r < 16; ++r) {
                float a = s0[r] * sc2, c = s1v[r] * sc2;
                if (win) { const int d0 = tq - (ks + (r & 3) + 8 * (r >> 2) + 4 * hh); if (d0 > 128 || d0 < -128) a = -INFINITY; const int d1 = d0 - 32; if (d1 > 128 || d1 < -128) c = -INFINITY; }
                s0[r] = a; s1v[r] = c; mx = fmaxf(mx, fmaxf(a, c));
            }
            mx = fmaxf(mx, __shfl_xor(mx, 32));
            const float mnew = fmaxf(m, mx), alpha = __builtin_amdgcn_exp2f(m - mnew);
            m = mnew;
            float ps = 0.f;
#pragma unroll
            for (int r = 0; r < 16; ++r) { s0[r] = __builtin_amdgcn_exp2f(s0[r] - mnew); s1v[r] = __builtin_amdgcn_exp2f(s1v[r] - mnew); ps += s0[r] + s1v[r]; }
            lsum = lsum * alpha + ps;
#pragma unroll
            for (int r = 0; r < 16; ++r) { o0[r] *= alpha; o1[r] *= alpha; }
#pragma unroll
            for (int k4 = 0; k4 < 4; ++k4) {
                const int sp = (k4 & 1) * 8;
                unsigned pw[4];
#pragma unroll
                for (int q2 = 0; q2 < 4; ++q2) pw[q2] = (k4 < 2) ? pk2(s0[sp + 2 * q2], s0[sp + 2 * q2 + 1]) : pk2(s1v[sp + 2 * q2], s1v[sp + 2 * q2 + 1]);
                const u32x4 pwv = {pw[0], pw[1], pw[2], pw[3]};
                const bf16x8 pf = __builtin_bit_cast(bf16x8, pwv);
                {
                    const uint2 x0 = *(const uint2*)(VT + l31 * 68 + 16 * k4 + 4 * hh), x1 = *(const uint2*)(VT + l31 * 68 + 16 * k4 + 8 + 4 * hh);
                    const u32x4 av = {x0.x, x0.y, x1.x, x1.y};
                    o0 = __builtin_amdgcn_mfma_f32_32x32x16_bf16(__builtin_bit_cast(bf16x8, av), pf, o0, 0, 0, 0);
                }
                {
                    const uint2 x0 = *(const uint2*)(VT + (32 + l31) * 68 + 16 * k4 + 4 * hh), x1 = *(const uint2*)(VT + (32 + l31) * 68 + 16 * k4 + 8 + 4 * hh);
                    const u32x4 av = {x0.x, x0.y, x1.x, x1.y};
                    o1 = __builtin_amdgcn_mfma_f32_32x32x16_bf16(__builtin_bit_cast(bf16x8, av), pf, o1, 0, 0, 0);
                }
            }
        }
        if (hasn) ATT_STORE((s + 1) & 1)
        __syncthreads();
    }
#undef ATT_LOAD
#undef ATT_VSCAT
#undef ATT_STORE
    lsum += __shfl_xor(lsum, 32);
    float* CO = (float*)smem;
    if (grp == 1) {
#pragma unroll
        for (int r = 0; r < 16; ++r) { CO[((wq * 34 + r) * 64 + lane)] = o0[r]; CO[((wq * 34 + 16 + r) * 64 + lane)] = o1[r]; }
        CO[((wq * 34 + 32) * 64 + lane)] = m; CO[((wq * 34 + 33) * 64 + lane)] = lsum;
    }
    __syncthreads();
    if (grp == 0) {
        const float m1 = CO[((wq * 34 + 32) * 64 + lane)], l1 = CO[((wq * 34 + 33) * 64 + lane)];
        float mf = fmaxf(m, m1);
        float sk2 = 0.f;
        if (j.sink) { sk2 = j.sink[h] * 1.4426950408889634f; mf = fmaxf(mf, sk2); }
        const float a0 = __builtin_amdgcn_exp2f(m - mf), a1 = __builtin_amdgcn_exp2f(m1 - mf);
        float lt = lsum * a0 + l1 * a1;
        if (j.sink) lt += __builtin_amdgcn_exp2f(sk2 - mf);
        const float inv = 1.f / lt;
        bf16* op = j.out + ((size_t)b * j.T + tq) * 1024 + j.outcol + h * 64;
#pragma unroll
        for (int rg = 0; rg < 4; ++rg) {
            float v[8];
#pragma unroll
            for (int k = 0; k < 4; ++k) {
                v[k] = (o0[rg * 4 + k] * a0 + CO[((wq * 34 + rg * 4 + k) * 64 + lane)] * a1) * inv;
                v[4 + k] = (o1[rg * 4 + k] * a0 + CO[((wq * 34 + 16 + rg * 4 + k) * 64 + lane)] * a1) * inv;
            }
            *(uint2*)(op + 8 * rg + 4 * hh) = make_uint2(pk2(v[0], v[1]), pk2(v[2], v[3]));
            *(uint2*)(op + 32 + 8 * rg + 4 * hh) = make_uint2(pk2(v[4], v[5]), pk2(v[6], v[7]));
        }
    }
}

struct KArgs { P p; TJobs J[2]; };

__device__ __forceinline__ AttnJob make_job(const P& p, int l, int variant) {
    unsigned char* ws = p.ws; unsigned char* big = ws + WS_BIG;
    bf16* proj = (bf16*)(big + B_PROJ); bf16* BRb = (bf16*)(ws + WS_BR);
    const float bscale = 0.10206207261596575f;
    AttnJob j{};
    if (variant == 0) {
        j.q1 = proj + C_AQ; j.ldq1 = PLD; j.k1 = proj + C_AK; j.ldk1 = PLD; j.v1 = proj + C_AV; j.ldv1 = PLD; j.kstride = 64; j.vstride = 64; j.kvgroup = 2;
        j.nbatch = 32; j.T = 256; j.nk2 = 0; j.window = 0; j.sink = p.a_sink + l * 4; j.scale = 0.125f; j.out = BRb; j.outcol = 0;
    } else if (variant == 1) {
        j.q1 = (bf16*)(big + B_QA1S); j.ldq1 = 256; j.q2 = proj + (size_t)NPROMPT * PLD + C_AQ; j.ldq2 = PLD;
        j.k1 = (bf16*)(big + B_KA1S); j.ldk1 = 128; j.v1 = proj + (size_t)NPROMPT * PLD + C_AV; j.ldv1 = PLD;
        j.k2 = (bf16*)(ws + WS_KAC); j.ldk2 = 128; j.v2 = (bf16*)(ws + WS_VAC); j.ldv2 = 128; j.kstride = 64; j.vstride = 64; j.kvgroup = 2;
        j.nbatch = 2; j.T = 4096; j.nk2 = 256; j.window = 1; j.sink = p.a_sink + l * 4; j.scale = 0.125f; j.out = BRb + (size_t)NPROMPT * 1024; j.outcol = 0;
    } else if (variant == 2) {
        j.q1 = (bf16*)(big + B_QB); j.ldq1 = 384; j.k1 = (bf16*)(big + B_KB); j.ldk1 = 384; j.v1 = (bf16*)(big + B_KV) + 64; j.ldv1 = 512; j.kstride = 96; j.vstride = 128; j.kvgroup = 1;
        j.nbatch = 32; j.T = 256; j.nk2 = 0; j.window = 0; j.sink = nullptr; j.scale = bscale; j.out = BRb; j.outcol = 256;
    } else {
        j.q1 = (bf16*)(big + B_CQ); j.ldq1 = 384; j.q2 = (bf16*)(big + B_QB) + (size_t)NPROMPT * 384; j.ldq2 = 384;
        j.k1 = (bf16*)(big + B_KB) + (size_t)NPROMPT * 384; j.ldk1 = 384; j.v1 = (bf16*)(big + B_KV) + (size_t)NPROMPT * 512 + 64; j.ldv1 = 512;
        j.k2 = (bf16*)(big + B_KB) + (size_t)NTOK * 384; j.ldk2 = 384; j.v2 = (bf16*)(big + B_KV) + (size_t)NTOK * 512 + 64; j.ldv2 = 512; j.kstride = 96; j.vstride = 128; j.kvgroup = 1;
        j.nbatch = 2; j.T = 4096; j.nk2 = 256; j.window = 0; j.sink = nullptr; j.scale = bscale; j.out = BRb + (size_t)NPROMPT * 1024; j.outcol = 256;
    }
    return j;
}

#define LDSP(smem) ((PG8_LAS unsigned char*)(smem))
__device__ __forceinline__ void ph_gemm_proj(const P& p, unsigned char* smem) {
    pg8::Gemm g{(bf16*)(p.ws + WS_H), (bf16*)(p.ws + WS_W + W_A), NTOK, 2304, 1024, 1024, 1024}; pg8::StaticOrder S; S.init(NTOK, 2304, gridDim.x, blockIdx.x);
    pg8::EpiStoreBf16 E{(bf16*)(p.ws + WS_BIG + B_PROJ), PLD, PLD};
    pg8::gemm_phase<pg8::EpiStoreBf16, pg8::StaticOrder, true, true>(LDSP(smem), g, S, E);
}
__device__ __forceinline__ void ph_gemm_mla(const P& p, unsigned char* smem) {
    unsigned char* big = p.ws + WS_BIG;
    { GemmArgs g{(bf16*)(big + B_CQ), (bf16*)(p.ws + WS_W + W_UQ), 192, 192, NTOK, 384, 192, 0}; EpiStore e{(bf16*)(big + B_QB), 384, 384}; gemm_tiles(g, e, smem); }
    { GemmArgs g{(bf16*)(big + B_CKV), (bf16*)(p.ws + WS_W + W_UKV), 128, 128, NKVROWS, 512, 128, 0}; EpiStore e{(bf16*)(big + B_KV), 512, 512}; gemm_tiles(g, e, smem); }
}
__device__ __forceinline__ void ph_gemm_br(const P& p, unsigned char* smem) {
    bf16* BRb = (bf16*)(p.ws + WS_BR); bf16* brb = (bf16*)(p.ws + WS_BIG + B_BRB);
#pragma unroll 1
    for (int m = 0; m < 4; ++m) {
        pg8::Gemm g{BRb + m * 256, (bf16*)(p.ws + WS_W + W_BR) + (size_t)m * 1024 * 256, NTOK, 1024, 256, 1024, 256}; pg8::StaticOrder S; S.init(NTOK, 1024, gridDim.x, blockIdx.x);
        pg8::EpiStoreBf16 E{brb + m * 1024, 4096, 1 << 30};
        pg8::gemm_phase<pg8::EpiStoreBf16, pg8::StaticOrder, true, true>(LDSP(smem), g, S, E);
    }
}
__device__ __forceinline__ void ph_gemm_gate(const P& p, unsigned char* smem) {
    pg8::Gemm g{(bf16*)(p.ws + WS_H), (bf16*)(p.ws + WS_W + W_G), NTOK, 4096, 1024, 1024, 1024}; pg8::StaticOrder S; S.init(NTOK, 4096, gridDim.x, blockIdx.x);
    pg8::EpiGateMix E{(const bf16*)(p.ws + WS_BIG + B_BRB), (bf16*)(p.ws + WS_BR)};
    pg8::gemm_phase<pg8::EpiGateMix, pg8::StaticOrder, true, true>(LDSP(smem), g, S, E);
}
__device__ __forceinline__ void ph_gemm_wo(const P& p, unsigned char* smem) {
    pg8::Gemm g{(bf16*)(p.ws + WS_BR), (bf16*)(p.ws + WS_W + W_O), NTOK, 1024, 1024, 1024, 1024}; pg8::StaticOrder S; S.init(NTOK, 1024, gridDim.x, blockIdx.x);
    pg8::EpiStoreBf16 E{(bf16*)(p.ws + WS_H), 1024, 1024};
    pg8::gemm_phase<pg8::EpiStoreBf16, pg8::StaticOrder, true, true>(LDSP(smem), g, S, E);
}
__device__ __forceinline__ void ph_gemm_up(const P& p, unsigned char* smem) {
    pg8::Gemm g{(bf16*)(p.ws + WS_H), (bf16*)(p.ws + WS_W + W_UP), NTOK, 5632, 1024, 1024, 1024}; pg8::StaticOrder S; S.init(NTOK, 5632, gridDim.x, blockIdx.x);
    pg8::EpiSwiglu E{(bf16*)(p.ws + WS_BIG + B_HID), DFF};
    pg8::gemm_phase<pg8::EpiSwiglu, pg8::StaticOrder, true, true>(LDSP(smem), g, S, E);
}
__device__ __forceinline__ void ph_gemm_down(const P& p, unsigned char* smem) {
    pg8::Gemm g{(bf16*)(p.ws + WS_BIG + B_HID), (bf16*)(p.ws + WS_W + W_DN), NTOK, 1024, DFF, DFF, DFF}; pg8::StaticOrder S; S.init(NTOK, 1024, gridDim.x, blockIdx.x);
    pg8::EpiStoreBf16 E{(bf16*)(p.ws + WS_BR), 1024, 1024};
    pg8::gemm_phase<pg8::EpiStoreBf16, pg8::StaticOrder, true, true>(LDSP(smem), g, S, E);
}
__device__ __forceinline__ void attn_dispatch(const P& p, int l, int variant, int blk, unsigned char* smem) {
    if (variant == 0) { const AttnJob j = make_job(p, l, 0); attn_mfma_item<64>(j, blk, smem); }
    else if (variant == 1) { const AttnJob j = make_job(p, l, 1); attn_mfma_item<64>(j, blk, smem); }
    else if (variant == 2) { const AttnJob j = make_job(p, l, 2); attn_mfma_item<96>(j, blk, smem); }
    else { const AttnJob j = make_job(p, l, 3); attn_mfma_item<96>(j, blk, smem); }
}
__device__ __forceinline__ void ph_mixers1(const P& p, int l, unsigned char* smem) {
    for (int item = blockIdx.x; item < 1024; item += gridDim.x) gdn_sample_prep_item(p, l, item, smem);
    for (int item = blockIdx.x; item < 768; item += gridDim.x) { const int vi = item >> 8; attn_dispatch(p, l, vi == 0 ? 1 : vi == 1 ? 2 : 0, item & 255, smem); }
    __syncthreads();
    ph_pool(p, l, smem);
}
__device__ __forceinline__ void ph_mixers2(const P& p, int l, unsigned char* smem) {
    const int nb = gridDim.x, bid = blockIdx.x;
    if (bid < 16) { gdn_sample_chain(p, l, bid, smem); return; }
    const int nw = nb - 16, wi = bid - 16;
    for (int item = wi; item < 384; item += nw) {
        if (item < 128) gdn_prompt_item(p, l, item, smem);
        else attn_dispatch(p, l, 3, item - 128, smem);
    }
}

#define GSYNC() grid.sync()
__global__ void __launch_bounds__(NT) mega(KArgs a) {
    extern __shared__ __attribute__((aligned(16))) unsigned char smem[];
    cg::grid_group grid = cg::this_grid();
    { const P p = fence_P(); ph_mod(p, smem); }
    __syncthreads();
    ph_convert(a.J[0], smem);
    GSYNC();
    { const P p = fence_P(); ph_prenorm(p, 0); }
    GSYNC();
#pragma unroll 1
    for (int l = 0; l < 2; ++l) {
        { const P p = fence_P(); ph_gemm_proj(p, smem); }
        GSYNC();
        { const P p = fence_P(); ph_postproj(p, l); }
        GSYNC();
        { const P p = fence_P(); ph_gemm_mla(p, smem); }
        GSYNC();
        { const P p = fence_P(); ph_prep2(p, l); }
        GSYNC();
        { const P p = fence_P(); ph_mixers1(p, l, smem); }
        GSYNC();
        { const P p = fence_P(); ph_mixers2(p, l, smem); }
        GSYNC();
        { const P p = fence_P(); ph_gdn_finalize(p, l); }
        GSYNC();
        { const P p = fence_P(); ph_gemm_br(p, smem); }
        GSYNC();
        { const P p = fence_P(); ph_gemm_gate(p, smem); }
        GSYNC();
        { const P p = fence_P(); ph_gemm_wo(p, smem); }
        GSYNC();
        { const P p = fence_P(); ph_post(p, l, 1); }
        GSYNC();
        { const P p = fence_P(); ph_gemm_up(p, smem); }
        GSYNC();
        { const P p = fence_P(); ph_gemm_down(p, smem); }
        GSYNC();
        { const P p = fence_P(); ph_post(p, l, 2); }
        if (l == 0) { __syncthreads(); ph_convert(a.J[1], smem); GSYNC(); }
    }
}

static void add_job(TJobs& J, const float* src, bf16* dst, int ldw, int K, int Ndst, int ldo, int mode, int arg, int nvalid) {
    TJob& j = J.j[J.n]; j.src = src; j.dst = dst; j.ldw = ldw; j.K = K; j.Ndst = Ndst; j.ldo = ldo; j.mode = mode; j.arg = arg; j.nvalid = nvalid; j.tile0 = J.total;
    J.total += (Ndst / 64) * (K / 64); J.n++;
}

extern "C" void kernel_launch(void* const* d_in, const int* in_sizes, int n_in, void* d_out, int out_size, void* d_ws, size_t ws_size, hipStream_t stream) {
    if (n_in != 32 || ws_size < WS_NEED) { fprintf(stderr, "kernel_launch: unexpected n_in %d or ws_size %zu (need %zu)\n", n_in, ws_size, (size_t)WS_NEED); return; }
    static int grid = 0;
    if (grid == 0) {
        int dev = 0, cus = 0, per_cu = 0;
        (void)hipGetDevice(&dev);
        (void)hipDeviceGetAttribute(&cus, hipDeviceAttributeMultiprocessorCount, dev);
        (void)hipFuncSetAttribute((const void*)mega, hipFuncAttributeMaxDynamicSharedMemorySize, LDS_BYTES);
        (void)hipOccupancyMaxActiveBlocksPerMultiprocessor(&per_cu, (const void*)mega, NT, LDS_BYTES);
        if (per_cu < 1) { fprintf(stderr, "kernel_launch: occupancy query says %d blocks/CU\n", per_cu); per_cu = 1; }
        if (per_cu > 1) per_cu = 1;
        grid = cus * per_cu;
    }
    KArgs a{};
    const float** pf = (const float**)&a.p;
    for (int i = 0; i < 32; ++i) pf[i] = (const float*)d_in[i];
    a.p.out = (float*)d_out; a.p.ws = (unsigned char*)d_ws;
    const P& p = a.p;
    bf16* Wb = (bf16*)(a.p.ws + WS_W);
    for (int l = 0; l < 2; ++l) {
        TJobs& J = a.J[l];
        add_job(J, p.w_in + (size_t)l * 1024 * PIN, (bf16*)((char*)Wb + W_A), PIN, 1024, 2304, 1024, 0, 0, 2160);
        add_job(J, p.w_in + (size_t)l * 1024 * PIN, (bf16*)((char*)Wb + W_G), PIN, 1024, 4096, 1024, 2, C_GATE, 4096);
        for (int m = 0; m < 4; ++m) add_job(J, p.w_br + ((size_t)l * 4 + m) * 256 * 1024, (bf16*)((char*)Wb + W_BR) + (size_t)m * 1024 * 256, 1024, 256, 1024, 256, 0, 0, 1024);
        add_job(J, p.w_o + (size_t)l * 1024 * 1024, (bf16*)((char*)Wb + W_O), 1024, 1024, 1024, 1024, 0, 0, 1024);
        add_job(J, p.w_up + (size_t)l * 1024 * 5632, (bf16*)((char*)Wb + W_UP), 5632, 1024, 5632, 1024, 1, 0, 5632);
        add_job(J, p.w_down + (size_t)l * DFF * 1024, (bf16*)((char*)Wb + W_DN), 1024, DFF, 1024, DFF, 0, 0, 1024);
        add_job(J, p.b_w_uq + (size_t)l * 192 * 384, (bf16*)((char*)Wb + W_UQ), 384, 192, 384, 192, 0, 0, 384);
        add_job(J, p.b_w_ukv + (size_t)l * 128 * 512, (bf16*)((char*)Wb + W_UKV), 512, 128, 512, 128, 0, 0, 512);
    }
    void* args[] = {&a};
    hipError_t e = hipLaunchCooperativeKernel((const void*)mega, dim3(grid), dim3(NT), args, LDS_BYTES, stream);
    if (e != hipSuccess) fprintf(stderr, "cooperative launch failed: %s (grid %d)\n", hipGetErrorString(e), grid);
}
```

```cpp
#include <hip/hip_runtime.h>
#include <hip/hip_cooperative_groups.h>
namespace cg = cooperative_groups;
#define NT 512
#define NWV 8
#define LDS_BYTES 147456
#include <stdint.h>
#include <stdio.h>

typedef unsigned short bf16;
typedef short bf16x8 __attribute__((ext_vector_type(8)));
typedef float f32x16 __attribute__((ext_vector_type(16)));

#define DM 1024
#define NTOK 16384
#define NPROMPT 8192
#define PLD 2176
#define C_AQ 0
#define C_AK 256
#define C_AV 384
#define C_BCQ 512
#define C_BCKV 704
#define C_BKR 832
#define C_CIN 864
#define C_DQKV 1120
#define C_DZ 1888
#define C_DBETA 2144
#define C_DALPHA 2152
#define C_GATE 2160
#define PIN 6256
#define DFF 2816
#define EPS 1e-6f
#define NKVROWS 16896

#define O_Y 0
#define O_CAK 16777216
#define O_CAV 18874368
#define O_CKV 20971520
#define O_KR 23068672
#define O_SF 23592960
#define O_SB 24641536

#define MB(x) ((size_t)(x) * 1024 * 1024)
#define WS_MOD 0
#define WS_TAB (WS_MOD + 147456)
#define WS_KAC (WS_TAB + 12288)
#define WS_VAC (WS_KAC + 512 * 128 * 2)
#define WS_GGC (WS_VAC + 512 * 128 * 2)
#define WS_BAR 786432
#define WS_W (MB(1))
#define W_A 0
#define W_G (W_A + 2304 * 1024 * 2)
#define W_BR (W_G + 4096 * 1024 * 2)
#define W_O (W_BR + 4 * 1024 * 256 * 2)
#define W_UP (W_O + 1024 * 1024 * 2)
#define W_DN (W_UP + 5632 * 1024 * 2)
#define W_UQ (W_DN + 1024 * 2816 * 2)
#define W_UKV (W_UQ + 384 * 192 * 2)
#define W_END (W_UKV + 512 * 128 * 2)
#define WS_H (MB(42))
#define WS_BR (MB(74))
#define WS_BIG (MB(106))
#define B_PROJ 0
#define B_CQ (B_PROJ + (size_t)16384 * 2176 * 2)
#define B_CKV (B_CQ + (size_t)16384 * 192 * 2)
#define B_QB (B_CKV + (size_t)16896 * 128 * 2)
#define B_KV (B_QB + (size_t)16384 * 384 * 2)
#define B_QA1S (B_KV + (size_t)16896 * 512 * 2)
#define B_KA1S (B_QA1S + (size_t)8192 * 256 * 2)
#define B_KB (B_KA1S + (size_t)8192 * 128 * 2)
#define B_GQK (B_KB + (size_t)16896 * 384 * 2)
#define B_GUW (B_GQK + (size_t)8192 * 512 * 2)
#define B_END_A (B_GUW + (size_t)1024 * 8192 * 2)
#define B_GOB B_CKV
#define B_BRB 0
#define B_HID 0
#define WS_NEED (WS_BIG + B_END_A)

struct P {
    const float *x_prompt, *x_sample, *cache_a_k, *cache_a_v, *cache_b_ckv, *cache_b_krope, *state_f, *state_b, *c, *c_ctx;
    const float *w_mod, *b_mod, *g_pre1, *g_post1, *g_pre2, *g_post2, *w_in, *a_sink, *b_g_cq, *b_g_ckv, *b_w_uq, *b_w_ukv;
    const float *c_w_pool, *c_scale, *d_conv, *d_a_log, *d_dt_bias, *d_g_norm, *w_br, *w_o, *w_up, *w_down;
    float* out;
    unsigned char* ws;
};


typedef const __attribute__((address_space(4))) unsigned char* kargp_t;
__device__ __forceinline__ P fence_P() {
    kargp_t kp = (kargp_t)__builtin_amdgcn_kernarg_segment_ptr();
    asm volatile("" : "+s"(kp));
    const __attribute__((address_space(4))) P* pp = (const __attribute__((address_space(4))) P*)kp;
    P q;
    q.x_prompt = pp->x_prompt;
    q.x_sample = pp->x_sample;
    q.cache_a_k = pp->cache_a_k;
    q.cache_a_v = pp->cache_a_v;
    q.cache_b_ckv = pp->cache_b_ckv;
    q.cache_b_krope = pp->cache_b_krope;
    q.state_f = pp->state_f;
    q.state_b = pp->state_b;
    q.c = pp->c;
    q.c_ctx = pp->c_ctx;
    q.w_mod = pp->w_mod;
    q.b_mod = pp->b_mod;
    q.g_pre1 = pp->g_pre1;
    q.g_post1 = pp->g_post1;
    q.g_pre2 = pp->g_pre2;
    q.g_post2 = pp->g_post2;
    q.w_in = pp->w_in;
    q.a_sink = pp->a_sink;
    q.b_g_cq = pp->b_g_cq;
    q.b_g_ckv = pp->b_g_ckv;
    q.b_w_uq = pp->b_w_uq;
    q.b_w_ukv = pp->b_w_ukv;
    q.c_w_pool = pp->c_w_pool;
    q.c_scale = pp->c_scale;
    q.d_conv = pp->d_conv;
    q.d_a_log = pp->d_a_log;
    q.d_dt_bias = pp->d_dt_bias;
    q.d_g_norm = pp->d_g_norm;
    q.w_br = pp->w_br;
    q.w_o = pp->w_o;
    q.w_up = pp->w_up;
    q.w_down = pp->w_down;
    q.out = pp->out;
    q.ws = pp->ws;
    return q;
}

__device__ __forceinline__ bf16 f2bf(float f) {
    unsigned u = __float_as_uint(f);
    u += 0x7fffu + ((u >> 16) & 1u);
    return (bf16)(u >> 16);
}
__device__ __forceinline__ float bf2f(bf16 h) { return __uint_as_float(((unsigned)h) << 16); }
__device__ __forceinline__ float wave_sum(float v) {
#pragma unroll
    for (int o = 32; o > 0; o >>= 1) v += __shfl_xor(v, o);
    return v;
}

__device__ __forceinline__ unsigned vzero() { unsigned z = 0; asm volatile("" : "+v"(z)); return z; }
__device__ __forceinline__ int tidx() { int t = threadIdx.x; asm volatile("" : "+v"(t)); return t; }
__device__ __forceinline__ float sigmoidf_(float x) { return 1.f / (1.f + __expf(-x)); }
__device__ __forceinline__ float siluf_(float x) { return x / (1.f + __expf(-x)); }

struct TJob { const float* src; bf16* dst; int ldw, K, Ndst, ldo, mode, arg, nvalid, tile0; };
struct TJobs { TJob j[16]; int n, total; };

__device__ __forceinline__ void ph_convert(const TJobs& J, unsigned char* smem) {
    float (*tile)[65] = (float (*)[65])smem;
    const int tid = tidx();
    for (int t = blockIdx.x; t < J.total; t += gridDim.x) {
        int ji = 0;
        for (int q = 1; q < J.n; ++q) if (t >= J.j[q].tile0) ji = q;
        const TJob jb = J.j[ji];
        const int local = t - jb.tile0, nkt = jb.K / 64, tn = local / nkt, tk = local % nkt;
        const int tx = tid & 63, ty = tid >> 6;
        const int n = tn * 64 + tx;
        int sc;
        if (jb.mode == 0) sc = (n < jb.nvalid) ? n + jb.arg : -1;
        else { const int pn = n >> 8, cc = n & 255, bj = cc >> 7, wc = (cc >> 5) & 3, nn = (cc >> 4) & 1, fq = (cc >> 2) & 3, ii = cc & 3;
            if (jb.mode == 1) sc = nn * DFF + pn * 128 + bj * 64 + wc * 16 + fq * 4 + ii;
            else sc = jb.arg + (2 * bj + nn) * 1024 + pn * 64 + wc * 16 + fq * 4 + ii; }
        for (int kk = ty; kk < 64; kk += NWV) tile[kk][tx] = (sc >= 0) ? jb.src[(size_t)(tk * 64 + kk) * jb.ldw + sc] : 0.f;
        __syncthreads();
        {
            const int q = tid, r = q >> 3, c8 = q & 7;
            unsigned w[4];
            for (int j = 0; j < 4; ++j) w[j] = (unsigned)f2bf(tile[c8 * 8 + 2 * j][r]) | ((unsigned)f2bf(tile[c8 * 8 + 2 * j + 1][r]) << 16);
            *(uint4*)(jb.dst + (size_t)(tn * 64 + r) * jb.ldo + tk * 64 + c8 * 8) = make_uint4(w[0], w[1], w[2], w[3]);
        }
        __syncthreads();
    }
}

__device__ __forceinline__ void ph_mod(const P& p, unsigned char* smem) {
    float (*cs)[1024] = (float (*)[1024])smem;
    float (*red)[3][64] = (float (*)[3][64])(smem + 3 * 1024 * 4);
    const int tid = tidx();
    float* mod = (float*)(p.ws + WS_MOD);
    for (int i = tid; i < 3072; i += NT) { const int r = i >> 10, k = i & 1023; const float v = (r == 0) ? p.c_ctx[k] : p.c[(r - 1) * 1024 + k]; cs[r][k] = siluf_(v); }
    __syncthreads();
    for (int it = blockIdx.x; it < 192; it += gridDim.x) {
        const int l = it / 96, cg = it % 96, col = cg * 64 + (tid & 63), kq = tid >> 6;
        float a0 = 0.f, a1 = 0.f, a2 = 0.f;
        const float* w = p.w_mod + ((size_t)l * 1024 + kq * 128) * 6144 + col;
        for (int k = 0; k < 128; ++k) { const float wv = w[(size_t)k * 6144]; a0 += cs[0][kq * 128 + k] * wv; a1 += cs[1][kq * 128 + k] * wv; a2 += cs[2][kq * 128 + k] * wv; }
        red[kq][0][tid & 63] = a0; red[kq][1][tid & 63] = a1; red[kq][2][tid & 63] = a2;
        __syncthreads();
        if (tid < 192) { const int r = tid >> 6, cc = tid & 63; const float s = red[0][r][cc] + red[1][r][cc] + red[2][r][cc] + red[3][r][cc] + red[4][r][cc] + red[5][r][cc] + red[6][r][cc] + red[7][r][cc] + p.b_mod[l * 6144 + cg * 64 + cc]; mod[(l * 3 + r) * 6144 + cg * 64 + cc] = s; }
        __syncthreads();
    }
    if (blockIdx.x == 0) {
        float* tab = (float*)(p.ws + WS_TAB);
        for (int i = tid; i < 64 * 16; i += NT) { const int pos = i >> 4, f = i & 15; const float inv = powf(10000.f, -(float)f / 16.f); float s, c; sincosf((float)pos * inv, &s, &c); tab[i] = c; tab[1024 + i] = s; }
        for (int i = tid; i < 64 * 8; i += NT) { const int pos = i >> 3, f = i & 7; const float inv = powf(10000.f, -(float)f / 8.f); float s, c; sincosf((float)pos * inv, &s, &c); tab[2048 + i] = c; tab[2560 + i] = s; }
    }
}

__device__ __forceinline__ const float* xrow_in(const P& p, int row) { return row < NPROMPT ? p.x_prompt + (size_t)row * DM : p.x_sample + (size_t)(row - NPROMPT) * DM; }
__device__ __forceinline__ int cond_row(int row) { return row < NPROMPT ? 0 : 1 + ((row - NPROMPT) >> 12); }

__device__ __forceinline__ void ph_prenorm(const P& p, int l) {
    const int lane = tidx() & 63;
    const float* mod = (const float*)(p.ws + WS_MOD);
    bf16* H = (bf16*)(p.ws + WS_H);
    for (int row = blockIdx.x * NWV + (tidx() >> 6); row < NTOK; row += gridDim.x * NWV) {
        const float* xr = (l == 0) ? xrow_in(p, row) : p.out + (size_t)row * DM;
        float4 v[4]; float ss = 0.f;
        for (int i = 0; i < 4; ++i) { v[i] = *(const float4*)(xr + i * 256 + lane * 4); ss += v[i].x * v[i].x + v[i].y * v[i].y + v[i].z * v[i].z + v[i].w * v[i].w; }
        ss = wave_sum(ss);
        const float rinv = rsqrtf(ss * (1.f / 1024.f) + EPS);
        const float* md = mod + (l * 3 + cond_row(row)) * 6144;
        for (int i = 0; i < 4; ++i) {
            const int col = i * 256 + lane * 4;
            const float4 g = *(const float4*)(p.g_pre1 + l * 1024 + col), sc = *(const float4*)(md + 1024 + col), sh = *(const float4*)(md + col);
            const float h0 = v[i].x * rinv * g.x * (1.f + sc.x) + sh.x, h1 = v[i].y * rinv * g.y * (1.f + sc.y) + sh.y;
            const float h2 = v[i].z * rinv * g.z * (1.f + sc.z) + sh.z, h3 = v[i].w * rinv * g.w * (1.f + sc.w) + sh.w;
            *(uint2*)(H + (size_t)row * DM + col) = make_uint2((unsigned)f2bf(h0) | ((unsigned)f2bf(h1) << 16), (unsigned)f2bf(h2) | ((unsigned)f2bf(h3) << 16));
        }
    }
}

__device__ __forceinline__ void ph_post(const P& p, int l, int which) {
    const int lane = tidx() & 63;
    const float* mod = (const float*)(p.ws + WS_MOD);
    bf16* H = (bf16*)(p.ws + WS_H);
    const bf16* src = (const bf16*)(p.ws + (which == 1 ? WS_H : WS_BR));
    const float* gpost = (which == 1 ? p.g_post1 : p.g_post2) + l * 1024;
    const int ga_off = which == 1 ? 2048 : 5120;
    const bool donext = (which == 1) || (l == 0);
    const int ln = which == 1 ? l : l + 1;
    const float* gpre = (which == 1 ? p.g_pre2 : p.g_pre1) + ln * 1024;
    const int sc_off = which == 1 ? 4096 : 1024, sh_off = which == 1 ? 3072 : 0;
    for (int row = blockIdx.x * NWV + (tidx() >> 6); row < NTOK; row += gridDim.x * NWV) {
        const float* xr = (l == 0 && which == 1) ? xrow_in(p, row) : p.out + (size_t)row * DM;
        const int cr = cond_row(row);
        const float* md = mod + (l * 3 + cr) * 6144;
        float4 x[4], s[4]; float ss = 0.f;
        for (int i = 0; i < 4; ++i) {
            const int col = i * 256 + lane * 4;
            x[i] = *(const float4*)(xr + col);
            const uint2 raw = *(const uint2*)(src + (size_t)row * DM + col);
            s[i] = make_float4(bf2f((bf16)(raw.x & 0xffff)), bf2f((bf16)(raw.x >> 16)), bf2f((bf16)(raw.y & 0xffff)), bf2f((bf16)(raw.y >> 16)));
            ss += s[i].x * s[i].x + s[i].y * s[i].y + s[i].z * s[i].z + s[i].w * s[i].w;
        }
        ss = wave_sum(ss);
        const float rinv = rsqrtf(ss * (1.f / 1024.f) + EPS);
        float ss2 = 0.f;
        for (int i = 0; i < 4; ++i) {
            const int col = i * 256 + lane * 4;
            const float4 g = *(const float4*)(gpost + col), ga = *(const float4*)(md + ga_off + col);
            x[i].x += ga.x * s[i].x * rinv * g.x; x[i].y += ga.y * s[i].y * rinv * g.y; x[i].z += ga.z * s[i].z * rinv * g.z; x[i].w += ga.w * s[i].w * rinv * g.w;
            *(float4*)(p.out + (size_t)row * DM + col) = x[i];
            ss2 += x[i].x * x[i].x + x[i].y * x[i].y + x[i].z * x[i].z + x[i].w * x[i].w;
        }
        if (donext) {
            ss2 = wave_sum(ss2);
            const float rinv2 = rsqrtf(ss2 * (1.f / 1024.f) + EPS);
            const float* md2 = mod + (ln * 3 + cr) * 6144;
            for (int i = 0; i < 4; ++i) {
                const int col = i * 256 + lane * 4;
                const float4 g = *(const float4*)(gpre + col), sc = *(const float4*)(md2 + sc_off + col), sh = *(const float4*)(md2 + sh_off + col);
                const float h0 = x[i].x * rinv2 * g.x * (1.f + sc.x) + sh.x, h1 = x[i].y * rinv2 * g.y * (1.f + sc.y) + sh.y;
                const float h2 = x[i].z * rinv2 * g.z * (1.f + sc.z) + sh.z, h3 = x[i].w * rinv2 * g.w * (1.f + sc.w) + sh.w;
                *(uint2*)(H + (size_t)row * DM + col) = make_uint2((unsigned)f2bf(h0) | ((unsigned)f2bf(h1) << 16), (unsigned)f2bf(h2) | ((unsigned)f2bf(h3) << 16));
            }
        }
    }
}

struct GemmArgs { const bf16* A; const bf16* Bt; int lda, ldb, M, N, K, pad; };

struct EpiStore {
    bf16* C; int ldc, nvalid;
    __device__ __forceinline__ void operator()(const f32x16 (&acc)[2][2], int rowbase, int colbase, int tn, int wn, int lane) const {
        _Pragma("unroll") for (int mi = 0; mi < 2; ++mi) _Pragma("unroll") for (int nj = 0; nj < 2; ++nj) {
            const int col = colbase + nj * 32 + (lane & 31);
            if (col < nvalid) _Pragma("unroll") for (int r = 0; r < 16; ++r) { const int row = rowbase + mi * 32 + (r & 3) + 8 * (r >> 2) + 4 * (lane >> 5); C[(size_t)row * ldc + col] = f2bf(acc[mi][nj][r]); }
        }
    }
};
struct EpiGate {
    bf16* C; int ldc;
    __device__ __forceinline__ void operator()(const f32x16 (&acc)[2][2], int rowbase, int colbase, int tn, int wn, int lane) const {
        _Pragma("unroll") for (int mi = 0; mi < 2; ++mi) _Pragma("unroll") for (int nj = 0; nj < 2; ++nj) {
            const int col = colbase + nj * 32 + (lane & 31);
            _Pragma("unroll") for (int r = 0; r < 16; ++r) { const int row = rowbase + mi * 32 + (r & 3) + 8 * (r >> 2) + 4 * (lane >> 5); bf16* q = C + (size_t)row * ldc + col; *q = f2bf(sigmoidf_(acc[mi][nj][r]) * bf2f(*q)); }
        }
    }
};
struct EpiSwiglu {
    bf16* C; int ldc;
    __device__ __forceinline__ void operator()(const f32x16 (&acc)[2][2], int rowbase, int colbase, int tn, int wn, int lane) const {
        const int col = tn * 64 + wn * 32 + (lane & 31);
        _Pragma("unroll") for (int mi = 0; mi < 2; ++mi) _Pragma("unroll") for (int r = 0; r < 16; ++r) {
            const int row = rowbase + mi * 32 + (r & 3) + 8 * (r >> 2) + 4 * (lane >> 5);
            C[(size_t)row * ldc + col] = f2bf(siluf_(acc[mi][0][r]) * acc[mi][1][r]);
        }
    }
};

template <class Epi>
__device__ __forceinline__ void gemm_tiles(const GemmArgs g, const Epi epi, unsigned char* smem) {
    const int vb = tidx() >> 8, tid = tidx() & 255, lane = tid & 63, w = tid >> 6, wm = w >> 1, wn = w & 1;
    bf16* As = (bf16*)(smem + vb * 65536);
    bf16* Bs = As + 2 * 128 * 64;
    const int nM = g.M / 128, nN = g.N / 128, nK = g.K / 64, ntiles = nM * nN;
    const int nvb = gridDim.x * 2, iters = (ntiles + nvb - 1) / nvb;
    for (int it = 0; it < iters; ++it) {
        const int t0 = it * nvb + blockIdx.x * 2 + vb;
        const bool valid = t0 < ntiles;
        const int t = valid ? t0 : 0;
        const int grp = t / (16 * nN), first = grp * 16, gsz = (nM - first) < 16 ? (nM - first) : 16, r0 = t - grp * 16 * nN;
        const int tm = first + r0 % gsz, tn = r0 / gsz;
        const bf16* Ag = g.A + (size_t)(tm * 128) * g.lda;
        const bf16* Bg = g.Bt + (size_t)(tn * 128) * g.ldb;
        typedef unsigned u32x4 __attribute__((ext_vector_type(4)));
        u32x4 ra0, ra1, ra2, ra3, rb0, rb1, rb2, rb3;
        f32x16 acc[2][2];
        _Pragma("unroll") for (int mi = 0; mi < 2; ++mi) _Pragma("unroll") for (int nj = 0; nj < 2; ++nj) _Pragma("unroll") for (int r = 0; r < 16; ++r) acc[mi][nj][r] = 0.f;
        const int lrow = tid >> 3, lch = tid & 7;
        const bf16* Ap = Ag + (size_t)lrow * g.lda + lch * 8;
        const bf16* Bp = Bg + (size_t)lrow * g.ldb + lch * 8;
        const size_t a32 = (size_t)32 * g.lda, b32 = (size_t)32 * g.ldb;
#define GLOAD(k0) { ra0 = *(const u32x4*)(Ap + (k0)); ra1 = *(const u32x4*)(Ap + a32 + (k0)); ra2 = *(const u32x4*)(Ap + 2 * a32 + (k0)); ra3 = *(const u32x4*)(Ap + 3 * a32 + (k0)); \
                    rb0 = *(const u32x4*)(Bp + (k0)); rb1 = *(const u32x4*)(Bp + b32 + (k0)); rb2 = *(const u32x4*)(Bp + 2 * b32 + (k0)); rb3 = *(const u32x4*)(Bp + 3 * b32 + (k0)); }
        GLOAD(0)
        const int soff = lrow * 64 + ((lch ^ (lrow & 7)) << 3);
        for (int kt = 0; kt < nK; ++kt) {
            bf16* Ab = As + (kt & 1) * 8192; bf16* Bb = Bs + (kt & 1) * 8192;
            *(u32x4*)(Ab + soff) = ra0; *(u32x4*)(Ab + soff + 2048) = ra1; *(u32x4*)(Ab + soff + 4096) = ra2; *(u32x4*)(Ab + soff + 6144) = ra3;
            *(u32x4*)(Bb + soff) = rb0; *(u32x4*)(Bb + soff + 2048) = rb1; *(u32x4*)(Bb + soff + 4096) = rb2; *(u32x4*)(Bb + soff + 6144) = rb3;
            __syncthreads();
            if (kt + 1 < nK) GLOAD((kt + 1) * 64)
#pragma unroll
            for (int kk = 0; kk < 4; ++kk) {
                bf16x8 a[2], b[2];
                const int ch = kk * 2 + (lane >> 5);
#pragma unroll
                for (int mi = 0; mi < 2; ++mi) { const int row = wm * 64 + mi * 32 + (lane & 31); a[mi] = *(const bf16x8*)(Ab + row * 64 + ((ch ^ (row & 7)) << 3)); }
#pragma unroll
                for (int nj = 0; nj < 2; ++nj) { const int row = wn * 64 + nj * 32 + (lane & 31); b[nj] = *(const bf16x8*)(Bb + row * 64 + ((ch ^ (row & 7)) << 3)); }
#pragma unroll
                for (int mi = 0; mi < 2; ++mi)
#pragma unroll
                    for (int nj = 0; nj < 2; ++nj) acc[mi][nj] = __builtin_amdgcn_mfma_f32_32x32x16_bf16(a[mi], b[nj], acc[mi][nj], 0, 0, 0);
            }
        }
        if (valid) epi(acc, tm * 128 + wm * 64, tn * 128 + wn * 64, tn, wn, lane);
        __syncthreads();
    }
}

namespace pg8 {
#define PG8_LAS __attribute__((address_space(3)))
typedef unsigned short bf16_t;
typedef short bf16x8 __attribute__((ext_vector_type(8)));
typedef float f32x4 __attribute__((ext_vector_type(4)));
typedef unsigned u32x4 __attribute__((ext_vector_type(4)));
constexpr int BM = 256, BK = 64, HALF = 128, HTB = HALF * BK * 2  , STAGE_BYTES = 8 * HTB, NXCD = 8, WGM = 8;

__host__ __device__ __forceinline__ int lds_byte(int r, int c) { const int st = (r >> 4) * 2 + (c >> 5), rr = r & 15, cc = c & 31, ob = rr * 64 + cc * 2; return st * 1024 + (ob ^ (((ob >> 9) & 1) << 5)); }
__host__ __device__ __forceinline__ void stage_rc(int b, int& R, int& C) { const int st = b / 1024, sb = b % 1024, swz = sb ^ (((sb >> 9) & 1) << 5); R = (st >> 1) * 16 + swz / 64; C = (st & 1) * 32 + (swz % 64) / 2; }
__host__ __device__ __forceinline__ int perm32(int rho) { const int n = rho >> 4, i = rho & 15; return 8 * (i >> 2) + 4 * n + (i & 3); }

struct Unit { int pm, pn; };
struct Gemm { const bf16_t* A; const bf16_t* Bt; int M, N, K, lda, ldb; };

struct StaticOrder {
    int nM, nN, nwg, G, c;
    __host__ __device__ void init(int M, int N, int G_, int c_) { nM = M / BM; nN = N / BM; nwg = nM * nN; G = G_; c = c_; }
    __host__ __device__ bool next(int i, Unit& u) const {
        const long L = (long)i * G + c; if (L >= nwg) return false;
        int wgid = (int)L; { const int q = nwg / NXCD, r = nwg % NXCD, xcd = wgid % NXCD, off = wgid / NXCD; wgid = (xcd < r ? xcd * (q + 1) : r * (q + 1) + (xcd - r) * q) + off; }
        const int nig = WGM * nN, gid = wgid / nig, fm = gid * WGM, gsz = (nM - fm) < WGM ? (nM - fm) : WGM;
        u.pm = fm + ((wgid % nig) % gsz); u.pn = (wgid % nig) / gsz; return true;
    }
    __device__ __forceinline__ void a_ready(const Unit&) const {}
    __device__ __forceinline__ void done(const Unit&) const {}
};

__device__ __forceinline__ unsigned cvt_pk_bf16(float lo, float hi) { unsigned r; asm volatile("v_cvt_pk_bf16_f32 %0, %1, %2" : "=v"(r) : "v"(lo), "v"(hi)); return r; }
template <class Epi, class Sched, bool ALIGN_EPI = false, bool SP2 = false>
__device__ __forceinline__ void gemm_phase(PG8_LAS unsigned char* lds, const Gemm g, const Sched& S, const Epi& E) {
    const int tid = tidx(), wid = __builtin_amdgcn_readfirstlane(tid >> 6), lane = tid & 63, wr = wid >> 2, wc = wid & 3, fr = lane & 15, fq = lane >> 4;
    const int K = g.K, nt = K / BK;
    unsigned voffA[2], voffB[2];
#pragma unroll
    for (int i = 0; i < 2; ++i) { int R, C; stage_rc(tid * 16 + i * 8192, R, C); const int Rb = Epi::PERM ? ((R & ~31) + perm32(R & 31)) : R;
        voffA[i] = (unsigned)(R * g.lda + C) * 2u; voffB[i] = (unsigned)(Rb * g.ldb + C) * 2u; }
    const size_t kstep = (size_t)(BK * 2);
    const size_t hstepA = (size_t)HALF * g.lda * 2, hstepB = (size_t)HALF * g.ldb * 2;
    const size_t tstepA = 2 * hstepA, tstepB = 2 * hstepB;
    const unsigned ldsw = (unsigned)wid * 1024u;
    const int aoff = lds_byte(wr * 64 + fr, fq * 8), boff = lds_byte(wc * 32 + fr, fq * 8);
#define PG8_SA(b, h) (((b) * 2 + (h)) * HTB)
#define PG8_SB(b, h) ((4 + (b) * 2 + (h)) * HTB)
#define PG8_STAGE(bufoff, gbase, voff) do { _Pragma("unroll") for (int _i = 0; _i < 2; ++_i) \
        __builtin_amdgcn_global_load_lds((const unsigned*)((const char*)(gbase) + (voff)[_i]), (PG8_LAS unsigned*)(lds + (bufoff) + ldsw + _i * 8192), 16, 0, 0); } while (0)
#define PG8_LDA(dst, b, h) do { _Pragma("unroll") for (int m = 0; m < 4; ++m) _Pragma("unroll") for (int k = 0; k < 2; ++k) dst[m][k] = *(const PG8_LAS bf16x8*)(lds + PG8_SA(b, h) + aoff + m * 2048 + k * 1024); } while (0)
#define PG8_LDB(dst, b, h) do { _Pragma("unroll") for (int n = 0; n < 2; ++n) _Pragma("unroll") for (int k = 0; k < 2; ++k) dst[n][k] = *(const PG8_LAS bf16x8*)(lds + PG8_SB(b, h) + boff + n * 2048 + k * 1024); } while (0)
#define PG8_MMA(ai, bj, At, Bt) do { __builtin_amdgcn_s_setprio(1); _Pragma("unroll") for (int m = 0; m < 4; ++m) _Pragma("unroll") for (int n = 0; n < 2; ++n) _Pragma("unroll") for (int k = 0; k < 2; ++k) \
        acc[ai][bj][m][n] = __builtin_amdgcn_mfma_f32_16x16x32_bf16(Bt[n][k], At[m][k], acc[ai][bj][m][n], 0, 0, 0); __builtin_amdgcn_s_setprio(0); } while (0)
#define PG8_WAIT_V(n) asm volatile("s_waitcnt vmcnt(" #n ")" ::: "memory")
#define PG8_WAIT_L(n) asm volatile("s_waitcnt lgkmcnt(" #n ")" ::: "memory")
#define PG8_BAR __builtin_amdgcn_s_barrier()
#define PG8_SCHED __builtin_amdgcn_sched_barrier(0)
    Unit cur, nxt; int ui = 0;
    if (!S.next(0, cur)) return;
    f32x4 acc[2][2][4][2];
#pragma unroll
    for (int a = 0; a < 2; ++a)
#pragma unroll
        for (int b = 0; b < 2; ++b)
#pragma unroll
            for (int m = 0; m < 4; ++m)
#pragma unroll
                for (int n = 0; n < 2; ++n) acc[a][b][m][n] = (f32x4){0.f, 0.f, 0.f, 0.f};
    bf16x8 At[4][2], B0[2][2], B1[2][2];
    const char* cA = (const char*)g.A + (size_t)cur.pm * tstepA; const char* cB = (const char*)g.Bt + (size_t)cur.pn * tstepB;
    S.a_ready(cur);
    if constexpr (SP2) {
        PG8_STAGE(PG8_SB(0, 0), cB, voffB); PG8_STAGE(PG8_SB(0, 1), cB + hstepB, voffB); PG8_STAGE(PG8_SA(0, 0), cA, voffA); PG8_STAGE(PG8_SA(0, 1), cA + hstepA, voffA);
        if (wr == 1) PG8_BAR;
        PG8_WAIT_V(2); PG8_BAR;
        PG8_STAGE(PG8_SB(1, 0), cB + kstep, voffB); PG8_STAGE(PG8_SA(1, 0), cA + kstep, voffA); PG8_STAGE(PG8_SB(1, 1), cB + hstepB + kstep, voffB);
        PG8_WAIT_V(6); PG8_BAR;
    } else {
        PG8_STAGE(PG8_SB(0, 0), cB, voffB); PG8_STAGE(PG8_SA(0, 0), cA, voffA); PG8_STAGE(PG8_SB(0, 1), cB + hstepB, voffB); PG8_STAGE(PG8_SA(0, 1), cA + hstepA, voffA);
        if (wr == 1) PG8_BAR;
        PG8_WAIT_V(4); PG8_BAR;
        PG8_STAGE(PG8_SB(1, 0), cB + kstep, voffB); PG8_STAGE(PG8_SA(1, 0), cA + kstep, voffA); PG8_STAGE(PG8_SB(1, 1), cB + hstepB + kstep, voffB);
        PG8_WAIT_V(6); PG8_BAR;
    }
    for (;;) {
        const bool has_next = S.next(ui + 1, nxt);
        const char* nA = has_next ? (const char*)g.A + (size_t)nxt.pm * tstepA : cA; const char* nB = has_next ? (const char*)g.Bt + (size_t)nxt.pn * tstepB : cB;
        for (int t = 0; t < nt; t += 2) {
            const bool last = (t == nt - 2);
            const char* a1 = cA + (size_t)(t + 1) * kstep;
            const char* a2 = last ? nA : cA + (size_t)(t + 2) * kstep; const char* b2 = last ? nB : cB + (size_t)(t + 2) * kstep;
            const char* a3 = a2 + kstep; const char* b3 = b2 + kstep;
            if (last && has_next) S.a_ready(nxt);
            if constexpr (SP2) {
            PG8_LDB(B0, 0, 0); PG8_LDB(B1, 0, 1); PG8_SCHED; PG8_LDA(At, 0, 0); PG8_STAGE(PG8_SA(1, 1), a1 + hstepA, voffA);
            PG8_WAIT_V(8); PG8_WAIT_L(0); PG8_BAR; PG8_MMA(0, 0, At, B0); PG8_MMA(0, 1, At, B1); PG8_BAR; PG8_SCHED;
            PG8_LDA(At, 0, 1); PG8_STAGE(PG8_SB(0, 0), b2, voffB); PG8_STAGE(PG8_SB(0, 1), b2 + hstepB, voffB); PG8_STAGE(PG8_SA(0, 0), a2, voffA);
            PG8_WAIT_V(8); PG8_WAIT_L(0); PG8_BAR; PG8_MMA(1, 0, At, B0); PG8_MMA(1, 1, At, B1); PG8_BAR; PG8_SCHED;
            PG8_LDB(B0, 1, 0); PG8_LDB(B1, 1, 1); PG8_SCHED; PG8_LDA(At, 1, 0); PG8_STAGE(PG8_SA(0, 1), a2 + hstepA, voffA);
            PG8_WAIT_V(8); PG8_WAIT_L(0); PG8_BAR; PG8_MMA(0, 0, At, B0); PG8_MMA(0, 1, At, B1); PG8_BAR; PG8_SCHED;
            PG8_LDA(At, 1, 1); PG8_STAGE(PG8_SB(1, 0), b3, voffB); PG8_STAGE(PG8_SB(1, 1), b3 + hstepB, voffB); PG8_STAGE(PG8_SA(1, 0), a3, voffA);
            PG8_WAIT_V(8); PG8_WAIT_L(0); PG8_BAR; PG8_MMA(1, 0, At, B0); PG8_MMA(1, 1, At, B1); PG8_BAR; PG8_SCHED;
            } else {
            PG8_LDB(B0, 0, 0); PG8_SCHED; PG8_LDA(At, 0, 0); PG8_STAGE(PG8_SA(1, 1), a1 + hstepA, voffA);
            PG8_WAIT_L(8); PG8_BAR; PG8_WAIT_L(0); PG8_MMA(0, 0, At, B0); PG8_BAR; PG8_SCHED;
            PG8_LDB(B1, 0, 1); PG8_STAGE(PG8_SB(0, 0), b2, voffB);
            PG8_BAR; PG8_WAIT_L(0); PG8_MMA(0, 1, At, B1); PG8_BAR;
            PG8_LDA(At, 0, 1); PG8_STAGE(PG8_SA(0, 0), a2, voffA);
            PG8_BAR; PG8_WAIT_L(0); PG8_MMA(1, 0, At, B0); PG8_BAR; PG8_SCHED;
            PG8_STAGE(PG8_SB(0, 1), b2 + hstepB, voffB);
            PG8_WAIT_V(6); PG8_BAR; PG8_MMA(1, 1, At, B1); PG8_BAR;
            PG8_LDB(B0, 1, 0); PG8_SCHED; PG8_LDA(At, 1, 0); PG8_STAGE(PG8_SA(0, 1), a2 + hstepA, voffA);
            PG8_WAIT_L(8); PG8_BAR; PG8_WAIT_L(0); PG8_MMA(0, 0, At, B0); PG8_BAR; PG8_SCHED;
            PG8_LDB(B1, 1, 1); PG8_STAGE(PG8_SB(1, 0), b3, voffB);
            PG8_BAR; PG8_WAIT_L(0); PG8_MMA(0, 1, At, B1); PG8_BAR;
            PG8_LDA(At, 1, 1); PG8_STAGE(PG8_SA(1, 0), a3, voffA);
            PG8_BAR; PG8_WAIT_L(0); PG8_MMA(1, 0, At, B0); PG8_BAR; PG8_SCHED;
            PG8_STAGE(PG8_SB(1, 1), b3 + hstepB, voffB);
            PG8_WAIT_V(6); PG8_BAR; PG8_MMA(1, 1, At, B1); PG8_BAR;
            }
        }
        if constexpr (ALIGN_EPI) { if (wr == 0) PG8_BAR; }
        if constexpr (!Epi::AFTER_DRAIN) { E(acc, cur, wr, wc, fr, fq); S.done(cur); }
        if (!has_next) break;
#pragma unroll
        for (int a = 0; a < 2; ++a)
#pragma unroll
            for (int b = 0; b < 2; ++b)
#pragma unroll
                for (int m = 0; m < 4; ++m)
#pragma unroll
                    for (int n = 0; n < 2; ++n) acc[a][b][m][n] = (f32x4){0.f, 0.f, 0.f, 0.f};
        cur = nxt; cA = nA; cB = nB; ++ui;
        if constexpr (ALIGN_EPI) { if (wr == 1) PG8_BAR; }
    }
    PG8_WAIT_V(0);
    if constexpr (!ALIGN_EPI) { if (wr == 0) PG8_BAR; }
    PG8_BAR;
    if constexpr (Epi::AFTER_DRAIN) { E.fused(acc, cur, wr, wc, fr, fq, lds, wid, lane); S.done(cur); }
#undef PG8_SA
#undef PG8_SB
#undef PG8_STAGE
#undef PG8_LDA
#undef PG8_LDB
#undef PG8_MMA
#undef PG8_WAIT_V
#undef PG8_WAIT_L
#undef PG8_BAR
#undef PG8_SCHED
}
}

namespace pg8 {
__device__ __forceinline__ float fsigmoid(float x) { return __builtin_amdgcn_rcpf(1.f + __expf(-x)); }
typedef unsigned u32x2 __attribute__((ext_vector_type(2)));
struct EpiStoreBf16 {
    static constexpr bool PERM = true, AFTER_DRAIN = false;
    bf16_t* O; int ldc, nvalid;
    __device__ __forceinline__ void operator()(const f32x4 (&acc)[2][2][4][2], const Unit& u, int wr, int wc, int fr, int fq) const {
        const int row0 = u.pm * BM + wr * 64 + fr, col0 = u.pn * BM + wc * 32 + 8 * fq;
#pragma unroll
        for (int ai = 0; ai < 2; ++ai)
#pragma unroll
            for (int m = 0; m < 4; ++m) { bf16_t* rowp = O + (size_t)(row0 + ai * HALF + m * 16) * ldc + col0;
#pragma unroll
                for (int bj = 0; bj < 2; ++bj) if (col0 + bj * HALF < nvalid) { const f32x4 v0 = acc[ai][bj][m][0], v1 = acc[ai][bj][m][1];
                    u32x4 w; w.x = cvt_pk_bf16(v0[0], v0[1]); w.y = cvt_pk_bf16(v0[2], v0[3]); w.z = cvt_pk_bf16(v1[0], v1[1]); w.w = cvt_pk_bf16(v1[2], v1[3]);
                    *(u32x4*)(rowp + bj * HALF) = w; } }
    }
};
struct EpiSwiglu {
    static constexpr bool PERM = false, AFTER_DRAIN = false;
    bf16_t* O; int ldc;
    __device__ __forceinline__ void operator()(const f32x4 (&acc)[2][2][4][2], const Unit& u, int wr, int wc, int fr, int fq) const {
        const int row0 = u.pm * BM + wr * 64 + fr, col0 = u.pn * 128 + wc * 16 + 4 * fq;
#pragma unroll
        for (int ai = 0; ai < 2; ++ai)
#pragma unroll
            for (int m = 0; m < 4; ++m) { bf16_t* rowp = O + (size_t)(row0 + ai * HALF + m * 16) * ldc + col0;
#pragma unroll
                for (int bj = 0; bj < 2; ++bj) { const f32x4 g = acc[ai][bj][m][0], v = acc[ai][bj][m][1];
                    u32x2 w; w.x = cvt_pk_bf16(g[0] * fsigmoid(g[0]) * v[0], g[1] * fsigmoid(g[1]) * v[1]); w.y = cvt_pk_bf16(g[2] * fsigmoid(g[2]) * v[2], g[3] * fsigmoid(g[3]) * v[3]);
                    *(u32x2*)(rowp + bj * 64) = w; } }
    }
};
struct EpiGateMix {
    static constexpr bool PERM = false, AFTER_DRAIN = false;
    const bf16_t* BRB; bf16_t* O;
    __device__ __forceinline__ void operator()(const f32x4 (&acc)[2][2][4][2], const Unit& u, int wr, int wc, int fr, int fq) const {
        const int row0 = u.pm * BM + wr * 64 + fr, d0 = u.pn * 64 + wc * 16 + 4 * fq;
#pragma unroll
        for (int ai = 0; ai < 2; ++ai)
#pragma unroll
            for (int m = 0; m < 4; ++m) { const size_t row = (size_t)(row0 + ai * HALF + m * 16);
                f32x4 s = {0.f, 0.f, 0.f, 0.f};
#pragma unroll
                for (int bj = 0; bj < 2; ++bj)
#pragma unroll
                    for (int n = 0; n < 2; ++n) { const u32x2 raw = *(const u32x2*)(BRB + row * 4096 + (2 * bj + n) * 1024 + d0); const f32x4 g = acc[ai][bj][m][n];
                        s[0] += fsigmoid(g[0]) * __uint_as_float(raw.x << 16); s[1] += fsigmoid(g[1]) * __uint_as_float(raw.x & 0xffff0000u);
                        s[2] += fsigmoid(g[2]) * __uint_as_float(raw.y << 16); s[3] += fsigmoid(g[3]) * __uint_as_float(raw.y & 0xffff0000u); }
                u32x2 w; w.x = cvt_pk_bf16(s[0], s[1]); w.y = cvt_pk_bf16(s[2], s[3]);
                *(u32x2*)(O + row * 1024 + d0) = w; }
    }
};
}

__device__ __forceinline__ void ph_postproj(const P& p, int l) {
    const int lane = tidx() & 63;
    const bf16* proj = (const bf16*)(p.ws + WS_BIG + B_PROJ);
    bf16* cq = (bf16*)(p.ws + WS_BIG + B_CQ);
    bf16* ckv = (bf16*)(p.ws + WS_BIG + B_CKV);
    for (int row = blockIdx.x * NWV + (tidx() >> 6); row < NKVROWS; row += gridDim.x * NWV) {
        if (row >= NTOK) {
            const int r = row - NTOK, b = r >> 8, s = r & 255;
            const float* src = p.cache_b_ckv + ((size_t)(b * 2 + l) * 256 + s) * 128;
            ckv[(size_t)row * 128 + lane] = f2bf(src[lane]); ckv[(size_t)row * 128 + 64 + lane] = f2bf(src[64 + lane]);
            continue;
        }
        const bf16* pr = proj + (size_t)row * PLD;
        float a0 = bf2f(pr[C_BCQ + lane]), a1 = bf2f(pr[C_BCQ + 64 + lane]), a2 = bf2f(pr[C_BCQ + 128 + lane]);
        float ss = wave_sum(a0 * a0 + a1 * a1 + a2 * a2);
        float rinv = rsqrtf(ss * (1.f / 192.f) + EPS);
        const float* gq = p.b_g_cq + l * 192;
        cq[(size_t)row * 192 + lane] = f2bf(a0 * rinv * gq[lane]); cq[(size_t)row * 192 + 64 + lane] = f2bf(a1 * rinv * gq[64 + lane]); cq[(size_t)row * 192 + 128 + lane] = f2bf(a2 * rinv * gq[128 + lane]);
        float k0 = bf2f(pr[C_BCKV + lane]), k1 = bf2f(pr[C_BCKV + 64 + lane]);
        ss = wave_sum(k0 * k0 + k1 * k1);
        rinv = rsqrtf(ss * (1.f / 128.f) + EPS);
        const float* gk = p.b_g_ckv + l * 128;
        k0 = k0 * rinv * gk[lane]; k1 = k1 * rinv * gk[64 + lane];
        ckv[(size_t)row * 128 + lane] = f2bf(k0); ckv[(size_t)row * 128 + 64 + lane] = f2bf(k1);
        if (row < NPROMPT) {
            const int b = row >> 8, s = row & 255;
            const size_t ci = (size_t)(b * 2 + l) * 256 + s;
            p.out[O_CKV + ci * 128 + lane] = k0; p.out[O_CKV + ci * 128 + 64 + lane] = k1;
            p.out[O_CAK + ci * 128 + lane] = bf2f(pr[C_AK + lane]); p.out[O_CAK + ci * 128 + 64 + lane] = bf2f(pr[C_AK + 64 + lane]);
            p.out[O_CAV + ci * 128 + lane] = bf2f(pr[C_AV + lane]); p.out[O_CAV + ci * 128 + 64 + lane] = bf2f(pr[C_AV + 64 + lane]);
            if (lane < 32) p.out[O_KR + ci * 32 + lane] = bf2f(pr[C_BKR + lane]);
        }
    }
}

__device__ __forceinline__ void ph_prep2(const P& p, int l) {
    const int lane = tidx() & 63;
    const float* tab = (const float*)(p.ws + WS_TAB);
    const bf16* proj = (const bf16*)(p.ws + WS_BIG + B_PROJ);
    const bf16* qb = (const bf16*)(p.ws + WS_BIG + B_QB);
    const bf16* kv = (const bf16*)(p.ws + WS_BIG + B_KV);
    bf16* qa1s = (bf16*)(p.ws + WS_BIG + B_QA1S);
    bf16* ka1s = (bf16*)(p.ws + WS_BIG + B_KA1S);
    bf16* qb1s = (bf16*)(p.ws + WS_BIG + B_CQ);
    bf16* kb = (bf16*)(p.ws + WS_BIG + B_KB);
    bf16* kac = (bf16*)(p.ws + WS_KAC);
    bf16* vac = (bf16*)(p.ws + WS_VAC);
    for (int row = blockIdx.x * NWV + (tidx() >> 6); row < NKVROWS; row += gridDim.x * NWV) {
        for (int h = 0; h < 4; ++h) kb[(size_t)row * 384 + h * 96 + lane] = kv[(size_t)row * 512 + h * 128 + lane];
        if (row >= NTOK) {
            const int r = row - NTOK, b = r >> 8, s = r & 255;
            if (lane < 32) { const bf16 v = f2bf(p.cache_b_krope[((size_t)(b * 2 + l) * 256 + s) * 32 + lane]); for (int h = 0; h < 4; ++h) kb[(size_t)row * 384 + h * 96 + 64 + lane] = v; }
            const size_t ci = ((size_t)(b * 2 + l) * 256 + s) * 128;
            kac[(size_t)r * 128 + lane] = f2bf(p.cache_a_k[ci + lane]); kac[(size_t)r * 128 + 64 + lane] = f2bf(p.cache_a_k[ci + 64 + lane]);
            vac[(size_t)r * 128 + lane] = f2bf(p.cache_a_v[ci + lane]); vac[(size_t)r * 128 + 64 + lane] = f2bf(p.cache_a_v[ci + 64 + lane]);
            continue;
        }
        const bf16* pr = proj + (size_t)row * PLD;
        if (row < NPROMPT) {
            if (lane < 32) { const bf16 v = pr[C_BKR + lane]; for (int h = 0; h < 4; ++h) kb[(size_t)row * 384 + h * 96 + 64 + lane] = v; }
            continue;
        }
        const int rs = row - NPROMPT, t = rs & 4095, gr = t >> 6, gc = t & 63;
        {
            if (lane < 32) {
                const int d = lane, qtr = d >> 3, f = d & 7, pos = (qtr < 2) ? gr : gc;
                const float c = tab[2048 + pos * 8 + f], s = tab[2560 + pos * 8 + f];
                const float x = bf2f(pr[C_BKR + d]);
                const float y = bf2f(pr[C_BKR + (d ^ 8)]);
                const float o = (qtr & 1) ? (x * c + y * s) : (x * c - y * s);
                const bf16 v = f2bf(o);
                for (int h = 0; h < 4; ++h) kb[(size_t)row * 384 + h * 96 + 64 + d] = v;
                for (int h = 0; h < 4; ++h) {
                    const float qx = bf2f(qb[(size_t)row * 384 + h * 96 + 64 + d]), qy = bf2f(qb[(size_t)row * 384 + h * 96 + 64 + (d ^ 8)]);
                    qb1s[(size_t)rs * 384 + h * 96 + 64 + d] = f2bf((qtr & 1) ? (qx * c + qy * s) : (qx * c - qy * s));
                }
            }
            for (int h = 0; h < 4; ++h) qb1s[(size_t)rs * 384 + h * 96 + lane] = qb[(size_t)row * 384 + h * 96 + lane];
        }
        {
            const int d = lane, qtr = d >> 4, f = d & 15, pos = (qtr < 2) ? gr : gc;
            const float c = tab[pos * 16 + f], s = tab[1024 + pos * 16 + f];
            for (int h = 0; h < 4; ++h) {
                const float x = bf2f(pr[C_AQ + h * 64 + d]), y = bf2f(pr[C_AQ + h * 64 + (d ^ 16)]);
                qa1s[(size_t)rs * 256 + h * 64 + d] = f2bf((qtr & 1) ? (x * c + y * s) : (x * c - y * s));
            }
            for (int h = 0; h < 2; ++h) {
                const float x = bf2f(pr[C_AK + h * 64 + d]), y = bf2f(pr[C_AK + h * 64 + (d ^ 16)]);
                ka1s[(size_t)rs * 128 + h * 64 + d] = f2bf((qtr & 1) ? (x * c + y * s) : (x * c - y * s));
            }
        }
    }
}

struct AttnJob {
    const bf16 *q1, *q2, *k1, *v1, *k2, *v2;
    const float* sink;
    bf16* out;
    int ldq1, ldq2, ldk1, ldv1, ldk2, ldv2;
    int kstride, vstride, kvgroup, nbatch, T, nk2, window, outcol;
    float scale; int pad;
};

template <int DQK>
__device__ __forceinline__ void attn_item(const AttnJob& j, int blk, unsigned char* smem) {
    float* Ks = (float*)smem;
    float* Vs = Ks + 32 * DQK;
    const int tid = tidx(), eh = (tid >> 8) * 32;
    const int nqb = j.T / 256;
    const int b = blk / (4 * nqb), h = (blk / nqb) % 4, qb0 = (blk % nqb) * 256;
    const int kh = h / j.kvgroup;
    const int t = qb0 + (tid & 255);
    float q[DQK], o[32];
    float m = -1e30f, lsum = 0.f;
#pragma unroll
    for (int e = 0; e < 32; ++e) o[e] = 0.f;
    for (int set = 0; set < 2; ++set) {
        if (set == 1 && j.nk2 == 0) break;
        const bf16* qp = (set == 0) ? j.q1 + ((size_t)b * j.T + t) * j.ldq1 + h * DQK : j.q2 + ((size_t)b * j.T + t) * j.ldq2 + h * DQK;
#pragma unroll
        for (int d = 0; d < DQK; d += 4) { const uint2 raw = *(const uint2*)(qp + d); q[d] = bf2f((bf16)(raw.x & 0xffff)) * j.scale; q[d + 1] = bf2f((bf16)(raw.x >> 16)) * j.scale; q[d + 2] = bf2f((bf16)(raw.y & 0xffff)) * j.scale; q[d + 3] = bf2f((bf16)(raw.y >> 16)) * j.scale; }
        const bf16* kp = (set == 0) ? j.k1 + (size_t)b * j.T * j.ldk1 + kh * j.kstride : j.k2 + (size_t)b * j.nk2 * j.ldk2 + kh * j.kstride;
        const bf16* vp = (set == 0) ? j.v1 + (size_t)b * j.T * j.ldv1 + kh * j.vstride : j.v2 + (size_t)b * j.nk2 * j.ldv2 + kh * j.vstride;
        const int ldk = (set == 0) ? j.ldk1 : j.ldk2, ldv = (set == 0) ? j.ldv1 : j.ldv2;
        int kbeg = 0, kend = (set == 0) ? j.T : j.nk2;
        const bool win = (set == 0) && j.window;
        if (win) { kbeg = qb0 - 128 < 0 ? 0 : qb0 - 128; kend = qb0 + 256 + 128 > j.T ? j.T : qb0 + 256 + 128; }
        for (int ks = kbeg; ks < kend; ks += 32) {
            __syncthreads();
            for (int e = tid; e < 32 * DQK / 4; e += NT) {
                const int key = e / (DQK / 4), c4 = e % (DQK / 4), s = ks + key;
                float4 val = make_float4(0.f, 0.f, 0.f, 0.f);
                if (s < kend) { const uint2 raw = *(const uint2*)(kp + (size_t)s * ldk + c4 * 4); val = make_float4(bf2f((bf16)(raw.x & 0xffff)), bf2f((bf16)(raw.x >> 16)), bf2f((bf16)(raw.y & 0xffff)), bf2f((bf16)(raw.y >> 16))); }
                *(float4*)&Ks[key * DQK + c4 * 4] = val;
            }
            for (int e = tid; e < 32 * 16; e += NT) {
                const int key = e >> 4, c4 = e & 15, s = ks + key;
                float4 val = make_float4(0.f, 0.f, 0.f, 0.f);
                if (s < kend) { const uint2 raw = *(const uint2*)(vp + (size_t)s * ldv + c4 * 4); val = make_float4(bf2f((bf16)(raw.x & 0xffff)), bf2f((bf16)(raw.x >> 16)), bf2f((bf16)(raw.y & 0xffff)), bf2f((bf16)(raw.y >> 16))); }
                *(float4*)&Vs[key * 64 + c4 * 4] = val;
            }
            __syncthreads();
            const int nk = (kend - ks) < 32 ? (kend - ks) : 32;
            for (int key = 0; key < nk; ++key) {
                const int s = ks + key;
                if (win) { const int dlt = t - s; if (dlt > 128 || dlt < -128) continue; }
                float sc = 0.f;
#pragma unroll
                for (int d = 0; d < DQK; d += 4) { const float4 kk = *(const float4*)&Ks[key * DQK + d]; sc += q[d] * kk.x + q[d + 1] * kk.y + q[d + 2] * kk.z + q[d + 3] * kk.w; }
                if (sc > m) { const float c = __expf(m - sc); lsum *= c;
#pragma unroll
                    for (int e = 0; e < 32; ++e) o[e] *= c;
                    m = sc; }
                const float pp = __expf(sc - m);
                lsum += pp;
#pragma unroll
                for (int e = 0; e < 32; e += 4) { const float4 vv = *(const float4*)&Vs[key * 64 + eh + e]; o[e] += pp * vv.x; o[e + 1] += pp * vv.y; o[e + 2] += pp * vv.z; o[e + 3] += pp * vv.w; }
            }
        }
    }
    if (j.sink) {
        const float sk = j.sink[h];
        const float mf = sk > m ? sk : m;
        const float c = __expf(m - mf);
        lsum = lsum * c + __expf(sk - mf);
#pragma unroll
        for (int e = 0; e < 32; ++e) o[e] *= c;
    }
    const float inv = 1.f / lsum;
    bf16* op = j.out + ((size_t)b * j.T + t) * 1024 + j.outcol + h * 64 + eh;
#pragma unroll
    for (int e = 0; e < 32; e += 2) *(unsigned*)(op + e) = (unsigned)f2bf(o[e] * inv) | ((unsigned)f2bf(o[e + 1] * inv) << 16);
}

__device__ __forceinline__ void ph_pool(const P& p, int l, unsigned char* smem) {
    float (*df)[257] = (float (*)[257])smem;
    const int tid = tidx(), half = tid >> 8, c256 = tid & 255;
    const bf16* proj = (const bf16*)(p.ws + WS_BIG + B_PROJ);
    bf16* br = (bf16*)(p.ws + WS_BR);
    for (int tile = blockIdx.x; tile < NTOK / 32; tile += gridDim.x) {
        const int row0 = tile * 32;
        int base, T;
        if (row0 < NPROMPT) { base = (row0 >> 8) << 8; T = 256; } else { base = NPROMPT + (((row0 - NPROMPT) >> 12) << 12); T = 4096; }
        __syncthreads();
        {
            const int c = c256, g = c >> 6, hw = 1 << g;
            for (int i = half * 16; i < half * 16 + 16; ++i) {
                const int t = row0 + i - base;
                const int lo = t - hw < 0 ? 0 : t - hw, hi = t + hw > T ? T : t + hw;
                float sacc = 0.f;
                for (int u = lo; u < hi; ++u) sacc += bf2f(proj[(size_t)(base + u) * PLD + C_CIN + c]);
                df[i][c] = sacc / (float)(hi - lo) - bf2f(proj[(size_t)(base + t) * PLD + C_CIN + c]);
            }
        }
        __syncthreads();
        {
            const int g = c256 >> 6, d = c256 & 63;
            float acc[16];
#pragma unroll
            for (int i = 0; i < 16; ++i) acc[i] = 0.f;
            const float* wp = p.c_w_pool + ((size_t)(l * 4 + g) * 64) * 64 + d;
            for (int c = 0; c < 64; ++c) {
                const float w = wp[c * 64];
#pragma unroll
                for (int i = 0; i < 16; ++i) acc[i] += df[half * 16 + i][g * 64 + c] * w;
            }
            const float sc = p.c_scale[l * 256 + c256];
#pragma unroll
            for (int i = 0; i < 16; ++i) br[(size_t)(row0 + half * 16 + i) * 1024 + 512 + c256] = f2bf(acc[i] * sc);
        }
    }
}

#define GS_KN 0
#define GS_QN 8192
#define GS_W 16384
#define GS_QG 24576
#define GS_KDT 32768
#define GS_ST 49152
#define GS_VNT 57344
#define GS_A 65536
#define GS_U 73728
#define GS_V 90112
#define GS_L 107520
#define GS_SM 123904

__device__ __forceinline__ int swz(int r, int c) { return r * 64 + ((((c) >> 3) ^ (r & 7)) << 3) + (c & 7); }
__device__ __forceinline__ unsigned pk2(float a, float b) { return (unsigned)f2bf(a) | ((unsigned)f2bf(b) << 16); }

__device__ __forceinline__ f32x16 mm_tile(const bf16* A, int m0, const bf16* B, int n0, f32x16 acc, int lane) {
    const int ra = m0 + (lane & 31), rb = n0 + (lane & 31), hh = lane >> 5;
#pragma unroll
    for (int kk = 0; kk < 4; ++kk) {
        const int ch = kk * 2 + hh;
        const bf16x8 a = *(const bf16x8*)(A + ra * 64 + ((ch ^ (ra & 7)) << 3));
        const bf16x8 b = *(const bf16x8*)(B + rb * 64 + ((ch ^ (rb & 7)) << 3));
        acc = __builtin_amdgcn_mfma_f32_32x32x16_bf16(a, b, acc, 0, 0, 0);
    }
    return acc;
}
__device__ __forceinline__ f32x16 zero16() { f32x16 z; _Pragma("unroll") for (int r = 0; r < 16; ++r) z[r] = 0.f; return z; }

struct GdnCtx { int base, T, h, dir, cidx, l; };

__device__ __forceinline__ void gdn_prep(const P& p, const GdnCtx& c, unsigned char* smem_) {
    unsigned char* smem = smem_ + vzero();
    const int tid = tidx(), lane = tid & 63, wv = tid >> 6;
    bf16* KN = (bf16*)(smem + GS_KN); bf16* QN = (bf16*)(smem + GS_QN); bf16* Wl = (bf16*)(smem + GS_W);
    float* Ul = (float*)(smem + GS_U); float* Vl = (float*)(smem + GS_V); float* Lm = (float*)(smem + GS_L);
    float* gcs = (float*)(smem + GS_SM); float* betas = gcs + 64; float* qdec = gcs + 128; float* kdec = gcs + 192; float* bexp = gcs + 256;
    const bf16* proj = (const bf16*)(p.ws + WS_BIG + B_PROJ);
    const float* convw = p.d_conv + (size_t)c.l * 5 * 768;
#pragma unroll 1
    for (int r = 0; r < 3; ++r) {
        const int w = tid + NT * r, i = w / 24, rem = w - i * 24, part = rem >> 3, g8 = rem & 7;
        const int tt = c.cidx * 64 + (c.dir ? 63 - i : i);
        const int ch = part * 256 + c.h * 64 + g8 * 8;
        float u[8];
#pragma unroll
        for (int k = 0; k < 8; ++k) u[k] = 0.f;
#pragma unroll
        for (int j = 0; j < 5; ++j) {
            const int ts = tt + j - 2;
            if (ts >= 0 && ts < c.T) {
                const uint4 raw = *(const uint4*)(proj + (size_t)(c.base + ts) * PLD + C_DQKV + ch);
                const float4 w0 = *(const float4*)(convw + j * 768 + ch), w1 = *(const float4*)(convw + j * 768 + ch + 4);
                u[0] += w0.x * bf2f((bf16)(raw.x & 0xffff)); u[1] += w0.y * bf2f((bf16)(raw.x >> 16)); u[2] += w0.z * bf2f((bf16)(raw.y & 0xffff)); u[3] += w0.w * bf2f((bf16)(raw.y >> 16));
                u[4] += w1.x * bf2f((bf16)(raw.z & 0xffff)); u[5] += w1.y * bf2f((bf16)(raw.z >> 16)); u[6] += w1.z * bf2f((bf16)(raw.w & 0xffff)); u[7] += w1.w * bf2f((bf16)(raw.w >> 16));
            }
        }
        float ss = 0.f;
#pragma unroll
        for (int k = 0; k < 8; ++k) { u[k] = siluf_(u[k]); ss += u[k] * u[k]; }
        ss += __shfl_xor(ss, 1); ss += __shfl_xor(ss, 2); ss += __shfl_xor(ss, 4);
        if (part < 2) {
            const float sc = rsqrtf(ss + EPS) * (part == 0 ? 0.125f : 1.f);
            bf16* dst = (part == 0 ? QN : KN) + i * 64 + ((g8 ^ (i & 7)) << 3);
            *(uint4*)dst = make_uint4(pk2(u[0] * sc, u[1] * sc), pk2(u[2] * sc, u[3] * sc), pk2(u[4] * sc, u[5] * sc), pk2(u[6] * sc, u[7] * sc));
        } else {
            *(float4*)(Vl + i * 68 + g8 * 8) = make_float4(u[0], u[1], u[2], u[3]);
            *(float4*)(Vl + i * 68 + g8 * 8 + 4) = make_float4(u[4], u[5], u[6], u[7]);
        }
    }
    if (wv == 0) {
        const int i = lane, tt = c.cidx * 64 + (c.dir ? 63 - i : i);
        const bf16* pr = proj + (size_t)(c.base + tt) * PLD;
        const float Aexp = expf(p.d_a_log[(c.l * 2 + c.dir) * 4 + c.h]), dtb = p.d_dt_bias[(c.l * 2 + c.dir) * 4 + c.h];
        const float beta = sigmoidf_(bf2f(pr[C_DBETA + c.dir * 4 + c.h]));
        const float al = bf2f(pr[C_DALPHA + c.dir * 4 + c.h]) + dtb;
        float g = -Aexp * (al > 20.f ? al : log1pf(expf(al)));
#pragma unroll
        for (int o = 1; o < 64; o <<= 1) { const float t = __shfl_up(g, o); if (lane >= o) g += t; }
        const float g63 = __shfl(g, 63);
        const float eg = expf(g);
        gcs[i] = g; betas[i] = beta; qdec[i] = eg; kdec[i] = expf(g63 - g); bexp[i] = beta * eg;
    }
    __syncthreads();
    if (wv < 4) {
        const int mt = wv >> 1, nt = wv & 1, hh = lane >> 5, j = nt * 32 + (lane & 31);
        f32x16 acc = zero16();
        if (nt <= mt) acc = mm_tile(KN, mt * 32, KN, nt * 32, acc, lane);
        const float gj = gcs[j];
#pragma unroll
        for (int r = 0; r < 16; ++r) {
            const int i = mt * 32 + (r & 3) + 8 * (r >> 2) + 4 * hh;
            Lm[i * 64 + j] = (j < i) ? betas[i] * acc[r] * __expf(gcs[i] - gj) : 0.f;
        }
    }
    __syncthreads();
    if (wv < 2) {
        const int col = lane; const bool isW = wv == 1;
        float x[64];
#pragma unroll
        for (int i = 0; i < 64; ++i) x[i] = isW ? bf2f(KN[swz(i, col)]) * bexp[i] : Vl[i * 68 + col] * betas[i];
#pragma unroll
        for (int i = 1; i < 64; ++i) {
            float a = x[i];
#pragma unroll
            for (int j4 = 0; j4 < (i + 3) / 4; ++j4) {
                const float4 lv = *(const float4*)&Lm[i * 64 + j4 * 4];
                a -= lv.x * x[j4 * 4]; a -= lv.y * x[j4 * 4 + 1]; a -= lv.z * x[j4 * 4 + 2]; a -= lv.w * x[j4 * 4 + 3];
            }
            x[i] = a;
        }
        if (isW) {
#pragma unroll
            for (int i = 0; i < 64; ++i) Wl[swz(i, col)] = f2bf(x[i]);
        } else {
#pragma unroll
            for (int i = 0; i < 64; ++i) Ul[i * 64 + col] = x[i];
        }
    }
    __syncthreads();
}

__device__ __forceinline__ void gdn_t0(unsigned char* smem_, int kb) {
    unsigned char* smem = smem_ + vzero();
    const int tid = tidx(), i = tid >> 3, cc = tid & 7;
    const bf16* KN = (const bf16*)(smem + GS_KN); const bf16* QN = (const bf16*)(smem + GS_QN);
    bf16* QG = (bf16*)(smem + GS_QG); bf16* KDT = (bf16*)(smem + GS_KDT + kb * 8192);
    const float* gcs = (const float*)(smem + GS_SM); const float qd = gcs[128 + i], kd = gcs[192 + i];
    const int off = i * 64 + ((cc ^ (i & 7)) << 3);
    const uint4 q = *(const uint4*)(QN + off), k = *(const uint4*)(KN + off);
    const unsigned qa[4] = {q.x, q.y, q.z, q.w}, ka[4] = {k.x, k.y, k.z, k.w};
    unsigned qo[4];
#pragma unroll
    for (int t = 0; t < 4; ++t) {
        qo[t] = pk2(bf2f((bf16)(qa[t] & 0xffff)) * qd, bf2f((bf16)(qa[t] >> 16)) * qd);
        KDT[swz(cc * 8 + 2 * t, i)] = f2bf(bf2f((bf16)(ka[t] & 0xffff)) * kd);
        KDT[swz(cc * 8 + 2 * t + 1, i)] = f2bf(bf2f((bf16)(ka[t] >> 16)) * kd);
    }
    *(uint4*)(QG + off) = make_uint4(qo[0], qo[1], qo[2], qo[3]);
}

__device__ __forceinline__ void gdn_t12(const P& p, const GdnCtx& c, unsigned char* smem_, int kb, f32x16& Sreg, int mode) {
    unsigned char* smem = smem_ + vzero();
    const int tid = tidx(), lane = tid & 63, wv = tid >> 6, hh = lane >> 5, l31 = lane & 31;
    const bf16* KN = (const bf16*)(smem + GS_KN); const bf16* QN = (const bf16*)(smem + GS_QN); const bf16* Wl = (const bf16*)(smem + GS_W);
    const bf16* QG = (const bf16*)(smem + GS_QG); const bf16* KDT = (const bf16*)(smem + GS_KDT + kb * 8192);
    bf16* ST = (bf16*)(smem + GS_ST); bf16* VNT = (bf16*)(smem + GS_VNT); bf16* Al = (bf16*)(smem + GS_A);
    const float* Ul = (const float*)(smem + GS_U); const float* gcs = (const float*)(smem + GS_SM);
    f32x16 O0 = zero16(), O1 = zero16();
    const float gl = gcs[128 + 63];
    if (wv < 4) {
        const int mt = wv >> 1, nt = wv & 1, e = nt * 32 + l31;
        f32x16 acc = mm_tile(Wl, mt * 32, ST, nt * 32, zero16(), lane);
#pragma unroll
        for (int rg = 0; rg < 4; ++rg) {
            const int i0 = mt * 32 + 8 * rg + 4 * hh;
            const float v0 = Ul[(i0) * 64 + e] - acc[rg * 4], v1 = Ul[(i0 + 1) * 64 + e] - acc[rg * 4 + 1], v2 = Ul[(i0 + 2) * 64 + e] - acc[rg * 4 + 2], v3 = Ul[(i0 + 3) * 64 + e] - acc[rg * 4 + 3];
            *(uint2*)(VNT + swz(e, i0)) = make_uint2(pk2(v0, v1), pk2(v2, v3));
        }
    } else if (wv < 6) {
        const int mt = wv - 4;
        O0 = mm_tile(QG, mt * 32, ST, 0, O0, lane);
        O1 = mm_tile(QG, mt * 32, ST, 32, O1, lane);
    } else {
        const int mt = wv - 6;
#pragma unroll
        for (int nt = 0; nt < 2; ++nt) {
            f32x16 acc = zero16();
            if (nt <= mt) acc = mm_tile(QN, mt * 32, KN, nt * 32, acc, lane);
            const int j = nt * 32 + l31; const float gj = gcs[j];
#pragma unroll
            for (int r = 0; r < 16; ++r) {
                const int i = mt * 32 + (r & 3) + 8 * (r >> 2) + 4 * hh;
                Al[swz(i, j)] = f2bf((j <= i) ? acc[r] * __expf(gcs[i] - gj) : 0.f);
            }
        }
    }
    __syncthreads();
    if (wv < 4) {
        const int mt = wv >> 1, nt = wv & 1, e = nt * 32 + l31;
#pragma unroll
        for (int r = 0; r < 16; ++r) Sreg[r] *= gl;
        Sreg = mm_tile(KDT, mt * 32, VNT, nt * 32, Sreg, lane);
#pragma unroll
        for (int rg = 0; rg < 4; ++rg) {
            const int d0 = mt * 32 + 8 * rg + 4 * hh;
            *(uint2*)(ST + swz(e, d0)) = make_uint2(pk2(Sreg[rg * 4], Sreg[rg * 4 + 1]), pk2(Sreg[rg * 4 + 2], Sreg[rg * 4 + 3]));
        }
    } else if (wv < 6) {
        const int mt = wv - 4;
        O0 = mm_tile(Al, mt * 32, VNT, 0, O0, lane);
        O1 = mm_tile(Al, mt * 32, VNT, 32, O1, lane);
        bf16* br = (bf16*)(p.ws + WS_BR);
        bf16* gob = (bf16*)(p.ws + WS_BIG + B_GOB);
        const bf16* proj = (const bf16*)(p.ws + WS_BIG + B_PROJ);
#pragma unroll
        for (int r = 0; r < 16; ++r) {
            const int i = mt * 32 + (r & 3) + 8 * (r >> 2) + 4 * hh;
            const int tt = c.cidx * 64 + (c.dir ? 63 - i : i);
            const size_t row = (size_t)(c.base + tt);
            bf16* b0 = br + row * 1024 + 768 + c.h * 64 + l31;
            if (mode == 0) { b0[0] = f2bf(O0[r]); b0[32] = f2bf(O1[r]); }
            else if (mode == 1) { bf16* g0 = gob + (row - NPROMPT) * 256 + c.h * 64 + l31; g0[0] = f2bf(O0[r]); g0[32] = f2bf(O1[r]); }
            else {
                const float a0 = O0[r] + bf2f(b0[0]), a1 = O1[r] + bf2f(b0[32]);
                float ss = a0 * a0 + a1 * a1;
                ss += __shfl_xor(ss, 1); ss += __shfl_xor(ss, 2); ss += __shfl_xor(ss, 4); ss += __shfl_xor(ss, 8); ss += __shfl_xor(ss, 16);
                const float rinv = rsqrtf(ss * (1.f / 64.f) + EPS);
                const bf16* zp = proj + row * PLD + C_DZ + c.h * 64 + l31;
                b0[0] = f2bf(a0 * rinv * p.d_g_norm[c.l * 64 + l31] * siluf_(bf2f(zp[0])));
                b0[32] = f2bf(a1 * rinv * p.d_g_norm[c.l * 64 + 32 + l31] * siluf_(bf2f(zp[32])));
            }
        }
    }
}

__device__ __forceinline__ void gdn_prompt_item(const P& p, int l, int item, unsigned char* smem_) {
    unsigned char* smem = smem_ + vzero();
    const int tid = tidx(), lane = tid & 63, wv = tid >> 6, hh = lane >> 5, l31 = lane & 31;
    const int b = item >> 2, h = item & 3;
    bf16* ST = (bf16*)(smem + GS_ST);
    f32x16 Sreg = zero16();
    int kb = 0;
#pragma unroll 1
    for (int s = 0; s < 8; ++s) {
        const int dir = s >> 2, n = s & 3;
        GdnCtx c; c.base = b * 256; c.T = 256; c.h = h; c.dir = dir; c.cidx = dir ? 3 - n : n; c.l = l;
        __syncthreads();
        if (n == 0) {
            Sreg = zero16();
            for (int q = tid; q < 2048; q += NT) ((unsigned*)ST)[q] = 0u;
        }
        gdn_prep(p, c, smem);
        gdn_t0(smem, kb);
        __syncthreads();
        gdn_t12(p, c, smem, kb, Sreg, dir ? 2 : 0);
        kb ^= 1;
        if (n == 3 && wv < 4) {
            const int mt = wv >> 1, nt = wv & 1;
            float* so = p.out + (dir ? O_SB : O_SF) + ((size_t)(b * 2 + l) * 4 + h) * 4096;
#pragma unroll
            for (int r = 0; r < 16; ++r) so[(mt * 32 + (r & 3) + 8 * (r >> 2) + 4 * hh) * 64 + nt * 32 + l31] = Sreg[r];
        }
    }
    __syncthreads();
}

__device__ __forceinline__ void gdn_sample_prep_item(const P& p, int l, int item, unsigned char* smem_) {
    unsigned char* smem = smem_ + vzero();
    const int tid = tidx();
    const int n = item & 63, dir = (item >> 6) & 1, h = (item >> 7) & 3, b = item >> 9;
    GdnCtx c; c.base = NPROMPT + b * 4096; c.T = 4096; c.h = h; c.dir = dir; c.cidx = dir ? 63 - n : n; c.l = l;
    __syncthreads();
    gdn_prep(p, c, smem);
    const bf16* KN = (const bf16*)(smem + GS_KN); const bf16* QN = (const bf16*)(smem + GS_QN); const bf16* Wl = (const bf16*)(smem + GS_W);
    const float* Ul = (const float*)(smem + GS_U); const float* gcs = (const float*)(smem + GS_SM);
    bf16* gqk = (bf16*)(p.ws + WS_BIG + B_GQK); bf16* guw = (bf16*)(p.ws + WS_BIG + B_GUW); float* ggc = (float*)(p.ws + WS_GGC);
    const int i = tid >> 3, cc = tid & 7, off = i * 64 + ((cc ^ (i & 7)) << 3);
    if (dir == 0) {
        const size_t tok = (size_t)b * 4096 + c.cidx * 64 + i;
        *(uint4*)(gqk + ((tok * 4 + h) * 2 + 0) * 64 + cc * 8) = *(const uint4*)(QN + off);
        *(uint4*)(gqk + ((tok * 4 + h) * 2 + 1) * 64 + cc * 8) = *(const uint4*)(KN + off);
    }
    bf16* uw = guw + (size_t)item * 8192;
    const float4 u0 = *(const float4*)(Ul + i * 64 + cc * 8), u1 = *(const float4*)(Ul + i * 64 + cc * 8 + 4);
    *(uint4*)(uw + i * 64 + cc * 8) = make_uint4(pk2(u0.x, u0.y), pk2(u0.z, u0.w), pk2(u1.x, u1.y), pk2(u1.z, u1.w));
    *(uint4*)(uw + 4096 + i * 64 + cc * 8) = *(const uint4*)(Wl + off);
    if (tid < 64) ggc[(size_t)item * 64 + tid] = gcs[tid];
}

__device__ __forceinline__ void gdn_sample_chain(const P& p, int l, int chain, unsigned char* smem_) {
    unsigned char* smem = smem_ + vzero();
    const int tid = tidx(), lane = tid & 63, wv = tid >> 6, hh = lane >> 5, l31 = lane & 31;
    const int dir = chain & 1, h = (chain >> 1) & 3, b = chain >> 3;
    bf16* KN = (bf16*)(smem + GS_KN); bf16* QN = (bf16*)(smem + GS_QN); bf16* Wl = (bf16*)(smem + GS_W); bf16* QG = (bf16*)(smem + GS_QG);
    bf16* ST = (bf16*)(smem + GS_ST); float* Ul = (float*)(smem + GS_U); float* gcs = (float*)(smem + GS_SM);
    const bf16* gqk = (const bf16*)(p.ws + WS_BIG + B_GQK); const bf16* guw = (const bf16*)(p.ws + WS_BIG + B_GUW); const float* ggc = (const float*)(p.ws + WS_GGC);
    const float* stp = (const float*)((uintptr_t)p.state_f + (uintptr_t)dir * ((uintptr_t)p.state_b - (uintptr_t)p.state_f)) + ((size_t)(b * 2 + l) * 4 + h) * 4096;
    f32x16 Sreg = zero16();
    __syncthreads();
    if (wv < 4) {
        const int mt = wv >> 1, nt = wv & 1, e = nt * 32 + l31;
#pragma unroll
        for (int r = 0; r < 16; ++r) Sreg[r] = stp[(mt * 32 + (r & 3) + 8 * (r >> 2) + 4 * hh) * 64 + e];
#pragma unroll
        for (int rg = 0; rg < 4; ++rg) { const int d0 = mt * 32 + 8 * rg + 4 * hh; *(uint2*)(ST + swz(e, d0)) = make_uint2(pk2(Sreg[rg * 4], Sreg[rg * 4 + 1]), pk2(Sreg[rg * 4 + 2], Sreg[rg * 4 + 3])); }
    }
    const int i = tid >> 3, cc = tid & 7, off = i * 64 + ((cc ^ (i & 7)) << 3);
    const int item0 = ((b * 4 + h) * 2 + dir) * 64;
    uint4 rq, rk, ru, rw; float rg_i, rg_l;
#define GDN_LOAD(n) { const int cidx_ = dir ? 63 - (n) : (n); const size_t tok_ = (size_t)b * 4096 + cidx_ * 64 + (dir ? 63 - i : i); \
        rq = *(const uint4*)(gqk + ((tok_ * 4 + h) * 2 + 0) * 64 + cc * 8); rk = *(const uint4*)(gqk + ((tok_ * 4 + h) * 2 + 1) * 64 + cc * 8); \
        const bf16* uw_ = guw + (size_t)(item0 + (n)) * 8192; ru = *(const uint4*)(uw_ + i * 64 + cc * 8); rw = *(const uint4*)(uw_ + 4096 + i * 64 + cc * 8); \
        rg_i = ggc[(size_t)(item0 + (n)) * 64 + i]; rg_l = ggc[(size_t)(item0 + (n)) * 64 + 63]; }
    GDN_LOAD(0)
#pragma unroll 1
    for (int n = 0; n < 64; ++n) {
        const int kb = n & 1;
        bf16* KDT = (bf16*)(smem + GS_KDT + kb * 8192);
        {
            const float qd = __expf(rg_i), kd = __expf(rg_l - rg_i);
            *(uint4*)(QN + off) = rq; *(uint4*)(KN + off) = rk; *(uint4*)(Wl + off) = rw;
            const unsigned qa[4] = {rq.x, rq.y, rq.z, rq.w}, ka[4] = {rk.x, rk.y, rk.z, rk.w}, ua[4] = {ru.x, ru.y, ru.z, ru.w};
            unsigned qo[4];
#pragma unroll
            for (int t = 0; t < 4; ++t) {
                qo[t] = pk2(bf2f((bf16)(qa[t] & 0xffff)) * qd, bf2f((bf16)(qa[t] >> 16)) * qd);
                KDT[swz(cc * 8 + 2 * t, i)] = f2bf(bf2f((bf16)(ka[t] & 0xffff)) * kd);
                KDT[swz(cc * 8 + 2 * t + 1, i)] = f2bf(bf2f((bf16)(ka[t] >> 16)) * kd);
            }
            *(uint4*)(QG + off) = make_uint4(qo[0], qo[1], qo[2], qo[3]);
            *(float4*)(Ul + i * 64 + cc * 8) = make_float4(bf2f((bf16)(ua[0] & 0xffff)), bf2f((bf16)(ua[0] >> 16)), bf2f((bf16)(ua[1] & 0xffff)), bf2f((bf16)(ua[1] >> 16)));
            *(float4*)(Ul + i * 64 + cc * 8 + 4) = make_float4(bf2f((bf16)(ua[2] & 0xffff)), bf2f((bf16)(ua[2] >> 16)), bf2f((bf16)(ua[3] & 0xffff)), bf2f((bf16)(ua[3] >> 16)));
            if (cc == 0) { gcs[i] = rg_i; if (i == 63) gcs[128 + 63] = qd; }
        }
        if (n + 1 < 64) GDN_LOAD(n + 1)
        __syncthreads();
        GdnCtx c; c.base = NPROMPT + b * 4096; c.T = 4096; c.h = h; c.dir = dir; c.cidx = dir ? 63 - n : n; c.l = l;
        gdn_t12(p, c, smem, kb, Sreg, dir);
    }
#undef GDN_LOAD
    __syncthreads();
}

__device__ __forceinline__ void ph_gdn_finalize(const P& p, int l) {
    const int tid = tidx(), lane = tid & 63;
    bf16* br = (bf16*)(p.ws + WS_BR);
    const bf16* gob = (const bf16*)(p.ws + WS_BIG + B_GOB);
    const bf16* proj = (const bf16*)(p.ws + WS_BIG + B_PROJ);
    for (int it = blockIdx.x * NWV + (tid >> 6); it < 8192 * 4; it += gridDim.x * NWV) {
        const int rs = it >> 2, h = it & 3; const size_t row = (size_t)NPROMPT + rs;
        bf16* b0 = br + row * 1024 + 768 + h * 64 + lane;
        const float a = bf2f(*b0) + bf2f(gob[(size_t)rs * 256 + h * 64 + lane]);
        const float ss = wave_sum(a * a);
        const float rinv = rsqrtf(ss * (1.f / 64.f) + EPS);
        const float z = bf2f(proj[row * PLD + C_DZ + h * 64 + lane]);
        *b0 = f2bf(a * rinv * p.d_g_norm[l * 64 + lane] * siluf_(z));
    }
}

template <int DQK>
__device__ __forceinline__ void attn_mfma_item(const AttnJob& j, int blk, unsigned char* smem_) {
    unsigned char* smem = smem_ + vzero();
    const int tid = tidx(), lane = tid & 63, wv = tid >> 6, grp = wv >> 2, wq = wv & 3, l31 = lane & 31, hh = lane >> 5, gt = tid & 255;
    constexpr int KLD = DQK + 8, NKC = DQK / 8, NKK = DQK / 16;
    constexpr int KBYTES = 64 * KLD * 2, VBYTES = 64 * 68 * 2, BUFB = KBYTES + VBYTES;
    constexpr int NKI = NKC * 64 / 256;
    const int nqb = j.T / 128;
    const int b = blk / (4 * nqb), h = (blk / nqb) % 4, q0 = (blk % nqb) * 128;
    const int kh = h / j.kvgroup;
    int kbeg = 0, kend = j.T;
    if (j.window) { kbeg = q0 - 128 < 0 ? 0 : q0 - 128; kend = q0 + 256 > j.T ? j.T : q0 + 256; }
    const int n1 = (kend - kbeg) >> 6, n2 = j.nk2 >> 6, nt = n1 + n2, nt0 = (nt + 1) >> 1;
    const int tbeg = grp ? nt0 : 0, tcnt = grp ? nt - nt0 : nt0;
    const int tq = q0 + wq * 32 + l31;
    const float sc2 = j.scale * 1.4426950408889634f;
    const bf16* k1p = j.k1 + (size_t)b * j.T * j.ldk1 + kh * j.kstride; const bf16* v1p = j.v1 + (size_t)b * j.T * j.ldv1 + kh * j.vstride;
    const bf16* k2p = j.k2 + (size_t)b * j.nk2 * j.ldk2 + kh * j.kstride; const bf16* v2p = j.v2 + (size_t)b * j.nk2 * j.ldv2 + kh * j.vstride;
    typedef unsigned u32x4 __attribute__((ext_vector_type(4)));
    u32x4 kr0, kr1, kr2, vr0, vr1;
    kr2 = (u32x4){0u, 0u, 0u, 0u};
#define ATT_LOAD(t_) { const int t__ = (t_); const bool s1__ = t__ < n1; const int ks__ = s1__ ? kbeg + t__ * 64 : (t__ - n1) * 64; \
        const bf16* kp__ = s1__ ? k1p : k2p; const bf16* vp__ = s1__ ? v1p : v2p; const int ldk__ = s1__ ? j.ldk1 : j.ldk2, ldv__ = s1__ ? j.ldv1 : j.ldv2; \
        { const int c_ = gt; kr0 = *(const u32x4*)(kp__ + (size_t)(ks__ + c_ / NKC) * ldk__ + (c_ % NKC) * 8); } \
        { const int c_ = gt + 256; kr1 = *(const u32x4*)(kp__ + (size_t)(ks__ + c_ / NKC) * ldk__ + (c_ % NKC) * 8); } \
        if (NKI > 2) { const int c_ = gt + 512; kr2 = *(const u32x4*)(kp__ + (size_t)(ks__ + c_ / NKC) * ldk__ + (c_ % NKC) * 8); } \
        { const int c_ = gt; vr0 = *(const u32x4*)(vp__ + (size_t)(ks__ + (c_ >> 3)) * ldv__ + (c_ & 7) * 8); } \
        { const int c_ = gt + 256; vr1 = *(const u32x4*)(vp__ + (size_t)(ks__ + (c_ >> 3)) * ldv__ + (c_ & 7) * 8); } }
#define ATT_VSCAT(vr_, c_) { const int key_ = (c_) >> 3, e0_ = ((c_) & 7) * 8; \
        VT[(e0_ + 0) * 68 + key_] = (bf16)(vr_[0] & 0xffff); VT[(e0_ + 1) * 68 + key_] = (bf16)(vr_[0] >> 16); VT[(e0_ + 2) * 68 + key_] = (bf16)(vr_[1] & 0xffff); VT[(e0_ + 3) * 68 + key_] = (bf16)(vr_[1] >> 16); \
        VT[(e0_ + 4) * 68 + key_] = (bf16)(vr_[2] & 0xffff); VT[(e0_ + 5) * 68 + key_] = (bf16)(vr_[2] >> 16); VT[(e0_ + 6) * 68 + key_] = (bf16)(vr_[3] & 0xffff); VT[(e0_ + 7) * 68 + key_] = (bf16)(vr_[3] >> 16); }
#define ATT_STORE(buf_) { bf16* Kl = (bf16*)(smem + ((buf_) * 2 + grp) * BUFB); bf16* VT = (bf16*)(smem + ((buf_) * 2 + grp) * BUFB + KBYTES); \
        { const int c_ = gt; *(u32x4*)(Kl + (c_ / NKC) * KLD + (c_ % NKC) * 8) = kr0; } \
        { const int c_ = gt + 256; *(u32x4*)(Kl + (c_ / NKC) * KLD + (c_ % NKC) * 8) = kr1; } \
        if (NKI > 2) { const int c_ = gt + 512; *(u32x4*)(Kl + (c_ / NKC) * KLD + (c_ % NKC) * 8) = kr2; } \
        ATT_VSCAT(vr0, gt) ATT_VSCAT(vr1, gt + 256) }
    bf16x8 qf[NKK];
    int qset = -1;
    f32x16 o0 = zero16(), o1 = zero16();
    float m = -1e30f, lsum = 0.f;
    __syncthreads();
    if (tcnt > 0) { ATT_LOAD(tbeg) ATT_STORE(0) }
    __syncthreads();
#pragma unroll 1
    for (int s = 0; s < nt0; ++s) {
        const bool has = s < tcnt, hasn = s + 1 < tcnt;
        if (hasn) ATT_LOAD(tbeg + s + 1)
        if (has) {
            const int t = tbeg + s; const bool s1 = t < n1; const int ks = s1 ? kbeg + t * 64 : (t - n1) * 64;
            const int set = s1 ? 0 : 1;
            if (set != qset) {
                qset = set;
                const bf16* qp = (set == 0 ? j.q1 + ((size_t)b * j.T + tq) * j.ldq1 : j.q2 + ((size_t)b * j.T + tq) * j.ldq2) + h * DQK;
#pragma unroll
                for (int kk = 0; kk < NKK; ++kk) qf[kk] = *(const bf16x8*)(qp + kk * 16 + hh * 8);
            }
            const bf16* Kl = (const bf16*)(smem + ((s & 1) * 2 + grp) * BUFB); const bf16* VT = (const bf16*)(smem + ((s & 1) * 2 + grp) * BUFB + KBYTES);
            f32x16 s0 = zero16(), s1v = zero16();
#pragma unroll
            for (int kk = 0; kk < NKK; ++kk) {
                const bf16x8 a0 = *(const bf16x8*)(Kl + l31 * KLD + kk * 16 + hh * 8);
                const bf16x8 a1 = *(const bf16x8*)(Kl + (32 + l31) * KLD + kk * 16 + hh * 8);
                s0 = __builtin_amdgcn_mfma_f32_32x32x16_bf16(a0, qf[kk], s0, 0, 0, 0);
                s1v = __builtin_amdgcn_mfma_f32_32x32x16_bf16(a1, qf[kk], s1v, 0, 0, 0);
            }
            const bool win = s1 && j.window;
            float mx = -INFINITY;
#pragma unroll
            for (int r = 0; r < 16; ++r) {
                float a = s0[r] * sc2, c = s1v[r] * sc2;
                if (win) { const int d0 = tq - (ks + (r & 3) + 8 * (r >> 2) + 4 * hh); if (d0 > 128 || d0 < -128) a = -INFINITY; const int d1 = d0 - 32; if (d1 > 128 || d1 < -128) c = -INFINITY; }
                s0[r] = a; s1v[r] = c; mx = fmaxf(mx, fmaxf(a, c));
            }
            mx = fmaxf(mx, __shfl_xor(mx, 32));
            const float mnew = fmaxf(m, mx), alpha = __builtin_amdgcn_exp2f(m - mnew);
            m = mnew;
            float ps = 0.f;
#pragma unroll
            for (int r = 0; r < 16; ++r) { s0[r] = __builtin_amdgcn_exp2f(s0[r] - mnew); s1v[r] = __builtin_amdgcn_exp2f(s1v[r] - mnew); ps += s0[r] + s1v[r]; }
            lsum = lsum * alpha + ps;
#pragma unroll
            for (int r = 0; r < 16; ++r) { o0[r] *= alpha; o1[r] *= alpha; }
#pragma unroll
            for (int k4 = 0; k4 < 4; ++k4) {
                const int sp = (k4 & 1) * 8;
                unsigned pw[4];
#pragma unroll
                for (int q2 = 0; q2 < 4; ++q2) pw[q2] = (k4 < 2) ? pk2(s0[sp + 2 * q2], s0[sp + 2 * q2 + 1]) : pk2(s1v[sp + 2 * q2], s1v[sp + 2 * q2 + 1]);
                const u32x4 pwv = {pw[0], pw[1], pw[2], pw[3]};
                const bf16x8 pf = __builtin_bit_cast(bf16x8, pwv);
                {
                    const uint2 x0 = *(const uint2*)(VT + l31 * 68 + 16 * k4 + 4 * hh), x1 = *(const uint2*)(VT + l31 * 68 + 16 * k4 + 8 + 4 * hh);
                    const u32x4 av = {x0.x, x0.y, x1.x, x1.y};
                    o0 = __builtin_amdgcn_mfma_f32_32x32x16_bf16(__builtin_bit_cast(bf16x8, av), pf, o0, 0, 0, 0);
                }
                {
                    const uint2 x0 = *(const uint2*)(VT + (32 + l31) * 68 + 16 * k4 + 4 * hh), x1 = *(const uint2*)(VT + (32 + l31) * 68 + 16 * k4 + 8 + 4 * hh);
                    const u32x4 av = {x0.x, x0.y, x1.x, x1.y};
                    o1 = __builtin_amdgcn_mfma_f32_32x32x16_bf16(__builtin_bit_cast(bf16x8, av), pf, o1, 0, 0, 0);
                }
            }
        }
        if (hasn) ATT_STORE((s + 1) & 1)
        __syncthreads();
    }
#undef ATT_LOAD
#undef ATT_VSCAT
#undef ATT_STORE
    lsum += __shfl_xor(lsum, 32);
    float* CO = (float*)smem;
    if (grp == 1) {
#pragma unroll
        for (int r = 0; r < 16; ++r) { CO[((wq * 34 + r) * 64 + lane)] = o0[r]; CO[((wq * 34 + 16 + r) * 64 + lane)] = o1[r]; }
        CO[((wq * 34 + 32) * 64 + lane)] = m; CO[((wq * 34 + 33) * 64 + lane)] = lsum;
    }
    __syncthreads();
    if (grp == 0) {
        const float m1 = CO[((wq * 34 + 32) * 64 + lane)], l1 = CO[((wq * 34 + 33) * 64 + lane)];
        float mf = fmaxf(m, m1);
        float sk2 = 0.f;
        if (j.sink) { sk2 = j.sink[h] * 1.4426950408889634f; mf = fmaxf(mf, sk2); }
        const float a0 = __builtin_amdgcn_exp2f(m - mf), a1 = __builtin_amdgcn_exp2f(m1 - mf);
        float lt = lsum * a0 + l1 * a1;
        if (j.sink) lt += __builtin_amdgcn_exp2f(sk2 - mf);
        const float inv = 1.f / lt;
        bf16* op = j.out + ((size_t)b * j.T + tq) * 1024 + j.outcol + h * 64;
#pragma unroll
        for (int rg = 0; rg < 4; ++rg) {
            float v[8];
#pragma unroll
            for (int k = 0; k < 4; ++k) {
                v[k] = (o0[rg * 4 + k] * a0 + CO[((wq * 34 + rg * 4 + k) * 64 + lane)] * a1) * inv;
                v[4 + k] = (o1[rg * 4 + k] * a0 + CO[((wq * 34 + 16 + rg * 4 + k) * 64 + lane)] * a1) * inv;
            }
            *(uint2*)(op + 8 * rg + 4 * hh) = make_uint2(pk2(v[0], v[1]), pk2(v[2], v[3]));
            *(uint2*)(op + 32 + 8 * rg + 4 * hh) = make_uint2(pk2(v[4], v[5]), pk2(v[6], v[7]));
        }
    }
}

#define XB_TMO      128
#define XB_XCNT(j)  (256  + 64 * (j))
#define XB_XSUB(j)  (1280 + 64 * (j))
#define XB_XGEN(j)  (2304 + 64 * (j))
#define XB_TOP      3328
#define XB_TOPGEN   3392
#define XCD_BAR_WORDS 3456
#define XB_SPIN_CAP (1u << 18)
#define LAS __attribute__((address_space(3)))

__device__ __forceinline__ unsigned xb_ld(unsigned* p)              { return __hip_atomic_load(p, __ATOMIC_RELAXED, __HIP_MEMORY_SCOPE_AGENT); }
__device__ __forceinline__ unsigned xb_add(unsigned* p, unsigned v) { return __hip_atomic_fetch_add(p, v, __ATOMIC_RELAXED, __HIP_MEMORY_SCOPE_AGENT); }
__device__ __forceinline__ unsigned xb_xcc_id() { return (unsigned)__builtin_amdgcn_s_getreg((3 << 11) | 20) & 0xFu; }
#define XB_SPIN(cond, bar) do { unsigned _sp = 0; while (cond) { __builtin_amdgcn_s_sleep(1); \
    if ((++_sp & 255u) == 0u) { if (xb_ld(&(bar)[XB_TMO])) break; if (_sp > XB_SPIN_CAP) { atomicAdd(&(bar)[XB_TMO], 1u); break; } } } } while (0)

struct XcdBarrier {
    unsigned* bar; unsigned x;
    volatile LAS unsigned* st;
};

__device__ __forceinline__ XcdBarrier xcd_barrier_post(unsigned* bar, volatile LAS unsigned* st) {
    XcdBarrier b; b.bar = bar; b.x = xb_xcc_id(); b.st = st;
    if (threadIdx.x == 0) (void)xb_add(&bar[XB_XCNT(b.x)], 1u);
    return b;
}
__device__ __forceinline__ void xcd_barrier_complete(unsigned* bar, unsigned x, unsigned& nloc, unsigned& nx) {
    const unsigned G = gridDim.x * gridDim.y * gridDim.z;
    unsigned sum, cnt, mine, sp = 0u;
    for (;;) {
        sum = 0u; cnt = 0u; mine = 0u;
#pragma unroll
        for (unsigned j = 0; j < 16; ++j) { const unsigned c = xb_ld(&bar[XB_XCNT(j)]); sum += c; cnt += (c > 0u) ? 1u : 0u; mine = (j == x) ? c : mine; }
        if (sum == G) break;
        __builtin_amdgcn_s_sleep(1);
        if ((++sp & 255u) == 0u) { if (xb_ld(&bar[XB_TMO])) break; if (sp > XB_SPIN_CAP) { atomicAdd(&bar[XB_TMO], 1u); break; } }
    }
    nloc = mine > 0u ? mine : 1u; nx = cnt > 0u ? cnt : 1u;
}

__device__ __forceinline__ void xcd_barrier(const XcdBarrier& b) {
    asm volatile("s_waitcnt vmcnt(0)" ::: "memory");
    __syncthreads();
    if (threadIdx.x == 0) {
        unsigned* bar = b.bar;
        __builtin_amdgcn_s_waitcnt(0);
        unsigned nloc = b.st[0], nx = b.st[1];
        if (nloc == 0u) { xcd_barrier_complete(bar, b.x, nloc, nx); b.st[0] = nloc; b.st[1] = nx; }
        const unsigned old = xb_add(&bar[XB_XSUB(b.x)], 1u);
        const unsigned gen = old / nloc;
        if (old + 1u == (gen + 1u) * nloc) {
            __builtin_amdgcn_fence(__ATOMIC_RELEASE, "agent");
            asm volatile("s_waitcnt vmcnt(0)" ::: "memory");
            const unsigned og = xb_add(&bar[XB_TOP], 1u);
            const unsigned tg = og / nx;
            if (og + 1u == (tg + 1u) * nx) xb_add(&bar[XB_TOPGEN], 1u);
            else XB_SPIN(xb_ld(&bar[XB_TOPGEN]) == tg, bar);
            __builtin_amdgcn_fence(__ATOMIC_ACQUIRE, "agent");
            xb_add(&bar[XB_XGEN(b.x)], 1u);
            asm volatile("s_waitcnt vmcnt(0)" ::: "memory");
        } else {
            XB_SPIN(xb_ld(&bar[XB_XGEN(b.x)]) == gen, bar);
            __builtin_amdgcn_fence(__ATOMIC_ACQUIRE, "agent");
            asm volatile("s_waitcnt vmcnt(0)" ::: "memory");
        }
    }
    __syncthreads();
}


struct KArgs { P p; TJobs J[2]; };

__device__ __forceinline__ AttnJob make_job(const P& p, int l, int variant) {
    unsigned char* ws = p.ws; unsigned char* big = ws + WS_BIG;
    bf16* proj = (bf16*)(big + B_PROJ); bf16* BRb = (bf16*)(ws + WS_BR);
    const float bscale = 0.10206207261596575f;
    AttnJob j{};
    if (variant == 0) {
        j.q1 = proj + C_AQ; j.ldq1 = PLD; j.k1 = proj + C_AK; j.ldk1 = PLD; j.v1 = proj + C_AV; j.ldv1 = PLD; j.kstride = 64; j.vstride = 64; j.kvgroup = 2;
        j.nbatch = 32; j.T = 256; j.nk2 = 0; j.window = 0; j.sink = p.a_sink + l * 4; j.scale = 0.125f; j.out = BRb; j.outcol = 0;
    } else if (variant == 1) {
        j.q1 = (bf16*)(big + B_QA1S); j.ldq1 = 256; j.q2 = proj + (size_t)NPROMPT * PLD + C_AQ; j.ldq2 = PLD;
        j.k1 = (bf16*)(big + B_KA1S); j.ldk1 = 128; j.v1 = proj + (size_t)NPROMPT * PLD + C_AV; j.ldv1 = PLD;
        j.k2 = (bf16*)(ws + WS_KAC); j.ldk2 = 128; j.v2 = (bf16*)(ws + WS_VAC); j.ldv2 = 128; j.kstride = 64; j.vstride = 64; j.kvgroup = 2;
        j.nbatch = 2; j.T = 4096; j.nk2 = 256; j.window = 1; j.sink = p.a_sink + l * 4; j.scale = 0.125f; j.out = BRb + (size_t)NPROMPT * 1024; j.outcol = 0;
    } else if (variant == 2) {
        j.q1 = (bf16*)(big + B_QB); j.ldq1 = 384; j.k1 = (bf16*)(big + B_KB); j.ldk1 = 384; j.v1 = (bf16*)(big + B_KV) + 64; j.ldv1 = 512; j.kstride = 96; j.vstride = 128; j.kvgroup = 1;
        j.nbatch = 32; j.T = 256; j.nk2 = 0; j.window = 0; j.sink = nullptr; j.scale = bscale; j.out = BRb; j.outcol = 256;
    } else {
        j.q1 = (bf16*)(big + B_CQ); j.ldq1 = 384; j.q2 = (bf16*)(big + B_QB) + (size_t)NPROMPT * 384; j.ldq2 = 384;
        j.k1 = (bf16*)(big + B_KB) + (size_t)NPROMPT * 384; j.ldk1 = 384; j.v1 = (bf16*)(big + B_KV) + (size_t)NPROMPT * 512 + 64; j.ldv1 = 512;
        j.k2 = (bf16*)(big + B_KB) + (size_t)NTOK * 384; j.ldk2 = 384; j.v2 = (bf16*)(big + B_KV) + (size_t)NTOK * 512 + 64; j.ldv2 = 512; j.kstride = 96; j.vstride = 128; j.kvgroup = 1;
        j.nbatch = 2; j.T = 4096; j.nk2 = 256; j.window = 0; j.sink = nullptr; j.scale = bscale; j.out = BRb + (size_t)NPROMPT * 1024; j.outcol = 256;
    }
    return j;
}

#define LDSP(smem) ((PG8_LAS unsigned char*)(smem))
__device__ __forceinline__ void ph_gemm_proj(const P& p, unsigned char* smem) {
    pg8::Gemm g{(bf16*)(p.ws + WS_H), (bf16*)(p.ws + WS_W + W_A), NTOK, 2304, 1024, 1024, 1024}; pg8::StaticOrder S; S.init(NTOK, 2304, gridDim.x, blockIdx.x);
    pg8::EpiStoreBf16 E{(bf16*)(p.ws + WS_BIG + B_PROJ), PLD, PLD};
    pg8::gemm_phase<pg8::EpiStoreBf16, pg8::StaticOrder, true, true>(LDSP(smem), g, S, E);
}
__device__ __forceinline__ void ph_gemm_mla(const P& p, unsigned char* smem) {
    unsigned char* big = p.ws + WS_BIG;
    { GemmArgs g{(bf16*)(big + B_CQ), (bf16*)(p.ws + WS_W + W_UQ), 192, 192, NTOK, 384, 192, 0}; EpiStore e{(bf16*)(big + B_QB), 384, 384}; gemm_tiles(g, e, smem); }
    { GemmArgs g{(bf16*)(big + B_CKV), (bf16*)(p.ws + WS_W + W_UKV), 128, 128, NKVROWS, 512, 128, 0}; EpiStore e{(bf16*)(big + B_KV), 512, 512}; gemm_tiles(g, e, smem); }
}
__device__ __forceinline__ void ph_gemm_br(const P& p, unsigned char* smem) {
    bf16* BRb = (bf16*)(p.ws + WS_BR); bf16* brb = (bf16*)(p.ws + WS_BIG + B_BRB);
#pragma unroll 1
    for (int m = 0; m < 4; ++m) {
        pg8::Gemm g{BRb + m * 256, (bf16*)(p.ws + WS_W + W_BR) + (size_t)m * 1024 * 256, NTOK, 1024, 256, 1024, 256}; pg8::StaticOrder S; S.init(NTOK, 1024, gridDim.x, blockIdx.x);
        pg8::EpiStoreBf16 E{brb + m * 1024, 4096, 1 << 30};
        pg8::gemm_phase<pg8::EpiStoreBf16, pg8::StaticOrder, true, true>(LDSP(smem), g, S, E);
    }
}
__device__ __forceinline__ void ph_gemm_gate(const P& p, unsigned char* smem) {
    pg8::Gemm g{(bf16*)(p.ws + WS_H), (bf16*)(p.ws + WS_W + W_G), NTOK, 4096, 1024, 1024, 1024}; pg8::StaticOrder S; S.init(NTOK, 4096, gridDim.x, blockIdx.x);
    pg8::EpiGateMix E{(const bf16*)(p.ws + WS_BIG + B_BRB), (bf16*)(p.ws + WS_BR)};
    pg8::gemm_phase<pg8::EpiGateMix, pg8::StaticOrder, true, true>(LDSP(smem), g, S, E);
}
__device__ __forceinline__ void ph_gemm_wo(const P& p, unsigned char* smem) {
    pg8::Gemm g{(bf16*)(p.ws + WS_BR), (bf16*)(p.ws + WS_W + W_O), NTOK, 1024, 1024, 1024, 1024}; pg8::StaticOrder S; S.init(NTOK, 1024, gridDim.x, blockIdx.x);
    pg8::EpiStoreBf16 E{(bf16*)(p.ws + WS_H), 1024, 1024};
    pg8::gemm_phase<pg8::EpiStoreBf16, pg8::StaticOrder, true, true>(LDSP(smem), g, S, E);
}
__device__ __forceinline__ void ph_gemm_up(const P& p, unsigned char* smem) {
    pg8::Gemm g{(bf16*)(p.ws + WS_H), (bf16*)(p.ws + WS_W + W_UP), NTOK, 5632, 1024, 1024, 1024}; pg8::StaticOrder S; S.init(NTOK, 5632, gridDim.x, blockIdx.x);
    pg8::EpiSwiglu E{(bf16*)(p.ws + WS_BIG + B_HID), DFF};
    pg8::gemm_phase<pg8::EpiSwiglu, pg8::StaticOrder, true, true>(LDSP(smem), g, S, E);
}
__device__ __forceinline__ void ph_gemm_down(const P& p, unsigned char* smem) {
    pg8::Gemm g{(bf16*)(p.ws + WS_BIG + B_HID), (bf16*)(p.ws + WS_W + W_DN), NTOK, 1024, DFF, DFF, DFF}; pg8::StaticOrder S; S.init(NTOK, 1024, gridDim.x, blockIdx.x);
    pg8::EpiStoreBf16 E{(bf16*)(p.ws + WS_BR), 1024, 1024};
    pg8::gemm_phase<pg8::EpiStoreBf16, pg8::StaticOrder, true, true>(LDSP(smem), g, S, E);
}
__device__ __forceinline__ void attn_dispatch(const P& p, int l, int variant, int blk, unsigned char* smem) {
    if (variant == 0) { const AttnJob j = make_job(p, l, 0); attn_mfma_item<64>(j, blk, smem); }
    else if (variant == 1) { const AttnJob j = make_job(p, l, 1); attn_mfma_item<64>(j, blk, smem); }
    else if (variant == 2) { const AttnJob j = make_job(p, l, 2); attn_mfma_item<96>(j, blk, smem); }
    else { const AttnJob j = make_job(p, l, 3); attn_mfma_item<96>(j, blk, smem); }
}
__device__ __forceinline__ void ph_mixers1(const P& p, int l, unsigned char* smem) {
    for (int item = blockIdx.x; item < 1024; item += gridDim.x) gdn_sample_prep_item(p, l, item, smem);
    for (int item = blockIdx.x; item < 768; item += gridDim.x) { const int vi = item >> 8; attn_dispatch(p, l, vi == 0 ? 1 : vi == 1 ? 2 : 0, item & 255, smem); }
    __syncthreads();
    ph_pool(p, l, smem);
}
__device__ __forceinline__ void ph_mixers2(const P& p, int l, unsigned char* smem) {
    const int nb = gridDim.x, bid = blockIdx.x;
    if (bid < 16) { gdn_sample_chain(p, l, bid, smem); return; }
    const int nw = nb - 16, wi = bid - 16;
    for (int item = wi; item < 384; item += nw) {
        if (item < 128) gdn_prompt_item(p, l, item, smem);
        else attn_dispatch(p, l, 3, item - 128, smem);
    }
}

#define GSYNC() xcd_barrier(xb)
__global__ void __launch_bounds__(NT) mega(KArgs a) {
    extern __shared__ __attribute__((aligned(16))) unsigned char smem[];
    cg::grid_group grid = cg::this_grid();
    volatile LAS unsigned* xst = (volatile LAS unsigned*)(smem + LDS_BYTES - 16);
    if (threadIdx.x == 0) { xst[0] = 0u; xst[1] = 0u; }
    __syncthreads();
    const XcdBarrier xb = xcd_barrier_post((unsigned*)(a.p.ws + WS_BAR), xst);
    { const P p = fence_P(); ph_mod(p, smem); }
    __syncthreads();
    ph_convert(a.J[0], smem);
    grid.sync();
    { const P p = fence_P(); ph_prenorm(p, 0); }
    GSYNC();
#pragma unroll 1
    for (int l = 0; l < 2; ++l) {
        { const P p = fence_P(); ph_gemm_proj(p, smem); }
        GSYNC();
        { const P p = fence_P(); ph_postproj(p, l); }
        GSYNC();
        { const P p = fence_P(); ph_gemm_mla(p, smem); }
        GSYNC();
        { const P p = fence_P(); ph_prep2(p, l); }
        GSYNC();
        { const P p = fence_P(); ph_mixers1(p, l, smem); }
        GSYNC();
        { const P p = fence_P(); ph_mixers2(p, l, smem); }
        GSYNC();
        { const P p = fence_P(); ph_gdn_finalize(p, l); }
        GSYNC();
        { const P p = fence_P(); ph_gemm_br(p, smem); }
        GSYNC();
        { const P p = fence_P(); ph_gemm_gate(p, smem); }
        GSYNC();
        { const P p = fence_P(); ph_gemm_wo(p, smem); }
        GSYNC();
        { const P p = fence_P(); ph_post(p, l, 1); }
        GSYNC();
        { const P p = fence_P(); ph_gemm_up(p, smem); }
        GSYNC();
        { const P p = fence_P(); ph_gemm_down(p, smem); }
        GSYNC();
        { const P p = fence_P(); ph_post(p, l, 2); }
        if (l == 0) { __syncthreads(); ph_convert(a.J[1], smem); GSYNC(); }
    }
}

static void add_job(TJobs& J, const float* src, bf16* dst, int ldw, int K, int Ndst, int ldo, int mode, int arg, int nvalid) {
    TJob& j = J.j[J.n]; j.src = src; j.dst = dst; j.ldw = ldw; j.K = K; j.Ndst = Ndst; j.ldo = ldo; j.mode = mode; j.arg = arg; j.nvalid = nvalid; j.tile0 = J.total;
    J.total += (Ndst / 64) * (K / 64); J.n++;
}

extern "C" void kernel_launch(void* const* d_in, const int* in_sizes, int n_in, void* d_out, int out_size, void* d_ws, size_t ws_size, hipStream_t stream) {
    if (n_in != 32 || ws_size < WS_NEED) { fprintf(stderr, "kernel_launch: unexpected n_in %d or ws_size %zu (need %zu)\n", n_in, ws_size, (size_t)WS_NEED); return; }
    static int grid = 0;
    if (grid == 0) {
        int dev = 0, cus = 0, per_cu = 0;
        (void)hipGetDevice(&dev);
        (void)hipDeviceGetAttribute(&cus, hipDeviceAttributeMultiprocessorCount, dev);
        (void)hipFuncSetAttribute((const void*)mega, hipFuncAttributeMaxDynamicSharedMemorySize, LDS_BYTES);
        (void)hipOccupancyMaxActiveBlocksPerMultiprocessor(&per_cu, (const void*)mega, NT, LDS_BYTES);
        if (per_cu < 1) { fprintf(stderr, "kernel_launch: occupancy query says %d blocks/CU\n", per_cu); per_cu = 1; }
        if (per_cu > 1) per_cu = 1;
        grid = cus * per_cu;
    }
    KArgs a{};
    const float** pf = (const float**)&a.p;
    for (int i = 0; i < 32; ++i) pf[i] = (const float*)d_in[i];
    a.p.out = (float*)d_out; a.p.ws = (unsigned char*)d_ws;
    const P& p = a.p;
    bf16* Wb = (bf16*)(a.p.ws + WS_W);
    for (int l = 0; l < 2; ++l) {
        TJobs& J = a.J[l];
        add_job(J, p.w_in + (size_t)l * 1024 * PIN, (bf16*)((char*)Wb + W_A), PIN, 1024, 2304, 1024, 0, 0, 2160);
        add_job(J, p.w_in + (size_t)l * 1024 * PIN, (bf16*)((char*)Wb + W_G), PIN, 1024, 4096, 1024, 2, C_GATE, 4096);
        for (int m = 0; m < 4; ++m) add_job(J, p.w_br + ((size_t)l * 4 + m) * 256 * 1024, (bf16*)((char*)Wb + W_BR) + (size_t)m * 1024 * 256, 1024, 256, 1024, 256, 0, 0, 1024);
        add_job(J, p.w_o + (size_t)l * 1024 * 1024, (bf16*)((char*)Wb + W_O), 1024, 1024, 1024, 1024, 0, 0, 1024);
        add_job(J, p.w_up + (size_t)l * 1024 * 5632, (bf16*)((char*)Wb + W_UP), 5632, 1024, 5632, 1024, 1, 0, 5632);
        add_job(J, p.w_down + (size_t)l * DFF * 1024, (bf16*)((char*)Wb + W_DN), 1024, DFF, 1024, DFF, 0, 0, 1024);
        add_job(J, p.b_w_uq + (size_t)l * 192 * 384, (bf16*)((char*)Wb + W_UQ), 384, 192, 384, 192, 0, 0, 384);
        add_job(J, p.b_w_ukv + (size_t)l * 128 * 512, (bf16*)((char*)Wb + W_UKV), 512, 128, 512, 128, 0, 0, 512);
    }
    (void)hipMemsetAsync((char*)d_ws + WS_BAR, 0, XCD_BAR_WORDS * 4, stream);
    void* args[] = {&a};
    hipError_t e = hipLaunchCooperativeKernel((const void*)mega, dim3(grid), dim3(NT), args, LDS_BYTES, stream);
    if (e != hipSuccess) fprintf(stderr, "cooperative launch failed: %s (grid %d)\n", hipGetErrorString(e), grid);
}
```

```cpp
#include <hip/hip_runtime.h>
#include <hip/hip_cooperative_groups.h>
namespace cg = cooperative_groups;
#define NT 512
#define NWV 8
#define LDS_BYTES 147456
#include <stdint.h>
#include <stdio.h>

typedef unsigned short bf16;
typedef short bf16x8 __attribute__((ext_vector_type(8)));
typedef float f32x16 __attribute__((ext_vector_type(16)));

#define DM 1024
#define NTOK 16384
#define NPROMPT 8192
#define PLD 2176
#define C_AQ 0
#define C_AK 256
#define C_AV 384
#define C_BCQ 512
#define C_BCKV 704
#define C_BKR 832
#define C_CIN 864
#define C_DQKV 1120
#define C_DZ 1888
#define C_DBETA 2144
#define C_DALPHA 2152
#define C_GATE 2160
#define PIN 6256
#define DFF 2816
#define EPS 1e-6f
#define NKVROWS 16896

#define O_Y 0
#define O_CAK 16777216
#define O_CAV 18874368
#define O_CKV 20971520
#define O_KR 23068672
#define O_SF 23592960
#define O_SB 24641536

#define MB(x) ((size_t)(x) * 1024 * 1024)
#define WS_MOD 0
#define WS_TAB (WS_MOD + 147456)
#define WS_KAC (WS_TAB + 12288)
#define WS_VAC (WS_KAC + 512 * 128 * 2)
#define WS_GGC (WS_VAC + 512 * 128 * 2)
#define WS_BAR 786432
#define WS_W (MB(1))
#define W_A 0
#define W_G (W_A + 2304 * 1024 * 2)
#define W_BR (W_G + 4096 * 1024 * 2)
#define W_O (W_BR + 4 * 1024 * 256 * 2)
#define W_UP (W_O + 1024 * 1024 * 2)
#define W_DN (W_UP + 5632 * 1024 * 2)
#define W_UQ (W_DN + 1024 * 2816 * 2)
#define W_UKV (W_UQ + 384 * 192 * 2)
#define W_END (W_UKV + 512 * 128 * 2)
#define WS_H (MB(42))
#define WS_BR (MB(74))
#define WS_BIG (MB(106))
#define B_PROJ 0
#define B_CQ (B_PROJ + (size_t)16384 * 2176 * 2)
#define B_CKV (B_CQ + (size_t)16384 * 192 * 2)
#define B_QB (B_CKV + (size_t)16896 * 128 * 2)
#define B_KV (B_QB + (size_t)16384 * 384 * 2)
#define B_QA1S (B_KV + (size_t)16896 * 512 * 2)
#define B_KA1S (B_QA1S + (size_t)8192 * 256 * 2)
#define B_KB (B_KA1S + (size_t)8192 * 128 * 2)
#define B_GQK (B_KB + (size_t)16896 * 384 * 2)
#define B_GUW (B_GQK + (size_t)8192 * 512 * 2)
#define B_END_A (B_GUW + (size_t)1024 * 8192 * 2)
#define B_GOB B_CKV
#define B_BRB 0
#define B_HID 0
#define WS_NEED (WS_BIG + B_END_A)

struct P {
    const float *x_prompt, *x_sample, *cache_a_k, *cache_a_v, *cache_b_ckv, *cache_b_krope, *state_f, *state_b, *c, *c_ctx;
    const float *w_mod, *b_mod, *g_pre1, *g_post1, *g_pre2, *g_post2, *w_in, *a_sink, *b_g_cq, *b_g_ckv, *b_w_uq, *b_w_ukv;
    const float *c_w_pool, *c_scale, *d_conv, *d_a_log, *d_dt_bias, *d_g_norm, *w_br, *w_o, *w_up, *w_down;
    float* out;
    unsigned char* ws;
};


typedef const __attribute__((address_space(4))) unsigned char* kargp_t;
__device__ __forceinline__ P fence_P() {
    kargp_t kp = (kargp_t)__builtin_amdgcn_kernarg_segment_ptr();
    asm volatile("" : "+s"(kp));
    const __attribute__((address_space(4))) P* pp = (const __attribute__((address_space(4))) P*)kp;
    P q;
    q.x_prompt = pp->x_prompt;
    q.x_sample = pp->x_sample;
    q.cache_a_k = pp->cache_a_k;
    q.cache_a_v = pp->cache_a_v;
    q.cache_b_ckv = pp->cache_b_ckv;
    q.cache_b_krope = pp->cache_b_krope;
    q.state_f = pp->state_f;
    q.state_b = pp->state_b;
    q.c = pp->c;
    q.c_ctx = pp->c_ctx;
    q.w_mod = pp->w_mod;
    q.b_mod = pp->b_mod;
    q.g_pre1 = pp->g_pre1;
    q.g_post1 = pp->g_post1;
    q.g_pre2 = pp->g_pre2;
    q.g_post2 = pp->g_post2;
    q.w_in = pp->w_in;
    q.a_sink = pp->a_sink;
    q.b_g_cq = pp->b_g_cq;
    q.b_g_ckv = pp->b_g_ckv;
    q.b_w_uq = pp->b_w_uq;
    q.b_w_ukv = pp->b_w_ukv;
    q.c_w_pool = pp->c_w_pool;
    q.c_scale = pp->c_scale;
    q.d_conv = pp->d_conv;
    q.d_a_log = pp->d_a_log;
    q.d_dt_bias = pp->d_dt_bias;
    q.d_g_norm = pp->d_g_norm;
    q.w_br = pp->w_br;
    q.w_o = pp->w_o;
    q.w_up = pp->w_up;
    q.w_down = pp->w_down;
    q.out = pp->out;
    q.ws = pp->ws;
    return q;
}

__device__ __forceinline__ bf16 f2bf(float f) {
    unsigned u = __float_as_uint(f);
    u += 0x7fffu + ((u >> 16) & 1u);
    return (bf16)(u >> 16);
}
__device__ __forceinline__ float bf2f(bf16 h) { return __uint_as_float(((unsigned)h) << 16); }
__device__ __forceinline__ float wave_sum(float v) {
#pragma unroll
    for (int o = 32; o > 0; o >>= 1) v += __shfl_xor(v, o);
    return v;
}

__device__ __forceinline__ unsigned vzero() { unsigned z = 0; asm volatile("" : "+v"(z)); return z; }
__device__ __forceinline__ int tidx() { int t = threadIdx.x; asm volatile("" : "+v"(t)); return t; }
__device__ __forceinline__ float sigmoidf_(float x) { return 1.f / (1.f + __expf(-x)); }
__device__ __forceinline__ float siluf_(float x) { return x / (1.f + __expf(-x)); }

struct TJob { const float* src; bf16* dst; int ldw, K, Ndst, ldo, mode, arg, nvalid, tile0; };
struct TJobs { TJob j[16]; int n, total; };

__device__ __forceinline__ void ph_convert(const TJobs& J, unsigned char* smem) {
    float (*tile)[65] = (float (*)[65])smem;
    const int tid = tidx();
    for (int t = blockIdx.x; t < J.total; t += gridDim.x) {
        int ji = 0;
        for (int q = 1; q < J.n; ++q) if (t >= J.j[q].tile0) ji = q;
        const TJob jb = J.j[ji];
        const int local = t - jb.tile0, nkt = jb.K / 64, tn = local / nkt, tk = local % nkt;
        const int tx = tid & 63, ty = tid >> 6;
        const int n = tn * 64 + tx;
        int sc;
        if (jb.mode == 0) sc = (n < jb.nvalid) ? n + jb.arg : -1;
        else { const int pn = n >> 8, cc = n & 255, bj = cc >> 7, wc = (cc >> 5) & 3, nn = (cc >> 4) & 1, fq = (cc >> 2) & 3, ii = cc & 3;
            if (jb.mode == 1) sc = nn * DFF + pn * 128 + bj * 64 + wc * 16 + fq * 4 + ii;
            else sc = jb.arg + (2 * bj + nn) * 1024 + pn * 64 + wc * 16 + fq * 4 + ii; }
        for (int kk = ty; kk < 64; kk += NWV) tile[kk][tx] = (sc >= 0) ? jb.src[(size_t)(tk * 64 + kk) * jb.ldw + sc] : 0.f;
        __syncthreads();
        {
            const int q = tid, r = q >> 3, c8 = q & 7;
            unsigned w[4];
            for (int j = 0; j < 4; ++j) w[j] = (unsigned)f2bf(tile[c8 * 8 + 2 * j][r]) | ((unsigned)f2bf(tile[c8 * 8 + 2 * j + 1][r]) << 16);
            *(uint4*)(jb.dst + (size_t)(tn * 64 + r) * jb.ldo + tk * 64 + c8 * 8) = make_uint4(w[0], w[1], w[2], w[3]);
        }
        __syncthreads();
    }
}

__device__ __forceinline__ void ph_mod(const P& p, unsigned char* smem) {
    float (*cs)[1024] = (float (*)[1024])smem;
    float (*red)[3][64] = (float (*)[3][64])(smem + 3 * 1024 * 4);
    const int tid = tidx();
    float* mod = (float*)(p.ws + WS_MOD);
    for (int i = tid; i < 3072; i += NT) { const int r = i >> 10, k = i & 1023; const float v = (r == 0) ? p.c_ctx[k] : p.c[(r - 1) * 1024 + k]; cs[r][k] = siluf_(v); }
    __syncthreads();
    for (int it = blockIdx.x; it < 192; it += gridDim.x) {
        const int l = it / 96, cg = it % 96, col = cg * 64 + (tid & 63), kq = tid >> 6;
        float a0 = 0.f, a1 = 0.f, a2 = 0.f;
        const float* w = p.w_mod + ((size_t)l * 1024 + kq * 128) * 6144 + col;
        for (int k = 0; k < 128; ++k) { const float wv = w[(size_t)k * 6144]; a0 += cs[0][kq * 128 + k] * wv; a1 += cs[1][kq * 128 + k] * wv; a2 += cs[2][kq * 128 + k] * wv; }
        red[kq][0][tid & 63] = a0; red[kq][1][tid & 63] = a1; red[kq][2][tid & 63] = a2;
        __syncthreads();
        if (tid < 192) { const int r = tid >> 6, cc = tid & 63; const float s = red[0][r][cc] + red[1][r][cc] + red[2][r][cc] + red[3][r][cc] + red[4][r][cc] + red[5][r][cc] + red[6][r][cc] + red[7][r][cc] + p.b_mod[l * 6144 + cg * 64 + cc]; mod[(l * 3 + r) * 6144 + cg * 64 + cc] = s; }
        __syncthreads();
    }
    if (blockIdx.x == 0) {
        float* tab = (float*)(p.ws + WS_TAB);
        for (int i = tid; i < 64 * 16; i += NT) { const int pos = i >> 4, f = i & 15; const float inv = powf(10000.f, -(float)f / 16.f); float s, c; sincosf((float)pos * inv, &s, &c); tab[i] = c; tab[1024 + i] = s; }
        for (int i = tid; i < 64 * 8; i += NT) { const int pos = i >> 3, f = i & 7; const float inv = powf(10000.f, -(float)f / 8.f); float s, c; sincosf((float)pos * inv, &s, &c); tab[2048 + i] = c; tab[2560 + i] = s; }
    }
}

__device__ __forceinline__ const float* xrow_in(const P& p, int row) { return row < NPROMPT ? p.x_prompt + (size_t)row * DM : p.x_sample + (size_t)(row - NPROMPT) * DM; }
__device__ __forceinline__ int cond_row(int row) { return row < NPROMPT ? 0 : 1 + ((row - NPROMPT) >> 12); }

__device__ __forceinline__ void ph_prenorm(const P& p, int l) {
    const int lane = tidx() & 63;
    const float* mod = (const float*)(p.ws + WS_MOD);
    bf16* H = (bf16*)(p.ws + WS_H);
    for (int row = blockIdx.x * NWV + (tidx() >> 6); row < NTOK; row += gridDim.x * NWV) {
        const float* xr = (l == 0) ? xrow_in(p, row) : p.out + (size_t)row * DM;
        float4 v[4]; float ss = 0.f;
        for (int i = 0; i < 4; ++i) { v[i] = *(const float4*)(xr + i * 256 + lane * 4); ss += v[i].x * v[i].x + v[i].y * v[i].y + v[i].z * v[i].z + v[i].w * v[i].w; }
        ss = wave_sum(ss);
        const float rinv = rsqrtf(ss * (1.f / 1024.f) + EPS);
        const float* md = mod + (l * 3 + cond_row(row)) * 6144;
        for (int i = 0; i < 4; ++i) {
            const int col = i * 256 + lane * 4;
            const float4 g = *(const float4*)(p.g_pre1 + l * 1024 + col), sc = *(const float4*)(md + 1024 + col), sh = *(const float4*)(md + col);
            const float h0 = v[i].x * rinv * g.x * (1.f + sc.x) + sh.x, h1 = v[i].y * rinv * g.y * (1.f + sc.y) + sh.y;
            const float h2 = v[i].z * rinv * g.z * (1.f + sc.z) + sh.z, h3 = v[i].w * rinv * g.w * (1.f + sc.w) + sh.w;
            *(uint2*)(H + (size_t)row * DM + col) = make_uint2((unsigned)f2bf(h0) | ((unsigned)f2bf(h1) << 16), (unsigned)f2bf(h2) | ((unsigned)f2bf(h3) << 16));
        }
    }
}

__device__ __forceinline__ void ph_post(const P& p, int l, int which) {
    const int lane = tidx() & 63;
    const float* mod = (const float*)(p.ws + WS_MOD);
    bf16* H = (bf16*)(p.ws + WS_H);
    const bf16* src = (const bf16*)(p.ws + (which == 1 ? WS_H : WS_BR));
    const float* gpost = (which == 1 ? p.g_post1 : p.g_post2) + l * 1024;
    const int ga_off = which == 1 ? 2048 : 5120;
    const bool donext = (which == 1) || (l == 0);
    const int ln = which == 1 ? l : l + 1;
    const float* gpre = (which == 1 ? p.g_pre2 : p.g_pre1) + ln * 1024;
    const int sc_off = which == 1 ? 4096 : 1024, sh_off = which == 1 ? 3072 : 0;
    for (int row = blockIdx.x * NWV + (tidx() >> 6); row < NTOK; row += gridDim.x * NWV) {
        const float* xr = (l == 0 && which == 1) ? xrow_in(p, row) : p.out + (size_t)row * DM;
        const int cr = cond_row(row);
        const float* md = mod + (l * 3 + cr) * 6144;
        float4 x[4], s[4]; float ss = 0.f;
        for (int i = 0; i < 4; ++i) {
            const int col = i * 256 + lane * 4;
            x[i] = *(const float4*)(xr + col);
            const uint2 raw = *(const uint2*)(src + (size_t)row * DM + col);
            s[i] = make_float4(bf2f((bf16)(raw.x & 0xffff)), bf2f((bf16)(raw.x >> 16)), bf2f((bf16)(raw.y & 0xffff)), bf2f((bf16)(raw.y >> 16)));
            ss += s[i].x * s[i].x + s[i].y * s[i].y + s[i].z * s[i].z + s[i].w * s[i].w;
        }
        ss = wave_sum(ss);
        const float rinv = rsqrtf(ss * (1.f / 1024.f) + EPS);
        float ss2 = 0.f;
        for (int i = 0; i < 4; ++i) {
            const int col = i * 256 + lane * 4;
            const float4 g = *(const float4*)(gpost + col), ga = *(const float4*)(md + ga_off + col);
            x[i].x += ga.x * s[i].x * rinv * g.x; x[i].y += ga.y * s[i].y * rinv * g.y; x[i].z += ga.z * s[i].z * rinv * g.z; x[i].w += ga.w * s[i].w * rinv * g.w;
            *(float4*)(p.out + (size_t)row * DM + col) = x[i];
            ss2 += x[i].x * x[i].x + x[i].y * x[i].y + x[i].z * x[i].z + x[i].w * x[i].w;
        }
        if (donext) {
            ss2 = wave_sum(ss2);
            const float rinv2 = rsqrtf(ss2 * (1.f / 1024.f) + EPS);
            const float* md2 = mod + (ln * 3 + cr) * 6144;
            for (int i = 0; i < 4; ++i) {
                const int col = i * 256 + lane * 4;
                const float4 g = *(const float4*)(gpre + col), sc = *(const float4*)(md2 + sc_off + col), sh = *(const float4*)(md2 + sh_off + col);
                const float h0 = x[i].x * rinv2 * g.x * (1.f + sc.x) + sh.x, h1 = x[i].y * rinv2 * g.y * (1.f + sc.y) + sh.y;
                const float h2 = x[i].z * rinv2 * g.z * (1.f + sc.z) + sh.z, h3 = x[i].w * rinv2 * g.w * (1.f + sc.w) + sh.w;
                *(uint2*)(H + (size_t)row * DM + col) = make_uint2((unsigned)f2bf(h0) | ((unsigned)f2bf(h1) << 16), (unsigned)f2bf(h2) | ((unsigned)f2bf(h3) << 16));
            }
        }
    }
}

struct GemmArgs { const bf16* A; const bf16* Bt; int lda, ldb, M, N, K, pad; };

struct EpiStore {
    bf16* C; int ldc, nvalid;
    __device__ __forceinline__ void operator()(const f32x16 (&acc)[2][2], int rowbase, int colbase, int tn, int wn, int lane) const {
        _Pragma("unroll") for (int mi = 0; mi < 2; ++mi) _Pragma("unroll") for (int nj = 0; nj < 2; ++nj) {
            const int col = colbase + nj * 32 + (lane & 31);
            if (col < nvalid) _Pragma("unroll") for (int r = 0; r < 16; ++r) { const int row = rowbase + mi * 32 + (r & 3) + 8 * (r >> 2) + 4 * (lane >> 5); C[(size_t)row * ldc + col] = f2bf(acc[mi][nj][r]); }
        }
    }
};
struct EpiGate {
    bf16* C; int ldc;
    __device__ __forceinline__ void operator()(const f32x16 (&acc)[2][2], int rowbase, int colbase, int tn, int wn, int lane) const {
        _Pragma("unroll") for (int mi = 0; mi < 2; ++mi) _Pragma("unroll") for (int nj = 0; nj < 2; ++nj) {
            const int col = colbase + nj * 32 + (lane & 31);
            _Pragma("unroll") for (int r = 0; r < 16; ++r) { const int row = rowbase + mi * 32 + (r & 3) + 8 * (r >> 2) + 4 * (lane >> 5); bf16* q = C + (size_t)row * ldc + col; *q = f2bf(sigmoidf_(acc[mi][nj][r]) * bf2f(*q)); }
        }
    }
};
struct EpiSwiglu {
    bf16* C; int ldc;
    __device__ __forceinline__ void operator()(const f32x16 (&acc)[2][2], int rowbase, int colbase, int tn, int wn, int lane) const {
        const int col = tn * 64 + wn * 32 + (lane & 31);
        _Pragma("unroll") for (int mi = 0; mi < 2; ++mi) _Pragma("unroll") for (int r = 0; r < 16; ++r) {
            const int row = rowbase + mi * 32 + (r & 3) + 8 * (r >> 2) + 4 * (lane >> 5);
            C[(size_t)row * ldc + col] = f2bf(siluf_(acc[mi][0][r]) * acc[mi][1][r]);
        }
    }
};

template <class Epi>
__device__ __forceinline__ void gemm_tiles(const GemmArgs g, const Epi epi, unsigned char* smem) {
    const int vb = tidx() >> 8, tid = tidx() & 255, lane = tid & 63, w = tid >> 6, wm = w >> 1, wn = w & 1;
    bf16* As = (bf16*)(smem + vb * 65536);
    bf16* Bs = As + 2 * 128 * 64;
    const int nM = g.M / 128, nN = g.N / 128, nK = g.K / 64, ntiles = nM * nN;
    const int nvb = gridDim.x * 2, iters = (ntiles + nvb - 1) / nvb;
    for (int it = 0; it < iters; ++it) {
        const int t0 = it * nvb + blockIdx.x * 2 + vb;
        const bool valid = t0 < ntiles;
        const int t = valid ? t0 : 0;
        const int grp = t / (16 * nN), first = grp * 16, gsz = (nM - first) < 16 ? (nM - first) : 16, r0 = t - grp * 16 * nN;
        const int tm = first + r0 % gsz, tn = r0 / gsz;
        const bf16* Ag = g.A + (size_t)(tm * 128) * g.lda;
        const bf16* Bg = g.Bt + (size_t)(tn * 128) * g.ldb;
        typedef unsigned u32x4 __attribute__((ext_vector_type(4)));
        u32x4 ra0, ra1, ra2, ra3, rb0, rb1, rb2, rb3;
        f32x16 acc[2][2];
        _Pragma("unroll") for (int mi = 0; mi < 2; ++mi) _Pragma("unroll") for (int nj = 0; nj < 2; ++nj) _Pragma("unroll") for (int r = 0; r < 16; ++r) acc[mi][nj][r] = 0.f;
        const int lrow = tid >> 3, lch = tid & 7;
        const bf16* Ap = Ag + (size_t)lrow * g.lda + lch * 8;
        const bf16* Bp = Bg + (size_t)lrow * g.ldb + lch * 8;
        const size_t a32 = (size_t)32 * g.lda, b32 = (size_t)32 * g.ldb;
#define GLOAD(k0) { ra0 = *(const u32x4*)(Ap + (k0)); ra1 = *(const u32x4*)(Ap + a32 + (k0)); ra2 = *(const u32x4*)(Ap + 2 * a32 + (k0)); ra3 = *(const u32x4*)(Ap + 3 * a32 + (k0)); \
                    rb0 = *(const u32x4*)(Bp + (k0)); rb1 = *(const u32x4*)(Bp + b32 + (k0)); rb2 = *(const u32x4*)(Bp + 2 * b32 + (k0)); rb3 = *(const u32x4*)(Bp + 3 * b32 + (k0)); }
        GLOAD(0)
        const int soff = lrow * 64 + ((lch ^ (lrow & 7)) << 3);
        for (int kt = 0; kt < nK; ++kt) {
            bf16* Ab = As + (kt & 1) * 8192; bf16* Bb = Bs + (kt & 1) * 8192;
            *(u32x4*)(Ab + soff) = ra0; *(u32x4*)(Ab + soff + 2048) = ra1; *(u32x4*)(Ab + soff + 4096) = ra2; *(u32x4*)(Ab + soff + 6144) = ra3;
            *(u32x4*)(Bb + soff) = rb0; *(u32x4*)(Bb + soff + 2048) = rb1; *(u32x4*)(Bb + soff + 4096) = rb2; *(u32x4*)(Bb + soff + 6144) = rb3;
            __syncthreads();
            if (kt + 1 < nK) GLOAD((kt + 1) * 64)
#pragma unroll
            for (int kk = 0; kk < 4; ++kk) {
                bf16x8 a[2], b[2];
                const int ch = kk * 2 + (lane >> 5);
#pragma unroll
                for (int mi = 0; mi < 2; ++mi) { const int row = wm * 64 + mi * 32 + (lane & 31); a[mi] = *(const bf16x8*)(Ab + row * 64 + ((ch ^ (row & 7)) << 3)); }
#pragma unroll
                for (int nj = 0; nj < 2; ++nj) { const int row = wn * 64 + nj * 32 + (lane & 31); b[nj] = *(const bf16x8*)(Bb + row * 64 + ((ch ^ (row & 7)) << 3)); }
#pragma unroll
                for (int mi = 0; mi < 2; ++mi)
#pragma unroll
                    for (int nj = 0; nj < 2; ++nj) acc[mi][nj] = __builtin_amdgcn_mfma_f32_32x32x16_bf16(a[mi], b[nj], acc[mi][nj], 0, 0, 0);
            }
        }
        if (valid) epi(acc, tm * 128 + wm * 64, tn * 128 + wn * 64, tn, wn, lane);
        __syncthreads();
    }
}

namespace pg8 {
#define PG8_LAS __attribute__((address_space(3)))
typedef unsigned short bf16_t;
typedef short bf16x8 __attribute__((ext_vector_type(8)));
typedef float f32x4 __attribute__((ext_vector_type(4)));
typedef unsigned u32x4 __attribute__((ext_vector_type(4)));
constexpr int BM = 256, BK = 64, HALF = 128, HTB = HALF * BK * 2  , STAGE_BYTES = 8 * HTB, NXCD = 8, WGM = 8;

__host__ __device__ __forceinline__ int lds_byte(int r, int c) { const int st = (r >> 4) * 2 + (c >> 5), rr = r & 15, cc = c & 31, ob = rr * 64 + cc * 2; return st * 1024 + (ob ^ (((ob >> 9) & 1) << 5)); }
__host__ __device__ __forceinline__ void stage_rc(int b, int& R, int& C) { const int st = b / 1024, sb = b % 1024, swz = sb ^ (((sb >> 9) & 1) << 5); R = (st >> 1) * 16 + swz / 64; C = (st & 1) * 32 + (swz % 64) / 2; }
__host__ __device__ __forceinline__ int perm32(int rho) { const int n = rho >> 4, i = rho & 15; return 8 * (i >> 2) + 4 * n + (i & 3); }

struct Unit { int pm, pn; };
struct Gemm { const bf16_t* A; const bf16_t* Bt; int M, N, K, lda, ldb; };

struct StaticOrder {
    int nM, nN, nwg, G, c;
    __host__ __device__ void init(int M, int N, int G_, int c_) { nM = M / BM; nN = N / BM; nwg = nM * nN; G = G_; c = c_; }
    __host__ __device__ bool next(int i, Unit& u) const {
        const long L = (long)i * G + c; if (L >= nwg) return false;
        int wgid = (int)L; { const int q = nwg / NXCD, r = nwg % NXCD, xcd = wgid % NXCD, off = wgid / NXCD; wgid = (xcd < r ? xcd * (q + 1) : r * (q + 1) + (xcd - r) * q) + off; }
        const int nig = WGM * nN, gid = wgid / nig, fm = gid * WGM, gsz = (nM - fm) < WGM ? (nM - fm) : WGM;
        u.pm = fm + ((wgid % nig) % gsz); u.pn = (wgid % nig) / gsz; return true;
    }
    __device__ __forceinline__ void a_ready(const Unit&) const {}
    __device__ __forceinline__ void done(const Unit&) const {}
};

__device__ __forceinline__ unsigned cvt_pk_bf16(float lo, float hi) { unsigned r; asm volatile("v_cvt_pk_bf16_f32 %0, %1, %2" : "=v"(r) : "v"(lo), "v"(hi)); return r; }
template <class Epi, class Sched, bool ALIGN_EPI = false, bool SP2 = false>
__device__ __forceinline__ void gemm_phase(PG8_LAS unsigned char* lds, const Gemm g, const Sched& S, const Epi& E) {
    const int tid = tidx(), wid = __builtin_amdgcn_readfirstlane(tid >> 6), lane = tid & 63, wr = wid >> 2, wc = wid & 3, fr = lane & 15, fq = lane >> 4;
    const int K = g.K, nt = K / BK;
    unsigned voffA[2], voffB[2];
#pragma unroll
    for (int i = 0; i < 2; ++i) { int R, C; stage_rc(tid * 16 + i * 8192, R, C); const int Rb = Epi::PERM ? ((R & ~31) + perm32(R & 31)) : R;
        voffA[i] = (unsigned)(R * g.lda + C) * 2u; voffB[i] = (unsigned)(Rb * g.ldb + C) * 2u; }
    const size_t kstep = (size_t)(BK * 2);
    const size_t hstepA = (size_t)HALF * g.lda * 2, hstepB = (size_t)HALF * g.ldb * 2;
    const size_t tstepA = 2 * hstepA, tstepB = 2 * hstepB;
    const unsigned ldsw = (unsigned)wid * 1024u;
    const int aoff = lds_byte(wr * 64 + fr, fq * 8), boff = lds_byte(wc * 32 + fr, fq * 8);
#define PG8_SA(b, h) (((b) * 2 + (h)) * HTB)
#define PG8_SB(b, h) ((4 + (b) * 2 + (h)) * HTB)
#define PG8_STAGE(bufoff, gbase, voff) do { _Pragma("unroll") for (int _i = 0; _i < 2; ++_i) \
        __builtin_amdgcn_global_load_lds((const unsigned*)((const char*)(gbase) + (voff)[_i]), (PG8_LAS unsigned*)(lds + (bufoff) + ldsw + _i * 8192), 16, 0, 0); } while (0)
#define PG8_LDA(dst, b, h) do { _Pragma("unroll") for (int m = 0; m < 4; ++m) _Pragma("unroll") for (int k = 0; k < 2; ++k) dst[m][k] = *(const PG8_LAS bf16x8*)(lds + PG8_SA(b, h) + aoff + m * 2048 + k * 1024); } while (0)
#define PG8_LDB(dst, b, h) do { _Pragma("unroll") for (int n = 0; n < 2; ++n) _Pragma("unroll") for (int k = 0; k < 2; ++k) dst[n][k] = *(const PG8_LAS bf16x8*)(lds + PG8_SB(b, h) + boff + n * 2048 + k * 1024); } while (0)
#define PG8_MMA(ai, bj, At, Bt) do { __builtin_amdgcn_s_setprio(1); _Pragma("unroll") for (int m = 0; m < 4; ++m) _Pragma("unroll") for (int n = 0; n < 2; ++n) _Pragma("unroll") for (int k = 0; k < 2; ++k) \
        acc[ai][bj][m][n] = __builtin_amdgcn_mfma_f32_16x16x32_bf16(Bt[n][k], At[m][k], acc[ai][bj][m][n], 0, 0, 0); __builtin_amdgcn_s_setprio(0); } while (0)
#define PG8_WAIT_V(n) asm volatile("s_waitcnt vmcnt(" #n ")" ::: "memory")
#define PG8_WAIT_L(n) asm volatile("s_waitcnt lgkmcnt(" #n ")" ::: "memory")
#define PG8_BAR __builtin_amdgcn_s_barrier()
#define PG8_SCHED __builtin_amdgcn_sched_barrier(0)
    Unit cur, nxt; int ui = 0;
    if (!S.next(0, cur)) return;
    f32x4 acc[2][2][4][2];
#pragma unroll
    for (int a = 0; a < 2; ++a)
#pragma unroll
        for (int b = 0; b < 2; ++b)
#pragma unroll
            for (int m = 0; m < 4; ++m)
#pragma unroll
                for (int n = 0; n < 2; ++n) acc[a][b][m][n] = (f32x4){0.f, 0.f, 0.f, 0.f};
    bf16x8 At[4][2], B0[2][2], B1[2][2];
    const char* cA = (const char*)g.A + (size_t)cur.pm * tstepA; const char* cB = (const char*)g.Bt + (size_t)cur.pn * tstepB;
    S.a_ready(cur);
    if constexpr (SP2) {
        PG8_STAGE(PG8_SB(0, 0), cB, voffB); PG8_STAGE(PG8_SB(0, 1), cB + hstepB, voffB); PG8_STAGE(PG8_SA(0, 0), cA, voffA); PG8_STAGE(PG8_SA(0, 1), cA + hstepA, voffA);
        if (wr == 1) PG8_BAR;
        PG8_WAIT_V(2); PG8_BAR;
        PG8_STAGE(PG8_SB(1, 0), cB + kstep, voffB); PG8_STAGE(PG8_SA(1, 0), cA + kstep, voffA); PG8_STAGE(PG8_SB(1, 1), cB + hstepB + kstep, voffB);
        PG8_WAIT_V(6); PG8_BAR;
    } else {
        PG8_STAGE(PG8_SB(0, 0), cB, voffB); PG8_STAGE(PG8_SA(0, 0), cA, voffA); PG8_STAGE(PG8_SB(0, 1), cB + hstepB, voffB); PG8_STAGE(PG8_SA(0, 1), cA + hstepA, voffA);
        if (wr == 1) PG8_BAR;
        PG8_WAIT_V(4); PG8_BAR;
        PG8_STAGE(PG8_SB(1, 0), cB + kstep, voffB); PG8_STAGE(PG8_SA(1, 0), cA + kstep, voffA); PG8_STAGE(PG8_SB(1, 1), cB + hstepB + kstep, voffB);
        PG8_WAIT_V(6); PG8_BAR;
    }
    for (;;) {
        const bool has_next = S.next(ui + 1, nxt);
        const char* nA = has_next ? (const char*)g.A + (size_t)nxt.pm * tstepA : cA; const char* nB = has_next ? (const char*)g.Bt + (size_t)nxt.pn * tstepB : cB;
        for (int t = 0; t < nt; t += 2) {
            const bool last = (t == nt - 2);
            const char* a1 = cA + (size_t)(t + 1) * kstep;
            const char* a2 = last ? nA : cA + (size_t)(t + 2) * kstep; const char* b2 = last ? nB : cB + (size_t)(t + 2) * kstep;
            const char* a3 = a2 + kstep; const char* b3 = b2 + kstep;
            if (last && has_next) S.a_ready(nxt);
            if constexpr (SP2) {
            PG8_LDB(B0, 0, 0); PG8_LDB(B1, 0, 1); PG8_SCHED; PG8_LDA(At, 0, 0); PG8_STAGE(PG8_SA(1, 1), a1 + hstepA, voffA);
            PG8_WAIT_V(8); PG8_WAIT_L(0); PG8_BAR; PG8_MMA(0, 0, At, B0); PG8_MMA(0, 1, At, B1); PG8_BAR; PG8_SCHED;
            PG8_LDA(At, 0, 1); PG8_STAGE(PG8_SB(0, 0), b2, voffB); PG8_STAGE(PG8_SB(0, 1), b2 + hstepB, voffB); PG8_STAGE(PG8_SA(0, 0), a2, voffA);
            PG8_WAIT_V(8); PG8_WAIT_L(0); PG8_BAR; PG8_MMA(1, 0, At, B0); PG8_MMA(1, 1, At, B1); PG8_BAR; PG8_SCHED;
            PG8_LDB(B0, 1, 0); PG8_LDB(B1, 1, 1); PG8_SCHED; PG8_LDA(At, 1, 0); PG8_STAGE(PG8_SA(0, 1), a2 + hstepA, voffA);
            PG8_WAIT_V(8); PG8_WAIT_L(0); PG8_BAR; PG8_MMA(0, 0, At, B0); PG8_MMA(0, 1, At, B1); PG8_BAR; PG8_SCHED;
            PG8_LDA(At, 1, 1); PG8_STAGE(PG8_SB(1, 0), b3, voffB); PG8_STAGE(PG8_SB(1, 1), b3 + hstepB, voffB); PG8_STAGE(PG8_SA(1, 0), a3, voffA);
            PG8_WAIT_V(8); PG8_WAIT_L(0); PG8_BAR; PG8_MMA(1, 0, At, B0); PG8_MMA(1, 1, At, B1); PG8_BAR; PG8_SCHED;
            } else {
            PG8_LDB(B0, 0, 0); PG8_SCHED; PG8_LDA(At, 0, 0); PG8_STAGE(PG8_SA(1, 1), a1 + hstepA, voffA);
            PG8_WAIT_L(8); PG8_BAR; PG8_WAIT_L(0); PG8_MMA(0, 0, At, B0); PG8_BAR; PG8_SCHED;
            PG8_LDB(B1, 0, 1); PG8_STAGE(PG8_SB(0, 0), b2, voffB);
            PG8_BAR; PG8_WAIT_L(0); PG8_MMA(0, 1, At, B1); PG8_BAR;
            PG8_LDA(At, 0, 1); PG8_STAGE(PG8_SA(0, 0), a2, voffA);
            PG8_BAR; PG8_WAIT_L(0); PG8_MMA(1, 0, At, B0); PG8_BAR; PG8_SCHED;
            PG8_STAGE(PG8_SB(0, 1), b2 + hstepB, voffB);
            PG8_WAIT_V(6); PG8_BAR; PG8_MMA(1, 1, At, B1); PG8_BAR;
            PG8_LDB(B0, 1, 0); PG8_SCHED; PG8_LDA(At, 1, 0); PG8_STAGE(PG8_SA(0, 1), a2 + hstepA, voffA);
            PG8_WAIT_L(8); PG8_BAR; PG8_WAIT_L(0); PG8_MMA(0, 0, At, B0); PG8_BAR; PG8_SCHED;
            PG8_LDB(B1, 1, 1); PG8_STAGE(PG8_SB(1, 0), b3, voffB);
            PG8_BAR; PG8_WAIT_L(0); PG8_MMA(0, 1, At, B1); PG8_BAR;
            PG8_LDA(At, 1, 1); PG8_STAGE(PG8_SA(1, 0), a3, voffA);
            PG8_BAR; PG8_WAIT_L(0); PG8_MMA(1, 0, At, B0); PG8_BAR; PG8_SCHED;
            PG8_STAGE(PG8_SB(1, 1), b3 + hstepB, voffB);
            PG8_WAIT_V(6); PG8_BAR; PG8_MMA(1, 1, At, B1); PG8_BAR;
            }
        }
        if constexpr (ALIGN_EPI) { if (wr == 0) PG8_BAR; }
        if constexpr (!Epi::AFTER_DRAIN) { E(acc, cur, wr, wc, fr, fq); S.done(cur); }
        if (!has_next) break;
#pragma unroll
        for (int a = 0; a < 2; ++a)
#pragma unroll
            for (int b = 0; b < 2; ++b)
#pragma unroll
                for (int m = 0; m < 4; ++m)
#pragma unroll
                    for (int n = 0; n < 2; ++n) acc[a][b][m][n] = (f32x4){0.f, 0.f, 0.f, 0.f};
        cur = nxt; cA = nA; cB = nB; ++ui;
        if constexpr (ALIGN_EPI) { if (wr == 1) PG8_BAR; }
    }
    PG8_WAIT_V(0);
    if constexpr (!ALIGN_EPI) { if (wr == 0) PG8_BAR; }
    PG8_BAR;
    if constexpr (Epi::AFTER_DRAIN) { E.fused(acc, cur, wr, wc, fr, fq, lds, wid, lane); S.done(cur); }
#undef PG8_SA
#undef PG8_SB
#undef PG8_STAGE
#undef PG8_LDA
#undef PG8_LDB
#undef PG8_MMA
#undef PG8_WAIT_V
#undef PG8_WAIT_L
#undef PG8_BAR
#undef PG8_SCHED
}
}

namespace pg8 {
__device__ __forceinline__ float fsigmoid(float x) { return __builtin_amdgcn_rcpf(1.f + __expf(-x)); }
typedef unsigned u32x2 __attribute__((ext_vector_type(2)));
struct EpiStoreBf16 {
    static constexpr bool PERM = true, AFTER_DRAIN = false;
    bf16_t* O; int ldc, nvalid;
    __device__ __forceinline__ void operator()(const f32x4 (&acc)[2][2][4][2], const Unit& u, int wr, int wc, int fr, int fq) const {
        const int row0 = u.pm * BM + wr * 64 + fr, col0 = u.pn * BM + wc * 32 + 8 * fq;
#pragma unroll
        for (int ai = 0; ai < 2; ++ai)
#pragma unroll
            for (int m = 0; m < 4; ++m) { bf16_t* rowp = O + (size_t)(row0 + ai * HALF + m * 16) * ldc + col0;
#pragma unroll
                for (int bj = 0; bj < 2; ++bj) if (col0 + bj * HALF < nvalid) { const f32x4 v0 = acc[ai][bj][m][0], v1 = acc[ai][bj][m][1];
                    u32x4 w; w.x = cvt_pk_bf16(v0[0], v0[1]); w.y = cvt_pk_bf16(v0[2], v0[3]); w.z = cvt_pk_bf16(v1[0], v1[1]); w.w = cvt_pk_bf16(v1[2], v1[3]);
                    *(u32x4*)(rowp + bj * HALF) = w; } }
    }
};
struct EpiSwiglu {
    static constexpr bool PERM = false, AFTER_DRAIN = false;
    bf16_t* O; int ldc;
    __device__ __forceinline__ void operator()(const f32x4 (&acc)[2][2][4][2], const Unit& u, int wr, int wc, int fr, int fq) const {
        const int row0 = u.pm * BM + wr * 64 + fr, col0 = u.pn * 128 + wc * 16 + 4 * fq;
#pragma unroll
        for (int ai = 0; ai < 2; ++ai)
#pragma unroll
            for (int m = 0; m < 4; ++m) { bf16_t* rowp = O + (size_t)(row0 + ai * HALF + m * 16) * ldc + col0;
#pragma unroll
                for (int bj = 0; bj < 2; ++bj) { const f32x4 g = acc[ai][bj][m][0], v = acc[ai][bj][m][1];
                    u32x2 w; w.x = cvt_pk_bf16(g[0] * fsigmoid(g[0]) * v[0], g[1] * fsigmoid(g[1]) * v[1]); w.y = cvt_pk_bf16(g[2] * fsigmoid(g[2]) * v[2], g[3] * fsigmoid(g[3]) * v[3]);
                    *(u32x2*)(rowp + bj * 64) = w; } }
    }
};
struct EpiGateMix {
    static constexpr bool PERM = false, AFTER_DRAIN = false;
    const bf16_t* BRB; bf16_t* O;
    __device__ __forceinline__ void operator()(const f32x4 (&acc)[2][2][4][2], const Unit& u, int wr, int wc, int fr, int fq) const {
        const int row0 = u.pm * BM + wr * 64 + fr, d0 = u.pn * 64 + wc * 16 + 4 * fq;
#pragma unroll
        for (int ai = 0; ai < 2; ++ai)
#pragma unroll
            for (int m = 0; m < 4; ++m) { const size_t row = (size_t)(row0 + ai * HALF + m * 16);
                f32x4 s = {0.f, 0.f, 0.f, 0.f};
#pragma unroll
                for (int bj = 0; bj < 2; ++bj)
#pragma unroll
                    for (int n = 0; n < 2; ++n) { const u32x2 raw = *(const u32x2*)(BRB + row * 4096 + (2 * bj + n) * 1024 + d0); const f32x4 g = acc[ai][bj][m][n];
                        s[0] += fsigmoid(g[0]) * __uint_as_float(raw.x << 16); s[1] += fsigmoid(g[1]) * __uint_as_float(raw.x & 0xffff0000u);
                        s[2] += fsigmoid(g[2]) * __uint_as_float(raw.y << 16); s[3] += fsigmoid(g[3]) * __uint_as_float(raw.y & 0xffff0000u); }
                u32x2 w; w.x = cvt_pk_bf16(s[0], s[1]); w.y = cvt_pk_bf16(s[2], s[3]);
                *(u32x2*)(O + row * 1024 + d0) = w; }
    }
};
}

__device__ __forceinline__ void ph_postproj(const P& p, int l) {
    const int lane = tidx() & 63;
    const bf16* proj = (const bf16*)(p.ws + WS_BIG + B_PROJ);
    bf16* cq = (bf16*)(p.ws + WS_BIG + B_CQ);
    bf16* ckv = (bf16*)(p.ws + WS_BIG + B_CKV);
    for (int row = blockIdx.x * NWV + (tidx() >> 6); row < NKVROWS; row += gridDim.x * NWV) {
        if (row >= NTOK) {
            const int r = row - NTOK, b = r >> 8, s = r & 255;
            const float* src = p.cache_b_ckv + ((size_t)(b * 2 + l) * 256 + s) * 128;
            ckv[(size_t)row * 128 + lane] = f2bf(src[lane]); ckv[(size_t)row * 128 + 64 + lane] = f2bf(src[64 + lane]);
            continue;
        }
        const bf16* pr = proj + (size_t)row * PLD;
        float a0 = bf2f(pr[C_BCQ + lane]), a1 = bf2f(pr[C_BCQ + 64 + lane]), a2 = bf2f(pr[C_BCQ + 128 + lane]);
        float ss = wave_sum(a0 * a0 + a1 * a1 + a2 * a2);
        float rinv = rsqrtf(ss * (1.f / 192.f) + EPS);
        const float* gq = p.b_g_cq + l * 192;
        cq[(size_t)row * 192 + lane] = f2bf(a0 * rinv * gq[lane]); cq[(size_t)row * 192 + 64 + lane] = f2bf(a1 * rinv * gq[64 + lane]); cq[(size_t)row * 192 + 128 + lane] = f2bf(a2 * rinv * gq[128 + lane]);
        float k0 = bf2f(pr[C_BCKV + lane]), k1 = bf2f(pr[C_BCKV + 64 + lane]);
        ss = wave_sum(k0 * k0 + k1 * k1);
        rinv = rsqrtf(ss * (1.f / 128.f) + EPS);
        const float* gk = p.b_g_ckv + l * 128;
        k0 = k0 * rinv * gk[lane]; k1 = k1 * rinv * gk[64 + lane];
        ckv[(size_t)row * 128 + lane] = f2bf(k0); ckv[(size_t)row * 128 + 64 + lane] = f2bf(k1);
        if (row < NPROMPT) {
            const int b = row >> 8, s = row & 255;
            const size_t ci = (size_t)(b * 2 + l) * 256 + s;
            p.out[O_CKV + ci * 128 + lane] = k0; p.out[O_CKV + ci * 128 + 64 + lane] = k1;
            p.out[O_CAK + ci * 128 + lane] = bf2f(pr[C_AK + lane]); p.out[O_CAK + ci * 128 + 64 + lane] = bf2f(pr[C_AK + 64 + lane]);
            p.out[O_CAV + ci * 128 + lane] = bf2f(pr[C_AV + lane]); p.out[O_CAV + ci * 128 + 64 + lane] = bf2f(pr[C_AV + 64 + lane]);
            if (lane < 32) p.out[O_KR + ci * 32 + lane] = bf2f(pr[C_BKR + lane]);
        }
    }
}

__device__ __forceinline__ void ph_prep2(const P& p, int l) {
    const int lane = tidx() & 63;
    const float* tab = (const float*)(p.ws + WS_TAB);
    const bf16* proj = (const bf16*)(p.ws + WS_BIG + B_PROJ);
    const bf16* qb = (const bf16*)(p.ws + WS_BIG + B_QB);
    const bf16* kv = (const bf16*)(p.ws + WS_BIG + B_KV);
    bf16* qa1s = (bf16*)(p.ws + WS_BIG + B_QA1S);
    bf16* ka1s = (bf16*)(p.ws + WS_BIG + B_KA1S);
    bf16* qb1s = (bf16*)(p.ws + WS_BIG + B_CQ);
    bf16* kb = (bf16*)(p.ws + WS_BIG + B_KB);
    bf16* kac = (bf16*)(p.ws + WS_KAC);
    bf16* vac = (bf16*)(p.ws + WS_VAC);
    for (int row = blockIdx.x * NWV + (tidx() >> 6); row < NKVROWS; row += gridDim.x * NWV) {
        for (int h = 0; h < 4; ++h) kb[(size_t)row * 384 + h * 96 + lane] = kv[(size_t)row * 512 + h * 128 + lane];
        if (row >= NTOK) {
            const int r = row - NTOK, b = r >> 8, s = r & 255;
            if (lane < 32) { const bf16 v = f2bf(p.cache_b_krope[((size_t)(b * 2 + l) * 256 + s) * 32 + lane]); for (int h = 0; h < 4; ++h) kb[(size_t)row * 384 + h * 96 + 64 + lane] = v; }
            const size_t ci = ((size_t)(b * 2 + l) * 256 + s) * 128;
            kac[(size_t)r * 128 + lane] = f2bf(p.cache_a_k[ci + lane]); kac[(size_t)r * 128 + 64 + lane] = f2bf(p.cache_a_k[ci + 64 + lane]);
            vac[(size_t)r * 128 + lane] = f2bf(p.cache_a_v[ci + lane]); vac[(size_t)r * 128 + 64 + lane] = f2bf(p.cache_a_v[ci + 64 + lane]);
            continue;
        }
        const bf16* pr = proj + (size_t)row * PLD;
        if (row < NPROMPT) {
            if (lane < 32) { const bf16 v = pr[C_BKR + lane]; for (int h = 0; h < 4; ++h) kb[(size_t)row * 384 + h * 96 + 64 + lane] = v; }
            continue;
        }
        const int rs = row - NPROMPT, t = rs & 4095, gr = t >> 6, gc = t & 63;
        {
            if (lane < 32) {
                const int d = lane, qtr = d >> 3, f = d & 7, pos = (qtr < 2) ? gr : gc;
                const float c = tab[2048 + pos * 8 + f], s = tab[2560 + pos * 8 + f];
                const float x = bf2f(pr[C_BKR + d]);
                const float y = bf2f(pr[C_BKR + (d ^ 8)]);
                const float o = (qtr & 1) ? (x * c + y * s) : (x * c - y * s);
                const bf16 v = f2bf(o);
                for (int h = 0; h < 4; ++h) kb[(size_t)row * 384 + h * 96 + 64 + d] = v;
                for (int h = 0; h < 4; ++h) {
                    const float qx = bf2f(qb[(size_t)row * 384 + h * 96 + 64 + d]), qy = bf2f(qb[(size_t)row * 384 + h * 96 + 64 + (d ^ 8)]);
                    qb1s[(size_t)rs * 384 + h * 96 + 64 + d] = f2bf((qtr & 1) ? (qx * c + qy * s) : (qx * c - qy * s));
                }
            }
            for (int h = 0; h < 4; ++h) qb1s[(size_t)rs * 384 + h * 96 + lane] = qb[(size_t)row * 384 + h * 96 + lane];
        }
        {
            const int d = lane, qtr = d >> 4, f = d & 15, pos = (qtr < 2) ? gr : gc;
            const float c = tab[pos * 16 + f], s = tab[1024 + pos * 16 + f];
            for (int h = 0; h < 4; ++h) {
                const float x = bf2f(pr[C_AQ + h * 64 + d]), y = bf2f(pr[C_AQ + h * 64 + (d ^ 16)]);
                qa1s[(size_t)rs * 256 + h * 64 + d] = f2bf((qtr & 1) ? (x * c + y * s) : (x * c - y * s));
            }
            for (int h = 0; h < 2; ++h) {
                const float x = bf2f(pr[C_AK + h * 64 + d]), y = bf2f(pr[C_AK + h * 64 + (d ^ 16)]);
                ka1s[(size_t)rs * 128 + h * 64 + d] = f2bf((qtr & 1) ? (x * c + y * s) : (x * c - y * s));
            }
        }
    }
}

struct AttnJob {
    const bf16 *q1, *q2, *k1, *v1, *k2, *v2;
    const float* sink;
    bf16* out;
    int ldq1, ldq2, ldk1, ldv1, ldk2, ldv2;
    int kstride, vstride, kvgroup, nbatch, T, nk2, window, outcol;
    float scale; int pad;
};

template <int DQK>
__device__ __forceinline__ void attn_item(const AttnJob& j, int blk, unsigned char* smem) {
    float* Ks = (float*)smem;
    float* Vs = Ks + 32 * DQK;
    const int tid = tidx(), eh = (tid >> 8) * 32;
    const int nqb = j.T / 256;
    const int b = blk / (4 * nqb), h = (blk / nqb) % 4, qb0 = (blk % nqb) * 256;
    const int kh = h / j.kvgroup;
    const int t = qb0 + (tid & 255);
    float q[DQK], o[32];
    float m = -1e30f, lsum = 0.f;
#pragma unroll
    for (int e = 0; e < 32; ++e) o[e] = 0.f;
    for (int set = 0; set < 2; ++set) {
        if (set == 1 && j.nk2 == 0) break;
        const bf16* qp = (set == 0) ? j.q1 + ((size_t)b * j.T + t) * j.ldq1 + h * DQK : j.q2 + ((size_t)b * j.T + t) * j.ldq2 + h * DQK;
#pragma unroll
        for (int d = 0; d < DQK; d += 4) { const uint2 raw = *(const uint2*)(qp + d); q[d] = bf2f((bf16)(raw.x & 0xffff)) * j.scale; q[d + 1] = bf2f((bf16)(raw.x >> 16)) * j.scale; q[d + 2] = bf2f((bf16)(raw.y & 0xffff)) * j.scale; q[d + 3] = bf2f((bf16)(raw.y >> 16)) * j.scale; }
        const bf16* kp = (set == 0) ? j.k1 + (size_t)b * j.T * j.ldk1 + kh * j.kstride : j.k2 + (size_t)b * j.nk2 * j.ldk2 + kh * j.kstride;
        const bf16* vp = (set == 0) ? j.v1 + (size_t)b * j.T * j.ldv1 + kh * j.vstride : j.v2 + (size_t)b * j.nk2 * j.ldv2 + kh * j.vstride;
        const int ldk = (set == 0) ? j.ldk1 : j.ldk2, ldv = (set == 0) ? j.ldv1 : j.ldv2;
        int kbeg = 0, kend = (set == 0) ? j.T : j.nk2;
        const bool win = (set == 0) && j.window;
        if (win) { kbeg = qb0 - 128 < 0 ? 0 : qb0 - 128; kend = qb0 + 256 + 128 > j.T ? j.T : qb0 + 256 + 128; }
        for (int ks = kbeg; ks < kend; ks += 32) {
            __syncthreads();
            for (int e = tid; e < 32 * DQK / 4; e += NT) {
                const int key = e / (DQK / 4), c4 = e % (DQK / 4), s = ks + key;
                float4 val = make_float4(0.f, 0.f, 0.f, 0.f);
                if (s < kend) { const uint2 raw = *(const uint2*)(kp + (size_t)s * ldk + c4 * 4); val = make_float4(bf2f((bf16)(raw.x & 0xffff)), bf2f((bf16)(raw.x >> 16)), bf2f((bf16)(raw.y & 0xffff)), bf2f((bf16)(raw.y >> 16))); }
                *(float4*)&Ks[key * DQK + c4 * 4] = val;
            }
            for (int e = tid; e < 32 * 16; e += NT) {
                const int key = e >> 4, c4 = e & 15, s = ks + key;
                float4 val = make_float4(0.f, 0.f, 0.f, 0.f);
                if (s < kend) { const uint2 raw = *(const uint2*)(vp + (size_t)s * ldv + c4 * 4); val = make_float4(bf2f((bf16)(raw.x & 0xffff)), bf2f((bf16)(raw.x >> 16)), bf2f((bf16)(raw.y & 0xffff)), bf2f((bf16)(raw.y >> 16))); }
                *(float4*)&Vs[key * 64 + c4 * 4] = val;
            }
            __syncthreads();
            const int nk = (kend - ks) < 32 ? (kend - ks) : 32;
            for (int key = 0; key < nk; ++key) {
                const int s = ks + key;
                if (win) { const int dlt = t - s; if (dlt > 128 || dlt < -128) continue; }
                float sc = 0.f;
#pragma unroll
                for (int d = 0; d < DQK; d += 4) { const float4 kk = *(const float4*)&Ks[key * DQK + d]; sc += q[d] * kk.x + q[d + 1] * kk.y + q[d + 2] * kk.z + q[d + 3] * kk.w; }
                if (sc > m) { const float c = __expf(m - sc); lsum *= c;
#pragma unroll
                    for (int e = 0; e < 32; ++e) o[e] *= c;
                    m = sc; }
                const float pp = __expf(sc - m);
                lsum += pp;
#pragma unroll
                for (int e = 0; e < 32; e += 4) { const float4 vv = *(const float4*)&Vs[key * 64 + eh + e]; o[e] += pp * vv.x; o[e + 1] += pp * vv.y; o[e + 2] += pp * vv.z; o[e + 3] += pp * vv.w; }
            }
        }
    }
    if (j.sink) {
        const float sk = j.sink[h];
        const float mf = sk > m ? sk : m;
        const float c = __expf(m - mf);
        lsum = lsum * c + __expf(sk - mf);
#pragma unroll
        for (int e = 0; e < 32; ++e) o[e] *= c;
    }
    const float inv = 1.f / lsum;
    bf16* op = j.out + ((size_t)b * j.T + t) * 1024 + j.outcol + h * 64 + eh;
#pragma unroll
    for (int e = 0; e < 32; e += 2) *(unsigned*)(op + e) = (unsigned)f2bf(o[e] * inv) | ((unsigned)f2bf(o[e + 1] * inv) << 16);
}

__device__ __forceinline__ void ph_pool(const P& p, int l, unsigned char* smem_) {
    unsigned char* smem = smem_ + vzero();
    float (*df)[257] = (float (*)[257])smem;
    float (*xs)[256] = (float (*)[256])(smem + 32 * 257 * 4);
    const int tid = tidx(), half = tid >> 8, c256 = tid & 255;
    const bf16* proj = (const bf16*)(p.ws + WS_BIG + B_PROJ);
    bf16* br = (bf16*)(p.ws + WS_BR);
    for (int tile = blockIdx.x; tile < NTOK / 32; tile += gridDim.x) {
        const int row0 = tile * 32;
        int base, T;
        if (row0 < NPROMPT) { base = (row0 >> 8) << 8; T = 256; } else { base = NPROMPT + (((row0 - NPROMPT) >> 12) << 12); T = 4096; }
        const int t0 = row0 - base;
        __syncthreads();
#pragma unroll
        for (int r = 0; r < 3; ++r) {
            const int q = tid + NT * r, rr = q >> 5, ch = q & 31, t = t0 - 8 + rr;
            float4 v0 = make_float4(0.f, 0.f, 0.f, 0.f), v1 = v0;
            if (t >= 0 && t < T) {
                const uint4 raw = *(const uint4*)(proj + (size_t)(base + t) * PLD + C_CIN + ch * 8);
                v0 = make_float4(bf2f((bf16)(raw.x & 0xffff)), bf2f((bf16)(raw.x >> 16)), bf2f((bf16)(raw.y & 0xffff)), bf2f((bf16)(raw.y >> 16)));
                v1 = make_float4(bf2f((bf16)(raw.z & 0xffff)), bf2f((bf16)(raw.z >> 16)), bf2f((bf16)(raw.w & 0xffff)), bf2f((bf16)(raw.w >> 16)));
            }
            *(float4*)&xs[rr][ch * 8] = v0; *(float4*)&xs[rr][ch * 8 + 4] = v1;
        }
        __syncthreads();
        {
            const int c = c256, g = c >> 6, hw = 1 << g;
            for (int i = half * 16; i < half * 16 + 16; ++i) {
                const int t = t0 + i;
                const int lo = t - hw < 0 ? 0 : t - hw, hi = t + hw > T ? T : t + hw;
                float sacc = 0.f;
                for (int u = lo; u < hi; ++u) sacc += xs[u - t0 + 8][c];
                df[i][c] = sacc / (float)(hi - lo) - xs[i + 8][c];
            }
        }
        __syncthreads();
        {
            const int g = c256 >> 6, d = c256 & 63;
            float acc[16];
#pragma unroll
            for (int i = 0; i < 16; ++i) acc[i] = 0.f;
            const float* wp = p.c_w_pool + ((size_t)(l * 4 + g) * 64) * 64 + d;
            for (int c = 0; c < 64; ++c) {
                const float w = wp[c * 64];
#pragma unroll
                for (int i = 0; i < 16; ++i) acc[i] += df[half * 16 + i][g * 64 + c] * w;
            }
            const float sc = p.c_scale[l * 256 + c256];
#pragma unroll
            for (int i = 0; i < 16; ++i) br[(size_t)(row0 + half * 16 + i) * 1024 + 512 + c256] = f2bf(acc[i] * sc);
        }
    }
}

#define GS_KN 0
#define GS_QN 8192
#define GS_W 16384
#define GS_QG 24576
#define GS_KDT 32768
#define GS_ST 49152
#define GS_VNT 57344
#define GS_A 65536
#define GS_U 73728
#define GS_X 90112
#define GS_L 124928
#define GS_SM 142336

__device__ __forceinline__ int swz(int r, int c) { return r * 64 + ((((c) >> 3) ^ (r & 7)) << 3) + (c & 7); }
__device__ __forceinline__ unsigned pk2(float a, float b) { return (unsigned)f2bf(a) | ((unsigned)f2bf(b) << 16); }

__device__ __forceinline__ f32x16 mm_tile(const bf16* A, int m0, const bf16* B, int n0, f32x16 acc, int lane) {
    const int ra = m0 + (lane & 31), rb = n0 + (lane & 31), hh = lane >> 5;
#pragma unroll
    for (int kk = 0; kk < 4; ++kk) {
        const int ch = kk * 2 + hh;
        const bf16x8 a = *(const bf16x8*)(A + ra * 64 + ((ch ^ (ra & 7)) << 3));
        const bf16x8 b = *(const bf16x8*)(B + rb * 64 + ((ch ^ (rb & 7)) << 3));
        acc = __builtin_amdgcn_mfma_f32_32x32x16_bf16(a, b, acc, 0, 0, 0);
    }
    return acc;
}
__device__ __forceinline__ f32x16 zero16() { f32x16 z; _Pragma("unroll") for (int r = 0; r < 16; ++r) z[r] = 0.f; return z; }

struct GdnCtx { int base, T, h, dir, cidx, l; };

typedef float f32x4v __attribute__((ext_vector_type(4)));
#define XLD 136
#define LLD 68
__device__ __forceinline__ void gdn_prep(const P& p, const GdnCtx& c, unsigned char* smem_) {
    unsigned char* smem = smem_ + vzero();
    const int tid = tidx(), lane = tid & 63, wv = tid >> 6;
    bf16* KN = (bf16*)(smem + GS_KN); bf16* QN = (bf16*)(smem + GS_QN); bf16* Wl = (bf16*)(smem + GS_W);
    float* Ul = (float*)(smem + GS_U); float* X = (float*)(smem + GS_X); float* Lm = (float*)(smem + GS_L);
    float* gcs = (float*)(smem + GS_SM); float* betas = gcs + 64; float* qdec = gcs + 128; float* kdec = gcs + 192; float* bexp = gcs + 256;
    const bf16* proj = (const bf16*)(p.ws + WS_BIG + B_PROJ);
    const float* convw = p.d_conv + (size_t)c.l * 5 * 768;
#pragma unroll
    for (int r = 0; r < 3; ++r) {
        const int w = tid + NT * r, i = w / 24, rem = w - i * 24, part = rem >> 3, g8 = rem & 7;
        const int tt = c.cidx * 64 + (c.dir ? 63 - i : i);
        const int ch = part * 256 + c.h * 64 + g8 * 8;
        float u[8];
#pragma unroll
        for (int k = 0; k < 8; ++k) u[k] = 0.f;
#pragma unroll
        for (int j = 0; j < 5; ++j) {
            const int ts = tt + j - 2;
            if (ts >= 0 && ts < c.T) {
                const uint4 raw = *(const uint4*)(proj + (size_t)(c.base + ts) * PLD + C_DQKV + ch);
                const float4 w0 = *(const float4*)(convw + j * 768 + ch), w1 = *(const float4*)(convw + j * 768 + ch + 4);
                u[0] += w0.x * bf2f((bf16)(raw.x & 0xffff)); u[1] += w0.y * bf2f((bf16)(raw.x >> 16)); u[2] += w0.z * bf2f((bf16)(raw.y & 0xffff)); u[3] += w0.w * bf2f((bf16)(raw.y >> 16));
                u[4] += w1.x * bf2f((bf16)(raw.z & 0xffff)); u[5] += w1.y * bf2f((bf16)(raw.z >> 16)); u[6] += w1.z * bf2f((bf16)(raw.w & 0xffff)); u[7] += w1.w * bf2f((bf16)(raw.w >> 16));
            }
        }
        float ss = 0.f;
#pragma unroll
        for (int k = 0; k < 8; ++k) { u[k] = siluf_(u[k]); ss += u[k] * u[k]; }
        ss += __shfl_xor(ss, 1); ss += __shfl_xor(ss, 2); ss += __shfl_xor(ss, 4);
        if (part < 2) {
            const float sc = rsqrtf(ss + EPS) * (part == 0 ? 0.125f : 1.f);
#pragma unroll
            for (int k = 0; k < 8; ++k) u[k] *= sc;
            bf16* dst = (part == 0 ? QN : KN) + i * 64 + ((g8 ^ (i & 7)) << 3);
            *(uint4*)dst = make_uint4(pk2(u[0], u[1]), pk2(u[2], u[3]), pk2(u[4], u[5]), pk2(u[6], u[7]));
        }
        if (part >= 1) {
            float* xd = X + i * XLD + (part == 2 ? 0 : 64) + g8 * 8;
            *(float4*)xd = make_float4(u[0], u[1], u[2], u[3]); *(float4*)(xd + 4) = make_float4(u[4], u[5], u[6], u[7]);
        }
    }
    if (wv == 0) {
        const int i = lane, tt = c.cidx * 64 + (c.dir ? 63 - i : i);
        const bf16* pr = proj + (size_t)(c.base + tt) * PLD;
        const float Aexp = __expf(p.d_a_log[(c.l * 2 + c.dir) * 4 + c.h]), dtb = p.d_dt_bias[(c.l * 2 + c.dir) * 4 + c.h];
        const float beta = sigmoidf_(bf2f(pr[C_DBETA + c.dir * 4 + c.h]));
        const float al = bf2f(pr[C_DALPHA + c.dir * 4 + c.h]) + dtb;
        float g = -Aexp * (al > 20.f ? al : log1pf(__expf(al)));
#pragma unroll
        for (int o = 1; o < 64; o <<= 1) { const float t = __shfl_up(g, o); if (lane >= o) g += t; }
        const float g63 = __shfl(g, 63);
        const float eg = __expf(g);
        gcs[i] = g; betas[i] = beta; qdec[i] = eg; kdec[i] = __expf(g63 - g); bexp[i] = beta * eg;
    }
    __syncthreads();
    {
        const int i = tid >> 3, cg = tid & 7;
        const float sv = betas[i], sk = bexp[i];
        float* xr = X + i * XLD + cg * 16;
        const float s0 = cg < 4 ? sv : sk;
#pragma unroll
        for (int q = 0; q < 4; ++q) { float4 v = *(float4*)(xr + q * 4); v.x *= s0; v.y *= s0; v.z *= s0; v.w *= s0; *(float4*)(xr + q * 4) = v; }
    }
    if (wv < 4) {
        const int mt = wv >> 1, nt = wv & 1, hh = lane >> 5, j = nt * 32 + (lane & 31);
        f32x16 acc = zero16();
        if (nt <= mt) acc = mm_tile(KN, mt * 32, KN, nt * 32, acc, lane);
        const float gj = gcs[j];
#pragma unroll
        for (int r = 0; r < 16; ++r) {
            const int i = mt * 32 + (r & 3) + 8 * (r >> 2) + 4 * hh;
            Lm[i * LLD + j] = (j < i) ? betas[i] * acc[r] * __expf(gcs[i] - gj) : 0.f;
        }
    }
    __syncthreads();
#pragma unroll
    for (int r = 0; r < 4; ++r) {
        if (r > 0) {
            f32x4v acc = {0.f, 0.f, 0.f, 0.f};
            const int li = lane & 15, kq = lane >> 4;
#pragma unroll
            for (int kk = 0; kk < 4 * r; ++kk) {
                const float av = Lm[(16 * r + li) * LLD + 4 * kk + kq];
                const float bv = X[(4 * kk + kq) * XLD + 16 * wv + li];
                acc = __builtin_amdgcn_mfma_f32_16x16x4f32(av, bv, acc, 0, 0, 0);
            }
#pragma unroll
            for (int q = 0; q < 4; ++q) X[(16 * r + 4 * kq + q) * XLD + 16 * wv + li] -= acc[q];
            __syncthreads();
        }
        if (wv < 2) {
            const int col = tid;
            float x[16];
#pragma unroll
            for (int ii = 0; ii < 16; ++ii) x[ii] = X[(16 * r + ii) * XLD + col];
#pragma unroll
            for (int ii = 1; ii < 16; ++ii) {
                float a0 = x[ii], a1 = 0.f;
#pragma unroll
                for (int j4 = 0; j4 < (ii + 3) / 4; ++j4) {
                    const float4 lv = *(const float4*)&Lm[(16 * r + ii) * LLD + 16 * r + 4 * j4];
                    a0 -= lv.x * x[4 * j4]; a1 -= lv.y * x[4 * j4 + 1]; a0 -= lv.z * x[4 * j4 + 2]; a1 -= lv.w * x[4 * j4 + 3];
                }
                x[ii] = a0 + a1;
                X[(16 * r + ii) * XLD + col] = x[ii];
            }
        }
        __syncthreads();
    }
    {
        const int i = tid >> 3, cc = tid & 7, off = i * 64 + ((cc ^ (i & 7)) << 3);
        const float* xr = X + i * XLD + cc * 8;
        *(float4*)(Ul + i * 64 + cc * 8) = *(const float4*)xr; *(float4*)(Ul + i * 64 + cc * 8 + 4) = *(const float4*)(xr + 4);
        const float4 w0 = *(const float4*)(xr + 64), w1 = *(const float4*)(xr + 68);
        *(uint4*)(Wl + off) = make_uint4(pk2(w0.x, w0.y), pk2(w0.z, w0.w), pk2(w1.x, w1.y), pk2(w1.z, w1.w));
    }
    __syncthreads();
}

__device__ __forceinline__ void gdn_t0(unsigned char* smem_, int kb) {
    unsigned char* smem = smem_ + vzero();
    const int tid = tidx(), i = tid >> 3, cc = tid & 7;
    const bf16* KN = (const bf16*)(smem + GS_KN); const bf16* QN = (const bf16*)(smem + GS_QN);
    bf16* QG = (bf16*)(smem + GS_QG); bf16* KDT = (bf16*)(smem + GS_KDT + kb * 8192);
    const float* gcs = (const float*)(smem + GS_SM); const float qd = gcs[128 + i], kd = gcs[192 + i];
    const int off = i * 64 + ((cc ^ (i & 7)) << 3);
    const uint4 q = *(const uint4*)(QN + off), k = *(const uint4*)(KN + off);
    const unsigned qa[4] = {q.x, q.y, q.z, q.w}, ka[4] = {k.x, k.y, k.z, k.w};
    unsigned qo[4];
#pragma unroll
    for (int t = 0; t < 4; ++t) {
        qo[t] = pk2(bf2f((bf16)(qa[t] & 0xffff)) * qd, bf2f((bf16)(qa[t] >> 16)) * qd);
        KDT[swz(cc * 8 + 2 * t, i)] = f2bf(bf2f((bf16)(ka[t] & 0xffff)) * kd);
        KDT[swz(cc * 8 + 2 * t + 1, i)] = f2bf(bf2f((bf16)(ka[t] >> 16)) * kd);
    }
    *(uint4*)(QG + off) = make_uint4(qo[0], qo[1], qo[2], qo[3]);
}

__device__ __forceinline__ void gdn_t12(const P& p, const GdnCtx& c, unsigned char* smem_, int kb, f32x16& Sreg, int mode) {
    unsigned char* smem = smem_ + vzero();
    const int tid = tidx(), lane = tid & 63, wv = tid >> 6, hh = lane >> 5, l31 = lane & 31;
    const bf16* KN = (const bf16*)(smem + GS_KN); const bf16* QN = (const bf16*)(smem + GS_QN); const bf16* Wl = (const bf16*)(smem + GS_W);
    const bf16* QG = (const bf16*)(smem + GS_QG); const bf16* KDT = (const bf16*)(smem + GS_KDT + kb * 8192);
    bf16* ST = (bf16*)(smem + GS_ST); bf16* VNT = (bf16*)(smem + GS_VNT); bf16* Al = (bf16*)(smem + GS_A);
    const float* Ul = (const float*)(smem + GS_U); const float* gcs = (const float*)(smem + GS_SM);
    f32x16 O0 = zero16(), O1 = zero16();
    const float gl = gcs[128 + 63];
    if (wv < 4) {
        const int mt = wv >> 1, nt = wv & 1, e = nt * 32 + l31;
        f32x16 acc = mm_tile(Wl, mt * 32, ST, nt * 32, zero16(), lane);
#pragma unroll
        for (int rg = 0; rg < 4; ++rg) {
            const int i0 = mt * 32 + 8 * rg + 4 * hh;
            const float v0 = Ul[(i0) * 64 + e] - acc[rg * 4], v1 = Ul[(i0 + 1) * 64 + e] - acc[rg * 4 + 1], v2 = Ul[(i0 + 2) * 64 + e] - acc[rg * 4 + 2], v3 = Ul[(i0 + 3) * 64 + e] - acc[rg * 4 + 3];
            *(uint2*)(VNT + swz(e, i0)) = make_uint2(pk2(v0, v1), pk2(v2, v3));
        }
    } else if (wv < 6) {
        const int mt = wv - 4;
        O0 = mm_tile(QG, mt * 32, ST, 0, O0, lane);
        O1 = mm_tile(QG, mt * 32, ST, 32, O1, lane);
    } else {
        const int mt = wv - 6;
#pragma unroll
        for (int nt = 0; nt < 2; ++nt) {
            f32x16 acc = zero16();
            if (nt <= mt) acc = mm_tile(QN, mt * 32, KN, nt * 32, acc, lane);
            const int j = nt * 32 + l31; const float gj = gcs[j];
#pragma unroll
            for (int r = 0; r < 16; ++r) {
                const int i = mt * 32 + (r & 3) + 8 * (r >> 2) + 4 * hh;
                Al[swz(i, j)] = f2bf((j <= i) ? acc[r] * __expf(gcs[i] - gj) : 0.f);
            }
        }
    }
    __syncthreads();
    if (wv < 4) {
        const int mt = wv >> 1, nt = wv & 1, e = nt * 32 + l31;
#pragma unroll
        for (int r = 0; r < 16; ++r) Sreg[r] *= gl;
        Sreg = mm_tile(KDT, mt * 32, VNT, nt * 32, Sreg, lane);
#pragma unroll
        for (int rg = 0; rg < 4; ++rg) {
            const int d0 = mt * 32 + 8 * rg + 4 * hh;
            *(uint2*)(ST + swz(e, d0)) = make_uint2(pk2(Sreg[rg * 4], Sreg[rg * 4 + 1]), pk2(Sreg[rg * 4 + 2], Sreg[rg * 4 + 3]));
        }
    } else if (wv < 6) {
        const int mt = wv - 4;
        O0 = mm_tile(Al, mt * 32, VNT, 0, O0, lane);
        O1 = mm_tile(Al, mt * 32, VNT, 32, O1, lane);
        bf16* br = (bf16*)(p.ws + WS_BR);
        bf16* gob = (bf16*)(p.ws + WS_BIG + B_GOB);
        const bf16* proj = (const bf16*)(p.ws + WS_BIG + B_PROJ);
#pragma unroll
        for (int r = 0; r < 16; ++r) {
            const int i = mt * 32 + (r & 3) + 8 * (r >> 2) + 4 * hh;
            const int tt = c.cidx * 64 + (c.dir ? 63 - i : i);
            const size_t row = (size_t)(c.base + tt);
            bf16* b0 = br + row * 1024 + 768 + c.h * 64 + l31;
            if (mode == 0) { b0[0] = f2bf(O0[r]); b0[32] = f2bf(O1[r]); }
            else if (mode == 1) { bf16* g0 = gob + (row - NPROMPT) * 256 + c.h * 64 + l31; g0[0] = f2bf(O0[r]); g0[32] = f2bf(O1[r]); }
            else {
                const float a0 = O0[r] + bf2f(b0[0]), a1 = O1[r] + bf2f(b0[32]);
                float ss = a0 * a0 + a1 * a1;
                ss += __shfl_xor(ss, 1); ss += __shfl_xor(ss, 2); ss += __shfl_xor(ss, 4); ss += __shfl_xor(ss, 8); ss += __shfl_xor(ss, 16);
                const float rinv = rsqrtf(ss * (1.f / 64.f) + EPS);
                const bf16* zp = proj + row * PLD + C_DZ + c.h * 64 + l31;
                b0[0] = f2bf(a0 * rinv * p.d_g_norm[c.l * 64 + l31] * siluf_(bf2f(zp[0])));
                b0[32] = f2bf(a1 * rinv * p.d_g_norm[c.l * 64 + 32 + l31] * siluf_(bf2f(zp[32])));
            }
        }
    }
}

__device__ __forceinline__ void gdn_prompt_item(const P& p, int l, int item, unsigned char* smem_) {
    unsigned char* smem = smem_ + vzero();
    const int tid = tidx(), lane = tid & 63, wv = tid >> 6, hh = lane >> 5, l31 = lane & 31;
    const int b = item >> 2, h = item & 3;
    bf16* ST = (bf16*)(smem + GS_ST);
    f32x16 Sreg = zero16();
    int kb = 0;
#pragma unroll 1
    for (int s = 0; s < 8; ++s) {
        const int dir = s >> 2, n = s & 3;
        GdnCtx c; c.base = b * 256; c.T = 256; c.h = h; c.dir = dir; c.cidx = dir ? 3 - n : n; c.l = l;
        __syncthreads();
        if (n == 0) {
            Sreg = zero16();
            for (int q = tid; q < 2048; q += NT) ((unsigned*)ST)[q] = 0u;
        }
        gdn_prep(p, c, smem);
        gdn_t0(smem, kb);
        __syncthreads();
        gdn_t12(p, c, smem, kb, Sreg, dir ? 2 : 0);
        kb ^= 1;
        if (n == 3 && wv < 4) {
            const int mt = wv >> 1, nt = wv & 1;
            float* so = p.out + (dir ? O_SB : O_SF) + ((size_t)(b * 2 + l) * 4 + h) * 4096;
#pragma unroll
            for (int r = 0; r < 16; ++r) so[(mt * 32 + (r & 3) + 8 * (r >> 2) + 4 * hh) * 64 + nt * 32 + l31] = Sreg[r];
        }
    }
    __syncthreads();
}

__device__ __forceinline__ void gdn_sample_prep_item(const P& p, int l, int item, unsigned char* smem_) {
    unsigned char* smem = smem_ + vzero();
    const int tid = tidx();
    const int n = item & 63, dir = (item >> 6) & 1, h = (item >> 7) & 3, b = item >> 9;
    GdnCtx c; c.base = NPROMPT + b * 4096; c.T = 4096; c.h = h; c.dir = dir; c.cidx = dir ? 63 - n : n; c.l = l;
    __syncthreads();
    gdn_prep(p, c, smem);
    const bf16* KN = (const bf16*)(smem + GS_KN); const bf16* QN = (const bf16*)(smem + GS_QN); const bf16* Wl = (const bf16*)(smem + GS_W);
    const float* Ul = (const float*)(smem + GS_U); const float* gcs = (const float*)(smem + GS_SM);
    bf16* gqk = (bf16*)(p.ws + WS_BIG + B_GQK); bf16* guw = (bf16*)(p.ws + WS_BIG + B_GUW); float* ggc = (float*)(p.ws + WS_GGC);
    const int i = tid >> 3, cc = tid & 7, off = i * 64 + ((cc ^ (i & 7)) << 3);
    if (dir == 0) {
        const size_t tok = (size_t)b * 4096 + c.cidx * 64 + i;
        *(uint4*)(gqk + ((tok * 4 + h) * 2 + 0) * 64 + cc * 8) = *(const uint4*)(QN + off);
        *(uint4*)(gqk + ((tok * 4 + h) * 2 + 1) * 64 + cc * 8) = *(const uint4*)(KN + off);
    }
    bf16* uw = guw + (size_t)item * 8192;
    const float4 u0 = *(const float4*)(Ul + i * 64 + cc * 8), u1 = *(const float4*)(Ul + i * 64 + cc * 8 + 4);
    *(uint4*)(uw + i * 64 + cc * 8) = make_uint4(pk2(u0.x, u0.y), pk2(u0.z, u0.w), pk2(u1.x, u1.y), pk2(u1.z, u1.w));
    *(uint4*)(uw + 4096 + i * 64 + cc * 8) = *(const uint4*)(Wl + off);
    if (tid < 64) ggc[(size_t)item * 64 + tid] = gcs[tid];
}

__device__ __forceinline__ void gdn_sample_chain(const P& p, int l, int chain, unsigned char* smem_) {
    unsigned char* smem = smem_ + vzero();
    const int tid = tidx(), lane = tid & 63, wv = tid >> 6, hh = lane >> 5, l31 = lane & 31;
    const int dir = chain & 1, h = (chain >> 1) & 3, b = chain >> 3;
    bf16* KN = (bf16*)(smem + GS_KN); bf16* QN = (bf16*)(smem + GS_QN); bf16* Wl = (bf16*)(smem + GS_W); bf16* QG = (bf16*)(smem + GS_QG);
    bf16* ST = (bf16*)(smem + GS_ST); float* Ul = (float*)(smem + GS_U); float* gcs = (float*)(smem + GS_SM);
    const bf16* gqk = (const bf16*)(p.ws + WS_BIG + B_GQK); const bf16* guw = (const bf16*)(p.ws + WS_BIG + B_GUW); const float* ggc = (const float*)(p.ws + WS_GGC);
    const float* stp = (const float*)((uintptr_t)p.state_f + (uintptr_t)dir * ((uintptr_t)p.state_b - (uintptr_t)p.state_f)) + ((size_t)(b * 2 + l) * 4 + h) * 4096;
    f32x16 Sreg = zero16();
    __syncthreads();
    if (wv < 4) {
        const int mt = wv >> 1, nt = wv & 1, e = nt * 32 + l31;
#pragma unroll
        for (int r = 0; r < 16; ++r) Sreg[r] = stp[(mt * 32 + (r & 3) + 8 * (r >> 2) + 4 * hh) * 64 + e];
#pragma unroll
        for (int rg = 0; rg < 4; ++rg) { const int d0 = mt * 32 + 8 * rg + 4 * hh; *(uint2*)(ST + swz(e, d0)) = make_uint2(pk2(Sreg[rg * 4], Sreg[rg * 4 + 1]), pk2(Sreg[rg * 4 + 2], Sreg[rg * 4 + 3])); }
    }
    const int i = tid >> 3, cc = tid & 7, off = i * 64 + ((cc ^ (i & 7)) << 3);
    const int item0 = ((b * 4 + h) * 2 + dir) * 64;
    uint4 rq, rk, ru, rw; float rg_i, rg_l;
#define GDN_LOAD(n) { const int cidx_ = dir ? 63 - (n) : (n); const size_t tok_ = (size_t)b * 4096 + cidx_ * 64 + (dir ? 63 - i : i); \
        rq = *(const uint4*)(gqk + ((tok_ * 4 + h) * 2 + 0) * 64 + cc * 8); rk = *(const uint4*)(gqk + ((tok_ * 4 + h) * 2 + 1) * 64 + cc * 8); \
        const bf16* uw_ = guw + (size_t)(item0 + (n)) * 8192; ru = *(const uint4*)(uw_ + i * 64 + cc * 8); rw = *(const uint4*)(uw_ + 4096 + i * 64 + cc * 8); \
        rg_i = ggc[(size_t)(item0 + (n)) * 64 + i]; rg_l = ggc[(size_t)(item0 + (n)) * 64 + 63]; }
    GDN_LOAD(0)
#pragma unroll 1
    for (int n = 0; n < 64; ++n) {
        const int kb = n & 1;
        bf16* KDT = (bf16*)(smem + GS_KDT + kb * 8192);
        {
            const float qd = __expf(rg_i), kd = __expf(rg_l - rg_i);
            *(uint4*)(QN + off) = rq; *(uint4*)(KN + off) = rk; *(uint4*)(Wl + off) = rw;
            const unsigned qa[4] = {rq.x, rq.y, rq.z, rq.w}, ka[4] = {rk.x, rk.y, rk.z, rk.w}, ua[4] = {ru.x, ru.y, ru.z, ru.w};
            unsigned qo[4];
#pragma unroll
            for (int t = 0; t < 4; ++t) {
                qo[t] = pk2(bf2f((bf16)(qa[t] & 0xffff)) * qd, bf2f((bf16)(qa[t] >> 16)) * qd);
                KDT[swz(cc * 8 + 2 * t, i)] = f2bf(bf2f((bf16)(ka[t] & 0xffff)) * kd);
                KDT[swz(cc * 8 + 2 * t + 1, i)] = f2bf(bf2f((bf16)(ka[t] >> 16)) * kd);
            }
            *(uint4*)(QG + off) = make_uint4(qo[0], qo[1], qo[2], qo[3]);
            *(float4*)(Ul + i * 64 + cc * 8) = make_float4(bf2f((bf16)(ua[0] & 0xffff)), bf2f((bf16)(ua[0] >> 16)), bf2f((bf16)(ua[1] & 0xffff)), bf2f((bf16)(ua[1] >> 16)));
            *(float4*)(Ul + i * 64 + cc * 8 + 4) = make_float4(bf2f((bf16)(ua[2] & 0xffff)), bf2f((bf16)(ua[2] >> 16)), bf2f((bf16)(ua[3] & 0xffff)), bf2f((bf16)(ua[3] >> 16)));
            if (cc == 0) { gcs[i] = rg_i; if (i == 63) gcs[128 + 63] = qd; }
        }
        if (n + 1 < 64) GDN_LOAD(n + 1)
        __syncthreads();
        GdnCtx c; c.base = NPROMPT + b * 4096; c.T = 4096; c.h = h; c.dir = dir; c.cidx = dir ? 63 - n : n; c.l = l;
        gdn_t12(p, c, smem, kb, Sreg, dir);
    }
#undef GDN_LOAD
    __syncthreads();
}

__device__ __forceinline__ void ph_gdn_finalize(const P& p, int l) {
    const int tid = tidx(), lane = tid & 63;
    bf16* br = (bf16*)(p.ws + WS_BR);
    const bf16* gob = (const bf16*)(p.ws + WS_BIG + B_GOB);
    const bf16* proj = (const bf16*)(p.ws + WS_BIG + B_PROJ);
    for (int it = blockIdx.x * NWV + (tid >> 6); it < 8192 * 4; it += gridDim.x * NWV) {
        const int rs = it >> 2, h = it & 3; const size_t row = (size_t)NPROMPT + rs;
        bf16* b0 = br + row * 1024 + 768 + h * 64 + lane;
        const float a = bf2f(*b0) + bf2f(gob[(size_t)rs * 256 + h * 64 + lane]);
        const float ss = wave_sum(a * a);
        const float rinv = rsqrtf(ss * (1.f / 64.f) + EPS);
        const float z = bf2f(proj[row * PLD + C_DZ + h * 64 + lane]);
        *b0 = f2bf(a * rinv * p.d_g_norm[l * 64 + lane] * siluf_(z));
    }
}

template <int DQK>
__device__ __forceinline__ void attn_mfma_item(const AttnJob& j, int blk, unsigned char* smem_) {
    unsigned char* smem = smem_ + vzero();
    const int tid = tidx(), lane = tid & 63, wv = tid >> 6, grp = wv >> 2, wq = wv & 3, l31 = lane & 31, hh = lane >> 5, gt = tid & 255;
    constexpr int KLD = DQK + 8, NKC = DQK / 8, NKK = DQK / 16;
    constexpr int KBYTES = 64 * KLD * 2, VBYTES = 64 * 68 * 2, BUFB = KBYTES + VBYTES;
    constexpr int NKI = NKC * 64 / 256;
    const int nqb = j.T / 128;
    const int b = blk / (4 * nqb), h = (blk / nqb) % 4, q0 = (blk % nqb) * 128;
    const int kh = h / j.kvgroup;
    int kbeg = 0, kend = j.T;
    if (j.window) { kbeg = q0 - 128 < 0 ? 0 : q0 - 128; kend = q0 + 256 > j.T ? j.T : q0 + 256; }
    const int n1 = (kend - kbeg) >> 6, n2 = j.nk2 >> 6, nt = n1 + n2, nt0 = (nt + 1) >> 1;
    const int tbeg = grp ? nt0 : 0, tcnt = grp ? nt - nt0 : nt0;
    const int tq = q0 + wq * 32 + l31;
    const float sc2 = j.scale * 1.4426950408889634f;
    const bf16* k1p = j.k1 + (size_t)b * j.T * j.ldk1 + kh * j.kstride; const bf16* v1p = j.v1 + (size_t)b * j.T * j.ldv1 + kh * j.vstride;
    const bf16* k2p = j.k2 + (size_t)b * j.nk2 * j.ldk2 + kh * j.kstride; const bf16* v2p = j.v2 + (size_t)b * j.nk2 * j.ldv2 + kh * j.vstride;
    typedef unsigned u32x4 __attribute__((ext_vector_type(4)));
    u32x4 kr0, kr1, kr2, vr0, vr1;
    kr2 = (u32x4){0u, 0u, 0u, 0u};
#define ATT_LOAD(t_) { const int t__ = (t_); const bool s1__ = t__ < n1; const int ks__ = s1__ ? kbeg + t__ * 64 : (t__ - n1) * 64; \
        const bf16* kp__ = s1__ ? k1p : k2p; const bf16* vp__ = s1__ ? v1p : v2p; const int ldk__ = s1__ ? j.ldk1 : j.ldk2, ldv__ = s1__ ? j.ldv1 : j.ldv2; \
        { const int c_ = gt; kr0 = *(const u32x4*)(kp__ + (size_t)(ks__ + c_ / NKC) * ldk__ + (c_ % NKC) * 8); } \
        { const int c_ = gt + 256; kr1 = *(const u32x4*)(kp__ + (size_t)(ks__ + c_ / NKC) * ldk__ + (c_ % NKC) * 8); } \
        if (NKI > 2) { const int c_ = gt + 512; kr2 = *(const u32x4*)(kp__ + (size_t)(ks__ + c_ / NKC) * ldk__ + (c_ % NKC) * 8); } \
        { const int c_ = gt; vr0 = *(const u32x4*)(vp__ + (size_t)(ks__ + (c_ >> 3)) * ldv__ + (c_ & 7) * 8); } \
        { const int c_ = gt + 256; vr1 = *(const u32x4*)(vp__ + (size_t)(ks__ + (c_ >> 3)) * ldv__ + (c_ & 7) * 8); } }
#define ATT_VSCAT(vr_, c_) { const int key_ = (c_) >> 3, e0_ = ((c_) & 7) * 8; \
        VT[(e0_ + 0) * 68 + key_] = (bf16)(vr_[0] & 0xffff); VT[(e0_ + 1) * 68 + key_] = (bf16)(vr_[0] >> 16); VT[(e0_ + 2) * 68 + key_] = (bf16)(vr_[1] & 0xffff); VT[(e0_ + 3) * 68 + key_] = (bf16)(vr_[1] >> 16); \
        VT[(e0_ + 4) * 68 + key_] = (bf16)(vr_[2] & 0xffff); VT[(e0_ + 5) * 68 + key_] = (bf16)(vr_[2] >> 16); VT[(e0_ + 6) * 68 + key_] = (bf16)(vr_[3] & 0xffff); VT[(e0_ + 7) * 68 + key_] = (bf16)(vr_[3] >> 16); }
#define ATT_STORE(buf_) { bf16* Kl = (bf16*)(smem + ((buf_) * 2 + grp) * BUFB); bf16* VT = (bf16*)(smem + ((buf_) * 2 + grp) * BUFB + KBYTES); \
        { const int c_ = gt; *(u32x4*)(Kl + (c_ / NKC) * KLD + (c_ % NKC) * 8) = kr0; } \
        { const int c_ = gt + 256; *(u32x4*)(Kl + (c_ / NKC) * KLD + (c_ % NKC) * 8) = kr1; } \
        if (NKI > 2) { const int c_ = gt + 512; *(u32x4*)(Kl + (c_ / NKC) * KLD + (c_ % NKC) * 8) = kr2; } \
        ATT_VSCAT(vr0, gt) ATT_VSCAT(vr1, gt + 256) }
    bf16x8 qf[NKK];
    int qset = -1;
    f32x16 o0 = zero16(), o1 = zero16();
    float m = -1e30f, lsum = 0.f;
    __syncthreads();
    if (tcnt > 0) { ATT_LOAD(tbeg) ATT_STORE(0) }
    __syncthreads();
#pragma unroll 1
    for (int s = 0; s < nt0; ++s) {
        const bool has = s < tcnt, hasn = s + 1 < tcnt;
        if (hasn) ATT_LOAD(tbeg + s + 1)
        if (has) {
            const int t = tbeg + s; const bool s1 = t < n1; const int ks = s1 ? kbeg + t * 64 : (t - n1) * 64;
            const int set = s1 ? 0 : 1;
            if (set != qset) {
                qset = set;
                const bf16* qp = (set == 0 ? j.q1 + ((size_t)b * j.T + tq) * j.ldq1 : j.q2 + ((size_t)b * j.T + tq) * j.ldq2) + h * DQK;
#pragma unroll
                for (int kk = 0; kk < NKK; ++kk) qf[kk] = *(const bf16x8*)(qp + kk * 16 + hh * 8);
            }
            const bf16* Kl = (const bf16*)(smem + ((s & 1) * 2 + grp) * BUFB); const bf16* VT = (const bf16*)(smem + ((s & 1) * 2 + grp) * BUFB + KBYTES);
            f32x16 s0 = zero16(), s1v = zero16();
#pragma unroll
            for (int kk = 0; kk < NKK; ++kk) {
                const bf16x8 a0 = *(const bf16x8*)(Kl + l31 * KLD + kk * 16 + hh * 8);
                const bf16x8 a1 = *(const bf16x8*)(Kl + (32 + l31) * KLD + kk * 16 + hh * 8);
                s0 = __builtin_amdgcn_mfma_f32_32x32x16_bf16(a0, qf[kk], s0, 0, 0, 0);
                s1v = __builtin_amdgcn_mfma_f32_32x32x16_bf16(a1, qf[kk], s1v, 0, 0, 0);
            }
            const bool win = s1 && j.window;
            float mx = -INFINITY;
#pragma unroll
            for (int r = 0; r < 16; ++r) {
                float a = s0[r] * sc2, c = s1v[r] * sc2;
                if (win) { const int d0 = tq - (ks + (r & 3) + 8 * (r >> 2) + 4 * hh); if (d0 > 128 || d0 < -128) a = -INFINITY; const int d1 = d0 - 32; if (d1 > 128 || d1 < -128) c = -INFINITY; }
                s0[r] = a; s1v[r] = c; mx = fmaxf(mx, fmaxf(a, c));
            }
            mx = fmaxf(mx, __shfl_xor(mx, 32));
            const float mnew = fmaxf(m, mx), alpha = __builtin_amdgcn_exp2f(m - mnew);
            m = mnew;
            float ps = 0.f;
#pragma unroll
            for (int r = 0; r < 16; ++r) { s0[r] = __builtin_amdgcn_exp2f(s0[r] - mnew); s1v[r] = __builtin_amdgcn_exp2f(s1v[r] - mnew); ps += s0[r] + s1v[r]; }
            lsum = lsum * alpha + ps;
#pragma unroll
            for (int r = 0; r < 16; ++r) { o0[r] *= alpha; o1[r] *= alpha; }
#pragma unroll
            for (int k4 = 0; k4 < 4; ++k4) {
                const int sp = (k4 & 1) * 8;
                unsigned pw[4];
#pragma unroll
                for (int q2 = 0; q2 < 4; ++q2) pw[q2] = (k4 < 2) ? pk2(s0[sp + 2 * q2], s0[sp + 2 * q2 + 1]) : pk2(s1v[sp + 2 * q2], s1v[sp + 2 * q2 + 1]);
                const u32x4 pwv = {pw[0], pw[1], pw[2], pw[3]};
                const bf16x8 pf = __builtin_bit_cast(bf16x8, pwv);
                {
                    const uint2 x0 = *(const uint2*)(VT + l31 * 68 + 16 * k4 + 4 * hh), x1 = *(const uint2*)(VT + l31 * 68 + 16 * k4 + 8 + 4 * hh);
                    const u32x4 av = {x0.x, x0.y, x1.x, x1.y};
                    o0 = __builtin_amdgcn_mfma_f32_32x32x16_bf16(__builtin_bit_cast(bf16x8, av), pf, o0, 0, 0, 0);
                }
                {
                    const uint2 x0 = *(const uint2*)(VT + (32 + l31) * 68 + 16 * k4 + 4 * hh), x1 = *(const uint2*)(VT + (32 + l31) * 68 + 16 * k4 + 8 + 4 * hh);
                    const u32x4 av = {x0.x, x0.y, x1.x, x1.y};
                    o1 = __builtin_amdgcn_mfma_f32_32x32x16_bf16(__builtin_bit_cast(bf16x8, av), pf, o1, 0, 0, 0);
                }
            }
        }
        if (hasn) ATT_STORE((s + 1) & 1)
        __syncthreads();
    }
#undef ATT_LOAD
#undef ATT_VSCAT
#undef ATT_STORE
    lsum += __shfl_xor(lsum, 32);
    float* CO = (float*)smem;
    if (grp == 1) {
#pragma unroll
        for (int r = 0; r < 16; ++r) { CO[((wq * 34 + r) * 64 + lane)] = o0[r]; CO[((wq * 34 + 16 + r) * 64 + lane)] = o1[r]; }
        CO[((wq * 34 + 32) * 64 + lane)] = m; CO[((wq * 34 + 33) * 64 + lane)] = lsum;
    }
    __syncthreads();
    if (grp == 0) {
        const float m1 = CO[((wq * 34 + 32) * 64 + lane)], l1 = CO[((wq * 34 + 33) * 64 + lane)];
        float mf = fmaxf(m, m1);
        float sk2 = 0.f;
        if (j.sink) { sk2 = j.sink[h] * 1.4426950408889634f; mf = fmaxf(mf, sk2); }
        const float a0 = __builtin_amdgcn_exp2f(m - mf), a1 = __builtin_amdgcn_exp2f(m1 - mf);
        float lt = lsum * a0 + l1 * a1;
        if (j.sink) lt += __builtin_amdgcn_exp2f(sk2 - mf);
        const float inv = 1.f / lt;
        bf16* op = j.out + ((size_t)b * j.T + tq) * 1024 + j.outcol + h * 64;
#pragma unroll
        for (int rg = 0; rg < 4; ++rg) {
            float v[8];
#pragma unroll
            for (int k = 0; k < 4; ++k) {
                v[k] = (o0[rg * 4 + k] * a0 + CO[((wq * 34 + rg * 4 + k) * 64 + lane)] * a1) * inv;
                v[4 + k] = (o1[rg * 4 + k] * a0 + CO[((wq * 34 + 16 + rg * 4 + k) * 64 + lane)] * a1) * inv;
            }
            *(uint2*)(op + 8 * rg + 4 * hh) = make_uint2(pk2(v[0], v[1]), pk2(v[2], v[3]));
            *(uint2*)(op + 32 + 8 * rg + 4 * hh) = make_uint2(pk2(v[4], v[5]), pk2(v[6], v[7]));
        }
    }
}

#define XB_TMO      128
#define XB_XCNT(j)  (256  + 64 * (j))
#define XB_XSUB(j)  (1280 + 64 * (j))
#define XB_XGEN(j)  (2304 + 64 * (j))
#define XB_TOP      3328
#define XB_TOPGEN   3392
#define XCD_BAR_WORDS 3456
#define XB_SPIN_CAP (1u << 18)
#define LAS __attribute__((address_space(3)))

__device__ __forceinline__ unsigned xb_ld(unsigned* p)              { return __hip_atomic_load(p, __ATOMIC_RELAXED, __HIP_MEMORY_SCOPE_AGENT); }
__device__ __forceinline__ unsigned xb_add(unsigned* p, unsigned v) { return __hip_atomic_fetch_add(p, v, __ATOMIC_RELAXED, __HIP_MEMORY_SCOPE_AGENT); }
__device__ __forceinline__ unsigned xb_xcc_id() { return (unsigned)__builtin_amdgcn_s_getreg((3 << 11) | 20) & 0xFu; }
#define XB_SPIN(cond, bar) do { unsigned _sp = 0; while (cond) { __builtin_amdgcn_s_sleep(1); \
    if ((++_sp & 255u) == 0u) { if (xb_ld(&(bar)[XB_TMO])) break; if (_sp > XB_SPIN_CAP) { atomicAdd(&(bar)[XB_TMO], 1u); break; } } } } while (0)

struct XcdBarrier {
    unsigned* bar; unsigned x;
    volatile LAS unsigned* st;
};

__device__ __forceinline__ XcdBarrier xcd_barrier_post(unsigned* bar, volatile LAS unsigned* st) {
    XcdBarrier b; b.bar = bar; b.x = xb_xcc_id(); b.st = st;
    if (threadIdx.x == 0) (void)xb_add(&bar[XB_XCNT(b.x)], 1u);
    return b;
}
__device__ __forceinline__ void xcd_barrier_complete(unsigned* bar, unsigned x, unsigned& nloc, unsigned& nx) {
    const unsigned G = gridDim.x * gridDim.y * gridDim.z;
    unsigned sum, cnt, mine, sp = 0u;
    for (;;) {
        sum = 0u; cnt = 0u; mine = 0u;
#pragma unroll
        for (unsigned j = 0; j < 16; ++j) { const unsigned c = xb_ld(&bar[XB_XCNT(j)]); sum += c; cnt += (c > 0u) ? 1u : 0u; mine = (j == x) ? c : mine; }
        if (sum == G) break;
        __builtin_amdgcn_s_sleep(1);
        if ((++sp & 255u) == 0u) { if (xb_ld(&bar[XB_TMO])) break; if (sp > XB_SPIN_CAP) { atomicAdd(&bar[XB_TMO], 1u); break; } }
    }
    nloc = mine > 0u ? mine : 1u; nx = cnt > 0u ? cnt : 1u;
}

__device__ __forceinline__ void xcd_barrier(const XcdBarrier& b) {
    asm volatile("s_waitcnt vmcnt(0)" ::: "memory");
    __syncthreads();
    if (threadIdx.x == 0) {
        unsigned* bar = b.bar;
        __builtin_amdgcn_s_waitcnt(0);
        unsigned nloc = b.st[0], nx = b.st[1];
        if (nloc == 0u) { xcd_barrier_complete(bar, b.x, nloc, nx); b.st[0] = nloc; b.st[1] = nx; }
        const unsigned old = xb_add(&bar[XB_XSUB(b.x)], 1u);
        const unsigned gen = old / nloc;
        if (old + 1u == (gen + 1u) * nloc) {
            __builtin_amdgcn_fence(__ATOMIC_RELEASE, "agent");
            asm volatile("s_waitcnt vmcnt(0)" ::: "memory");
            const unsigned og = xb_add(&bar[XB_TOP], 1u);
            const unsigned tg = og / nx;
            if (og + 1u == (tg + 1u) * nx) xb_add(&bar[XB_TOPGEN], 1u);
            else XB_SPIN(xb_ld(&bar[XB_TOPGEN]) == tg, bar);
            __builtin_amdgcn_fence(__ATOMIC_ACQUIRE, "agent");
            xb_add(&bar[XB_XGEN(b.x)], 1u);
            asm volatile("s_waitcnt vmcnt(0)" ::: "memory");
        } else {
            XB_SPIN(xb_ld(&bar[XB_XGEN(b.x)]) == gen, bar);
            __builtin_amdgcn_fence(__ATOMIC_ACQUIRE, "agent");
            asm volatile("s_waitcnt vmcnt(0)" ::: "memory");
        }
    }
    __syncthreads();
}


struct KArgs { P p; TJobs J[2]; };

__device__ __forceinline__ AttnJob make_job(const P& p, int l, int variant) {
    unsigned char* ws = p.ws; unsigned char* big = ws + WS_BIG;
    bf16* proj = (bf16*)(big + B_PROJ); bf16* BRb = (bf16*)(ws + WS_BR);
    const float bscale = 0.10206207261596575f;
    AttnJob j{};
    if (variant == 0) {
        j.q1 = proj + C_AQ; j.ldq1 = PLD; j.k1 = proj + C_AK; j.ldk1 = PLD; j.v1 = proj + C_AV; j.ldv1 = PLD; j.kstride = 64; j.vstride = 64; j.kvgroup = 2;
        j.nbatch = 32; j.T = 256; j.nk2 = 0; j.window = 0; j.sink = p.a_sink + l * 4; j.scale = 0.125f; j.out = BRb; j.outcol = 0;
    } else if (variant == 1) {
        j.q1 = (bf16*)(big + B_QA1S); j.ldq1 = 256; j.q2 = proj + (size_t)NPROMPT * PLD + C_AQ; j.ldq2 = PLD;
        j.k1 = (bf16*)(big + B_KA1S); j.ldk1 = 128; j.v1 = proj + (size_t)NPROMPT * PLD + C_AV; j.ldv1 = PLD;
        j.k2 = (bf16*)(ws + WS_KAC); j.ldk2 = 128; j.v2 = (bf16*)(ws + WS_VAC); j.ldv2 = 128; j.kstride = 64; j.vstride = 64; j.kvgroup = 2;
        j.nbatch = 2; j.T = 4096; j.nk2 = 256; j.window = 1; j.sink = p.a_sink + l * 4; j.scale = 0.125f; j.out = BRb + (size_t)NPROMPT * 1024; j.outcol = 0;
    } else if (variant == 2) {
        j.q1 = (bf16*)(big + B_QB); j.ldq1 = 384; j.k1 = (bf16*)(big + B_KB); j.ldk1 = 384; j.v1 = (bf16*)(big + B_KV) + 64; j.ldv1 = 512; j.kstride = 96; j.vstride = 128; j.kvgroup = 1;
        j.nbatch = 32; j.T = 256; j.nk2 = 0; j.window = 0; j.sink = nullptr; j.scale = bscale; j.out = BRb; j.outcol = 256;
    } else {
        j.q1 = (bf16*)(big + B_CQ); j.ldq1 = 384; j.q2 = (bf16*)(big + B_QB) + (size_t)NPROMPT * 384; j.ldq2 = 384;
        j.k1 = (bf16*)(big + B_KB) + (size_t)NPROMPT * 384; j.ldk1 = 384; j.v1 = (bf16*)(big + B_KV) + (size_t)NPROMPT * 512 + 64; j.ldv1 = 512;
        j.k2 = (bf16*)(big + B_KB) + (size_t)NTOK * 384; j.ldk2 = 384; j.v2 = (bf16*)(big + B_KV) + (size_t)NTOK * 512 + 64; j.ldv2 = 512; j.kstride = 96; j.vstride = 128; j.kvgroup = 1;
        j.nbatch = 2; j.T = 4096; j.nk2 = 256; j.window = 0; j.sink = nullptr; j.scale = bscale; j.out = BRb + (size_t)NPROMPT * 1024; j.outcol = 256;
    }
    return j;
}

#define LDSP(smem) ((PG8_LAS unsigned char*)(smem))
__device__ __forceinline__ void ph_gemm_proj(const P& p, unsigned char* smem) {
    pg8::Gemm g{(bf16*)(p.ws + WS_H), (bf16*)(p.ws + WS_W + W_A), NTOK, 2304, 1024, 1024, 1024}; pg8::StaticOrder S; S.init(NTOK, 2304, gridDim.x, blockIdx.x);
    pg8::EpiStoreBf16 E{(bf16*)(p.ws + WS_BIG + B_PROJ), PLD, PLD};
    pg8::gemm_phase<pg8::EpiStoreBf16, pg8::StaticOrder, true, true>(LDSP(smem), g, S, E);
}
__device__ __forceinline__ void ph_gemm_mla(const P& p, unsigned char* smem) {
    unsigned char* big = p.ws + WS_BIG;
    { GemmArgs g{(bf16*)(big + B_CQ), (bf16*)(p.ws + WS_W + W_UQ), 192, 192, NTOK, 384, 192, 0}; EpiStore e{(bf16*)(big + B_QB), 384, 384}; gemm_tiles(g, e, smem); }
    { GemmArgs g{(bf16*)(big + B_CKV), (bf16*)(p.ws + WS_W + W_UKV), 128, 128, NKVROWS, 512, 128, 0}; EpiStore e{(bf16*)(big + B_KV), 512, 512}; gemm_tiles(g, e, smem); }
}
__device__ __forceinline__ void ph_gemm_br(const P& p, unsigned char* smem) {
    bf16* BRb = (bf16*)(p.ws + WS_BR); bf16* brb = (bf16*)(p.ws + WS_BIG + B_BRB);
#pragma unroll 1
    for (int m = 0; m < 4; ++m) {
        pg8::Gemm g{BRb + m * 256, (bf16*)(p.ws + WS_W + W_BR) + (size_t)m * 1024 * 256, NTOK, 1024, 256, 1024, 256}; pg8::StaticOrder S; S.init(NTOK, 1024, gridDim.x, blockIdx.x);
        pg8::EpiStoreBf16 E{brb + m * 1024, 4096, 1 << 30};
        pg8::gemm_phase<pg8::EpiStoreBf16, pg8::StaticOrder, true, true>(LDSP(smem), g, S, E);
    }
}
__device__ __forceinline__ void ph_gemm_gate(const P& p, unsigned char* smem) {
    pg8::Gemm g{(bf16*)(p.ws + WS_H), (bf16*)(p.ws + WS_W + W_G), NTOK, 4096, 1024, 1024, 1024}; pg8::StaticOrder S; S.init(NTOK, 4096, gridDim.x, blockIdx.x);
    pg8::EpiGateMix E{(const bf16*)(p.ws + WS_BIG + B_BRB), (bf16*)(p.ws + WS_BR)};
    pg8::gemm_phase<pg8::EpiGateMix, pg8::StaticOrder, true, true>(LDSP(smem), g, S, E);
}
__device__ __forceinline__ void ph_gemm_wo(const P& p, unsigned char* smem) {
    pg8::Gemm g{(bf16*)(p.ws + WS_BR), (bf16*)(p.ws + WS_W + W_O), NTOK, 1024, 1024, 1024, 1024}; pg8::StaticOrder S; S.init(NTOK, 1024, gridDim.x, blockIdx.x);
    pg8::EpiStoreBf16 E{(bf16*)(p.ws + WS_H), 1024, 1024};
    pg8::gemm_phase<pg8::EpiStoreBf16, pg8::StaticOrder, true, true>(LDSP(smem), g, S, E);
}
__device__ __forceinline__ void ph_gemm_up(const P& p, unsigned char* smem) {
    pg8::Gemm g{(bf16*)(p.ws + WS_H), (bf16*)(p.ws + WS_W + W_UP), NTOK, 5632, 1024, 1024, 1024}; pg8::StaticOrder S; S.init(NTOK, 5632, gridDim.x, blockIdx.x);
    pg8::EpiSwiglu E{(bf16*)(p.ws + WS_BIG + B_HID), DFF};
    pg8::gemm_phase<pg8::EpiSwiglu, pg8::StaticOrder, true, true>(LDSP(smem), g, S, E);
}
__device__ __forceinline__ void ph_gemm_down(const P& p, unsigned char* smem) {
    pg8::Gemm g{(bf16*)(p.ws + WS_BIG + B_HID), (bf16*)(p.ws + WS_W + W_DN), NTOK, 1024, DFF, DFF, DFF}; pg8::StaticOrder S; S.init(NTOK, 1024, gridDim.x, blockIdx.x);
    pg8::EpiStoreBf16 E{(bf16*)(p.ws + WS_BR), 1024, 1024};
    pg8::gemm_phase<pg8::EpiStoreBf16, pg8::StaticOrder, true, true>(LDSP(smem), g, S, E);
}
__device__ __forceinline__ void attn_dispatch(const P& p, int l, int variant, int blk, unsigned char* smem) {
    if (variant == 0) { const AttnJob j = make_job(p, l, 0); attn_mfma_item<64>(j, blk, smem); }
    else if (variant == 1) { const AttnJob j = make_job(p, l, 1); attn_mfma_item<64>(j, blk, smem); }
    else if (variant == 2) { const AttnJob j = make_job(p, l, 2); attn_mfma_item<96>(j, blk, smem); }
    else { const AttnJob j = make_job(p, l, 3); attn_mfma_item<96>(j, blk, smem); }
}
#ifndef REPEAT_MASK
#define REPEAT_MASK 0
#endif
#define NREP(bit) (1 + ((REPEAT_MASK >> (bit)) & 1))
__device__ __forceinline__ void ph_mixers1(const P& p, int l, unsigned char* smem) {
#pragma unroll 1
    for (int rep = 0; rep < NREP(16); ++rep)
        for (int item = blockIdx.x; item < 1024; item += gridDim.x) gdn_sample_prep_item(p, l, item, smem);
#pragma unroll 1
    for (int rep = 0; rep < NREP(17); ++rep)
        for (int item = blockIdx.x; item < 768; item += gridDim.x) { const int vi = item >> 8; attn_dispatch(p, l, vi == 0 ? 1 : vi == 1 ? 2 : 0, item & 255, smem); }
    __syncthreads();
#pragma unroll 1
    for (int rep = 0; rep < NREP(18); ++rep) ph_pool(p, l, smem);
}
__device__ __forceinline__ void ph_mixers2(const P& p, int l, unsigned char* smem) {
    const int nb = gridDim.x, bid = blockIdx.x;
    if (bid < 16) {
#pragma unroll 1
        for (int rep = 0; rep < NREP(19); ++rep) gdn_sample_chain(p, l, bid, smem);
        return; }
    const int nw = nb - 16, wi = bid - 16;
#pragma unroll 1
    for (int rep = 0; rep < NREP(20); ++rep)
    for (int item = wi; item < 384; item += nw) {
        if (item < 128) gdn_prompt_item(p, l, item, smem);
        else attn_dispatch(p, l, 3, item - 128, smem);
    }
}

#define GSYNC() do { XcdBarrier xb_; xb_.bar = (unsigned*)(fence_P().ws + WS_BAR); xb_.x = xb_xcc_id(); xb_.st = (volatile LAS unsigned*)(smem + LDS_BYTES - 16); xcd_barrier(xb_); } while (0)
#define PH(id, call) do { int nrep_ = 1 + ((REPEAT_MASK >> (id)) & 1); if (REPEAT_MASK) asm volatile("" : "+s"(nrep_)); _Pragma("unroll 1") for (int rep_ = 0; rep_ < nrep_; ++rep_) { if (rep_) GSYNC(); const P p = fence_P(); call; } } while (0)
__global__ void __launch_bounds__(NT) mega(KArgs a) {
    extern __shared__ __attribute__((aligned(16))) unsigned char smem[];
    cg::grid_group grid = cg::this_grid();
    volatile LAS unsigned* xst = (volatile LAS unsigned*)(smem + LDS_BYTES - 16);
    if (threadIdx.x == 0) { xst[0] = 0u; xst[1] = 0u; }
    __syncthreads();
    (void)xcd_barrier_post((unsigned*)(a.p.ws + WS_BAR), xst);
    { const P p = fence_P(); ph_mod(p, smem); }
    __syncthreads();
    ph_convert(a.J[0], smem);
    grid.sync();
    PH(1, ph_prenorm(p, 0));
    GSYNC();
#pragma unroll 1
    for (int l = 0; l < 2; ++l) {
        PH(2, ph_gemm_proj(p, smem));
        GSYNC();
        PH(3, ph_postproj(p, l));
        GSYNC();
        PH(4, ph_gemm_mla(p, smem));
        GSYNC();
        PH(5, ph_prep2(p, l));
        GSYNC();
        PH(6, ph_mixers1(p, l, smem));
        GSYNC();
        PH(7, ph_mixers2(p, l, smem));
        GSYNC();
        { const P p = fence_P(); ph_gdn_finalize(p, l); }
        GSYNC();
        PH(9, ph_gemm_br(p, smem));
        GSYNC();
        PH(10, ph_gemm_gate(p, smem));
        GSYNC();
        PH(11, ph_gemm_wo(p, smem));
        GSYNC();
        { const P p = fence_P(); ph_post(p, l, 1); }
        GSYNC();
        PH(13, ph_gemm_up(p, smem));
        GSYNC();
        PH(14, ph_gemm_down(p, smem));
        GSYNC();
        { const P p = fence_P(); ph_post(p, l, 2); }
        if (l == 0) { __syncthreads(); ph_convert(a.J[1], smem); GSYNC(); }
    }
}

static void add_job(TJobs& J, const float* src, bf16* dst, int ldw, int K, int Ndst, int ldo, int mode, int arg, int nvalid) {
    TJob& j = J.j[J.n]; j.src = src; j.dst = dst; j.ldw = ldw; j.K = K; j.Ndst = Ndst; j.ldo = ldo; j.mode = mode; j.arg = arg; j.nvalid = nvalid; j.tile0 = J.total;
    J.total += (Ndst / 64) * (K / 64); J.n++;
}

extern "C" void kernel_launch(void* const* d_in, const int* in_sizes, int n_in, void* d_out, int out_size, void* d_ws, size_t ws_size, hipStream_t stream) {
    if (n_in != 32 || ws_size < WS_NEED) { fprintf(stderr, "kernel_launch: unexpected n_in %d or ws_size %zu (need %zu)\n", n_in, ws_size, (size_t)WS_NEED); return; }
    static int grid = 0;
    if (grid == 0) {
        int dev = 0, cus = 0, per_cu = 0;
        (void)hipGetDevice(&dev);
        (void)hipDeviceGetAttribute(&cus, hipDeviceAttributeMultiprocessorCount, dev);
        (void)hipFuncSetAttribute((const void*)mega, hipFuncAttributeMaxDynamicSharedMemorySize, LDS_BYTES);
        (void)hipOccupancyMaxActiveBlocksPerMultiprocessor(&per_cu, (const void*)mega, NT, LDS_BYTES);
        if (per_cu < 1) { fprintf(stderr, "kernel_launch: occupancy query says %d blocks/CU\n", per_cu); per_cu = 1; }
        if (per_cu > 1) per_cu = 1;
        grid = cus * per_cu;
    }
    KArgs a{};
    const float** pf = (const float**)&a.p;
    for (int i = 0; i < 32; ++i) pf[i] = (const float*)d_in[i];
    a.p.out = (float*)d_out; a.p.ws = (unsigned char*)d_ws;
    const P& p = a.p;
    bf16* Wb = (bf16*)(a.p.ws + WS_W);
    for (int l = 0; l < 2; ++l) {
        TJobs& J = a.J[l];
        add_job(J, p.w_in + (size_t)l * 1024 * PIN, (bf16*)((char*)Wb + W_A), PIN, 1024, 2304, 1024, 0, 0, 2160);
        add_job(J, p.w_in + (size_t)l * 1024 * PIN, (bf16*)((char*)Wb + W_G), PIN, 1024, 4096, 1024, 2, C_GATE, 4096);
        for (int m = 0; m < 4; ++m) add_job(J, p.w_br + ((size_t)l * 4 + m) * 256 * 1024, (bf16*)((char*)Wb + W_BR) + (size_t)m * 1024 * 256, 1024, 256, 1024, 256, 0, 0, 1024);
        add_job(J, p.w_o + (size_t)l * 1024 * 1024, (bf16*)((char*)Wb + W_O), 1024, 1024, 1024, 1024, 0, 0, 1024);
        add_job(J, p.w_up + (size_t)l * 1024 * 5632, (bf16*)((char*)Wb + W_UP), 5632, 1024, 5632, 1024, 1, 0, 5632);
        add_job(J, p.w_down + (size_t)l * DFF * 1024, (bf16*)((char*)Wb + W_DN), 1024, DFF, 1024, DFF, 0, 0, 1024);
        add_job(J, p.b_w_uq + (size_t)l * 192 * 384, (bf16*)((char*)Wb + W_UQ), 384, 192, 384, 192, 0, 0, 384);
        add_job(J, p.b_w_ukv + (size_t)l * 128 * 512, (bf16*)((char*)Wb + W_UKV), 512, 128, 512, 128, 0, 0, 512);
    }
    (void)hipMemsetAsync((char*)d_ws + WS_BAR, 0, XCD_BAR_WORDS * 4, stream);
    void* args[] = {&a};
    hipError_t e = hipLaunchCooperativeKernel((const void*)mega, dim3(grid), dim3(NT), args, LDS_BYTES, stream);
    if (e != hipSuccess) fprintf(stderr, "cooperative launch failed: %s (grid %d)\n", hipGetErrorString(e), grid);
}
```

```cpp
#include <hip/hip_runtime.h>
#include <hip/hip_cooperative_groups.h>
namespace cg = cooperative_groups;
#define NT 512
#define NWV 8
#define LDS_BYTES 147456
#include <stdint.h>
#include <stdio.h>

typedef unsigned short bf16;
typedef short bf16x8 __attribute__((ext_vector_type(8)));
typedef float f32x16 __attribute__((ext_vector_type(16)));

#define DM 1024
#define NTOK 16384
#define NPROMPT 8192
#define PLD 2176
#define C_AQ 0
#define C_AK 256
#define C_AV 384
#define C_BCQ 512
#define C_BCKV 704
#define C_BKR 832
#define C_CIN 864
#define C_DQKV 1120
#define C_DZ 1888
#define C_DBETA 2144
#define C_DALPHA 2152
#define C_GATE 2160
#define PIN 6256
#define DFF 2816
#define EPS 1e-6f
#define NKVROWS 16896

#define O_Y 0
#define O_CAK 16777216
#define O_CAV 18874368
#define O_CKV 20971520
#define O_KR 23068672
#define O_SF 23592960
#define O_SB 24641536

#define MB(x) ((size_t)(x) * 1024 * 1024)
#define WS_MOD 0
#define WS_TAB (WS_MOD + 147456)
#define WS_KAC (WS_TAB + 12288)
#define WS_VAC (WS_KAC + 512 * 128 * 2)
#define WS_GGC (WS_VAC + 512 * 128 * 2)
#define WS_BAR 786432
#define WS_W (MB(1))
#define W_A 0
#define W_G (W_A + 2304 * 1024 * 2)
#define W_BR (W_G + 4096 * 1024 * 2)
#define W_O (W_BR + 4 * 1024 * 256 * 2)
#define W_UP (W_O + 1024 * 1024 * 2)
#define W_DN (W_UP + 5632 * 1024 * 2)
#define W_UQ (W_DN + 1024 * 2816 * 2)
#define W_UKV (W_UQ + 384 * 192 * 2)
#define W_END (W_UKV + 512 * 128 * 2)
#define WS_H (MB(42))
#define H_GMB 0
#define H_GS (1024 * 16384)
#define WS_BR (MB(74))
#define WS_BIG (MB(106))
#define B_PROJ 0
#define B_CQ (B_PROJ + (size_t)16384 * 2176 * 2)
#define B_CKV (B_CQ + (size_t)16384 * 192 * 2)
#define B_QB (B_CKV + (size_t)16896 * 128 * 2)
#define B_KV (B_QB + (size_t)16384 * 384 * 2)
#define B_QA1S (B_KV + (size_t)16896 * 512 * 2)
#define B_KA1S (B_QA1S + (size_t)8192 * 256 * 2)
#define B_KB (B_KA1S + (size_t)8192 * 128 * 2)
#define B_GQK (B_KB + (size_t)16896 * 384 * 2)
#define B_GUW (B_GQK + (size_t)8192 * 512 * 2)
#define B_END_A (B_GUW + (size_t)1024 * 8192 * 2)
#define B_GOB B_CKV
#define B_BRB 0
#define B_HID 0
#define WS_NEED (WS_BIG + B_END_A)

struct P {
    const float *x_prompt, *x_sample, *cache_a_k, *cache_a_v, *cache_b_ckv, *cache_b_krope, *state_f, *state_b, *c, *c_ctx;
    const float *w_mod, *b_mod, *g_pre1, *g_post1, *g_pre2, *g_post2, *w_in, *a_sink, *b_g_cq, *b_g_ckv, *b_w_uq, *b_w_ukv;
    const float *c_w_pool, *c_scale, *d_conv, *d_a_log, *d_dt_bias, *d_g_norm, *w_br, *w_o, *w_up, *w_down;
    float* out;
    unsigned char* ws;
};


typedef const __attribute__((address_space(4))) unsigned char* kargp_t;
__device__ __forceinline__ P fence_P() {
    kargp_t kp = (kargp_t)__builtin_amdgcn_kernarg_segment_ptr();
    asm volatile("" : "+s"(kp));
    const __attribute__((address_space(4))) P* pp = (const __attribute__((address_space(4))) P*)kp;
    P q;
    q.x_prompt = pp->x_prompt;
    q.x_sample = pp->x_sample;
    q.cache_a_k = pp->cache_a_k;
    q.cache_a_v = pp->cache_a_v;
    q.cache_b_ckv = pp->cache_b_ckv;
    q.cache_b_krope = pp->cache_b_krope;
    q.state_f = pp->state_f;
    q.state_b = pp->state_b;
    q.c = pp->c;
    q.c_ctx = pp->c_ctx;
    q.w_mod = pp->w_mod;
    q.b_mod = pp->b_mod;
    q.g_pre1 = pp->g_pre1;
    q.g_post1 = pp->g_post1;
    q.g_pre2 = pp->g_pre2;
    q.g_post2 = pp->g_post2;
    q.w_in = pp->w_in;
    q.a_sink = pp->a_sink;
    q.b_g_cq = pp->b_g_cq;
    q.b_g_ckv = pp->b_g_ckv;
    q.b_w_uq = pp->b_w_uq;
    q.b_w_ukv = pp->b_w_ukv;
    q.c_w_pool = pp->c_w_pool;
    q.c_scale = pp->c_scale;
    q.d_conv = pp->d_conv;
    q.d_a_log = pp->d_a_log;
    q.d_dt_bias = pp->d_dt_bias;
    q.d_g_norm = pp->d_g_norm;
    q.w_br = pp->w_br;
    q.w_o = pp->w_o;
    q.w_up = pp->w_up;
    q.w_down = pp->w_down;
    q.out = pp->out;
    q.ws = pp->ws;
    return q;
}

__device__ __forceinline__ bf16 f2bf(float f) {
    unsigned u = __float_as_uint(f);
    u += 0x7fffu + ((u >> 16) & 1u);
    return (bf16)(u >> 16);
}
__device__ __forceinline__ float bf2f(bf16 h) { return __uint_as_float(((unsigned)h) << 16); }
__device__ __forceinline__ float wave_sum(float v) {
#pragma unroll
    for (int o = 32; o > 0; o >>= 1) v += __shfl_xor(v, o);
    return v;
}

__device__ __forceinline__ unsigned vzero() { unsigned z = 0; asm volatile("" : "+v"(z)); return z; }
__device__ __forceinline__ int tidx() { int t = threadIdx.x; asm volatile("" : "+v"(t)); return t; }
__device__ __forceinline__ float sigmoidf_(float x) { return 1.f / (1.f + __expf(-x)); }
__device__ __forceinline__ float siluf_(float x) { return x / (1.f + __expf(-x)); }

struct TJob { const float* src; bf16* dst; int ldw, K, Ndst, ldo, mode, arg, nvalid, tile0; };
struct TJobs { TJob j[16]; int n, total; };

__device__ __forceinline__ void ph_convert(const TJobs& J, unsigned char* smem) {
    float (*tile)[65] = (float (*)[65])smem;
    const int tid = tidx();
    for (int t = blockIdx.x; t < J.total; t += gridDim.x) {
        int ji = 0;
        for (int q = 1; q < J.n; ++q) if (t >= J.j[q].tile0) ji = q;
        const TJob jb = J.j[ji];
        const int local = t - jb.tile0, nkt = jb.K / 64, tn = local / nkt, tk = local % nkt;
        const int tx = tid & 63, ty = tid >> 6;
        const int n = tn * 64 + tx;
        int sc;
        if (jb.mode == 0) sc = (n < jb.nvalid) ? n + jb.arg : -1;
        else { const int pn = n >> 8, cc = n & 255, bj = cc >> 7, wc = (cc >> 5) & 3, nn = (cc >> 4) & 1, fq = (cc >> 2) & 3, ii = cc & 3;
            if (jb.mode == 1) sc = nn * DFF + pn * 128 + bj * 64 + wc * 16 + fq * 4 + ii;
            else sc = jb.arg + (2 * bj + nn) * 1024 + pn * 64 + wc * 16 + fq * 4 + ii; }
        for (int kk = ty; kk < 64; kk += NWV) tile[kk][tx] = (sc >= 0) ? jb.src[(size_t)(tk * 64 + kk) * jb.ldw + sc] : 0.f;
        __syncthreads();
        {
            const int q = tid, r = q >> 3, c8 = q & 7;
            unsigned w[4];
            for (int j = 0; j < 4; ++j) w[j] = (unsigned)f2bf(tile[c8 * 8 + 2 * j][r]) | ((unsigned)f2bf(tile[c8 * 8 + 2 * j + 1][r]) << 16);
            *(uint4*)(jb.dst + (size_t)(tn * 64 + r) * jb.ldo + tk * 64 + c8 * 8) = make_uint4(w[0], w[1], w[2], w[3]);
        }
        __syncthreads();
    }
}

__device__ __forceinline__ void ph_mod(const P& p, unsigned char* smem) {
    float (*cs)[1024] = (float (*)[1024])smem;
    float (*red)[3][64] = (float (*)[3][64])(smem + 3 * 1024 * 4);
    const int tid = tidx();
    float* mod = (float*)(p.ws + WS_MOD);
    for (int i = tid; i < 3072; i += NT) { const int r = i >> 10, k = i & 1023; const float v = (r == 0) ? p.c_ctx[k] : p.c[(r - 1) * 1024 + k]; cs[r][k] = siluf_(v); }
    __syncthreads();
    for (int it = blockIdx.x; it < 192; it += gridDim.x) {
        const int l = it / 96, cg = it % 96, col = cg * 64 + (tid & 63), kq = tid >> 6;
        float a0 = 0.f, a1 = 0.f, a2 = 0.f;
        const float* w = p.w_mod + ((size_t)l * 1024 + kq * 128) * 6144 + col;
        for (int k = 0; k < 128; ++k) { const float wv = w[(size_t)k * 6144]; a0 += cs[0][kq * 128 + k] * wv; a1 += cs[1][kq * 128 + k] * wv; a2 += cs[2][kq * 128 + k] * wv; }
        red[kq][0][tid & 63] = a0; red[kq][1][tid & 63] = a1; red[kq][2][tid & 63] = a2;
        __syncthreads();
        if (tid < 192) { const int r = tid >> 6, cc = tid & 63; const float s = red[0][r][cc] + red[1][r][cc] + red[2][r][cc] + red[3][r][cc] + red[4][r][cc] + red[5][r][cc] + red[6][r][cc] + red[7][r][cc] + p.b_mod[l * 6144 + cg * 64 + cc]; mod[(l * 3 + r) * 6144 + cg * 64 + cc] = s; }
        __syncthreads();
    }
    if (blockIdx.x == 0) {
        float* tab = (float*)(p.ws + WS_TAB);
        for (int i = tid; i < 64 * 16; i += NT) { const int pos = i >> 4, f = i & 15; const float inv = powf(10000.f, -(float)f / 16.f); float s, c; sincosf((float)pos * inv, &s, &c); tab[i] = c; tab[1024 + i] = s; }
        for (int i = tid; i < 64 * 8; i += NT) { const int pos = i >> 3, f = i & 7; const float inv = powf(10000.f, -(float)f / 8.f); float s, c; sincosf((float)pos * inv, &s, &c); tab[2048 + i] = c; tab[2560 + i] = s; }
    }
}

__device__ __forceinline__ const float* xrow_in(const P& p, int row) { return row < NPROMPT ? p.x_prompt + (size_t)row * DM : p.x_sample + (size_t)(row - NPROMPT) * DM; }
__device__ __forceinline__ int cond_row(int row) { return row < NPROMPT ? 0 : 1 + ((row - NPROMPT) >> 12); }

__device__ __forceinline__ void ph_prenorm(const P& p, int l) {
    const int lane = tidx() & 63;
    const float* mod = (const float*)(p.ws + WS_MOD);
    bf16* H = (bf16*)(p.ws + WS_H);
    for (int row = blockIdx.x * NWV + (tidx() >> 6); row < NTOK; row += gridDim.x * NWV) {
        const float* xr = (l == 0) ? xrow_in(p, row) : p.out + (size_t)row * DM;
        float4 v[4]; float ss = 0.f;
        for (int i = 0; i < 4; ++i) { v[i] = *(const float4*)(xr + i * 256 + lane * 4); ss += v[i].x * v[i].x + v[i].y * v[i].y + v[i].z * v[i].z + v[i].w * v[i].w; }
        ss = wave_sum(ss);
        const float rinv = rsqrtf(ss * (1.f / 1024.f) + EPS);
        const float* md = mod + (l * 3 + cond_row(row)) * 6144;
        for (int i = 0; i < 4; ++i) {
            const int col = i * 256 + lane * 4;
            const float4 g = *(const float4*)(p.g_pre1 + l * 1024 + col), sc = *(const float4*)(md + 1024 + col), sh = *(const float4*)(md + col);
            const float h0 = v[i].x * rinv * g.x * (1.f + sc.x) + sh.x, h1 = v[i].y * rinv * g.y * (1.f + sc.y) + sh.y;
            const float h2 = v[i].z * rinv * g.z * (1.f + sc.z) + sh.z, h3 = v[i].w * rinv * g.w * (1.f + sc.w) + sh.w;
            *(uint2*)(H + (size_t)row * DM + col) = make_uint2((unsigned)f2bf(h0) | ((unsigned)f2bf(h1) << 16), (unsigned)f2bf(h2) | ((unsigned)f2bf(h3) << 16));
        }
    }
}

__device__ __forceinline__ void ph_post(const P& p, int l, int which) {
    const int lane = tidx() & 63;
    const float* mod = (const float*)(p.ws + WS_MOD);
    bf16* H = (bf16*)(p.ws + WS_H);
    const bf16* src = (const bf16*)(p.ws + (which == 1 ? WS_H : WS_BR));
    const float* gpost = (which == 1 ? p.g_post1 : p.g_post2) + l * 1024;
    const int ga_off = which == 1 ? 2048 : 5120;
    const bool donext = (which == 1) || (l == 0);
    const int ln = which == 1 ? l : l + 1;
    const float* gpre = (which == 1 ? p.g_pre2 : p.g_pre1) + ln * 1024;
    const int sc_off = which == 1 ? 4096 : 1024, sh_off = which == 1 ? 3072 : 0;
    for (int row = blockIdx.x * NWV + (tidx() >> 6); row < NTOK; row += gridDim.x * NWV) {
        const float* xr = (l == 0 && which == 1) ? xrow_in(p, row) : p.out + (size_t)row * DM;
        const int cr = cond_row(row);
        const float* md = mod + (l * 3 + cr) * 6144;
        float4 x[4], s[4]; float ss = 0.f;
        for (int i = 0; i < 4; ++i) {
            const int col = i * 256 + lane * 4;
            x[i] = *(const float4*)(xr + col);
            const uint2 raw = *(const uint2*)(src + (size_t)row * DM + col);
            s[i] = make_float4(bf2f((bf16)(raw.x & 0xffff)), bf2f((bf16)(raw.x >> 16)), bf2f((bf16)(raw.y & 0xffff)), bf2f((bf16)(raw.y >> 16)));
            ss += s[i].x * s[i].x + s[i].y * s[i].y + s[i].z * s[i].z + s[i].w * s[i].w;
        }
        ss = wave_sum(ss);
        const float rinv = rsqrtf(ss * (1.f / 1024.f) + EPS);
        float ss2 = 0.f;
        for (int i = 0; i < 4; ++i) {
            const int col = i * 256 + lane * 4;
            const float4 g = *(const float4*)(gpost + col), ga = *(const float4*)(md + ga_off + col);
            x[i].x += ga.x * s[i].x * rinv * g.x; x[i].y += ga.y * s[i].y * rinv * g.y; x[i].z += ga.z * s[i].z * rinv * g.z; x[i].w += ga.w * s[i].w * rinv * g.w;
            *(float4*)(p.out + (size_t)row * DM + col) = x[i];
            ss2 += x[i].x * x[i].x + x[i].y * x[i].y + x[i].z * x[i].z + x[i].w * x[i].w;
        }
        if (donext) {
            ss2 = wave_sum(ss2);
            const float rinv2 = rsqrtf(ss2 * (1.f / 1024.f) + EPS);
            const float* md2 = mod + (ln * 3 + cr) * 6144;
            for (int i = 0; i < 4; ++i) {
                const int col = i * 256 + lane * 4;
                const float4 g = *(const float4*)(gpre + col), sc = *(const float4*)(md2 + sc_off + col), sh = *(const float4*)(md2 + sh_off + col);
                const float h0 = x[i].x * rinv2 * g.x * (1.f + sc.x) + sh.x, h1 = x[i].y * rinv2 * g.y * (1.f + sc.y) + sh.y;
                const float h2 = x[i].z * rinv2 * g.z * (1.f + sc.z) + sh.z, h3 = x[i].w * rinv2 * g.w * (1.f + sc.w) + sh.w;
                *(uint2*)(H + (size_t)row * DM + col) = make_uint2((unsigned)f2bf(h0) | ((unsigned)f2bf(h1) << 16), (unsigned)f2bf(h2) | ((unsigned)f2bf(h3) << 16));
            }
        }
    }
}

struct GemmArgs { const bf16* A; const bf16* Bt; int lda, ldb, M, N, K, pad; };

struct EpiStore {
    bf16* C; int ldc, nvalid;
    __device__ __forceinline__ void operator()(const f32x16 (&acc)[2][2], int rowbase, int colbase, int tn, int wn, int lane) const {
        _Pragma("unroll") for (int mi = 0; mi < 2; ++mi) _Pragma("unroll") for (int nj = 0; nj < 2; ++nj) {
            const int col = colbase + nj * 32 + (lane & 31);
            if (col < nvalid) _Pragma("unroll") for (int r = 0; r < 16; ++r) { const int row = rowbase + mi * 32 + (r & 3) + 8 * (r >> 2) + 4 * (lane >> 5); C[(size_t)row * ldc + col] = f2bf(acc[mi][nj][r]); }
        }
    }
};
struct EpiGate {
    bf16* C; int ldc;
    __device__ __forceinline__ void operator()(const f32x16 (&acc)[2][2], int rowbase, int colbase, int tn, int wn, int lane) const {
        _Pragma("unroll") for (int mi = 0; mi < 2; ++mi) _Pragma("unroll") for (int nj = 0; nj < 2; ++nj) {
            const int col = colbase + nj * 32 + (lane & 31);
            _Pragma("unroll") for (int r = 0; r < 16; ++r) { const int row = rowbase + mi * 32 + (r & 3) + 8 * (r >> 2) + 4 * (lane >> 5); bf16* q = C + (size_t)row * ldc + col; *q = f2bf(sigmoidf_(acc[mi][nj][r]) * bf2f(*q)); }
        }
    }
};
struct EpiSwiglu {
    bf16* C; int ldc;
    __device__ __forceinline__ void operator()(const f32x16 (&acc)[2][2], int rowbase, int colbase, int tn, int wn, int lane) const {
        const int col = tn * 64 + wn * 32 + (lane & 31);
        _Pragma("unroll") for (int mi = 0; mi < 2; ++mi) _Pragma("unroll") for (int r = 0; r < 16; ++r) {
            const int row = rowbase + mi * 32 + (r & 3) + 8 * (r >> 2) + 4 * (lane >> 5);
            C[(size_t)row * ldc + col] = f2bf(siluf_(acc[mi][0][r]) * acc[mi][1][r]);
        }
    }
};

template <class Epi>
__device__ __forceinline__ void gemm_tiles(const GemmArgs g, const Epi epi, unsigned char* smem) {
    const int vb = tidx() >> 8, tid = tidx() & 255, lane = tid & 63, w = tid >> 6, wm = w >> 1, wn = w & 1;
    bf16* As = (bf16*)(smem + vb * 65536);
    bf16* Bs = As + 2 * 128 * 64;
    const int nM = g.M / 128, nN = g.N / 128, nK = g.K / 64, ntiles = nM * nN;
    const int nvb = gridDim.x * 2, iters = (ntiles + nvb - 1) / nvb;
    for (int it = 0; it < iters; ++it) {
        const int t0 = it * nvb + blockIdx.x * 2 + vb;
        const bool valid = t0 < ntiles;
        const int t = valid ? t0 : 0;
        const int grp = t / (16 * nN), first = grp * 16, gsz = (nM - first) < 16 ? (nM - first) : 16, r0 = t - grp * 16 * nN;
        const int tm = first + r0 % gsz, tn = r0 / gsz;
        const bf16* Ag = g.A + (size_t)(tm * 128) * g.lda;
        const bf16* Bg = g.Bt + (size_t)(tn * 128) * g.ldb;
        typedef unsigned u32x4 __attribute__((ext_vector_type(4)));
        u32x4 ra0, ra1, ra2, ra3, rb0, rb1, rb2, rb3;
        f32x16 acc[2][2];
        _Pragma("unroll") for (int mi = 0; mi < 2; ++mi) _Pragma("unroll") for (int nj = 0; nj < 2; ++nj) _Pragma("unroll") for (int r = 0; r < 16; ++r) acc[mi][nj][r] = 0.f;
        const int lrow = tid >> 3, lch = tid & 7;
        const bf16* Ap = Ag + (size_t)lrow * g.lda + lch * 8;
        const bf16* Bp = Bg + (size_t)lrow * g.ldb + lch * 8;
        const size_t a32 = (size_t)32 * g.lda, b32 = (size_t)32 * g.ldb;
#define GLOAD(k0) { ra0 = *(const u32x4*)(Ap + (k0)); ra1 = *(const u32x4*)(Ap + a32 + (k0)); ra2 = *(const u32x4*)(Ap + 2 * a32 + (k0)); ra3 = *(const u32x4*)(Ap + 3 * a32 + (k0)); \
                    rb0 = *(const u32x4*)(Bp + (k0)); rb1 = *(const u32x4*)(Bp + b32 + (k0)); rb2 = *(const u32x4*)(Bp + 2 * b32 + (k0)); rb3 = *(const u32x4*)(Bp + 3 * b32 + (k0)); }
        GLOAD(0)
        const int soff = lrow * 64 + ((lch ^ (lrow & 7)) << 3);
        for (int kt = 0; kt < nK; ++kt) {
            bf16* Ab = As + (kt & 1) * 8192; bf16* Bb = Bs + (kt & 1) * 8192;
            *(u32x4*)(Ab + soff) = ra0; *(u32x4*)(Ab + soff + 2048) = ra1; *(u32x4*)(Ab + soff + 4096) = ra2; *(u32x4*)(Ab + soff + 6144) = ra3;
            *(u32x4*)(Bb + soff) = rb0; *(u32x4*)(Bb + soff + 2048) = rb1; *(u32x4*)(Bb + soff + 4096) = rb2; *(u32x4*)(Bb + soff + 6144) = rb3;
            __syncthreads();
            if (kt + 1 < nK) GLOAD((kt + 1) * 64)
#pragma unroll
            for (int kk = 0; kk < 4; ++kk) {
                bf16x8 a[2], b[2];
                const int ch = kk * 2 + (lane >> 5);
#pragma unroll
                for (int mi = 0; mi < 2; ++mi) { const int row = wm * 64 + mi * 32 + (lane & 31); a[mi] = *(const bf16x8*)(Ab + row * 64 + ((ch ^ (row & 7)) << 3)); }
#pragma unroll
                for (int nj = 0; nj < 2; ++nj) { const int row = wn * 64 + nj * 32 + (lane & 31); b[nj] = *(const bf16x8*)(Bb + row * 64 + ((ch ^ (row & 7)) << 3)); }
#pragma unroll
                for (int mi = 0; mi < 2; ++mi)
#pragma unroll
                    for (int nj = 0; nj < 2; ++nj) acc[mi][nj] = __builtin_amdgcn_mfma_f32_32x32x16_bf16(a[mi], b[nj], acc[mi][nj], 0, 0, 0);
            }
        }
        if (valid) epi(acc, tm * 128 + wm * 64, tn * 128 + wn * 64, tn, wn, lane);
        __syncthreads();
    }
}

namespace pg8 {
#define PG8_LAS __attribute__((address_space(3)))
typedef unsigned short bf16_t;
typedef short bf16x8 __attribute__((ext_vector_type(8)));
typedef float f32x4 __attribute__((ext_vector_type(4)));
typedef unsigned u32x4 __attribute__((ext_vector_type(4)));
constexpr int BM = 256, BK = 64, HALF = 128, HTB = HALF * BK * 2  , STAGE_BYTES = 8 * HTB, NXCD = 8, WGM = 8;

__host__ __device__ __forceinline__ int lds_byte(int r, int c) { const int st = (r >> 4) * 2 + (c >> 5), rr = r & 15, cc = c & 31, ob = rr * 64 + cc * 2; return st * 1024 + (ob ^ (((ob >> 9) & 1) << 5)); }
__host__ __device__ __forceinline__ void stage_rc(int b, int& R, int& C) { const int st = b / 1024, sb = b % 1024, swz = sb ^ (((sb >> 9) & 1) << 5); R = (st >> 1) * 16 + swz / 64; C = (st & 1) * 32 + (swz % 64) / 2; }
__host__ __device__ __forceinline__ int perm32(int rho) { const int n = rho >> 4, i = rho & 15; return 8 * (i >> 2) + 4 * n + (i & 3); }

struct Unit { int pm, pn; };
struct Gemm { const bf16_t* A; const bf16_t* Bt; int M, N, K, lda, ldb; };

struct StaticOrder {
    int nM, nN, nwg, G, c;
    __host__ __device__ void init(int M, int N, int G_, int c_) { nM = M / BM; nN = N / BM; nwg = nM * nN; G = G_; c = c_; }
    __host__ __device__ bool next(int i, Unit& u) const {
        const long L = (long)i * G + c; if (L >= nwg) return false;
        int wgid = (int)L; { const int q = nwg / NXCD, r = nwg % NXCD, xcd = wgid % NXCD, off = wgid / NXCD; wgid = (xcd < r ? xcd * (q + 1) : r * (q + 1) + (xcd - r) * q) + off; }
        const int nig = WGM * nN, gid = wgid / nig, fm = gid * WGM, gsz = (nM - fm) < WGM ? (nM - fm) : WGM;
        u.pm = fm + ((wgid % nig) % gsz); u.pn = (wgid % nig) / gsz; return true;
    }
    __device__ __forceinline__ void a_ready(const Unit&) const {}
    __device__ __forceinline__ void done(const Unit&) const {}
};

__device__ __forceinline__ unsigned cvt_pk_bf16(float lo, float hi) { unsigned r; asm volatile("v_cvt_pk_bf16_f32 %0, %1, %2" : "=v"(r) : "v"(lo), "v"(hi)); return r; }
template <class Epi, class Sched, bool ALIGN_EPI = false, bool SP2 = false>
__device__ __forceinline__ void gemm_phase(PG8_LAS unsigned char* lds, const Gemm g, const Sched& S, const Epi& E) {
    const int tid = tidx(), wid = __builtin_amdgcn_readfirstlane(tid >> 6), lane = tid & 63, wr = wid >> 2, wc = wid & 3, fr = lane & 15, fq = lane >> 4;
    const int K = g.K, nt = K / BK;
    unsigned voffA[2], voffB[2];
#pragma unroll
    for (int i = 0; i < 2; ++i) { int R, C; stage_rc(tid * 16 + i * 8192, R, C); const int Rb = Epi::PERM ? ((R & ~31) + perm32(R & 31)) : R;
        voffA[i] = (unsigned)(R * g.lda + C) * 2u; voffB[i] = (unsigned)(Rb * g.ldb + C) * 2u; }
    const size_t kstep = (size_t)(BK * 2);
    const size_t hstepA = (size_t)HALF * g.lda * 2, hstepB = (size_t)HALF * g.ldb * 2;
    const size_t tstepA = 2 * hstepA, tstepB = 2 * hstepB;
    const unsigned ldsw = (unsigned)wid * 1024u;
    const int aoff = lds_byte(wr * 64 + fr, fq * 8), boff = lds_byte(wc * 32 + fr, fq * 8);
#define PG8_SA(b, h) (((b) * 2 + (h)) * HTB)
#define PG8_SB(b, h) ((4 + (b) * 2 + (h)) * HTB)
#define PG8_STAGE(bufoff, gbase, voff) do { _Pragma("unroll") for (int _i = 0; _i < 2; ++_i) \
        __builtin_amdgcn_global_load_lds((const unsigned*)((const char*)(gbase) + (voff)[_i]), (PG8_LAS unsigned*)(lds + (bufoff) + ldsw + _i * 8192), 16, 0, 0); } while (0)
#define PG8_LDA(dst, b, h) do { _Pragma("unroll") for (int m = 0; m < 4; ++m) _Pragma("unroll") for (int k = 0; k < 2; ++k) dst[m][k] = *(const PG8_LAS bf16x8*)(lds + PG8_SA(b, h) + aoff + m * 2048 + k * 1024); } while (0)
#define PG8_LDB(dst, b, h) do { _Pragma("unroll") for (int n = 0; n < 2; ++n) _Pragma("unroll") for (int k = 0; k < 2; ++k) dst[n][k] = *(const PG8_LAS bf16x8*)(lds + PG8_SB(b, h) + boff + n * 2048 + k * 1024); } while (0)
#define PG8_MMA(ai, bj, At, Bt) do { __builtin_amdgcn_s_setprio(1); _Pragma("unroll") for (int m = 0; m < 4; ++m) _Pragma("unroll") for (int n = 0; n < 2; ++n) _Pragma("unroll") for (int k = 0; k < 2; ++k) \
        acc[ai][bj][m][n] = __builtin_amdgcn_mfma_f32_16x16x32_bf16(Bt[n][k], At[m][k], acc[ai][bj][m][n], 0, 0, 0); __builtin_amdgcn_s_setprio(0); } while (0)
#define PG8_WAIT_V(n) asm volatile("s_waitcnt vmcnt(" #n ")" ::: "memory")
#define PG8_WAIT_L(n) asm volatile("s_waitcnt lgkmcnt(" #n ")" ::: "memory")
#define PG8_BAR __builtin_amdgcn_s_barrier()
#define PG8_SCHED __builtin_amdgcn_sched_barrier(0)
    Unit cur, nxt; int ui = 0;
    if (!S.next(0, cur)) return;
    f32x4 acc[2][2][4][2];
#pragma unroll
    for (int a = 0; a < 2; ++a)
#pragma unroll
        for (int b = 0; b < 2; ++b)
#pragma unroll
            for (int m = 0; m < 4; ++m)
#pragma unroll
                for (int n = 0; n < 2; ++n) acc[a][b][m][n] = (f32x4){0.f, 0.f, 0.f, 0.f};
    bf16x8 At[4][2], B0[2][2], B1[2][2];
    const char* cA = (const char*)g.A + (size_t)cur.pm * tstepA; const char* cB = (const char*)g.Bt + (size_t)cur.pn * tstepB;
    S.a_ready(cur);
    if constexpr (SP2) {
        PG8_STAGE(PG8_SB(0, 0), cB, voffB); PG8_STAGE(PG8_SB(0, 1), cB + hstepB, voffB); PG8_STAGE(PG8_SA(0, 0), cA, voffA); PG8_STAGE(PG8_SA(0, 1), cA + hstepA, voffA);
        if (wr == 1) PG8_BAR;
        PG8_WAIT_V(2); PG8_BAR;
        PG8_STAGE(PG8_SB(1, 0), cB + kstep, voffB); PG8_STAGE(PG8_SA(1, 0), cA + kstep, voffA); PG8_STAGE(PG8_SB(1, 1), cB + hstepB + kstep, voffB);
        PG8_WAIT_V(6); PG8_BAR;
    } else {
        PG8_STAGE(PG8_SB(0, 0), cB, voffB); PG8_STAGE(PG8_SA(0, 0), cA, voffA); PG8_STAGE(PG8_SB(0, 1), cB + hstepB, voffB); PG8_STAGE(PG8_SA(0, 1), cA + hstepA, voffA);
        if (wr == 1) PG8_BAR;
        PG8_WAIT_V(4); PG8_BAR;
        PG8_STAGE(PG8_SB(1, 0), cB + kstep, voffB); PG8_STAGE(PG8_SA(1, 0), cA + kstep, voffA); PG8_STAGE(PG8_SB(1, 1), cB + hstepB + kstep, voffB);
        PG8_WAIT_V(6); PG8_BAR;
    }
    for (;;) {
        const bool has_next = S.next(ui + 1, nxt);
        const char* nA = has_next ? (const char*)g.A + (size_t)nxt.pm * tstepA : cA; const char* nB = has_next ? (const char*)g.Bt + (size_t)nxt.pn * tstepB : cB;
        for (int t = 0; t < nt; t += 2) {
            const bool last = (t == nt - 2);
            const char* a1 = cA + (size_t)(t + 1) * kstep;
            const char* a2 = last ? nA : cA + (size_t)(t + 2) * kstep; const char* b2 = last ? nB : cB + (size_t)(t + 2) * kstep;
            const char* a3 = a2 + kstep; const char* b3 = b2 + kstep;
            if (last && has_next) S.a_ready(nxt);
            if constexpr (SP2) {
            PG8_LDB(B0, 0, 0); PG8_LDB(B1, 0, 1); PG8_SCHED; PG8_LDA(At, 0, 0); PG8_STAGE(PG8_SA(1, 1), a1 + hstepA, voffA);
            PG8_WAIT_V(8); PG8_WAIT_L(0); PG8_BAR; PG8_MMA(0, 0, At, B0); PG8_MMA(0, 1, At, B1); PG8_BAR; PG8_SCHED;
            PG8_LDA(At, 0, 1); PG8_STAGE(PG8_SB(0, 0), b2, voffB); PG8_STAGE(PG8_SB(0, 1), b2 + hstepB, voffB); PG8_STAGE(PG8_SA(0, 0), a2, voffA);
            PG8_WAIT_V(8); PG8_WAIT_L(0); PG8_BAR; PG8_MMA(1, 0, At, B0); PG8_MMA(1, 1, At, B1); PG8_BAR; PG8_SCHED;
            PG8_LDB(B0, 1, 0); PG8_LDB(B1, 1, 1); PG8_SCHED; PG8_LDA(At, 1, 0); PG8_STAGE(PG8_SA(0, 1), a2 + hstepA, voffA);
            PG8_WAIT_V(8); PG8_WAIT_L(0); PG8_BAR; PG8_MMA(0, 0, At, B0); PG8_MMA(0, 1, At, B1); PG8_BAR; PG8_SCHED;
            PG8_LDA(At, 1, 1); PG8_STAGE(PG8_SB(1, 0), b3, voffB); PG8_STAGE(PG8_SB(1, 1), b3 + hstepB, voffB); PG8_STAGE(PG8_SA(1, 0), a3, voffA);
            PG8_WAIT_V(8); PG8_WAIT_L(0); PG8_BAR; PG8_MMA(1, 0, At, B0); PG8_MMA(1, 1, At, B1); PG8_BAR; PG8_SCHED;
            } else {
            PG8_LDB(B0, 0, 0); PG8_SCHED; PG8_LDA(At, 0, 0); PG8_STAGE(PG8_SA(1, 1), a1 + hstepA, voffA);
            PG8_WAIT_L(8); PG8_BAR; PG8_WAIT_L(0); PG8_MMA(0, 0, At, B0); PG8_BAR; PG8_SCHED;
            PG8_LDB(B1, 0, 1); PG8_STAGE(PG8_SB(0, 0), b2, voffB);
            PG8_BAR; PG8_WAIT_L(0); PG8_MMA(0, 1, At, B1); PG8_BAR;
            PG8_LDA(At, 0, 1); PG8_STAGE(PG8_SA(0, 0), a2, voffA);
            PG8_BAR; PG8_WAIT_L(0); PG8_MMA(1, 0, At, B0); PG8_BAR; PG8_SCHED;
            PG8_STAGE(PG8_SB(0, 1), b2 + hstepB, voffB);
            PG8_WAIT_V(6); PG8_BAR; PG8_MMA(1, 1, At, B1); PG8_BAR;
            PG8_LDB(B0, 1, 0); PG8_SCHED; PG8_LDA(At, 1, 0); PG8_STAGE(PG8_SA(0, 1), a2 + hstepA, voffA);
            PG8_WAIT_L(8); PG8_BAR; PG8_WAIT_L(0); PG8_MMA(0, 0, At, B0); PG8_BAR; PG8_SCHED;
            PG8_LDB(B1, 1, 1); PG8_STAGE(PG8_SB(1, 0), b3, voffB);
            PG8_BAR; PG8_WAIT_L(0); PG8_MMA(0, 1, At, B1); PG8_BAR;
            PG8_LDA(At, 1, 1); PG8_STAGE(PG8_SA(1, 0), a3, voffA);
            PG8_BAR; PG8_WAIT_L(0); PG8_MMA(1, 0, At, B0); PG8_BAR; PG8_SCHED;
            PG8_STAGE(PG8_SB(1, 1), b3 + hstepB, voffB);
            PG8_WAIT_V(6); PG8_BAR; PG8_MMA(1, 1, At, B1); PG8_BAR;
            }
        }
        if constexpr (ALIGN_EPI) { if (wr == 0) PG8_BAR; }
        if constexpr (!Epi::AFTER_DRAIN) { E(acc, cur, wr, wc, fr, fq); S.done(cur); }
        if (!has_next) break;
#pragma unroll
        for (int a = 0; a < 2; ++a)
#pragma unroll
            for (int b = 0; b < 2; ++b)
#pragma unroll
                for (int m = 0; m < 4; ++m)
#pragma unroll
                    for (int n = 0; n < 2; ++n) acc[a][b][m][n] = (f32x4){0.f, 0.f, 0.f, 0.f};
        cur = nxt; cA = nA; cB = nB; ++ui;
        if constexpr (ALIGN_EPI) { if (wr == 1) PG8_BAR; }
    }
    PG8_WAIT_V(0);
    if constexpr (!ALIGN_EPI) { if (wr == 0) PG8_BAR; }
    PG8_BAR;
    if constexpr (Epi::AFTER_DRAIN) { E.fused(acc, cur, wr, wc, fr, fq, lds, wid, lane); S.done(cur); }
#undef PG8_SA
#undef PG8_SB
#undef PG8_STAGE
#undef PG8_LDA
#undef PG8_LDB
#undef PG8_MMA
#undef PG8_WAIT_V
#undef PG8_WAIT_L
#undef PG8_BAR
#undef PG8_SCHED
}
}

namespace pg8 {
__device__ __forceinline__ float fsigmoid(float x) { return __builtin_amdgcn_rcpf(1.f + __expf(-x)); }
typedef unsigned u32x2 __attribute__((ext_vector_type(2)));
struct EpiStoreBf16 {
    static constexpr bool PERM = true, AFTER_DRAIN = false;
    bf16_t* O; int ldc, nvalid;
    __device__ __forceinline__ void operator()(const f32x4 (&acc)[2][2][4][2], const Unit& u, int wr, int wc, int fr, int fq) const {
        const int row0 = u.pm * BM + wr * 64 + fr, col0 = u.pn * BM + wc * 32 + 8 * fq;
#pragma unroll
        for (int ai = 0; ai < 2; ++ai)
#pragma unroll
            for (int m = 0; m < 4; ++m) { bf16_t* rowp = O + (size_t)(row0 + ai * HALF + m * 16) * ldc + col0;
#pragma unroll
                for (int bj = 0; bj < 2; ++bj) if (col0 + bj * HALF < nvalid) { const f32x4 v0 = acc[ai][bj][m][0], v1 = acc[ai][bj][m][1];
                    u32x4 w; w.x = cvt_pk_bf16(v0[0], v0[1]); w.y = cvt_pk_bf16(v0[2], v0[3]); w.z = cvt_pk_bf16(v1[0], v1[1]); w.w = cvt_pk_bf16(v1[2], v1[3]);
                    *(u32x4*)(rowp + bj * HALF) = w; } }
    }
};
struct EpiSwiglu {
    static constexpr bool PERM = false, AFTER_DRAIN = false;
    bf16_t* O; int ldc;
    __device__ __forceinline__ void operator()(const f32x4 (&acc)[2][2][4][2], const Unit& u, int wr, int wc, int fr, int fq) const {
        const int row0 = u.pm * BM + wr * 64 + fr, col0 = u.pn * 128 + wc * 16 + 4 * fq;
#pragma unroll
        for (int ai = 0; ai < 2; ++ai)
#pragma unroll
            for (int m = 0; m < 4; ++m) { bf16_t* rowp = O + (size_t)(row0 + ai * HALF + m * 16) * ldc + col0;
#pragma unroll
                for (int bj = 0; bj < 2; ++bj) { const f32x4 g = acc[ai][bj][m][0], v = acc[ai][bj][m][1];
                    u32x2 w; w.x = cvt_pk_bf16(g[0] * fsigmoid(g[0]) * v[0], g[1] * fsigmoid(g[1]) * v[1]); w.y = cvt_pk_bf16(g[2] * fsigmoid(g[2]) * v[2], g[3] * fsigmoid(g[3]) * v[3]);
                    *(u32x2*)(rowp + bj * 64) = w; } }
    }
};
struct EpiGateMix {
    static constexpr bool PERM = false, AFTER_DRAIN = false;
    const bf16_t* BRB; bf16_t* O;
    __device__ __forceinline__ void operator()(const f32x4 (&acc)[2][2][4][2], const Unit& u, int wr, int wc, int fr, int fq) const {
        const int row0 = u.pm * BM + wr * 64 + fr, d0 = u.pn * 64 + wc * 16 + 4 * fq;
#pragma unroll
        for (int ai = 0; ai < 2; ++ai)
#pragma unroll
            for (int m = 0; m < 4; ++m) { const size_t row = (size_t)(row0 + ai * HALF + m * 16);
                f32x4 s = {0.f, 0.f, 0.f, 0.f};
#pragma unroll
                for (int bj = 0; bj < 2; ++bj)
#pragma unroll
                    for (int n = 0; n < 2; ++n) { const u32x2 raw = *(const u32x2*)(BRB + row * 4096 + (2 * bj + n) * 1024 + d0); const f32x4 g = acc[ai][bj][m][n];
                        s[0] += fsigmoid(g[0]) * __uint_as_float(raw.x << 16); s[1] += fsigmoid(g[1]) * __uint_as_float(raw.x & 0xffff0000u);
                        s[2] += fsigmoid(g[2]) * __uint_as_float(raw.y << 16); s[3] += fsigmoid(g[3]) * __uint_as_float(raw.y & 0xffff0000u); }
                u32x2 w; w.x = cvt_pk_bf16(s[0], s[1]); w.y = cvt_pk_bf16(s[2], s[3]);
                *(u32x2*)(O + row * 1024 + d0) = w; }
    }
};
}

__device__ __forceinline__ void ph_postproj(const P& p, int l) {
    const int lane = tidx() & 63;
    const bf16* proj = (const bf16*)(p.ws + WS_BIG + B_PROJ);
    bf16* cq = (bf16*)(p.ws + WS_BIG + B_CQ);
    bf16* ckv = (bf16*)(p.ws + WS_BIG + B_CKV);
    for (int row = blockIdx.x * NWV + (tidx() >> 6); row < NKVROWS; row += gridDim.x * NWV) {
        if (row >= NTOK) {
            const int r = row - NTOK, b = r >> 8, s = r & 255;
            const float* src = p.cache_b_ckv + ((size_t)(b * 2 + l) * 256 + s) * 128;
            ckv[(size_t)row * 128 + lane] = f2bf(src[lane]); ckv[(size_t)row * 128 + 64 + lane] = f2bf(src[64 + lane]);
            continue;
        }
        const bf16* pr = proj + (size_t)row * PLD;
        float a0 = bf2f(pr[C_BCQ + lane]), a1 = bf2f(pr[C_BCQ + 64 + lane]), a2 = bf2f(pr[C_BCQ + 128 + lane]);
        float ss = wave_sum(a0 * a0 + a1 * a1 + a2 * a2);
        float rinv = rsqrtf(ss * (1.f / 192.f) + EPS);
        const float* gq = p.b_g_cq + l * 192;
        cq[(size_t)row * 192 + lane] = f2bf(a0 * rinv * gq[lane]); cq[(size_t)row * 192 + 64 + lane] = f2bf(a1 * rinv * gq[64 + lane]); cq[(size_t)row * 192 + 128 + lane] = f2bf(a2 * rinv * gq[128 + lane]);
        float k0 = bf2f(pr[C_BCKV + lane]), k1 = bf2f(pr[C_BCKV + 64 + lane]);
        ss = wave_sum(k0 * k0 + k1 * k1);
        rinv = rsqrtf(ss * (1.f / 128.f) + EPS);
        const float* gk = p.b_g_ckv + l * 128;
        k0 = k0 * rinv * gk[lane]; k1 = k1 * rinv * gk[64 + lane];
        ckv[(size_t)row * 128 + lane] = f2bf(k0); ckv[(size_t)row * 128 + 64 + lane] = f2bf(k1);
        if (row < NPROMPT) {
            const int b = row >> 8, s = row & 255;
            const size_t ci = (size_t)(b * 2 + l) * 256 + s;
            p.out[O_CKV + ci * 128 + lane] = k0; p.out[O_CKV + ci * 128 + 64 + lane] = k1;
            p.out[O_CAK + ci * 128 + lane] = bf2f(pr[C_AK + lane]); p.out[O_CAK + ci * 128 + 64 + lane] = bf2f(pr[C_AK + 64 + lane]);
            p.out[O_CAV + ci * 128 + lane] = bf2f(pr[C_AV + lane]); p.out[O_CAV + ci * 128 + 64 + lane] = bf2f(pr[C_AV + 64 + lane]);
            if (lane < 32) p.out[O_KR + ci * 32 + lane] = bf2f(pr[C_BKR + lane]);
        }
    }
}

__device__ __forceinline__ void ph_prep2(const P& p, int l) {
    const int lane = tidx() & 63;
    const float* tab = (const float*)(p.ws + WS_TAB);
    const bf16* proj = (const bf16*)(p.ws + WS_BIG + B_PROJ);
    const bf16* qb = (const bf16*)(p.ws + WS_BIG + B_QB);
    const bf16* kv = (const bf16*)(p.ws + WS_BIG + B_KV);
    bf16* qa1s = (bf16*)(p.ws + WS_BIG + B_QA1S);
    bf16* ka1s = (bf16*)(p.ws + WS_BIG + B_KA1S);
    bf16* qb1s = (bf16*)(p.ws + WS_BIG + B_CQ);
    bf16* kb = (bf16*)(p.ws + WS_BIG + B_KB);
    bf16* kac = (bf16*)(p.ws + WS_KAC);
    bf16* vac = (bf16*)(p.ws + WS_VAC);
    for (int row = blockIdx.x * NWV + (tidx() >> 6); row < NKVROWS; row += gridDim.x * NWV) {
        for (int h = 0; h < 4; ++h) kb[(size_t)row * 384 + h * 96 + lane] = kv[(size_t)row * 512 + h * 128 + lane];
        if (row >= NTOK) {
            const int r = row - NTOK, b = r >> 8, s = r & 255;
            if (lane < 32) { const bf16 v = f2bf(p.cache_b_krope[((size_t)(b * 2 + l) * 256 + s) * 32 + lane]); for (int h = 0; h < 4; ++h) kb[(size_t)row * 384 + h * 96 + 64 + lane] = v; }
            const size_t ci = ((size_t)(b * 2 + l) * 256 + s) * 128;
            kac[(size_t)r * 128 + lane] = f2bf(p.cache_a_k[ci + lane]); kac[(size_t)r * 128 + 64 + lane] = f2bf(p.cache_a_k[ci + 64 + lane]);
            vac[(size_t)r * 128 + lane] = f2bf(p.cache_a_v[ci + lane]); vac[(size_t)r * 128 + 64 + lane] = f2bf(p.cache_a_v[ci + 64 + lane]);
            continue;
        }
        const bf16* pr = proj + (size_t)row * PLD;
        if (row < NPROMPT) {
            if (lane < 32) { const bf16 v = pr[C_BKR + lane]; for (int h = 0; h < 4; ++h) kb[(size_t)row * 384 + h * 96 + 64 + lane] = v; }
            continue;
        }
        const int rs = row - NPROMPT, t = rs & 4095, gr = t >> 6, gc = t & 63;
        {
            if (lane < 32) {
                const int d = lane, qtr = d >> 3, f = d & 7, pos = (qtr < 2) ? gr : gc;
                const float c = tab[2048 + pos * 8 + f], s = tab[2560 + pos * 8 + f];
                const float x = bf2f(pr[C_BKR + d]);
                const float y = bf2f(pr[C_BKR + (d ^ 8)]);
                const float o = (qtr & 1) ? (x * c + y * s) : (x * c - y * s);
                const bf16 v = f2bf(o);
                for (int h = 0; h < 4; ++h) kb[(size_t)row * 384 + h * 96 + 64 + d] = v;
                for (int h = 0; h < 4; ++h) {
                    const float qx = bf2f(qb[(size_t)row * 384 + h * 96 + 64 + d]), qy = bf2f(qb[(size_t)row * 384 + h * 96 + 64 + (d ^ 8)]);
                    qb1s[(size_t)rs * 384 + h * 96 + 64 + d] = f2bf((qtr & 1) ? (qx * c + qy * s) : (qx * c - qy * s));
                }
            }
            for (int h = 0; h < 4; ++h) qb1s[(size_t)rs * 384 + h * 96 + lane] = qb[(size_t)row * 384 + h * 96 + lane];
        }
        {
            const int d = lane, qtr = d >> 4, f = d & 15, pos = (qtr < 2) ? gr : gc;
            const float c = tab[pos * 16 + f], s = tab[1024 + pos * 16 + f];
            for (int h = 0; h < 4; ++h) {
                const float x = bf2f(pr[C_AQ + h * 64 + d]), y = bf2f(pr[C_AQ + h * 64 + (d ^ 16)]);
                qa1s[(size_t)rs * 256 + h * 64 + d] = f2bf((qtr & 1) ? (x * c + y * s) : (x * c - y * s));
            }
            for (int h = 0; h < 2; ++h) {
                const float x = bf2f(pr[C_AK + h * 64 + d]), y = bf2f(pr[C_AK + h * 64 + (d ^ 16)]);
                ka1s[(size_t)rs * 128 + h * 64 + d] = f2bf((qtr & 1) ? (x * c + y * s) : (x * c - y * s));
            }
        }
    }
}

struct AttnJob {
    const bf16 *q1, *q2, *k1, *v1, *k2, *v2;
    const float* sink;
    bf16* out;
    int ldq1, ldq2, ldk1, ldv1, ldk2, ldv2;
    int kstride, vstride, kvgroup, nbatch, T, nk2, window, outcol;
    float scale; int pad;
};

template <int DQK>
__device__ __forceinline__ void attn_item(const AttnJob& j, int blk, unsigned char* smem) {
    float* Ks = (float*)smem;
    float* Vs = Ks + 32 * DQK;
    const int tid = tidx(), eh = (tid >> 8) * 32;
    const int nqb = j.T / 256;
    const int b = blk / (4 * nqb), h = (blk / nqb) % 4, qb0 = (blk % nqb) * 256;
    const int kh = h / j.kvgroup;
    const int t = qb0 + (tid & 255);
    float q[DQK], o[32];
    float m = -1e30f, lsum = 0.f;
#pragma unroll
    for (int e = 0; e < 32; ++e) o[e] = 0.f;
    for (int set = 0; set < 2; ++set) {
        if (set == 1 && j.nk2 == 0) break;
        const bf16* qp = (set == 0) ? j.q1 + ((size_t)b * j.T + t) * j.ldq1 + h * DQK : j.q2 + ((size_t)b * j.T + t) * j.ldq2 + h * DQK;
#pragma unroll
        for (int d = 0; d < DQK; d += 4) { const uint2 raw = *(const uint2*)(qp + d); q[d] = bf2f((bf16)(raw.x & 0xffff)) * j.scale; q[d + 1] = bf2f((bf16)(raw.x >> 16)) * j.scale; q[d + 2] = bf2f((bf16)(raw.y & 0xffff)) * j.scale; q[d + 3] = bf2f((bf16)(raw.y >> 16)) * j.scale; }
        const bf16* kp = (set == 0) ? j.k1 + (size_t)b * j.T * j.ldk1 + kh * j.kstride : j.k2 + (size_t)b * j.nk2 * j.ldk2 + kh * j.kstride;
        const bf16* vp = (set == 0) ? j.v1 + (size_t)b * j.T * j.ldv1 + kh * j.vstride : j.v2 + (size_t)b * j.nk2 * j.ldv2 + kh * j.vstride;
        const int ldk = (set == 0) ? j.ldk1 : j.ldk2, ldv = (set == 0) ? j.ldv1 : j.ldv2;
        int kbeg = 0, kend = (set == 0) ? j.T : j.nk2;
        const bool win = (set == 0) && j.window;
        if (win) { kbeg = qb0 - 128 < 0 ? 0 : qb0 - 128; kend = qb0 + 256 + 128 > j.T ? j.T : qb0 + 256 + 128; }
        for (int ks = kbeg; ks < kend; ks += 32) {
            __syncthreads();
            for (int e = tid; e < 32 * DQK / 4; e += NT) {
                const int key = e / (DQK / 4), c4 = e % (DQK / 4), s = ks + key;
                float4 val = make_float4(0.f, 0.f, 0.f, 0.f);
                if (s < kend) { const uint2 raw = *(const uint2*)(kp + (size_t)s * ldk + c4 * 4); val = make_float4(bf2f((bf16)(raw.x & 0xffff)), bf2f((bf16)(raw.x >> 16)), bf2f((bf16)(raw.y & 0xffff)), bf2f((bf16)(raw.y >> 16))); }
                *(float4*)&Ks[key * DQK + c4 * 4] = val;
            }
            for (int e = tid; e < 32 * 16; e += NT) {
                const int key = e >> 4, c4 = e & 15, s = ks + key;
                float4 val = make_float4(0.f, 0.f, 0.f, 0.f);
                if (s < kend) { const uint2 raw = *(const uint2*)(vp + (size_t)s * ldv + c4 * 4); val = make_float4(bf2f((bf16)(raw.x & 0xffff)), bf2f((bf16)(raw.x >> 16)), bf2f((bf16)(raw.y & 0xffff)), bf2f((bf16)(raw.y >> 16))); }
                *(float4*)&Vs[key * 64 + c4 * 4] = val;
            }
            __syncthreads();
            const int nk = (kend - ks) < 32 ? (kend - ks) : 32;
            for (int key = 0; key < nk; ++key) {
                const int s = ks + key;
                if (win) { const int dlt = t - s; if (dlt > 128 || dlt < -128) continue; }
                float sc = 0.f;
#pragma unroll
                for (int d = 0; d < DQK; d += 4) { const float4 kk = *(const float4*)&Ks[key * DQK + d]; sc += q[d] * kk.x + q[d + 1] * kk.y + q[d + 2] * kk.z + q[d + 3] * kk.w; }
                if (sc > m) { const float c = __expf(m - sc); lsum *= c;
#pragma unroll
                    for (int e = 0; e < 32; ++e) o[e] *= c;
                    m = sc; }
                const float pp = __expf(sc - m);
                lsum += pp;
#pragma unroll
                for (int e = 0; e < 32; e += 4) { const float4 vv = *(const float4*)&Vs[key * 64 + eh + e]; o[e] += pp * vv.x; o[e + 1] += pp * vv.y; o[e + 2] += pp * vv.z; o[e + 3] += pp * vv.w; }
            }
        }
    }
    if (j.sink) {
        const float sk = j.sink[h];
        const float mf = sk > m ? sk : m;
        const float c = __expf(m - mf);
        lsum = lsum * c + __expf(sk - mf);
#pragma unroll
        for (int e = 0; e < 32; ++e) o[e] *= c;
    }
    const float inv = 1.f / lsum;
    bf16* op = j.out + ((size_t)b * j.T + t) * 1024 + j.outcol + h * 64 + eh;
#pragma unroll
    for (int e = 0; e < 32; e += 2) *(unsigned*)(op + e) = (unsigned)f2bf(o[e] * inv) | ((unsigned)f2bf(o[e + 1] * inv) << 16);
}

__device__ __forceinline__ void ph_pool(const P& p, int l, unsigned char* smem_) {
    unsigned char* smem = smem_ + vzero();
    float (*df)[257] = (float (*)[257])smem;
    float (*xs)[256] = (float (*)[256])(smem + 32 * 257 * 4);
    const int tid = tidx(), half = tid >> 8, c256 = tid & 255;
    const bf16* proj = (const bf16*)(p.ws + WS_BIG + B_PROJ);
    bf16* br = (bf16*)(p.ws + WS_BR);
    for (int tile = blockIdx.x; tile < NTOK / 32; tile += gridDim.x) {
        const int row0 = tile * 32;
        int base, T;
        if (row0 < NPROMPT) { base = (row0 >> 8) << 8; T = 256; } else { base = NPROMPT + (((row0 - NPROMPT) >> 12) << 12); T = 4096; }
        const int t0 = row0 - base;
        __syncthreads();
#pragma unroll
        for (int r = 0; r < 3; ++r) {
            const int q = tid + NT * r, rr = q >> 5, ch = q & 31, t = t0 - 8 + rr;
            float4 v0 = make_float4(0.f, 0.f, 0.f, 0.f), v1 = v0;
            if (t >= 0 && t < T) {
                const uint4 raw = *(const uint4*)(proj + (size_t)(base + t) * PLD + C_CIN + ch * 8);
                v0 = make_float4(bf2f((bf16)(raw.x & 0xffff)), bf2f((bf16)(raw.x >> 16)), bf2f((bf16)(raw.y & 0xffff)), bf2f((bf16)(raw.y >> 16)));
                v1 = make_float4(bf2f((bf16)(raw.z & 0xffff)), bf2f((bf16)(raw.z >> 16)), bf2f((bf16)(raw.w & 0xffff)), bf2f((bf16)(raw.w >> 16)));
            }
            *(float4*)&xs[rr][ch * 8] = v0; *(float4*)&xs[rr][ch * 8 + 4] = v1;
        }
        __syncthreads();
        {
            const int c = c256, g = c >> 6, hw = 1 << g;
            for (int i = half * 16; i < half * 16 + 16; ++i) {
                const int t = t0 + i;
                const int lo = t - hw < 0 ? 0 : t - hw, hi = t + hw > T ? T : t + hw;
                float sacc = 0.f;
                for (int u = lo; u < hi; ++u) sacc += xs[u - t0 + 8][c];
                df[i][c] = sacc / (float)(hi - lo) - xs[i + 8][c];
            }
        }
        __syncthreads();
        {
            const int g = c256 >> 6, d = c256 & 63;
            float acc[16];
#pragma unroll
            for (int i = 0; i < 16; ++i) acc[i] = 0.f;
            const float* wp = p.c_w_pool + ((size_t)(l * 4 + g) * 64) * 64 + d;
            for (int c = 0; c < 64; ++c) {
                const float w = wp[c * 64];
#pragma unroll
                for (int i = 0; i < 16; ++i) acc[i] += df[half * 16 + i][g * 64 + c] * w;
            }
            const float sc = p.c_scale[l * 256 + c256];
#pragma unroll
            for (int i = 0; i < 16; ++i) br[(size_t)(row0 + half * 16 + i) * 1024 + 512 + c256] = f2bf(acc[i] * sc);
        }
    }
}

#define GS_KN 0
#define GS_QN 8192
#define GS_W 16384
#define GS_QG 24576
#define GS_KDT 32768
#define GS_ST 49152
#define GS_VNT 57344
#define GS_A 65536
#define GS_U 73728
#define GS_X 90112
#define GS_L 124928
#define GS_SM 142336

__device__ __forceinline__ int swz(int r, int c) { return r * 64 + ((((c) >> 3) ^ (r & 7)) << 3) + (c & 7); }
__device__ __forceinline__ unsigned pk2(float a, float b) { return (unsigned)f2bf(a) | ((unsigned)f2bf(b) << 16); }

__device__ __forceinline__ f32x16 mm_tile(const bf16* A, int m0, const bf16* B, int n0, f32x16 acc, int lane) {
    const int ra = m0 + (lane & 31), rb = n0 + (lane & 31), hh = lane >> 5;
#pragma unroll
    for (int kk = 0; kk < 4; ++kk) {
        const int ch = kk * 2 + hh;
        const bf16x8 a = *(const bf16x8*)(A + ra * 64 + ((ch ^ (ra & 7)) << 3));
        const bf16x8 b = *(const bf16x8*)(B + rb * 64 + ((ch ^ (rb & 7)) << 3));
        acc = __builtin_amdgcn_mfma_f32_32x32x16_bf16(a, b, acc, 0, 0, 0);
    }
    return acc;
}
__device__ __forceinline__ f32x16 zero16() { f32x16 z; _Pragma("unroll") for (int r = 0; r < 16; ++r) z[r] = 0.f; return z; }

struct GdnCtx { int base, T, h, dir, cidx, l; };

typedef float f32x4v __attribute__((ext_vector_type(4)));
#define XLD 136
#define LLD 68
__device__ __forceinline__ void gdn_prep(const P& p, const GdnCtx& c, unsigned char* smem_) {
    unsigned char* smem = smem_ + vzero();
    const int tid = tidx(), lane = tid & 63, wv = tid >> 6;
    bf16* KN = (bf16*)(smem + GS_KN); bf16* QN = (bf16*)(smem + GS_QN); bf16* Wl = (bf16*)(smem + GS_W);
    float* Ul = (float*)(smem + GS_U); float* X = (float*)(smem + GS_X); float* Lm = (float*)(smem + GS_L);
    float* gcs = (float*)(smem + GS_SM); float* betas = gcs + 64; float* qdec = gcs + 128; float* kdec = gcs + 192; float* bexp = gcs + 256;
    const bf16* proj = (const bf16*)(p.ws + WS_BIG + B_PROJ);
    const float* convw = p.d_conv + (size_t)c.l * 5 * 768;
#pragma unroll
    for (int r = 0; r < 3; ++r) {
        const int w = tid + NT * r, i = w / 24, rem = w - i * 24, part = rem >> 3, g8 = rem & 7;
        const int tt = c.cidx * 64 + (c.dir ? 63 - i : i);
        const int ch = part * 256 + c.h * 64 + g8 * 8;
        float u[8];
#pragma unroll
        for (int k = 0; k < 8; ++k) u[k] = 0.f;
#pragma unroll
        for (int j = 0; j < 5; ++j) {
            const int ts = tt + j - 2;
            if (ts >= 0 && ts < c.T) {
                const uint4 raw = *(const uint4*)(proj + (size_t)(c.base + ts) * PLD + C_DQKV + ch);
                const float4 w0 = *(const float4*)(convw + j * 768 + ch), w1 = *(const float4*)(convw + j * 768 + ch + 4);
                u[0] += w0.x * bf2f((bf16)(raw.x & 0xffff)); u[1] += w0.y * bf2f((bf16)(raw.x >> 16)); u[2] += w0.z * bf2f((bf16)(raw.y & 0xffff)); u[3] += w0.w * bf2f((bf16)(raw.y >> 16));
                u[4] += w1.x * bf2f((bf16)(raw.z & 0xffff)); u[5] += w1.y * bf2f((bf16)(raw.z >> 16)); u[6] += w1.z * bf2f((bf16)(raw.w & 0xffff)); u[7] += w1.w * bf2f((bf16)(raw.w >> 16));
            }
        }
        float ss = 0.f;
#pragma unroll
        for (int k = 0; k < 8; ++k) { u[k] = siluf_(u[k]); ss += u[k] * u[k]; }
        ss += __shfl_xor(ss, 1); ss += __shfl_xor(ss, 2); ss += __shfl_xor(ss, 4);
        if (part < 2) {
            const float sc = rsqrtf(ss + EPS) * (part == 0 ? 0.125f : 1.f);
#pragma unroll
            for (int k = 0; k < 8; ++k) u[k] *= sc;
            bf16* dst = (part == 0 ? QN : KN) + i * 64 + ((g8 ^ (i & 7)) << 3);
            *(uint4*)dst = make_uint4(pk2(u[0], u[1]), pk2(u[2], u[3]), pk2(u[4], u[5]), pk2(u[6], u[7]));
        }
        if (part >= 1) {
            float* xd = X + i * XLD + (part == 2 ? 0 : 64) + g8 * 8;
            *(float4*)xd = make_float4(u[0], u[1], u[2], u[3]); *(float4*)(xd + 4) = make_float4(u[4], u[5], u[6], u[7]);
        }
    }
    if (wv == 0) {
        const int i = lane, tt = c.cidx * 64 + (c.dir ? 63 - i : i);
        const bf16* pr = proj + (size_t)(c.base + tt) * PLD;
        const float Aexp = __expf(p.d_a_log[(c.l * 2 + c.dir) * 4 + c.h]), dtb = p.d_dt_bias[(c.l * 2 + c.dir) * 4 + c.h];
        const float beta = sigmoidf_(bf2f(pr[C_DBETA + c.dir * 4 + c.h]));
        const float al = bf2f(pr[C_DALPHA + c.dir * 4 + c.h]) + dtb;
        float g = -Aexp * (al > 20.f ? al : log1pf(__expf(al)));
#pragma unroll
        for (int o = 1; o < 64; o <<= 1) { const float t = __shfl_up(g, o); if (lane >= o) g += t; }
        const float g63 = __shfl(g, 63);
        const float eg = __expf(g);
        gcs[i] = g; betas[i] = beta; qdec[i] = eg; kdec[i] = __expf(g63 - g); bexp[i] = beta * eg;
    }
    __syncthreads();
    {
        const int i = tid >> 3, cg = tid & 7;
        const float sv = betas[i], sk = bexp[i];
        float* xr = X + i * XLD + cg * 16;
        const float s0 = cg < 4 ? sv : sk;
#pragma unroll
        for (int q = 0; q < 4; ++q) { float4 v = *(float4*)(xr + q * 4); v.x *= s0; v.y *= s0; v.z *= s0; v.w *= s0; *(float4*)(xr + q * 4) = v; }
    }
    if (wv < 4) {
        const int mt = wv >> 1, nt = wv & 1, hh = lane >> 5, j = nt * 32 + (lane & 31);
        f32x16 acc = zero16();
        if (nt <= mt) acc = mm_tile(KN, mt * 32, KN, nt * 32, acc, lane);
        const float gj = gcs[j];
#pragma unroll
        for (int r = 0; r < 16; ++r) {
            const int i = mt * 32 + (r & 3) + 8 * (r >> 2) + 4 * hh;
            Lm[i * LLD + j] = (j < i) ? betas[i] * acc[r] * __expf(gcs[i] - gj) : 0.f;
        }
    }
    __syncthreads();
#pragma unroll
    for (int r = 0; r < 4; ++r) {
        if (r > 0) {
            f32x4v acc = {0.f, 0.f, 0.f, 0.f};
            const int li = lane & 15, kq = lane >> 4;
#pragma unroll
            for (int kk = 0; kk < 4 * r; ++kk) {
                const float av = Lm[(16 * r + li) * LLD + 4 * kk + kq];
                const float bv = X[(4 * kk + kq) * XLD + 16 * wv + li];
                acc = __builtin_amdgcn_mfma_f32_16x16x4f32(av, bv, acc, 0, 0, 0);
            }
#pragma unroll
            for (int q = 0; q < 4; ++q) X[(16 * r + 4 * kq + q) * XLD + 16 * wv + li] -= acc[q];
            __syncthreads();
        }
        if (wv < 2) {
            const int col = tid;
            float x[16];
#pragma unroll
            for (int ii = 0; ii < 16; ++ii) x[ii] = X[(16 * r + ii) * XLD + col];
#pragma unroll
            for (int ii = 1; ii < 16; ++ii) {
                float a0 = x[ii], a1 = 0.f;
#pragma unroll
                for (int j4 = 0; j4 < (ii + 3) / 4; ++j4) {
                    const float4 lv = *(const float4*)&Lm[(16 * r + ii) * LLD + 16 * r + 4 * j4];
                    a0 -= lv.x * x[4 * j4]; a1 -= lv.y * x[4 * j4 + 1]; a0 -= lv.z * x[4 * j4 + 2]; a1 -= lv.w * x[4 * j4 + 3];
                }
                x[ii] = a0 + a1;
                X[(16 * r + ii) * XLD + col] = x[ii];
            }
        }
        __syncthreads();
    }
    {
        const int i = tid >> 3, cc = tid & 7, off = i * 64 + ((cc ^ (i & 7)) << 3);
        const float* xr = X + i * XLD + cc * 8;
        *(float4*)(Ul + i * 64 + cc * 8) = *(const float4*)xr; *(float4*)(Ul + i * 64 + cc * 8 + 4) = *(const float4*)(xr + 4);
        const float4 w0 = *(const float4*)(xr + 64), w1 = *(const float4*)(xr + 68);
        *(uint4*)(Wl + off) = make_uint4(pk2(w0.x, w0.y), pk2(w0.z, w0.w), pk2(w1.x, w1.y), pk2(w1.z, w1.w));
    }
    __syncthreads();
}

__device__ __forceinline__ void gdn_t0(unsigned char* smem_, int kb) {
    unsigned char* smem = smem_ + vzero();
    const int tid = tidx(), i = tid >> 3, cc = tid & 7;
    const bf16* KN = (const bf16*)(smem + GS_KN); const bf16* QN = (const bf16*)(smem + GS_QN);
    bf16* QG = (bf16*)(smem + GS_QG); bf16* KDT = (bf16*)(smem + GS_KDT + kb * 8192);
    const float* gcs = (const float*)(smem + GS_SM); const float qd = gcs[128 + i], kd = gcs[192 + i];
    const int off = i * 64 + ((cc ^ (i & 7)) << 3);
    const uint4 q = *(const uint4*)(QN + off), k = *(const uint4*)(KN + off);
    const unsigned qa[4] = {q.x, q.y, q.z, q.w}, ka[4] = {k.x, k.y, k.z, k.w};
    unsigned qo[4];
#pragma unroll
    for (int t = 0; t < 4; ++t) {
        qo[t] = pk2(bf2f((bf16)(qa[t] & 0xffff)) * qd, bf2f((bf16)(qa[t] >> 16)) * qd);
        KDT[swz(cc * 8 + 2 * t, i)] = f2bf(bf2f((bf16)(ka[t] & 0xffff)) * kd);
        KDT[swz(cc * 8 + 2 * t + 1, i)] = f2bf(bf2f((bf16)(ka[t] >> 16)) * kd);
    }
    *(uint4*)(QG + off) = make_uint4(qo[0], qo[1], qo[2], qo[3]);
}

__device__ __forceinline__ void gdn_t12(const P& p, const GdnCtx& c, unsigned char* smem_, int kb, f32x16& Sreg, int mode) {
    unsigned char* smem = smem_ + vzero();
    const int tid = tidx(), lane = tid & 63, wv = tid >> 6, hh = lane >> 5, l31 = lane & 31;
    const bf16* KN = (const bf16*)(smem + GS_KN); const bf16* QN = (const bf16*)(smem + GS_QN); const bf16* Wl = (const bf16*)(smem + GS_W);
    const bf16* QG = (const bf16*)(smem + GS_QG); const bf16* KDT = (const bf16*)(smem + GS_KDT + kb * 8192);
    bf16* ST = (bf16*)(smem + GS_ST); bf16* VNT = (bf16*)(smem + GS_VNT); bf16* Al = (bf16*)(smem + GS_A);
    const float* Ul = (const float*)(smem + GS_U); const float* gcs = (const float*)(smem + GS_SM);
    f32x16 O0 = zero16(), O1 = zero16();
    const float gl = gcs[128 + 63];
    if (wv < 4) {
        const int mt = wv >> 1, nt = wv & 1, e = nt * 32 + l31;
        f32x16 acc = mm_tile(Wl, mt * 32, ST, nt * 32, zero16(), lane);
#pragma unroll
        for (int rg = 0; rg < 4; ++rg) {
            const int i0 = mt * 32 + 8 * rg + 4 * hh;
            const float v0 = Ul[(i0) * 64 + e] - acc[rg * 4], v1 = Ul[(i0 + 1) * 64 + e] - acc[rg * 4 + 1], v2 = Ul[(i0 + 2) * 64 + e] - acc[rg * 4 + 2], v3 = Ul[(i0 + 3) * 64 + e] - acc[rg * 4 + 3];
            *(uint2*)(VNT + swz(e, i0)) = make_uint2(pk2(v0, v1), pk2(v2, v3));
        }
    } else if (wv < 6) {
        const int mt = wv - 4;
        O0 = mm_tile(QG, mt * 32, ST, 0, O0, lane);
        O1 = mm_tile(QG, mt * 32, ST, 32, O1, lane);
    } else {
        const int mt = wv - 6;
#pragma unroll
        for (int nt = 0; nt < 2; ++nt) {
            f32x16 acc = zero16();
            if (nt <= mt) acc = mm_tile(QN, mt * 32, KN, nt * 32, acc, lane);
            const int j = nt * 32 + l31; const float gj = gcs[j];
#pragma unroll
            for (int r = 0; r < 16; ++r) {
                const int i = mt * 32 + (r & 3) + 8 * (r >> 2) + 4 * hh;
                Al[swz(i, j)] = f2bf((j <= i) ? acc[r] * __expf(gcs[i] - gj) : 0.f);
            }
        }
    }
    __syncthreads();
    if (wv < 4) {
        const int mt = wv >> 1, nt = wv & 1, e = nt * 32 + l31;
#pragma unroll
        for (int r = 0; r < 16; ++r) Sreg[r] *= gl;
        Sreg = mm_tile(KDT, mt * 32, VNT, nt * 32, Sreg, lane);
#pragma unroll
        for (int rg = 0; rg < 4; ++rg) {
            const int d0 = mt * 32 + 8 * rg + 4 * hh;
            *(uint2*)(ST + swz(e, d0)) = make_uint2(pk2(Sreg[rg * 4], Sreg[rg * 4 + 1]), pk2(Sreg[rg * 4 + 2], Sreg[rg * 4 + 3]));
        }
    } else if (wv < 6) {
        const int mt = wv - 4;
        O0 = mm_tile(Al, mt * 32, VNT, 0, O0, lane);
        O1 = mm_tile(Al, mt * 32, VNT, 32, O1, lane);
        bf16* br = (bf16*)(p.ws + WS_BR);
        bf16* gob = (bf16*)(p.ws + WS_BIG + B_GOB);
        const bf16* proj = (const bf16*)(p.ws + WS_BIG + B_PROJ);
#pragma unroll
        for (int r = 0; r < 16; ++r) {
            const int i = mt * 32 + (r & 3) + 8 * (r >> 2) + 4 * hh;
            const int tt = c.cidx * 64 + (c.dir ? 63 - i : i);
            const size_t row = (size_t)(c.base + tt);
            bf16* b0 = br + row * 1024 + 768 + c.h * 64 + l31;
            if (mode == 0) { b0[0] = f2bf(O0[r]); b0[32] = f2bf(O1[r]); }
            else if (mode == 1) { bf16* g0 = gob + row * 256 + c.h * 64 + l31; g0[0] = f2bf(O0[r]); g0[32] = f2bf(O1[r]); }
            else {
                const float a0 = O0[r] + bf2f(b0[0]), a1 = O1[r] + bf2f(b0[32]);
                float ss = a0 * a0 + a1 * a1;
                ss += __shfl_xor(ss, 1); ss += __shfl_xor(ss, 2); ss += __shfl_xor(ss, 4); ss += __shfl_xor(ss, 8); ss += __shfl_xor(ss, 16);
                const float rinv = rsqrtf(ss * (1.f / 64.f) + EPS);
                const bf16* zp = proj + row * PLD + C_DZ + c.h * 64 + l31;
                b0[0] = f2bf(a0 * rinv * p.d_g_norm[c.l * 64 + l31] * siluf_(bf2f(zp[0])));
                b0[32] = f2bf(a1 * rinv * p.d_g_norm[c.l * 64 + 32 + l31] * siluf_(bf2f(zp[32])));
            }
        }
    }
}

__device__ __forceinline__ void gdn_prompt_item(const P& p, int l, int item, unsigned char* smem_) {
    unsigned char* smem = smem_ + vzero();
    const int tid = tidx(), lane = tid & 63, wv = tid >> 6, hh = lane >> 5, l31 = lane & 31;
    const int dir = item & 1, h = (item >> 1) & 3, b = item >> 3;
    bf16* ST = (bf16*)(smem + GS_ST);
    f32x16 Sreg = zero16();
    __syncthreads();
    for (int q = tid; q < 2048; q += NT) ((unsigned*)ST)[q] = 0u;
    int kb = 0;
#pragma unroll 1
    for (int n = 0; n < 4; ++n) {
        GdnCtx c; c.base = b * 256; c.T = 256; c.h = h; c.dir = dir; c.cidx = dir ? 3 - n : n; c.l = l;
        __syncthreads();
        gdn_prep(p, c, smem);
        gdn_t0(smem, kb);
        __syncthreads();
        gdn_t12(p, c, smem, kb, Sreg, dir);
        kb ^= 1;
    }
    if (wv < 4) {
        const int mt = wv >> 1, nt = wv & 1;
        float* so = p.out + (dir ? O_SB : O_SF) + ((size_t)(b * 2 + l) * 4 + h) * 4096;
#pragma unroll
        for (int r = 0; r < 16; ++r) so[(mt * 32 + (r & 3) + 8 * (r >> 2) + 4 * hh) * 64 + nt * 32 + l31] = Sreg[r];
    }
    __syncthreads();
}

__device__ __forceinline__ void gdn_sample_prep_item(const P& p, int l, int item, unsigned char* smem_) {
    unsigned char* smem = smem_ + vzero();
    const int tid = tidx(), lane = tid & 63, wv = tid >> 6, hh = lane >> 5, l31 = lane & 31;
    const int n = item & 63, dir = (item >> 6) & 1, h = (item >> 7) & 3, b = item >> 9;
    GdnCtx c; c.base = NPROMPT + b * 4096; c.T = 4096; c.h = h; c.dir = dir; c.cidx = dir ? 63 - n : n; c.l = l;
    __syncthreads();
    gdn_prep(p, c, smem);
    const bf16* KN = (const bf16*)(smem + GS_KN); const bf16* QN = (const bf16*)(smem + GS_QN); const bf16* Wl = (const bf16*)(smem + GS_W);
    const float* Ul = (const float*)(smem + GS_U); const float* gcs = (const float*)(smem + GS_SM); const float* X = (const float*)(smem + GS_X);
    bf16* WT = (bf16*)(smem + GS_VNT); bf16* UT = (bf16*)(smem + GS_A); const bf16* KDT = (const bf16*)(smem + GS_KDT);
    bf16* gqk = (bf16*)(p.ws + WS_BIG + B_GQK); bf16* guw = (bf16*)(p.ws + WS_BIG + B_GUW); float* ggc = (float*)(p.ws + WS_GGC);
    unsigned char* gmb = p.ws + WS_H + H_GMB + (size_t)item * 16384;
    const int i = tid >> 3, cc = tid & 7, off = i * 64 + ((cc ^ (i & 7)) << 3);
    gdn_t0(smem, 0);
    {
        const float* xr = X + i * XLD + cc * 8;
#pragma unroll
        for (int k = 0; k < 8; ++k) { UT[swz(cc * 8 + k, i)] = f2bf(xr[k]); WT[swz(cc * 8 + k, i)] = f2bf(xr[64 + k]); }
    }
    if (dir == 0) {
        const size_t tok = (size_t)b * 4096 + c.cidx * 64 + i;
        *(uint4*)(gqk + ((tok * 4 + h) * 2 + 0) * 64 + cc * 8) = *(const uint4*)(QN + off);
        *(uint4*)(gqk + ((tok * 4 + h) * 2 + 1) * 64 + cc * 8) = *(const uint4*)(KN + off);
    }
    bf16* uw = guw + (size_t)item * 8192;
    const float4 u0 = *(const float4*)(Ul + i * 64 + cc * 8), u1 = *(const float4*)(Ul + i * 64 + cc * 8 + 4);
    *(uint4*)(uw + i * 64 + cc * 8) = make_uint4(pk2(u0.x, u0.y), pk2(u0.z, u0.w), pk2(u1.x, u1.y), pk2(u1.z, u1.w));
    *(uint4*)(uw + 4096 + i * 64 + cc * 8) = *(const uint4*)(Wl + off);
    if (tid < 64) ggc[(size_t)item * 64 + tid] = gcs[tid];
    __syncthreads();
    if (wv < 4) {
        const int mt = wv >> 1, nt = wv & 1, d = nt * 32 + l31;
        const f32x16 acc = mm_tile(WT, mt * 32, KDT, nt * 32, zero16(), lane);
        bf16* Mg = (bf16*)gmb;
#pragma unroll
        for (int rg = 0; rg < 4; ++rg) *(uint2*)(Mg + swz(d, mt * 32 + 8 * rg + 4 * hh)) = make_uint2(pk2(-acc[rg * 4], -acc[rg * 4 + 1]), pk2(-acc[rg * 4 + 2], -acc[rg * 4 + 3]));
    } else {
        const int t = wv - 4, mt = t >> 1, nt = t & 1;
        const f32x16 acc = mm_tile(KDT, mt * 32, UT, nt * 32, zero16(), lane);
        unsigned* Bg = (unsigned*)(gmb + 8192);
#pragma unroll
        for (int q = 0; q < 8; ++q) Bg[(t * 8 + q) * 64 + lane] = pk2(acc[2 * q], acc[2 * q + 1]);
    }
}

__device__ __forceinline__ void gdn_sample_chain(const P& p, int l, int chain, unsigned char* smem_) {
    unsigned char* smem = smem_ + vzero();
    const int tid = tidx(), lane = tid & 63, wv = tid >> 6, hh = lane >> 5, l31 = lane & 31;
    const int dir = chain & 1, h = (chain >> 1) & 3, b = chain >> 3;
    const int item0 = ((b * 4 + h) * 2 + dir) * 64;
    const unsigned char* gmb = p.ws + WS_H + H_GMB + (size_t)item0 * 16384;
    unsigned char* gs = p.ws + WS_H + H_GS + (size_t)item0 * 8192;
    const float* ggc = (const float*)(p.ws + WS_GGC) + (size_t)item0 * 64;
    const float* stp = (const float*)((uintptr_t)p.state_f + (uintptr_t)dir * ((uintptr_t)p.state_b - (uintptr_t)p.state_f)) + ((size_t)(b * 2 + l) * 4 + h) * 4096;
    const int mt = (wv >> 1) & 1, nt = wv & 1, e = nt * 32 + l31;
    f32x16 Sreg = zero16();
    __syncthreads();
    if (wv < 4) {
#pragma unroll
        for (int r = 0; r < 16; ++r) Sreg[r] = stp[(mt * 32 + (r & 3) + 8 * (r >> 2) + 4 * hh) * 64 + e];
#pragma unroll
        for (int rg = 0; rg < 4; ++rg) { const int d0 = mt * 32 + 8 * rg + 4 * hh; const uint2 v = make_uint2(pk2(Sreg[rg * 4], Sreg[rg * 4 + 1]), pk2(Sreg[rg * 4 + 2], Sreg[rg * 4 + 3]));
            *(uint2*)((bf16*)(smem + GS_ST) + swz(e, d0)) = v; *(uint2*)((bf16*)gs + swz(e, d0)) = v; }
    }
    typedef unsigned u32x4 __attribute__((ext_vector_type(4)));
    u32x4 rM = *(const u32x4*)(gmb + tid * 16);
    unsigned rB[8], rBn[8];
    float gl = __expf(ggc[63]), gln = 0.f;
#pragma unroll
    for (int q = 0; q < 8; ++q) { rB[q] = 0u; rBn[q] = 0u; }
    if (wv < 4) {
#pragma unroll
        for (int q = 0; q < 8; ++q) rB[q] = ((const unsigned*)(gmb + 8192))[(wv * 8 + q) * 64 + lane];
    }
#pragma unroll 1
    for (int n = 0; n < 64; ++n) {
        const int kb = n & 1;
        *(u32x4*)(smem + GS_KDT + kb * 8192 + tid * 16) = rM;
        __syncthreads();
        if (n + 1 < 64) {
            const unsigned char* g1 = gmb + (size_t)(n + 1) * 16384;
            rM = *(const u32x4*)(g1 + tid * 16);
            gln = __expf(ggc[(n + 1) * 64 + 63]);
            if (wv < 4) {
#pragma unroll
                for (int q = 0; q < 8; ++q) rBn[q] = ((const unsigned*)(g1 + 8192))[(wv * 8 + q) * 64 + lane];
            }
        }
        if (wv < 4) {
            const bf16* Ml = (const bf16*)(smem + GS_KDT + kb * 8192);
            const bf16* STc = (const bf16*)(smem + GS_ST + kb * 8192);
            bf16* STn = (bf16*)(smem + GS_ST + (kb ^ 1) * 8192);
#pragma unroll
            for (int q = 0; q < 8; ++q) { Sreg[2 * q] = Sreg[2 * q] * gl + __uint_as_float(rB[q] << 16); Sreg[2 * q + 1] = Sreg[2 * q + 1] * gl + __uint_as_float(rB[q] & 0xffff0000u); }
            Sreg = mm_tile(Ml, mt * 32, STc, nt * 32, Sreg, lane);
            bf16* gsn = (bf16*)(gs + (size_t)(n + 1) * 8192);
#pragma unroll
            for (int rg = 0; rg < 4; ++rg) { const int d0 = mt * 32 + 8 * rg + 4 * hh; const uint2 v = make_uint2(pk2(Sreg[rg * 4], Sreg[rg * 4 + 1]), pk2(Sreg[rg * 4 + 2], Sreg[rg * 4 + 3]));
                *(uint2*)(STn + swz(e, d0)) = v; if (n + 1 < 64) *(uint2*)(gsn + swz(e, d0)) = v; }
        }
        gl = gln;
#pragma unroll
        for (int q = 0; q < 8; ++q) rB[q] = rBn[q];
    }
    __syncthreads();
}

__device__ __forceinline__ void gdn_sample_out_item(const P& p, int l, int item, unsigned char* smem_) {
    unsigned char* smem = smem_ + vzero();
    const int tid = tidx(), lane = tid & 63, wv = tid >> 6, hh = lane >> 5, l31 = lane & 31;
    const int cch = item & 63, h = (item >> 6) & 3, b = item >> 8;
    bf16* KN = (bf16*)(smem + GS_KN); bf16* QN = (bf16*)(smem + GS_QN); bf16* Wl = (bf16*)(smem + GS_W); bf16* QG = (bf16*)(smem + GS_QG);
    bf16* ST = (bf16*)(smem + GS_ST); bf16* VNT = (bf16*)(smem + GS_VNT); bf16* Al = (bf16*)(smem + GS_A);
    float* Ul = (float*)(smem + GS_U); float* gcs = (float*)(smem + GS_SM);
    const bf16* gqk = (const bf16*)(p.ws + WS_BIG + B_GQK); const bf16* guw = (const bf16*)(p.ws + WS_BIG + B_GUW); const float* ggc = (const float*)(p.ws + WS_GGC);
    const int i = tid >> 3, cc = tid & 7, off = i * 64 + ((cc ^ (i & 7)) << 3);
    f32x16 O0 = zero16(), O1 = zero16();
    __syncthreads();
#pragma unroll 1
    for (int dir = 0; dir < 2; ++dir) {
        const int n = dir ? 63 - cch : cch, cd = ((b * 4 + h) * 2 + dir) * 64 + n, pi = dir ? 63 - i : i;
        {
            const size_t tok = (size_t)b * 4096 + cch * 64 + i;
            const uint4 rq = *(const uint4*)(gqk + ((tok * 4 + h) * 2 + 0) * 64 + cc * 8), rk = *(const uint4*)(gqk + ((tok * 4 + h) * 2 + 1) * 64 + cc * 8);
            const bf16* uw = guw + (size_t)cd * 8192;
            const uint4 ru = *(const uint4*)(uw + pi * 64 + cc * 8), rw = *(const uint4*)(uw + 4096 + pi * 64 + cc * 8);
            const float gci = ggc[(size_t)cd * 64 + pi];
            const uint4 rs = *(const uint4*)(p.ws + WS_H + H_GS + (size_t)cd * 8192 + tid * 16);
            const float qd = __expf(gci);
            *(uint4*)(QN + off) = rq; *(uint4*)(KN + off) = rk; *(uint4*)(Wl + off) = rw; *(uint4*)((unsigned char*)ST + tid * 16) = rs;
            const unsigned qa[4] = {rq.x, rq.y, rq.z, rq.w}, ua[4] = {ru.x, ru.y, ru.z, ru.w};
            unsigned qo[4];
#pragma unroll
            for (int t = 0; t < 4; ++t) qo[t] = pk2(bf2f((bf16)(qa[t] & 0xffff)) * qd, bf2f((bf16)(qa[t] >> 16)) * qd);
            *(uint4*)(QG + off) = make_uint4(qo[0], qo[1], qo[2], qo[3]);
            *(float4*)(Ul + i * 64 + cc * 8) = make_float4(bf2f((bf16)(ua[0] & 0xffff)), bf2f((bf16)(ua[0] >> 16)), bf2f((bf16)(ua[1] & 0xffff)), bf2f((bf16)(ua[1] >> 16)));
            *(float4*)(Ul + i * 64 + cc * 8 + 4) = make_float4(bf2f((bf16)(ua[2] & 0xffff)), bf2f((bf16)(ua[2] >> 16)), bf2f((bf16)(ua[3] & 0xffff)), bf2f((bf16)(ua[3] >> 16)));
            if (cc == 0) gcs[i] = gci;
        }
        __syncthreads();
        if (wv < 4) {
            const int mt = wv >> 1, nt = wv & 1, e = nt * 32 + l31;
            const f32x16 acc = mm_tile(Wl, mt * 32, ST, nt * 32, zero16(), lane);
#pragma unroll
            for (int rg = 0; rg < 4; ++rg) {
                const int i0 = mt * 32 + 8 * rg + 4 * hh;
                const float v0 = Ul[(i0) * 64 + e] - acc[rg * 4], v1 = Ul[(i0 + 1) * 64 + e] - acc[rg * 4 + 1], v2 = Ul[(i0 + 2) * 64 + e] - acc[rg * 4 + 2], v3 = Ul[(i0 + 3) * 64 + e] - acc[rg * 4 + 3];
                *(uint2*)(VNT + swz(e, i0)) = make_uint2(pk2(v0, v1), pk2(v2, v3));
            }
        } else if (wv < 6) {
            const int mt = wv - 4;
            O0 = mm_tile(QG, mt * 32, ST, 0, O0, lane);
            O1 = mm_tile(QG, mt * 32, ST, 32, O1, lane);
        } else {
            const int mt = wv - 6;
#pragma unroll
            for (int nt = 0; nt < 2; ++nt) {
                f32x16 acc = zero16();
                if (dir ? (nt >= mt) : (nt <= mt)) acc = mm_tile(QN, mt * 32, KN, nt * 32, acc, lane);
                const int j = nt * 32 + l31; const float gj = gcs[j];
#pragma unroll
                for (int r = 0; r < 16; ++r) {
                    const int ii = mt * 32 + (r & 3) + 8 * (r >> 2) + 4 * hh;
                    const bool keep = dir ? (j >= ii) : (j <= ii);
                    Al[swz(ii, j)] = f2bf(keep ? acc[r] * __expf(gcs[ii] - gj) : 0.f);
                }
            }
        }
        __syncthreads();
        if (wv >= 4 && wv < 6) {
            const int mt = wv - 4;
            O0 = mm_tile(Al, mt * 32, VNT, 0, O0, lane);
            O1 = mm_tile(Al, mt * 32, VNT, 32, O1, lane);
        }
    }
    if (wv >= 4 && wv < 6) {
        const int mt = wv - 4;
        bf16* br = (bf16*)(p.ws + WS_BR);
        const bf16* proj = (const bf16*)(p.ws + WS_BIG + B_PROJ);
#pragma unroll
        for (int r = 0; r < 16; ++r) {
            const int ii = mt * 32 + (r & 3) + 8 * (r >> 2) + 4 * hh;
            const size_t row = (size_t)NPROMPT + (size_t)b * 4096 + cch * 64 + ii;
            float ss = O0[r] * O0[r] + O1[r] * O1[r];
            ss += __shfl_xor(ss, 1); ss += __shfl_xor(ss, 2); ss += __shfl_xor(ss, 4); ss += __shfl_xor(ss, 8); ss += __shfl_xor(ss, 16);
            const float rinv = rsqrtf(ss * (1.f / 64.f) + EPS);
            const bf16* zp = proj + row * PLD + C_DZ + h * 64 + l31;
            bf16* b0 = br + row * 1024 + 768 + h * 64 + l31;
            b0[0] = f2bf(O0[r] * rinv * p.d_g_norm[l * 64 + l31] * siluf_(bf2f(zp[0])));
            b0[32] = f2bf(O1[r] * rinv * p.d_g_norm[l * 64 + 32 + l31] * siluf_(bf2f(zp[32])));
        }
    }
}

template <int DQK>
__device__ __forceinline__ void attn_mfma_item(const AttnJob& j, int blk, unsigned char* smem_) {
    unsigned char* smem = smem_ + vzero();
    const int tid = tidx(), lane = tid & 63, wv = tid >> 6, grp = wv >> 2, wq = wv & 3, l31 = lane & 31, hh = lane >> 5, gt = tid & 255;
    constexpr int KLD = DQK + 8, NKC = DQK / 8, NKK = DQK / 16;
    constexpr int KBYTES = 64 * KLD * 2, VBYTES = 64 * 68 * 2, BUFB = KBYTES + VBYTES;
    constexpr int NKI = NKC * 64 / 256;
    const int nqb = j.T / 128;
    const int b = blk / (4 * nqb), h = (blk / nqb) % 4, q0 = (blk % nqb) * 128;
    const int kh = h / j.kvgroup;
    int kbeg = 0, kend = j.T;
    if (j.window) { kbeg = q0 - 128 < 0 ? 0 : q0 - 128; kend = q0 + 256 > j.T ? j.T : q0 + 256; }
    const int n1 = (kend - kbeg) >> 6, n2 = j.nk2 >> 6, nt = n1 + n2, nt0 = (nt + 1) >> 1;
    const int tbeg = grp ? nt0 : 0, tcnt = grp ? nt - nt0 : nt0;
    const int tq = q0 + wq * 32 + l31;
    const float sc2 = j.scale * 1.4426950408889634f;
    const bf16* k1p = j.k1 + (size_t)b * j.T * j.ldk1 + kh * j.kstride; const bf16* v1p = j.v1 + (size_t)b * j.T * j.ldv1 + kh * j.vstride;
    const bf16* k2p = j.k2 + (size_t)b * j.nk2 * j.ldk2 + kh * j.kstride; const bf16* v2p = j.v2 + (size_t)b * j.nk2 * j.ldv2 + kh * j.vstride;
    typedef unsigned u32x4 __attribute__((ext_vector_type(4)));
    u32x4 kr0, kr1, kr2, vr0, vr1;
    kr2 = (u32x4){0u, 0u, 0u, 0u};
#define ATT_LOAD(t_) { const int t__ = (t_); const bool s1__ = t__ < n1; const int ks__ = s1__ ? kbeg + t__ * 64 : (t__ - n1) * 64; \
        const bf16* kp__ = s1__ ? k1p : k2p; const bf16* vp__ = s1__ ? v1p : v2p; const int ldk__ = s1__ ? j.ldk1 : j.ldk2, ldv__ = s1__ ? j.ldv1 : j.ldv2; \
        { const int c_ = gt; kr0 = *(const u32x4*)(kp__ + (size_t)(ks__ + c_ / NKC) * ldk__ + (c_ % NKC) * 8); } \
        { const int c_ = gt + 256; kr1 = *(const u32x4*)(kp__ + (size_t)(ks__ + c_ / NKC) * ldk__ + (c_ % NKC) * 8); } \
        if (NKI > 2) { const int c_ = gt + 512; kr2 = *(const u32x4*)(kp__ + (size_t)(ks__ + c_ / NKC) * ldk__ + (c_ % NKC) * 8); } \
        { const int c_ = gt; vr0 = *(const u32x4*)(vp__ + (size_t)(ks__ + (c_ >> 3)) * ldv__ + (c_ & 7) * 8); } \
        { const int c_ = gt + 256; vr1 = *(const u32x4*)(vp__ + (size_t)(ks__ + (c_ >> 3)) * ldv__ + (c_ & 7) * 8); } }
#define ATT_VSCAT(vr_, c_) { const int key_ = (c_) >> 3, e0_ = ((c_) & 7) * 8; \
        VT[(e0_ + 0) * 68 + key_] = (bf16)(vr_[0] & 0xffff); VT[(e0_ + 1) * 68 + key_] = (bf16)(vr_[0] >> 16); VT[(e0_ + 2) * 68 + key_] = (bf16)(vr_[1] & 0xffff); VT[(e0_ + 3) * 68 + key_] = (bf16)(vr_[1] >> 16); \
        VT[(e0_ + 4) * 68 + key_] = (bf16)(vr_[2] & 0xffff); VT[(e0_ + 5) * 68 + key_] = (bf16)(vr_[2] >> 16); VT[(e0_ + 6) * 68 + key_] = (bf16)(vr_[3] & 0xffff); VT[(e0_ + 7) * 68 + key_] = (bf16)(vr_[3] >> 16); }
#define ATT_STORE(buf_) { bf16* Kl = (bf16*)(smem + ((buf_) * 2 + grp) * BUFB); bf16* VT = (bf16*)(smem + ((buf_) * 2 + grp) * BUFB + KBYTES); \
        { const int c_ = gt; *(u32x4*)(Kl + (c_ / NKC) * KLD + (c_ % NKC) * 8) = kr0; } \
        { const int c_ = gt + 256; *(u32x4*)(Kl + (c_ / NKC) * KLD + (c_ % NKC) * 8) = kr1; } \
        if (NKI > 2) { const int c_ = gt + 512; *(u32x4*)(Kl + (c_ / NKC) * KLD + (c_ % NKC) * 8) = kr2; } \
        ATT_VSCAT(vr0, gt) ATT_VSCAT(vr1, gt + 256) }
    bf16x8 qf[NKK];
    int qset = -1;
    f32x16 o0 = zero16(), o1 = zero16();
    float m = -1e30f, lsum = 0.f;
    __syncthreads();
    if (tcnt > 0) { ATT_LOAD(tbeg) ATT_STORE(0) }
    __syncthreads();
#pragma unroll 1
    for (int s = 0; s < nt0; ++s) {
        const bool has = s < tcnt, hasn = s + 1 < tcnt;
        if (hasn) ATT_LOAD(tbeg + s + 1)
        if (has) {
            const int t = tbeg + s; const bool s1 = t < n1; const int ks = s1 ? kbeg + t * 64 : (t - n1) * 64;
            const int set = s1 ? 0 : 1;
            if (set != qset) {
                qset = set;
                const bf16* qp = (set == 0 ? j.q1 + ((size_t)b * j.T + tq) * j.ldq1 : j.q2 + ((size_t)b * j.T + tq) * j.ldq2) + h * DQK;
#pragma unroll
                for (int kk = 0; kk < NKK; ++kk) qf[kk] = *(const bf16x8*)(qp + kk * 16 + hh * 8);
            }
            const bf16* Kl = (const bf16*)(smem + ((s & 1) * 2 + grp) * BUFB); const bf16* VT = (const bf16*)(smem + ((s & 1) * 2 + grp) * BUFB + KBYTES);
            f32x16 s0 = zero16(), s1v = zero16();
#pragma unroll
            for (int kk = 0; kk < NKK; ++kk) {
                const bf16x8 a0 = *(const bf16x8*)(Kl + l31 * KLD + kk * 16 + hh * 8);
                const bf16x8 a1 = *(const bf16x8*)(Kl + (32 + l31) * KLD + kk * 16 + hh * 8);
                s0 = __builtin_amdgcn_mfma_f32_32x32x16_bf16(a0, qf[kk], s0, 0, 0, 0);
                s1v = __builtin_amdgcn_mfma_f32_32x32x16_bf16(a1, qf[kk], s1v, 0, 0, 0);
            }
            const bool win = s1 && j.window;
            float mx = -INFINITY;
#pragma unroll
            for (int r = 0; r < 16; ++r) {
                float a = s0[r] * sc2, c = s1v[r] * sc2;
                if (win) { const int d0 = tq - (ks + (r & 3) + 8 * (r >> 2) + 4 * hh); if (d0 > 128 || d0 < -128) a = -INFINITY; const int d1 = d0 - 32; if (d1 > 128 || d1 < -128) c = -INFINITY; }
                s0[r] = a; s1v[r] = c; mx = fmaxf(mx, fmaxf(a, c));
            }
            mx = fmaxf(mx, __shfl_xor(mx, 32));
            const float mnew = fmaxf(m, mx), alpha = __builtin_amdgcn_exp2f(m - mnew);
            m = mnew;
            float ps = 0.f;
#pragma unroll
            for (int r = 0; r < 16; ++r) { s0[r] = __builtin_amdgcn_exp2f(s0[r] - mnew); s1v[r] = __builtin_amdgcn_exp2f(s1v[r] - mnew); ps += s0[r] + s1v[r]; }
            lsum = lsum * alpha + ps;
#pragma unroll
            for (int r = 0; r < 16; ++r) { o0[r] *= alpha; o1[r] *= alpha; }
#pragma unroll
            for (int k4 = 0; k4 < 4; ++k4) {
                const int sp = (k4 & 1) * 8;
                unsigned pw[4];
#pragma unroll
                for (int q2 = 0; q2 < 4; ++q2) pw[q2] = (k4 < 2) ? pk2(s0[sp + 2 * q2], s0[sp + 2 * q2 + 1]) : pk2(s1v[sp + 2 * q2], s1v[sp + 2 * q2 + 1]);
                const u32x4 pwv = {pw[0], pw[1], pw[2], pw[3]};
                const bf16x8 pf = __builtin_bit_cast(bf16x8, pwv);
                {
                    const uint2 x0 = *(const uint2*)(VT + l31 * 68 + 16 * k4 + 4 * hh), x1 = *(const uint2*)(VT + l31 * 68 + 16 * k4 + 8 + 4 * hh);
                    const u32x4 av = {x0.x, x0.y, x1.x, x1.y};
                    o0 = __builtin_amdgcn_mfma_f32_32x32x16_bf16(__builtin_bit_cast(bf16x8, av), pf, o0, 0, 0, 0);
                }
                {
                    const uint2 x0 = *(const uint2*)(VT + (32 + l31) * 68 + 16 * k4 + 4 * hh), x1 = *(const uint2*)(VT + (32 + l31) * 68 + 16 * k4 + 8 + 4 * hh);
                    const u32x4 av = {x0.x, x0.y, x1.x, x1.y};
                    o1 = __builtin_amdgcn_mfma_f32_32x32x16_bf16(__builtin_bit_cast(bf16x8, av), pf, o1, 0, 0, 0);
                }
            }
        }
        if (hasn) ATT_STORE((s + 1) & 1)
        __syncthreads();
    }
#undef ATT_LOAD
#undef ATT_VSCAT
#undef ATT_STORE
    lsum += __shfl_xor(lsum, 32);
    float* CO = (float*)smem;
    if (grp == 1) {
#pragma unroll
        for (int r = 0; r < 16; ++r) { CO[((wq * 34 + r) * 64 + lane)] = o0[r]; CO[((wq * 34 + 16 + r) * 64 + lane)] = o1[r]; }
        CO[((wq * 34 + 32) * 64 + lane)] = m; CO[((wq * 34 + 33) * 64 + lane)] = lsum;
    }
    __syncthreads();
    if (grp == 0) {
        const float m1 = CO[((wq * 34 + 32) * 64 + lane)], l1 = CO[((wq * 34 + 33) * 64 + lane)];
        float mf = fmaxf(m, m1);
        float sk2 = 0.f;
        if (j.sink) { sk2 = j.sink[h] * 1.4426950408889634f; mf = fmaxf(mf, sk2); }
        const float a0 = __builtin_amdgcn_exp2f(m - mf), a1 = __builtin_amdgcn_exp2f(m1 - mf);
        float lt = lsum * a0 + l1 * a1;
        if (j.sink) lt += __builtin_amdgcn_exp2f(sk2 - mf);
        const float inv = 1.f / lt;
        bf16* op = j.out + ((size_t)b * j.T + tq) * 1024 + j.outcol + h * 64;
#pragma unroll
        for (int rg = 0; rg < 4; ++rg) {
            float v[8];
#pragma unroll
            for (int k = 0; k < 4; ++k) {
                v[k] = (o0[rg * 4 + k] * a0 + CO[((wq * 34 + rg * 4 + k) * 64 + lane)] * a1) * inv;
                v[4 + k] = (o1[rg * 4 + k] * a0 + CO[((wq * 34 + 16 + rg * 4 + k) * 64 + lane)] * a1) * inv;
            }
            *(uint2*)(op + 8 * rg + 4 * hh) = make_uint2(pk2(v[0], v[1]), pk2(v[2], v[3]));
            *(uint2*)(op + 32 + 8 * rg + 4 * hh) = make_uint2(pk2(v[4], v[5]), pk2(v[6], v[7]));
        }
    }
}

#define XB_TMO      128
#define XB_XCNT(j)  (256  + 64 * (j))
#define XB_XSUB(j)  (1280 + 64 * (j))
#define XB_XGEN(j)  (2304 + 64 * (j))
#define XB_TOP      3328
#define XB_TOPGEN   3392
#define XCD_BAR_WORDS 3456
#define XB_SPIN_CAP (1u << 18)
#define LAS __attribute__((address_space(3)))

__device__ __forceinline__ unsigned xb_ld(unsigned* p)              { return __hip_atomic_load(p, __ATOMIC_RELAXED, __HIP_MEMORY_SCOPE_AGENT); }
__device__ __forceinline__ unsigned xb_add(unsigned* p, unsigned v) { return __hip_atomic_fetch_add(p, v, __ATOMIC_RELAXED, __HIP_MEMORY_SCOPE_AGENT); }
__device__ __forceinline__ unsigned xb_xcc_id() { return (unsigned)__builtin_amdgcn_s_getreg((3 << 11) | 20) & 0xFu; }
#define XB_SPIN(cond, bar) do { unsigned _sp = 0; while (cond) { __builtin_amdgcn_s_sleep(1); \
    if ((++_sp & 255u) == 0u) { if (xb_ld(&(bar)[XB_TMO])) break; if (_sp > XB_SPIN_CAP) { atomicAdd(&(bar)[XB_TMO], 1u); break; } } } } while (0)

struct XcdBarrier {
    unsigned* bar; unsigned x;
    volatile LAS unsigned* st;
};

__device__ __forceinline__ XcdBarrier xcd_barrier_post(unsigned* bar, volatile LAS unsigned* st) {
    XcdBarrier b; b.bar = bar; b.x = xb_xcc_id(); b.st = st;
    if (threadIdx.x == 0) (void)xb_add(&bar[XB_XCNT(b.x)], 1u);
    return b;
}
__device__ __forceinline__ void xcd_barrier_complete(unsigned* bar, unsigned x, unsigned& nloc, unsigned& nx) {
    const unsigned G = gridDim.x * gridDim.y * gridDim.z;
    unsigned sum, cnt, mine, sp = 0u;
    for (;;) {
        sum = 0u; cnt = 0u; mine = 0u;
#pragma unroll
        for (unsigned j = 0; j < 16; ++j) { const unsigned c = xb_ld(&bar[XB_XCNT(j)]); sum += c; cnt += (c > 0u) ? 1u : 0u; mine = (j == x) ? c : mine; }
        if (sum == G) break;
        __builtin_amdgcn_s_sleep(1);
        if ((++sp & 255u) == 0u) { if (xb_ld(&bar[XB_TMO])) break; if (sp > XB_SPIN_CAP) { atomicAdd(&bar[XB_TMO], 1u); break; } }
    }
    nloc = mine > 0u ? mine : 1u; nx = cnt > 0u ? cnt : 1u;
}

__device__ __forceinline__ void xcd_barrier(const XcdBarrier& b) {
    asm volatile("s_waitcnt vmcnt(0)" ::: "memory");
    __syncthreads();
    if (threadIdx.x == 0) {
        unsigned* bar = b.bar;
        __builtin_amdgcn_s_waitcnt(0);
        unsigned nloc = b.st[0], nx = b.st[1];
        if (nloc == 0u) { xcd_barrier_complete(bar, b.x, nloc, nx); b.st[0] = nloc; b.st[1] = nx; }
        const unsigned old = xb_add(&bar[XB_XSUB(b.x)], 1u);
        const unsigned gen = old / nloc;
        if (old + 1u == (gen + 1u) * nloc) {
            __builtin_amdgcn_fence(__ATOMIC_RELEASE, "agent");
            asm volatile("s_waitcnt vmcnt(0)" ::: "memory");
            const unsigned og = xb_add(&bar[XB_TOP], 1u);
            const unsigned tg = og / nx;
            if (og + 1u == (tg + 1u) * nx) xb_add(&bar[XB_TOPGEN], 1u);
            else XB_SPIN(xb_ld(&bar[XB_TOPGEN]) == tg, bar);
            __builtin_amdgcn_fence(__ATOMIC_ACQUIRE, "agent");
            xb_add(&bar[XB_XGEN(b.x)], 1u);
            asm volatile("s_waitcnt vmcnt(0)" ::: "memory");
        } else {
            XB_SPIN(xb_ld(&bar[XB_XGEN(b.x)]) == gen, bar);
            __builtin_amdgcn_fence(__ATOMIC_ACQUIRE, "agent");
            asm volatile("s_waitcnt vmcnt(0)" ::: "memory");
        }
    }
    __syncthreads();
}


struct KArgs { P p; TJobs J[2]; };

__device__ __forceinline__ AttnJob make_job(const P& p, int l, int variant) {
    unsigned char* ws = p.ws; unsigned char* big = ws + WS_BIG;
    bf16* proj = (bf16*)(big + B_PROJ); bf16* BRb = (bf16*)(ws + WS_BR);
    const float bscale = 0.10206207261596575f;
    AttnJob j{};
    if (variant == 0) {
        j.q1 = proj + C_AQ; j.ldq1 = PLD; j.k1 = proj + C_AK; j.ldk1 = PLD; j.v1 = proj + C_AV; j.ldv1 = PLD; j.kstride = 64; j.vstride = 64; j.kvgroup = 2;
        j.nbatch = 32; j.T = 256; j.nk2 = 0; j.window = 0; j.sink = p.a_sink + l * 4; j.scale = 0.125f; j.out = BRb; j.outcol = 0;
    } else if (variant == 1) {
        j.q1 = (bf16*)(big + B_QA1S); j.ldq1 = 256; j.q2 = proj + (size_t)NPROMPT * PLD + C_AQ; j.ldq2 = PLD;
        j.k1 = (bf16*)(big + B_KA1S); j.ldk1 = 128; j.v1 = proj + (size_t)NPROMPT * PLD + C_AV; j.ldv1 = PLD;
        j.k2 = (bf16*)(ws + WS_KAC); j.ldk2 = 128; j.v2 = (bf16*)(ws + WS_VAC); j.ldv2 = 128; j.kstride = 64; j.vstride = 64; j.kvgroup = 2;
        j.nbatch = 2; j.T = 4096; j.nk2 = 256; j.window = 1; j.sink = p.a_sink + l * 4; j.scale = 0.125f; j.out = BRb + (size_t)NPROMPT * 1024; j.outcol = 0;
    } else if (variant == 2) {
        j.q1 = (bf16*)(big + B_QB); j.ldq1 = 384; j.k1 = (bf16*)(big + B_KB); j.ldk1 = 384; j.v1 = (bf16*)(big + B_KV) + 64; j.ldv1 = 512; j.kstride = 96; j.vstride = 128; j.kvgroup = 1;
        j.nbatch = 32; j.T = 256; j.nk2 = 0; j.window = 0; j.sink = nullptr; j.scale = bscale; j.out = BRb; j.outcol = 256;
    } else {
        j.q1 = (bf16*)(big + B_CQ); j.ldq1 = 384; j.q2 = (bf16*)(big + B_QB) + (size_t)NPROMPT * 384; j.ldq2 = 384;
        j.k1 = (bf16*)(big + B_KB) + (size_t)NPROMPT * 384; j.ldk1 = 384; j.v1 = (bf16*)(big + B_KV) + (size_t)NPROMPT * 512 + 64; j.ldv1 = 512;
        j.k2 = (bf16*)(big + B_KB) + (size_t)NTOK * 384; j.ldk2 = 384; j.v2 = (bf16*)(big + B_KV) + (size_t)NTOK * 512 + 64; j.ldv2 = 512; j.kstride = 96; j.vstride = 128; j.kvgroup = 1;
        j.nbatch = 2; j.T = 4096; j.nk2 = 256; j.window = 0; j.sink = nullptr; j.scale = bscale; j.out = BRb + (size_t)NPROMPT * 1024; j.outcol = 256;
    }
    return j;
}

#define LDSP(smem) ((PG8_LAS unsigned char*)(smem))
__device__ __forceinline__ void ph_gemm_proj(const P& p, unsigned char* smem) {
    pg8::Gemm g{(bf16*)(p.ws + WS_H), (bf16*)(p.ws + WS_W + W_A), NTOK, 2304, 1024, 1024, 1024}; pg8::StaticOrder S; S.init(NTOK, 2304, gridDim.x, blockIdx.x);
    pg8::EpiStoreBf16 E{(bf16*)(p.ws + WS_BIG + B_PROJ), PLD, PLD};
    pg8::gemm_phase<pg8::EpiStoreBf16, pg8::StaticOrder, true, true>(LDSP(smem), g, S, E);
}
__device__ __forceinline__ void ph_gemm_mla(const P& p, unsigned char* smem) {
    unsigned char* big = p.ws + WS_BIG;
    { GemmArgs g{(bf16*)(big + B_CQ), (bf16*)(p.ws + WS_W + W_UQ), 192, 192, NTOK, 384, 192, 0}; EpiStore e{(bf16*)(big + B_QB), 384, 384}; gemm_tiles(g, e, smem); }
    { GemmArgs g{(bf16*)(big + B_CKV), (bf16*)(p.ws + WS_W + W_UKV), 128, 128, NKVROWS, 512, 128, 0}; EpiStore e{(bf16*)(big + B_KV), 512, 512}; gemm_tiles(g, e, smem); }
}
__device__ __forceinline__ void ph_gemm_br(const P& p, int l, unsigned char* smem) {
    ph_prenorm(p, l);
    bf16* BRb = (bf16*)(p.ws + WS_BR); bf16* brb = (bf16*)(p.ws + WS_BIG + B_BRB);
#pragma unroll 1
    for (int m = 0; m < 4; ++m) {
        pg8::Gemm g{BRb + m * 256, (bf16*)(p.ws + WS_W + W_BR) + (size_t)m * 1024 * 256, NTOK, 1024, 256, 1024, 256}; pg8::StaticOrder S; S.init(NTOK, 1024, gridDim.x, blockIdx.x);
        pg8::EpiStoreBf16 E{brb + m * 1024, 4096, 1 << 30};
        pg8::gemm_phase<pg8::EpiStoreBf16, pg8::StaticOrder, true, true>(LDSP(smem), g, S, E);
    }
}
__device__ __forceinline__ void ph_gemm_gate(const P& p, unsigned char* smem) {
    pg8::Gemm g{(bf16*)(p.ws + WS_H), (bf16*)(p.ws + WS_W + W_G), NTOK, 4096, 1024, 1024, 1024}; pg8::StaticOrder S; S.init(NTOK, 4096, gridDim.x, blockIdx.x);
    pg8::EpiGateMix E{(const bf16*)(p.ws + WS_BIG + B_BRB), (bf16*)(p.ws + WS_BR)};
    pg8::gemm_phase<pg8::EpiGateMix, pg8::StaticOrder, true, true>(LDSP(smem), g, S, E);
}
__device__ __forceinline__ void ph_gemm_wo(const P& p, unsigned char* smem) {
    pg8::Gemm g{(bf16*)(p.ws + WS_BR), (bf16*)(p.ws + WS_W + W_O), NTOK, 1024, 1024, 1024, 1024}; pg8::StaticOrder S; S.init(NTOK, 1024, gridDim.x, blockIdx.x);
    pg8::EpiStoreBf16 E{(bf16*)(p.ws + WS_H), 1024, 1024};
    pg8::gemm_phase<pg8::EpiStoreBf16, pg8::StaticOrder, true, true>(LDSP(smem), g, S, E);
}
__device__ __forceinline__ void ph_gemm_up(const P& p, unsigned char* smem) {
    pg8::Gemm g{(bf16*)(p.ws + WS_H), (bf16*)(p.ws + WS_W + W_UP), NTOK, 5632, 1024, 1024, 1024}; pg8::StaticOrder S; S.init(NTOK, 5632, gridDim.x, blockIdx.x);
    pg8::EpiSwiglu E{(bf16*)(p.ws + WS_BIG + B_HID), DFF};
    pg8::gemm_phase<pg8::EpiSwiglu, pg8::StaticOrder, true, true>(LDSP(smem), g, S, E);
}
__device__ __forceinline__ void ph_gemm_down(const P& p, unsigned char* smem) {
    pg8::Gemm g{(bf16*)(p.ws + WS_BIG + B_HID), (bf16*)(p.ws + WS_W + W_DN), NTOK, 1024, DFF, DFF, DFF}; pg8::StaticOrder S; S.init(NTOK, 1024, gridDim.x, blockIdx.x);
    pg8::EpiStoreBf16 E{(bf16*)(p.ws + WS_BR), 1024, 1024};
    pg8::gemm_phase<pg8::EpiStoreBf16, pg8::StaticOrder, true, true>(LDSP(smem), g, S, E);
}
__device__ __forceinline__ void attn_dispatch(const P& p, int l, int variant, int blk, unsigned char* smem) {
    if (variant == 0) { const AttnJob j = make_job(p, l, 0); attn_mfma_item<64>(j, blk, smem); }
    else if (variant == 1) { const AttnJob j = make_job(p, l, 1); attn_mfma_item<64>(j, blk, smem); }
    else if (variant == 2) { const AttnJob j = make_job(p, l, 2); attn_mfma_item<96>(j, blk, smem); }
    else { const AttnJob j = make_job(p, l, 3); attn_mfma_item<96>(j, blk, smem); }
}
#ifndef REPEAT_MASK
#define REPEAT_MASK 0
#endif
#define NREP(bit) (1 + ((REPEAT_MASK >> (bit)) & 1))
__device__ __forceinline__ void ph_mixers1(const P& p, int l, unsigned char* smem) {
#pragma unroll 1
    for (int rep = 0; rep < NREP(16); ++rep)
        for (int item = blockIdx.x; item < 1024; item += gridDim.x) gdn_sample_prep_item(p, l, item, smem);
#pragma unroll 1
    for (int rep = 0; rep < NREP(17); ++rep)
        for (int item = blockIdx.x; item < 768; item += gridDim.x) { const int vi = item >> 8; attn_dispatch(p, l, vi == 0 ? 1 : vi == 1 ? 2 : 0, item & 255, smem); }
    __syncthreads();
#pragma unroll 1
    for (int rep = 0; rep < NREP(18); ++rep) ph_pool(p, l, smem);
}
__device__ __forceinline__ void ph_mixers3(const P& p, int l, unsigned char* smem) {
    for (int item = blockIdx.x; item < 512; item += gridDim.x) gdn_sample_out_item(p, l, item, smem);
    const int tid = tidx(), lane = tid & 63;
    bf16* br = (bf16*)(p.ws + WS_BR);
    const bf16* gob = (const bf16*)(p.ws + WS_BIG + B_GOB);
    const bf16* proj = (const bf16*)(p.ws + WS_BIG + B_PROJ);
    for (int it = blockIdx.x * NWV + (tid >> 6); it < NPROMPT * 4; it += gridDim.x * NWV) {
        const size_t row = it >> 2; const int h = it & 3;
        bf16* b0 = br + row * 1024 + 768 + h * 64 + lane;
        const float a = bf2f(*b0) + bf2f(gob[row * 256 + h * 64 + lane]);
        const float ss = wave_sum(a * a);
        const float rinv = rsqrtf(ss * (1.f / 64.f) + EPS);
        const float z = bf2f(proj[row * PLD + C_DZ + h * 64 + lane]);
        *b0 = f2bf(a * rinv * p.d_g_norm[l * 64 + lane] * siluf_(z));
    }
}
__device__ __forceinline__ void ph_mixers2(const P& p, int l, unsigned char* smem) {
    const int nb = gridDim.x, bid = blockIdx.x;
    if (bid < 16) {
#pragma unroll 1
        for (int rep = 0; rep < NREP(19); ++rep) gdn_sample_chain(p, l, bid, smem);
    }
#pragma unroll 1
    for (int rep = 0; rep < NREP(20); ++rep)
    for (int item = bid; item < 512; item += nb) {
        if (item < 256) gdn_prompt_item(p, l, item, smem);
        else attn_dispatch(p, l, 3, item - 256, smem);
    }
}

#define GSYNC() do { XcdBarrier xb_; xb_.bar = (unsigned*)(fence_P().ws + WS_BAR); xb_.x = xb_xcc_id(); xb_.st = (volatile LAS unsigned*)(smem + LDS_BYTES - 16); xcd_barrier(xb_); } while (0)
#define PH(id, call) do { int nrep_ = 1 + ((REPEAT_MASK >> (id)) & 1); if (REPEAT_MASK) asm volatile("" : "+s"(nrep_)); _Pragma("unroll 1") for (int rep_ = 0; rep_ < nrep_; ++rep_) { if (rep_) GSYNC(); const P p = fence_P(); call; } } while (0)
__global__ void __launch_bounds__(NT) mega(KArgs a) {
    extern __shared__ __attribute__((aligned(16))) unsigned char smem[];
    cg::grid_group grid = cg::this_grid();
    volatile LAS unsigned* xst = (volatile LAS unsigned*)(smem + LDS_BYTES - 16);
    if (threadIdx.x == 0) { xst[0] = 0u; xst[1] = 0u; }
    __syncthreads();
    (void)xcd_barrier_post((unsigned*)(a.p.ws + WS_BAR), xst);
    { const P p = fence_P(); ph_mod(p, smem); }
    __syncthreads();
    ph_convert(a.J[0], smem);
    grid.sync();
    PH(1, ph_prenorm(p, 0));
    GSYNC();
#pragma unroll 1
    for (int l = 0; l < 2; ++l) {
        PH(2, ph_gemm_proj(p, smem));
        GSYNC();
        PH(3, ph_postproj(p, l));
        GSYNC();
        PH(4, ph_gemm_mla(p, smem));
        GSYNC();
        PH(5, ph_prep2(p, l));
        GSYNC();
        PH(6, ph_mixers1(p, l, smem));
        GSYNC();
        PH(7, ph_mixers2(p, l, smem));
        GSYNC();
        PH(8, ph_mixers3(p, l, smem));
        GSYNC();
        PH(9, ph_gemm_br(p, l, smem));
        GSYNC();
        PH(10, ph_gemm_gate(p, smem));
        GSYNC();
        PH(11, ph_gemm_wo(p, smem));
        GSYNC();
        { const P p = fence_P(); ph_post(p, l, 1); }
        GSYNC();
        PH(13, ph_gemm_up(p, smem));
        GSYNC();
        PH(14, ph_gemm_down(p, smem));
        GSYNC();
        { const P p = fence_P(); ph_post(p, l, 2); }
        if (l == 0) { __syncthreads(); ph_convert(a.J[1], smem); GSYNC(); }
    }
}

static void add_job(TJobs& J, const float* src, bf16* dst, int ldw, int K, int Ndst, int ldo, int mode, int arg, int nvalid) {
    TJob& j = J.j[J.n]; j.src = src; j.dst = dst; j.ldw = ldw; j.K = K; j.Ndst = Ndst; j.ldo = ldo; j.mode = mode; j.arg = arg; j.nvalid = nvalid; j.tile0 = J.total;
    J.total += (Ndst / 64) * (K / 64); J.n++;
}

extern "C" void kernel_launch(void* const* d_in, const int* in_sizes, int n_in, void* d_out, int out_size, void* d_ws, size_t ws_size, hipStream_t stream) {
    if (n_in != 32 || ws_size < WS_NEED) { fprintf(stderr, "kernel_launch: unexpected n_in %d or ws_size %zu (need %zu)\n", n_in, ws_size, (size_t)WS_NEED); return; }
    static int grid = 0;
    if (grid == 0) {
        int dev = 0, cus = 0, per_cu = 0;
        (void)hipGetDevice(&dev);
        (void)hipDeviceGetAttribute(&cus, hipDeviceAttributeMultiprocessorCount, dev);
        (void)hipFuncSetAttribute((const void*)mega, hipFuncAttributeMaxDynamicSharedMemorySize, LDS_BYTES);
        (void)hipOccupancyMaxActiveBlocksPerMultiprocessor(&per_cu, (const void*)mega, NT, LDS_BYTES);
        if (per_cu < 1) { fprintf(stderr, "kernel_launch: occupancy query says %d blocks/CU\n", per_cu); per_cu = 1; }
        if (per_cu > 1) per_cu = 1;
        grid = cus * per_cu;
    }
    KArgs a{};
    const float** pf = (const float**)&a.p;
    for (int i = 0; i < 32; ++i) pf[i] = (const float*)d_in[i];
    a.p.out = (float*)d_out; a.p.ws = (unsigned char*)d_ws;
    const P& p = a.p;
    bf16* Wb = (bf16*)(a.p.ws + WS_W);
    for (int l = 0; l < 2; ++l) {
        TJobs& J = a.J[l];
        add_job(J, p.w_in + (size_t)l * 1024 * PIN, (bf16*)((char*)Wb + W_A), PIN, 1024, 2304, 1024, 0, 0, 2160);
        add_job(J, p.w_in + (size_t)l * 1024 * PIN, (bf16*)((char*)Wb + W_G), PIN, 1024, 4096, 1024, 2, C_GATE, 4096);
        for (int m = 0; m < 4; ++m) add_job(J, p.w_br + ((size_t)l * 4 + m) * 256 * 1024, (bf16*)((char*)Wb + W_BR) + (size_t)m * 1024 * 256, 1024, 256, 1024, 256, 0, 0, 1024);
        add_job(J, p.w_o + (size_t)l * 1024 * 1024, (bf16*)((char*)Wb + W_O), 1024, 1024, 1024, 1024, 0, 0, 1024);
        add_job(J, p.w_up + (size_t)l * 1024 * 5632, (bf16*)((char*)Wb + W_UP), 5632, 1024, 5632, 1024, 1, 0, 5632);
        add_job(J, p.w_down + (size_t)l * DFF * 1024, (bf16*)((char*)Wb + W_DN), 1024, DFF, 1024, DFF, 0, 0, 1024);
        add_job(J, p.b_w_uq + (size_t)l * 192 * 384, (bf16*)((char*)Wb + W_UQ), 384, 192, 384, 192, 0, 0, 384);
        add_job(J, p.b_w_ukv + (size_t)l * 128 * 512, (bf16*)((char*)Wb + W_UKV), 512, 128, 512, 128, 0, 0, 512);
    }
    (void)hipMemsetAsync((char*)d_ws + WS_BAR, 0, XCD_BAR_WORDS * 4, stream);
    void* args[] = {&a};
    hipError_t e = hipLaunchCooperativeKernel((const void*)mega, dim3(grid), dim3(NT), args, LDS_BYTES, stream);
    if (e != hipSuccess) fprintf(stderr, "cooperative launch failed: %s (grid %d)\n", hipGetErrorString(e), grid);
}
```
